# Optimizing an MI355X kernel written in HIP

```python
import math
import jax, jax.numpy as jnp
from jax import lax
import numpy as np

D_MODEL = 1024
BATCH = 2
SEQ = 8192
DEPTH = 1

D_FF = 2816
RMS_EPS = 1e-6
SUBLN_EPS = 1e-5
CONV_WIDTH = 4
DN_HEADS = 8
DN_HEAD_DIM = 64
DN_WIDTH = DN_HEADS * DN_HEAD_DIM
DN_CHUNK = 64
DIFF_HEADS = 4
DIFF_HEAD_DIM = 64
DIFF_V_DIM = 2 * DIFF_HEAD_DIM
DIFF_QK_WIDTH = DIFF_HEADS * 2 * DIFF_HEAD_DIM
DIFF_V_WIDTH = DIFF_HEADS * DIFF_V_DIM
Q_BLOCK = 128
N_BRANCHES = 2
IN_SPLIT_SIZES = (3 * DN_WIDTH, DN_WIDTH, DN_HEADS, DN_HEADS, DIFF_QK_WIDTH, DIFF_QK_WIDTH, DIFF_V_WIDTH, N_BRANCHES * D_MODEL)
W_IN_COLS = sum(IN_SPLIT_SIZES)

kernel_name = "hybrid_gdn_diffattn_macaron"


def lambda_init(layer_idx):
    return 0.8 - 0.6 * math.exp(-0.3 * layer_idx)


def rms_norm(x, g, eps=RMS_EPS):
    xf = x.astype(jnp.float32)
    y = xf * lax.rsqrt(jnp.mean(xf * xf, axis=-1, keepdims=True) + eps)
    return (y * g.astype(jnp.float32)).astype(x.dtype)


def l2_normalize(x, eps=1e-6):
    xf = x.astype(jnp.float32)
    return xf * lax.rsqrt(jnp.sum(xf * xf, axis=-1, keepdims=True) + eps)


def swiglu_ffn(x, w_gate, w_up, w_down):
    return (jax.nn.silu(x @ w_gate) * (x @ w_up)) @ w_down


def causal_depthwise_conv(x, w):
    width = w.shape[0]
    return lax.conv_general_dilated(
        x, w[:, None, :], window_strides=(1,), padding=[(width - 1, 0)],
        dimension_numbers=('NWC', 'WIO', 'NWC'), feature_group_count=x.shape[-1])


def gated_delta_rule_chunked(q, k, v, g, beta):
    B, H, T, dk = q.shape
    dv = v.shape[-1]
    C = DN_CHUNK
    N = T // C
    f32 = jnp.float32
    q = (q.astype(f32) * dk ** -0.5).reshape(B, H, N, C, dk)
    k = k.astype(f32).reshape(B, H, N, C, dk)
    v = v.astype(f32).reshape(B, H, N, C, dv)
    g = g.astype(f32).reshape(B, H, N, C)
    beta = beta.astype(f32).reshape(B, H, N, C)
    gc = jnp.cumsum(g, axis=-1)
    incl = jnp.tril(jnp.ones((C, C), dtype=bool))
    strict = jnp.tril(jnp.ones((C, C), dtype=bool), k=-1)
    rel = gc[..., :, None] - gc[..., None, :]
    decay = jnp.where(incl, jnp.exp(jnp.where(incl, rel, 0.0)), 0.0)
    kb = k * beta[..., None]
    a_strict = jnp.where(strict, jnp.einsum('bhncd,bhnsd->bhncs', kb, k) * decay, 0.0)
    eye = jnp.eye(C, dtype=f32)
    t_inv = lax.linalg.triangular_solve(eye + a_strict, jnp.broadcast_to(eye, a_strict.shape),
                                        left_side=True, lower=True, unit_diagonal=True)
    u = jnp.einsum('bhncs,bhnse->bhnce', t_inv, v * beta[..., None])
    w = jnp.einsum('bhncs,bhnsd->bhncd', t_inv, kb * jnp.exp(gc)[..., None])
    attn = jnp.einsum('bhncd,bhnsd->bhncs', q, k) * decay
    q_dec = q * jnp.exp(gc)[..., None]
    k_dec = k * jnp.exp(gc[..., -1:] - gc)[..., None]
    chunk_decay = jnp.exp(gc[..., -1])

    def step(state, xs):
        u_n, w_n, q_n, k_n, attn_n, cd_n = xs
        v_new = u_n - jnp.einsum('bhcd,bhde->bhce', w_n, state)
        o_n = jnp.einsum('bhcd,bhde->bhce', q_n, state) + jnp.einsum('bhcs,bhse->bhce', attn_n, v_new)
        state = state * cd_n[..., None, None] + jnp.einsum('bhcd,bhce->bhde', k_n, v_new)
        return state, o_n

    def to_front(t):
        return jnp.moveaxis(t, 2, 0)

    s0 = jnp.zeros((B, H, dk, dv), f32)
    _, o = lax.scan(step, s0, (to_front(u), to_front(w), to_front(q_dec), to_front(k_dec),
                               to_front(attn), to_front(chunk_decay)))
    return jnp.moveaxis(o, 0, 2).reshape(B, H, T, dv)


def differential_attention(q1, q2, k1, k2, v, lam, slopes):
    B, H, T, d = q1.shape
    nb = T // Q_BLOCK
    f32 = jnp.float32
    scale = d ** -0.5
    k1f, k2f, vf = k1.astype(f32), k2.astype(f32), v.astype(f32)
    kpos = jnp.arange(T, dtype=jnp.int32)

    def probs(qb, kf, bias, causal):
        s = jnp.einsum('bhqd,bhkd->bhqk', qb, kf) * scale + bias
        s = jnp.where(causal, s, -jnp.inf)
        return jax.nn.softmax(s, axis=-1)

    def block(args):
        q1b, q2b, start = args
        qpos = start + jnp.arange(Q_BLOCK, dtype=jnp.int32)
        dist = qpos[:, None] - kpos[None, :]
        causal = dist >= 0
        bias = -slopes[:, None, None] * dist.astype(f32)[None]
        p = probs(q1b.astype(f32), k1f, bias, causal) - lam * probs(q2b.astype(f32), k2f, bias, causal)
        return jnp.einsum('bhqk,bhke->bhqe', p, vf)

    def to_blocks(t):
        return t.reshape(B, H, nb, Q_BLOCK, d).transpose(2, 0, 1, 3, 4)

    starts = jnp.arange(nb, dtype=jnp.int32) * Q_BLOCK
    out = lax.map(block, (to_blocks(q1), to_blocks(q2), starts))
    return out.transpose(1, 2, 0, 3, 4).reshape(B, H, T, v.shape[-1])


def setup_inputs(seed: int = 0) -> dict:
    key = jax.random.key(seed)
    ks = jax.random.split(key, 24)
    f32 = jnp.float32
    L = DEPTH

    def normal(k, shape, fan_in):
        return jax.random.normal(k, shape, f32) * fan_in ** -0.5

    def gain(k, shape):
        return 1.0 + 0.02 * jax.random.normal(k, shape, f32)

    x = jax.random.normal(ks[0], (BATCH, SEQ, D_MODEL), f32)
    ffn1_norm = gain(ks[1], (L, D_MODEL))
    ffn1_w_gate = normal(ks[2], (L, D_MODEL, D_FF), D_MODEL)
    ffn1_w_up = normal(ks[3], (L, D_MODEL, D_FF), D_MODEL)
    ffn1_w_down = normal(ks[4], (L, D_FF, D_MODEL), D_FF)
    mix_norm = gain(ks[5], (L, D_MODEL))
    w_in = normal(ks[6], (L, D_MODEL, W_IN_COLS), D_MODEL)
    conv_qkv = normal(ks[7], (L, CONV_WIDTH, 3 * DN_WIDTH), CONV_WIDTH)
    dn_a_log = jnp.log(jax.random.uniform(ks[8], (L, DN_HEADS), f32, 1.0, 16.0))
    dt = jnp.exp(jax.random.uniform(ks[9], (L, DN_HEADS), f32, math.log(1e-3), math.log(1e-1)))
    dn_dt_bias = dt + jnp.log(-jnp.expm1(-dt))
    dn_out_norm = gain(ks[10], (L, DN_HEAD_DIM))
    diff_lambda_q1 = 0.1 * jax.random.normal(ks[11], (L, DIFF_HEAD_DIM), f32)
    diff_lambda_k1 = 0.1 * jax.random.normal(ks[12], (L, DIFF_HEAD_DIM), f32)
    diff_lambda_q2 = 0.1 * jax.random.normal(ks[13], (L, DIFF_HEAD_DIM), f32)
    diff_lambda_k2 = 0.1 * jax.random.normal(ks[14], (L, DIFF_HEAD_DIM), f32)
    diff_subln = gain(ks[15], (L, DIFF_V_DIM))
    w_branch_a = normal(ks[16], (L, DN_WIDTH, D_MODEL), DN_WIDTH)
    w_branch_b = normal(ks[17], (L, DIFF_V_WIDTH, D_MODEL), DIFF_V_WIDTH)
    w_out = normal(ks[18], (L, D_MODEL, D_MODEL), D_MODEL)
    ffn2_norm = gain(ks[19], (L, D_MODEL))
    ffn2_w_gate = normal(ks[20], (L, D_MODEL, D_FF), D_MODEL)
    ffn2_w_up = normal(ks[21], (L, D_MODEL, D_FF), D_MODEL)
    ffn2_w_down = normal(ks[22], (L, D_FF, D_MODEL), D_FF)
    final_norm = gain(ks[23], (D_MODEL,))
    return {"x": x, "ffn1_norm": ffn1_norm, "ffn1_w_gate": ffn1_w_gate, "ffn1_w_up": ffn1_w_up,
            "ffn1_w_down": ffn1_w_down, "mix_norm": mix_norm, "w_in": w_in, "conv_qkv": conv_qkv,
            "dn_a_log": dn_a_log, "dn_dt_bias": dn_dt_bias, "dn_out_norm": dn_out_norm,
            "diff_lambda_q1": diff_lambda_q1, "diff_lambda_k1": diff_lambda_k1,
            "diff_lambda_q2": diff_lambda_q2, "diff_lambda_k2": diff_lambda_k2, "diff_subln": diff_subln,
            "w_branch_a": w_branch_a, "w_branch_b": w_branch_b, "w_out": w_out,
            "ffn2_norm": ffn2_norm, "ffn2_w_gate": ffn2_w_gate, "ffn2_w_up": ffn2_w_up,
            "ffn2_w_down": ffn2_w_down, "final_norm": final_norm}


def reference(x, ffn1_norm, ffn1_w_gate, ffn1_w_up, ffn1_w_down, mix_norm, w_in, conv_qkv,
              dn_a_log, dn_dt_bias, dn_out_norm, diff_lambda_q1, diff_lambda_k1, diff_lambda_q2,
              diff_lambda_k2, diff_subln, w_branch_a, w_branch_b, w_out, ffn2_norm, ffn2_w_gate,
              ffn2_w_up, ffn2_w_down, final_norm):
    B, T, _ = x.shape
    f32 = jnp.float32
    split_points = [int(s) for s in np.cumsum(IN_SPLIT_SIZES)[:-1]]
    slopes = jnp.asarray([2.0 ** (-8.0 * (i + 1) / DIFF_HEADS) for i in range(DIFF_HEADS)], f32)

    for l in range(DEPTH):
        x = x + 0.5 * swiglu_ffn(rms_norm(x, ffn1_norm[l]), ffn1_w_gate[l], ffn1_w_up[l], ffn1_w_down[l])

        h = rms_norm(x, mix_norm[l])
        proj = h @ w_in[l]
        qkv_dn, z_dn, a_dn, b_dn, q_df, k_df, v_df, gate_logits = jnp.split(proj, split_points, axis=-1)

        qkv_dn = jax.nn.silu(causal_depthwise_conv(qkv_dn, conv_qkv[l]))
        q_dn, k_dn, v_dn = jnp.split(qkv_dn, 3, axis=-1)

        def dn_heads(t):
            return t.reshape(B, T, DN_HEADS, DN_HEAD_DIM).transpose(0, 2, 1, 3)

        q_dn = l2_normalize(dn_heads(q_dn))
        k_dn = l2_normalize(dn_heads(k_dn))
        v_dn = dn_heads(v_dn)
        g_dn = -jnp.exp(dn_a_log[l].astype(f32)) * jax.nn.softplus(a_dn.astype(f32) + dn_dt_bias[l].astype(f32))
        beta_dn = jax.nn.sigmoid(b_dn.astype(f32))
        o_dn = gated_delta_rule_chunked(q_dn, k_dn, v_dn, g_dn.transpose(0, 2, 1), beta_dn.transpose(0, 2, 1))
        o_dn = o_dn.transpose(0, 2, 1, 3).astype(x.dtype)
        o_dn = rms_norm(o_dn, dn_out_norm[l]) * jax.nn.silu(z_dn.reshape(B, T, DN_HEADS, DN_HEAD_DIM))
        y_a = o_dn.reshape(B, T, DN_WIDTH) @ w_branch_a[l]

        q_df = q_df.reshape(B, T, DIFF_HEADS, 2, DIFF_HEAD_DIM).transpose(3, 0, 2, 1, 4)
        k_df = k_df.reshape(B, T, DIFF_HEADS, 2, DIFF_HEAD_DIM).transpose(3, 0, 2, 1, 4)
        v_df = v_df.reshape(B, T, DIFF_HEADS, DIFF_V_DIM).transpose(0, 2, 1, 3)
        lam_init = lambda_init(l)
        lam = (jnp.exp(jnp.sum(diff_lambda_q1[l].astype(f32) * diff_lambda_k1[l].astype(f32)))
               - jnp.exp(jnp.sum(diff_lambda_q2[l].astype(f32) * diff_lambda_k2[l].astype(f32)))
               + lam_init)
        o_df = differential_attention(q_df[0], q_df[1], k_df[0], k_df[1], v_df, lam, slopes)
        o_df = o_df.transpose(0, 2, 1, 3).astype(x.dtype)
        o_df = rms_norm(o_df, diff_subln[l], eps=SUBLN_EPS) * (1.0 - lam_init)
        y_b = o_df.reshape(B, T, DIFF_V_WIDTH) @ w_branch_b[l]

        gate_a, gate_b = jnp.split(jax.nn.sigmoid(gate_logits), 2, axis=-1)
        x = x + (gate_a * y_a + gate_b * y_b) @ w_out[l]

        x = x + 0.5 * swiglu_ffn(rms_norm(x, ffn2_norm[l]), ffn2_w_gate[l], ffn2_w_up[l], ffn2_w_down[l])

    return rms_norm(x, final_norm)
```

```cpp
#include <hip/hip_runtime.h>
#include <hip/hip_cooperative_groups.h>
#include <cstdio>
#include <cstdint>
namespace cg = cooperative_groups;
__device__ __forceinline__ int lane_id() { int l = (int)__builtin_amdgcn_mbcnt_hi(~0u, __builtin_amdgcn_mbcnt_lo(~0u, 0u)); asm volatile("" : "+v"(l)); return l; }
namespace pg8 {
#define PG8_LAS __attribute__((address_space(3)))
typedef unsigned short bf16_t;
typedef short bf16x8 __attribute__((ext_vector_type(8)));
typedef float f32x4 __attribute__((ext_vector_type(4)));
typedef unsigned u32x4 __attribute__((ext_vector_type(4)));
constexpr int BM = 256, BK = 64, HALF = 128, HTB = HALF * BK * 2  , STAGE_BYTES = 8 * HTB, NXCD = 8, WGM = 8;

__host__ __device__ __forceinline__ int lds_byte(int r, int c) { const int st = (r >> 4) * 2 + (c >> 5), rr = r & 15, cc = c & 31, ob = rr * 64 + cc * 2; return st * 1024 + (ob ^ (((ob >> 9) & 1) << 5)); }
__host__ __device__ __forceinline__ void stage_rc(int b, int& R, int& C) { const int st = b / 1024, sb = b % 1024, swz = sb ^ (((sb >> 9) & 1) << 5); R = (st >> 1) * 16 + swz / 64; C = (st & 1) * 32 + (swz % 64) / 2; }
__host__ __device__ __forceinline__ int perm32(int rho) { const int n = rho >> 4, i = rho & 15; return 8 * (i >> 2) + 4 * n + (i & 3); }

struct Unit { int pm, pn; };
struct Gemm { const bf16_t* A; const bf16_t* Bt; int M, N, K; };

struct StaticOrder {
    int nM, nN, nwg, G, c;
    __host__ __device__ void init(int M, int N, int G_, int c_) { nM = M / BM; nN = N / BM; nwg = nM * nN; G = G_; c = c_; }
    __host__ __device__ bool next(int i, Unit& u) const {
        const long L = (long)i * G + c; if (L >= nwg) return false;
        int wgid = (int)L; { const int q = nwg / NXCD, r = nwg % NXCD, xcd = wgid % NXCD, off = wgid / NXCD; wgid = (xcd < r ? xcd * (q + 1) : r * (q + 1) + (xcd - r) * q) + off; }
        const int nig = WGM * nN, gid = wgid / nig, fm = gid * WGM, gsz = (nM - fm) < WGM ? (nM - fm) : WGM;
        u.pm = fm + ((wgid % nig) % gsz); u.pn = (wgid % nig) / gsz; return true;
    }
    __device__ __forceinline__ void a_ready(const Unit&) const {}
    __device__ __forceinline__ void done(const Unit&) const {}
};

__device__ __forceinline__ unsigned cvt_pk_bf16(float lo, float hi) { unsigned r; asm volatile("v_cvt_pk_bf16_f32 %0, %1, %2" : "=v"(r) : "v"(lo), "v"(hi)); return r; }
__device__ __forceinline__ float fast_sigmoid(float v) { return __builtin_amdgcn_rcpf(1.0f + __builtin_amdgcn_exp2f(-1.4426950408889634f * v)); }
__device__ __forceinline__ float fast_silu(float v) { return v * fast_sigmoid(v); }
__device__ __forceinline__ void load_rs(float (&rs)[2][4], const float* ssq, int row0, float eps) {
#pragma unroll
    for (int ai = 0; ai < 2; ++ai)
#pragma unroll
        for (int m = 0; m < 4; ++m) { const f32x4* p = (const f32x4*)(ssq + (size_t)(row0 + ai * HALF + m * 16) * 16); const f32x4 a = p[0], b = p[1], c = p[2], d = p[3];
            const float s = ((a[0] + a[1]) + (a[2] + a[3])) + ((b[0] + b[1]) + (b[2] + b[3])) + ((c[0] + c[1]) + (c[2] + c[3])) + ((d[0] + d[1]) + (d[2] + d[3]));
            rs[ai][m] = 1.0f / sqrtf(s * (1.0f / 1024.0f) + eps); }
}
struct EpiSwiGLU {
    static constexpr bool PERM = true, AFTER_DRAIN = false;
    bf16_t* H; int ldh; const float* ssq; float eps;
    __device__ __forceinline__ void operator()(const f32x4 (&acc)[2][2][4][2], const Unit& u, int wr, int wc, int fr, int fq) const {
        const int row0 = u.pm * BM + wr * 64 + fr, col0 = u.pn * HALF + wc * 32 + 8 * fq;
        float rs[2][4]; load_rs(rs, ssq, row0, eps);
#pragma unroll
        for (int ai = 0; ai < 2; ++ai)
#pragma unroll
            for (int m = 0; m < 4; ++m) { bf16_t* rowp = H + (size_t)(row0 + ai * HALF + m * 16) * ldh + col0; const float s = rs[ai][m];
                float h[8];
#pragma unroll
                for (int n = 0; n < 2; ++n)
#pragma unroll
                    for (int j = 0; j < 4; ++j) h[n * 4 + j] = fast_silu(acc[ai][0][m][n][j] * s) * (acc[ai][1][m][n][j] * s);
                u32x4 w; w.x = cvt_pk_bf16(h[0], h[1]); w.y = cvt_pk_bf16(h[2], h[3]); w.z = cvt_pk_bf16(h[4], h[5]); w.w = cvt_pk_bf16(h[6], h[7]);
                *(u32x4*)rowp = w; }
    }
};
struct EpiResid {
    static constexpr bool PERM = false, AFTER_DRAIN = false;
    const float* base; float* out; bf16_t* xb; float* ssq_out; float scale;
    __device__ __forceinline__ void operator()(const f32x4 (&acc)[2][2][4][2], const Unit& u, int wr, int wc, int fr, int fq) const {
        typedef unsigned u32x2v __attribute__((ext_vector_type(2)));
        const int row0 = u.pm * BM + wr * 64 + fr, col0 = u.pn * BM + wc * 32 + 4 * fq;
#pragma unroll
        for (int ai = 0; ai < 2; ++ai)
#pragma unroll
            for (int m = 0; m < 4; ++m) { const int row = row0 + ai * HALF + m * 16; const size_t off = (size_t)row * 1024 + col0; float ss = 0.f;
#pragma unroll
                for (int bj = 0; bj < 2; ++bj)
#pragma unroll
                    for (int n = 0; n < 2; ++n) { const f32x4 bs = *(const f32x4*)(base + off + bj * HALF + n * 16); const f32x4 o = bs + acc[ai][bj][m][n] * scale;
                        *(f32x4*)(out + off + bj * HALF + n * 16) = o; ss += (o[0] * o[0] + o[1] * o[1]) + (o[2] * o[2] + o[3] * o[3]);
                        u32x2v w; w.x = cvt_pk_bf16(o[0], o[1]); w.y = cvt_pk_bf16(o[2], o[3]); *(u32x2v*)(xb + off + bj * HALF + n * 16) = w; }
                ss += __shfl_xor(ss, 16); ss += __shfl_xor(ss, 32);
                if (fq == 0) ssq_out[(size_t)row * 16 + u.pn * 4 + wc] = ss; }
    }
};
struct EpiStoreBf16 {
    static constexpr bool PERM = true, AFTER_DRAIN = false;
    bf16_t* O; int ldc;
    __device__ __forceinline__ void operator()(const f32x4 (&acc)[2][2][4][2], const Unit& u, int wr, int wc, int fr, int fq) const {
        const int row0 = u.pm * BM + wr * 64 + fr, col0 = u.pn * BM + wc * 32 + 8 * fq;
#pragma unroll
        for (int ai = 0; ai < 2; ++ai)
#pragma unroll
            for (int m = 0; m < 4; ++m) { bf16_t* rowp = O + (size_t)(row0 + ai * HALF + m * 16) * ldc + col0;
#pragma unroll
                for (int bj = 0; bj < 2; ++bj) { const f32x4 v0 = acc[ai][bj][m][0], v1 = acc[ai][bj][m][1];
                    u32x4 w; w.x = cvt_pk_bf16(v0[0], v0[1]); w.y = cvt_pk_bf16(v0[2], v0[3]); w.z = cvt_pk_bf16(v1[0], v1[1]); w.w = cvt_pk_bf16(v1[2], v1[3]);
                    *(u32x4*)(rowp + bj * HALF) = w; } }
    }
};
struct EpiWin {
    static constexpr bool PERM = true, AFTER_DRAIN = false;
    bf16_t *PRE, *Z, *QO, *KD, *VD; float* AB; const float* ssq; float eps, qscale;
    __device__ __forceinline__ void operator()(const f32x4 (&acc)[2][2][4][2], const Unit& u, int wr, int wc, int fr, int fq) const {
        const int row0 = u.pm * BM + wr * 64 + fr, cl0 = wc * 32 + 8 * fq, pn = u.pn;
        float rs[2][4]; load_rs(rs, ssq, row0, eps);
        if (pn == 14) {
            if (wc == 0 && fq < 2) {
#pragma unroll
                for (int ai = 0; ai < 2; ++ai)
#pragma unroll
                    for (int m = 0; m < 4; ++m) { float* rowp = AB + (size_t)(row0 + ai * HALF + m * 16) * 16 + 8 * fq; const float s = rs[ai][m];
                        *(f32x4*)rowp = acc[ai][0][m][0] * s; *(f32x4*)(rowp + 4) = acc[ai][0][m][1] * s; }
            }
            return;
        }
        bf16_t* base; int ld, cb; float sc = 1.f; bool dup = false;
        if (pn < 6) { base = PRE; ld = 1536; cb = pn * 256; }
        else if (pn < 8) { base = Z; ld = 512; cb = (pn - 6) * 256; }
        else if (pn < 10) { base = QO; ld = 1024; cb = (pn - 8) * 256; sc = qscale; dup = true; }
        else if (pn < 12) { base = KD; ld = 512; cb = (pn - 10) * 256; }
        else { base = VD; ld = 512; cb = (pn - 12) * 256; }
#pragma unroll
        for (int ai = 0; ai < 2; ++ai)
#pragma unroll
            for (int m = 0; m < 4; ++m) { const float s = rs[ai][m] * sc; bf16_t* rowp = base + (size_t)(row0 + ai * HALF + m * 16) * ld;
#pragma unroll
                for (int bj = 0; bj < 2; ++bj) { const f32x4 v0 = acc[ai][bj][m][0] * s, v1 = acc[ai][bj][m][1] * s;
                    u32x4 w; w.x = cvt_pk_bf16(v0[0], v0[1]); w.y = cvt_pk_bf16(v0[2], v0[3]); w.z = cvt_pk_bf16(v1[0], v1[1]); w.w = cvt_pk_bf16(v1[2], v1[3]);
                    const int c = cb + bj * HALF + cl0;
                    if (dup) { const int qc = ((c >> 6) * 2) * 64 + (c & 63); *(u32x4*)(rowp + qc) = w; *(u32x4*)(rowp + qc + 64) = w; }
                    else *(u32x4*)(rowp + c) = w; } }
    }
};
struct EpiGateMerge {
    static constexpr bool PERM = true, AFTER_DRAIN = false;
    const bf16_t *YA, *YB; bf16_t* MG; const float* ssq; float eps;
    __device__ __forceinline__ void operator()(const f32x4 (&acc)[2][2][4][2], const Unit& u, int wr, int wc, int fr, int fq) const {
        const int row0 = u.pm * BM + wr * 64 + fr, col0 = u.pn * HALF + wc * 32 + 8 * fq;
        float rs[2][4]; load_rs(rs, ssq, row0, eps);
#pragma unroll
        for (int ai = 0; ai < 2; ++ai)
#pragma unroll
            for (int m = 0; m < 4; ++m) { const size_t off = (size_t)(row0 + ai * HALF + m * 16) * 1024 + col0; const float s = rs[ai][m];
                const u32x4 ya = *(const u32x4*)(YA + off), yb = *(const u32x4*)(YB + off);
                float o[8];
#pragma unroll
                for (int n = 0; n < 2; ++n)
#pragma unroll
                    for (int j = 0; j < 4; ++j) { const int e = n * 4 + j; const unsigned wa = ya[e >> 1], wb = yb[e >> 1];
                        const float fa = __uint_as_float((e & 1) ? (wa & 0xffff0000u) : (wa << 16)), fb = __uint_as_float((e & 1) ? (wb & 0xffff0000u) : (wb << 16));
                        o[e] = fast_sigmoid(acc[ai][0][m][n][j] * s) * fa + fast_sigmoid(acc[ai][1][m][n][j] * s) * fb; }
                u32x4 w; w.x = cvt_pk_bf16(o[0], o[1]); w.y = cvt_pk_bf16(o[2], o[3]); w.z = cvt_pk_bf16(o[4], o[5]); w.w = cvt_pk_bf16(o[6], o[7]);
                *(u32x4*)(MG + off) = w; }
    }
};

template <class Epi, class Sched, bool ALIGN_EPI = false, bool SP2 = false>
__device__ __forceinline__ void gemm_phase(PG8_LAS unsigned char* lds, const Gemm g, const Sched& S, const Epi& E, const int wave_id) {
    const int wid = wave_id, lane = lane_id(), tid = wid * 64 + lane, wr = wid >> 2, wc = wid & 3, fr = lane & 15, fq = lane >> 4;
    const int K = g.K, nt = K / BK;
    unsigned voffA[2], voffB[2];
#pragma unroll
    for (int i = 0; i < 2; ++i) { int R, C; stage_rc(tid * 16 + i * 8192, R, C); const int Rb = Epi::PERM ? ((R & ~31) + perm32(R & 31)) : R;
        voffA[i] = (unsigned)(R * K + C) * 2u; voffB[i] = (unsigned)(Rb * K + C) * 2u; }
    const size_t kstep = (size_t)(BK * 2);
    const size_t hstep = (size_t)HALF * K * 2;
    const size_t tstep = 2 * hstep;
    const unsigned ldsw = (unsigned)wid * 1024u;
    const int aoff = lds_byte(wr * 64 + fr, fq * 8), boff = lds_byte(wc * 32 + fr, fq * 8);
#define PG8_SA(b, h) (((b) * 2 + (h)) * HTB)
#define PG8_SB(b, h) ((4 + (b) * 2 + (h)) * HTB)
#define PG8_STAGE(bufoff, gbase, voff) do { _Pragma("unroll") for (int _i = 0; _i < 2; ++_i) \
        __builtin_amdgcn_global_load_lds((const unsigned*)((const char*)(gbase) + (voff)[_i]), (PG8_LAS unsigned*)(lds + (bufoff) + ldsw + _i * 8192), 16, 0, 0); } while (0)
#define PG8_LDA(dst, b, h) do { _Pragma("unroll") for (int m = 0; m < 4; ++m) _Pragma("unroll") for (int k = 0; k < 2; ++k) dst[m][k] = *(const PG8_LAS bf16x8*)(lds + PG8_SA(b, h) + aoff + m * 2048 + k * 1024); } while (0)
#define PG8_LDB(dst, b, h) do { _Pragma("unroll") for (int n = 0; n < 2; ++n) _Pragma("unroll") for (int k = 0; k < 2; ++k) dst[n][k] = *(const PG8_LAS bf16x8*)(lds + PG8_SB(b, h) + boff + n * 2048 + k * 1024); } while (0)
#define PG8_MMA(ai, bj, At, Bt) do { __builtin_amdgcn_s_setprio(1); _Pragma("unroll") for (int m = 0; m < 4; ++m) _Pragma("unroll") for (int n = 0; n < 2; ++n) _Pragma("unroll") for (int k = 0; k < 2; ++k) \
        acc[ai][bj][m][n] = __builtin_amdgcn_mfma_f32_16x16x32_bf16(Bt[n][k], At[m][k], acc[ai][bj][m][n], 0, 0, 0); __builtin_amdgcn_s_setprio(0); } while (0)
#define PG8_WAIT_V(n) asm volatile("s_waitcnt vmcnt(" #n ")" ::: "memory")
#define PG8_WAIT_L(n) asm volatile("s_waitcnt lgkmcnt(" #n ")" ::: "memory")
#define PG8_BAR __builtin_amdgcn_s_barrier()
#define PG8_SCHED __builtin_amdgcn_sched_barrier(0)
    Unit cur, nxt; int ui = 0;
    if (!S.next(0, cur)) return;
    f32x4 acc[2][2][4][2];
#pragma unroll
    for (int a = 0; a < 2; ++a)
#pragma unroll
        for (int b = 0; b < 2; ++b)
#pragma unroll
            for (int m = 0; m < 4; ++m)
#pragma unroll
                for (int n = 0; n < 2; ++n) acc[a][b][m][n] = (f32x4){0.f, 0.f, 0.f, 0.f};
    bf16x8 At[4][2], B0[2][2], B1[2][2];
    const char* cA = (const char*)g.A + (size_t)cur.pm * tstep; const char* cB = (const char*)g.Bt + (size_t)cur.pn * tstep;
    S.a_ready(cur);
    if constexpr (SP2) {
        PG8_STAGE(PG8_SB(0, 0), cB, voffB); PG8_STAGE(PG8_SB(0, 1), cB + hstep, voffB); PG8_STAGE(PG8_SA(0, 0), cA, voffA); PG8_STAGE(PG8_SA(0, 1), cA + hstep, voffA);
        if (wr == 1) PG8_BAR;
        PG8_WAIT_V(2); PG8_BAR;
        PG8_STAGE(PG8_SB(1, 0), cB + kstep, voffB); PG8_STAGE(PG8_SA(1, 0), cA + kstep, voffA); PG8_STAGE(PG8_SB(1, 1), cB + hstep + kstep, voffB);
        PG8_WAIT_V(6); PG8_BAR;
    } else {
        PG8_STAGE(PG8_SB(0, 0), cB, voffB); PG8_STAGE(PG8_SA(0, 0), cA, voffA); PG8_STAGE(PG8_SB(0, 1), cB + hstep, voffB); PG8_STAGE(PG8_SA(0, 1), cA + hstep, voffA);
        if (wr == 1) PG8_BAR;
        PG8_WAIT_V(4); PG8_BAR;
        PG8_STAGE(PG8_SB(1, 0), cB + kstep, voffB); PG8_STAGE(PG8_SA(1, 0), cA + kstep, voffA); PG8_STAGE(PG8_SB(1, 1), cB + hstep + kstep, voffB);
        PG8_WAIT_V(6); PG8_BAR;
    }
    for (;;) {
        const bool has_next = S.next(ui + 1, nxt);
        const char* nA = has_next ? (const char*)g.A + (size_t)nxt.pm * tstep : cA; const char* nB = has_next ? (const char*)g.Bt + (size_t)nxt.pn * tstep : cB;
        for (int t = 0; t < nt; t += 2) {
            const bool last = (t == nt - 2);
            const char* a1 = cA + (size_t)(t + 1) * kstep;
            const char* a2 = last ? nA : cA + (size_t)(t + 2) * kstep; const char* b2 = last ? nB : cB + (size_t)(t + 2) * kstep;
            const char* a3 = a2 + kstep; const char* b3 = b2 + kstep;
            if (last && has_next) S.a_ready(nxt);
            if constexpr (SP2) {
            PG8_LDB(B0, 0, 0); PG8_LDB(B1, 0, 1); PG8_SCHED; PG8_LDA(At, 0, 0); PG8_STAGE(PG8_SA(1, 1), a1 + hstep, voffA);
            PG8_WAIT_V(8); PG8_WAIT_L(0); PG8_BAR; PG8_MMA(0, 0, At, B0); PG8_MMA(0, 1, At, B1); PG8_BAR; PG8_SCHED;
            PG8_LDA(At, 0, 1); PG8_STAGE(PG8_SB(0, 0), b2, voffB); PG8_STAGE(PG8_SB(0, 1), b2 + hstep, voffB); PG8_STAGE(PG8_SA(0, 0), a2, voffA);
            PG8_WAIT_V(8); PG8_WAIT_L(0); PG8_BAR; PG8_MMA(1, 0, At, B0); PG8_MMA(1, 1, At, B1); PG8_BAR; PG8_SCHED;
            PG8_LDB(B0, 1, 0); PG8_LDB(B1, 1, 1); PG8_SCHED; PG8_LDA(At, 1, 0); PG8_STAGE(PG8_SA(0, 1), a2 + hstep, voffA);
            PG8_WAIT_V(8); PG8_WAIT_L(0); PG8_BAR; PG8_MMA(0, 0, At, B0); PG8_MMA(0, 1, At, B1); PG8_BAR; PG8_SCHED;
            PG8_LDA(At, 1, 1); PG8_STAGE(PG8_SB(1, 0), b3, voffB); PG8_STAGE(PG8_SB(1, 1), b3 + hstep, voffB); PG8_STAGE(PG8_SA(1, 0), a3, voffA);
            PG8_WAIT_V(8); PG8_WAIT_L(0); PG8_BAR; PG8_MMA(1, 0, At, B0); PG8_MMA(1, 1, At, B1); PG8_BAR; PG8_SCHED;
            } else {
            PG8_LDB(B0, 0, 0); PG8_SCHED; PG8_LDA(At, 0, 0); PG8_STAGE(PG8_SA(1, 1), a1 + hstep, voffA);
            PG8_WAIT_L(8); PG8_BAR; PG8_WAIT_L(0); PG8_MMA(0, 0, At, B0); PG8_BAR; PG8_SCHED;
            PG8_LDB(B1, 0, 1); PG8_STAGE(PG8_SB(0, 0), b2, voffB);
            PG8_BAR; PG8_WAIT_L(0); PG8_MMA(0, 1, At, B1); PG8_BAR;
            PG8_LDA(At, 0, 1); PG8_STAGE(PG8_SA(0, 0), a2, voffA);
            PG8_BAR; PG8_WAIT_L(0); PG8_MMA(1, 0, At, B0); PG8_BAR; PG8_SCHED;
            PG8_STAGE(PG8_SB(0, 1), b2 + hstep, voffB);
            PG8_WAIT_V(6); PG8_BAR; PG8_MMA(1, 1, At, B1); PG8_BAR;
            PG8_LDB(B0, 1, 0); PG8_SCHED; PG8_LDA(At, 1, 0); PG8_STAGE(PG8_SA(0, 1), a2 + hstep, voffA);
            PG8_WAIT_L(8); PG8_BAR; PG8_WAIT_L(0); PG8_MMA(0, 0, At, B0); PG8_BAR; PG8_SCHED;
            PG8_LDB(B1, 1, 1); PG8_STAGE(PG8_SB(1, 0), b3, voffB);
            PG8_BAR; PG8_WAIT_L(0); PG8_MMA(0, 1, At, B1); PG8_BAR;
            PG8_LDA(At, 1, 1); PG8_STAGE(PG8_SA(1, 0), a3, voffA);
            PG8_BAR; PG8_WAIT_L(0); PG8_MMA(1, 0, At, B0); PG8_BAR; PG8_SCHED;
            PG8_STAGE(PG8_SB(1, 1), b3 + hstep, voffB);
            PG8_WAIT_V(6); PG8_BAR; PG8_MMA(1, 1, At, B1); PG8_BAR;
            }
        }
        if constexpr (ALIGN_EPI) { if (wr == 0) PG8_BAR; }
        if constexpr (!Epi::AFTER_DRAIN) { E(acc, cur, wr, wc, fr, fq); S.done(cur); }
        if (!has_next) break;
#pragma unroll
        for (int a = 0; a < 2; ++a)
#pragma unroll
            for (int b = 0; b < 2; ++b)
#pragma unroll
                for (int m = 0; m < 4; ++m)
#pragma unroll
                    for (int n = 0; n < 2; ++n) acc[a][b][m][n] = (f32x4){0.f, 0.f, 0.f, 0.f};
        cur = nxt; cA = nA; cB = nB; ++ui;
        if constexpr (ALIGN_EPI) { if (wr == 1) PG8_BAR; }
    }
    PG8_WAIT_V(0);
    if constexpr (!ALIGN_EPI) { if (wr == 0) PG8_BAR; }
    PG8_BAR;
    if constexpr (Epi::AFTER_DRAIN) { E.fused(acc, cur, wr, wc, fr, fq, lds, wid, lane); S.done(cur); }
#undef PG8_SA
#undef PG8_SB
#undef PG8_STAGE
#undef PG8_LDA
#undef PG8_LDB
#undef PG8_MMA
#undef PG8_WAIT_V
#undef PG8_WAIT_L
#undef PG8_BAR
#undef PG8_SCHED
}
}
#include <hip/hip_bf16.h>
#include <cmath>
namespace attn_body {
using bf16=__hip_bfloat16;
using bf16x8=__attribute__((ext_vector_type(8)))short;
using s16x4=__attribute__((ext_vector_type(4)))short;
using f32x16=__attribute__((ext_vector_type(16)))float;
using u32x4=__attribute__((ext_vector_type(4)))unsigned;
constexpr int BATCH=2,NHEAD=16,SEQ=8192,D=64,DM=NHEAD*D,KP=512;
constexpr int NW=8,QBLK=32,QB=QBLK*NW,KVBLK=64,NQB=SEQ/QB;
constexpr int ATTN_PITCH=DM, ATTN_UNIT_ROWS=QB;
__device__ __forceinline__ int crow(int r,int hi){return (r&3)+8*(r>>2)+4*hi;}
#define SBAR() __builtin_amdgcn_sched_barrier(0)
__device__ __forceinline__ void cmask(f32x16&p0,f32x16&p1,int jb,int qrel,int hi){
  const float NEG=-INFINITY; int lim=qrel-64*jb-4*hi; asm volatile("":"+v"(lim));
  #pragma unroll
  for(int r=0;r<16;++r){const int cr=(r&3)+8*(r>>2); if(cr>lim)p0[r]=NEG; if(cr+32>lim)p1[r]=NEG;}
}

constexpr int NSLOT=3, SLOTB=8192;
constexpr int LDS_K=0, LDS_V=NSLOT*SLOTB, LDS_WS=2*NSLOT*SLOTB, LDS_OST=LDS_WS+NW*64*4, LDS_BYTES=LDS_OST+NW*4096;
constexpr float C2=0.125f*1.4426950408889634f;
__device__ __forceinline__ void glds16(const void*gsrc,unsigned lds_dst){unsigned keep;
  asm volatile("s_mov_b32 %0, m0\n\ts_mov_b32 m0, %2\n\ts_nop 0\n\tglobal_load_lds_dwordx4 %1, off\n\ts_mov_b32 m0, %0":"=&s"(keep):"v"(gsrc),"s"(lds_dst):"memory");}
__device__ __forceinline__ float max3f(float a,float b,float c){float r;asm("v_max3_f32 %0, %1, %2, %3":"=v"(r):"v"(a),"v"(b),"v"(c));return r;}
__device__ __forceinline__ float max2f(float a,float b){float r;asm("v_max_f32_e32 %0, %1, %2":"=v"(r):"v"(a),"v"(b));return r;}
__device__ __forceinline__ float fadd_s(float a,float b){float r;asm("v_add_f32_e32 %0, %1, %2":"=v"(r):"v"(a),"v"(b));return r;}
__device__ __forceinline__ float fsub_s(float a,float b){float r;asm("v_sub_f32_e32 %0, %1, %2":"=v"(r):"v"(a),"v"(b));return r;}
typedef float f32x2_t __attribute__((ext_vector_type(2))); typedef __bf16 bf16x2_t __attribute__((ext_vector_type(2)));
__device__ __forceinline__ unsigned cvtpk_s(float lo,float hi){f32x2_t v={lo,hi};bf16x2_t b=__builtin_convertvector(v,bf16x2_t);return __builtin_bit_cast(unsigned,b);}
#define WAIT_BAR(N) asm volatile("s_waitcnt vmcnt(" #N ") lgkmcnt(0)\n\ts_barrier":::"memory")

__device__ __forceinline__ void qkt(f32x16&p0,f32x16&p1,const char*Kslot,const bf16x8*qr,const f32x16&negm,int r32,int hi){
  const char*kb=Kslot+hi*1024+r32*16;
  #pragma unroll
  for(int d0=0;d0<4;++d0){
    const bf16x8 b0=*reinterpret_cast<const bf16x8*>(kb+d0*2048);
    const bf16x8 b1=*reinterpret_cast<const bf16x8*>(kb+d0*2048+512);
    if(d0==0){p0=__builtin_amdgcn_mfma_f32_32x32x16_bf16(b0,qr[0],negm,0,0,0);p1=__builtin_amdgcn_mfma_f32_32x32x16_bf16(b1,qr[0],negm,0,0,0);}
    else{p0=__builtin_amdgcn_mfma_f32_32x32x16_bf16(b0,qr[d0],p0,0,0,0);p1=__builtin_amdgcn_mfma_f32_32x32x16_bf16(b1,qr[d0],p1,0,0,0);}}
}
typedef __attribute__((address_space(3))) const char* lds_cptr;
typedef short v4i16_t __attribute__((ext_vector_type(4)));
__device__ __forceinline__ void kload8(bf16x8*kf,lds_cptr kp){
  kf[0]=*(const __attribute__((address_space(3))) bf16x8*)(kp);      kf[1]=*(const __attribute__((address_space(3))) bf16x8*)(kp+512);
  kf[2]=*(const __attribute__((address_space(3))) bf16x8*)(kp+2048); kf[3]=*(const __attribute__((address_space(3))) bf16x8*)(kp+2560);
  kf[4]=*(const __attribute__((address_space(3))) bf16x8*)(kp+4096); kf[5]=*(const __attribute__((address_space(3))) bf16x8*)(kp+4608);
  kf[6]=*(const __attribute__((address_space(3))) bf16x8*)(kp+6144); kf[7]=*(const __attribute__((address_space(3))) bf16x8*)(kp+6656);
}
__device__ __forceinline__ void kload2(bf16x8*kf,lds_cptr kp,int j){ kf[2*j]=*(const __attribute__((address_space(3))) bf16x8*)(kp+j*2048); kf[2*j+1]=*(const __attribute__((address_space(3))) bf16x8*)(kp+j*2048+512); }
__device__ __forceinline__ s16x4 vtr(lds_cptr p){ return __builtin_bit_cast(s16x4,__builtin_amdgcn_ds_read_tr16_b64_v4i16((__attribute__((address_space(3))) v4i16_t*)p)); }
__device__ __forceinline__ float rowmax(const f32x16&p0,const f32x16&p1){
  float a=max3f(p0[0],p0[1],p1[0]),b=max3f(p0[2],p0[3],p1[1]);a=max3f(a,p1[2],p1[3]);
  #pragma unroll
  for(int r=4;r<16;r+=4){a=max3f(a,p0[r],p0[r+1]);b=max3f(b,p0[r+2],p0[r+3]);a=max3f(a,p1[r],p1[r+1]);b=max3f(b,p1[r+2],p1[r+3]);}
  const float m=max2f(a,b);
  auto rr=__builtin_amdgcn_permlane32_swap(__float_as_uint(m),__float_as_uint(m),false,false);
  return max2f(__uint_as_float(rr[0]),__uint_as_float(rr[1]));
}
__device__ __forceinline__ void pv(f32x16*o,int vb,bf16x8 pa0,bf16x8 pa1,bf16x8 pa2,bf16x8 pa3){
  #pragma unroll
  for(int d0=0;d0<2;++d0){s16x4 lo[4],hi[4];
    #pragma unroll
    for(int ks=0;ks<4;++ks){
      asm volatile("ds_read_b64_tr_b16 %0,%1 offset:%c2":"=&v"(lo[ks]):"v"(vb),"i"(d0*4096+ks*1024):"memory");
      asm volatile("ds_read_b64_tr_b16 %0,%1 offset:%c2":"=&v"(hi[ks]):"v"(vb),"i"(d0*4096+ks*1024+512):"memory");}
    asm volatile("s_waitcnt lgkmcnt(0)":::"memory");SBAR();
    #define PK(k) (bf16x8){lo[k][0],lo[k][1],lo[k][2],lo[k][3],hi[k][0],hi[k][1],hi[k][2],hi[k][3]}
    o[d0]=__builtin_amdgcn_mfma_f32_32x32x16_bf16(pa0,PK(0),o[d0],0,0,0);
    o[d0]=__builtin_amdgcn_mfma_f32_32x32x16_bf16(pa1,PK(1),o[d0],0,0,0);
    o[d0]=__builtin_amdgcn_mfma_f32_32x32x16_bf16(pa2,PK(2),o[d0],0,0,0);
    o[d0]=__builtin_amdgcn_mfma_f32_32x32x16_bf16(pa3,PK(3),o[d0],0,0,0);
    #undef PK
  }
}

#ifndef ATTN_STORE16
#define ATTN_STORE16(p,v) (*(u32x4*)(p)=(v))
#endif
template<int THRL> __device__ __forceinline__ void attn_unit(int b,int h,int qb,const bf16*Q,const bf16*__restrict__ K,const bf16*__restrict__ V,bf16*O,char*shm,const int wave_id){
  const int wid=wave_id,lane=lane_id(),tid=wid*64+lane,r32=lane&31,hi=lane>>5;
  const long rowbase=(long)b*SEQ; const int q0=qb*QB;
  const bf16*Qw=Q+(rowbase+q0+wid*QBLK)*DM+h*D;
  const bf16*Kh=K+rowbase*KP+(h>>1)*D,*Vh=V+rowbase*KP+(h>>2)*128+(h&1)*D;
  const unsigned lds0=(unsigned)(uintptr_t)shm;
  float*wsf=(float*)(shm+LDS_WS)+wid*64;
  const bf16*ksrc=Kh+(long)lane*KP+wid*8;
  const bf16*vsrc=Vh+(long)(16*(wid&3)+(lane>>2))*KP+(wid>>2)*32+(lane&3)*8;
  const unsigned kdst=lds0+LDS_K+wid*1024, vdst=lds0+LDS_V+wid*1024;
  #define DMA_K(t,slot) glds16(ksrc+(long)(t)*KVBLK*KP,(unsigned)__builtin_amdgcn_readfirstlane(kdst+(slot)))
  #define DMA_V(t,slot) glds16(vsrc+(long)(t)*KVBLK*KP,(unsigned)__builtin_amdgcn_readfirstlane(vdst+(slot)))
  const int vb0=(int)(lds0+LDS_V)+((lane>>4)&1)*32+(lane&3)*8+(4*hi+((lane&15)>>2))*64;
  const char*Kbase=shm+LDS_K; bf16x8 kf[8];
  const lds_cptr shm3=(lds_cptr)shm; const lds_cptr kp0=shm3+LDS_K+hi*1024+r32*16; const lds_cptr vp0=shm3+LDS_V+((lane>>4)&1)*32+(lane&3)*8+(4*hi+((lane&15)>>2))*64;
  const int NT=(q0+QB)/KVBLK;
  DMA_K(0,0);DMA_V(0,0);DMA_K(1,SLOTB);
  bf16x8 qr[4];
  #pragma unroll
  for(int d0=0;d0<4;++d0)qr[d0]=*reinterpret_cast<const bf16x8*>(&Qw[(long)r32*DM+d0*16+hi*8]);
  float mhat=0.f,l_reg=0.f;f32x16 o[2];o[0]=f32x16{};o[1]=f32x16{};const f32x16 negm=f32x16{};
  const int qrel=wid*QBLK+r32;
  const unsigned slb_=0x3eb8aa3bu-((unsigned)__builtin_amdgcn_readfirstlane(h>>2)<<24); const float sl2=__uint_as_float(slb_);
  const float qposf=(float)(q0+qrel-4*hi);
  const float s1_=sl2, s8_=__uint_as_float(slb_+(3u<<23)), s32_=__uint_as_float(slb_+(5u<<23));
  #define AADD(d,a,sv) asm volatile("v_add_f32_e32 %0, %1, %2":"=v"(d):"s"(sv),"v"(a))
  #define ALIBI(P0,P1,t) do{ float bq_=__builtin_fmaf(sl2,((float)(64*(t))-qposf),-mhat); \
    _Pragma("unroll") for(int q_=0;q_<4;++q_){ float b0_=bq_,b1_,b2_,b3_,c_; AADD(b1_,b0_,s1_); AADD(b2_,b1_,s1_); AADD(b3_,b2_,s1_); \
      P0[4*q_]+=b0_; P0[4*q_+1]+=b1_; P0[4*q_+2]+=b2_; P0[4*q_+3]+=b3_; \
      AADD(c_,b0_,s32_); P1[4*q_]+=c_; AADD(c_,b1_,s32_); P1[4*q_+1]+=c_; AADD(c_,b2_,s32_); P1[4*q_+2]+=c_; AADD(c_,b3_,s32_); P1[4*q_+3]+=c_; \
      if(q_<3){ AADD(bq_,b0_,s8_); } } }while(0)
  #define CMASK(P0,P1,t) do{int jb_=(t)-(NT-4); if(jb_>=0)cmask(P0,P1,jb_,qrel,hi);}while(0)
  bool resc=false;
  #define START(P0,P1) do{ const float rm=rowmax(P0,P1); resc=false; \
    { const float dl=rm; mhat=fadd_s(mhat,dl); \
      _Pragma("unroll") for(int r=0;r<16;++r){P0[r]=fsub_s(P0[r],dl);P1[r]=fsub_s(P1[r],dl);} \
      } \
    _Pragma("unroll") for(int r=0;r<16;++r)P0[r]=__builtin_amdgcn_exp2f(P0[r]); }while(0)
  #define RESC() do{ if(resc){ asm volatile("s_waitcnt lgkmcnt(0)":::"memory"); \
      _Pragma("unroll") for(int d_=0;d_<2;++d_) _Pragma("unroll") for(int r=0;r<16;++r)o[d_][r]*=wsf[crow(r,hi)]; } }while(0)
  f32x16 pA0,pA1,pB0,pB1;
  int sl_prev=0,sl_cur=0,sl_next=SLOTB;
  #define ROT() do{sl_prev=sl_cur;sl_cur=sl_next;sl_next=(sl_next==(NSLOT-1)*SLOTB)?0:sl_next+SLOTB;}while(0)
  DMA_K(2,2*SLOTB);
  WAIT_BAR(3);
  qkt(pA0,pA1,Kbase,qr,negm,r32,hi);asm volatile("s_nop 15\n\ts_nop 7":"+v"(pA0),"+v"(pA1));ALIBI(pA0,pA1,0);CMASK(pA0,pA1,0);
  START(pA0,pA1);
  _Pragma("unroll") for(int r=0;r<16;++r)pA1[r]=__builtin_amdgcn_exp2f(pA1[r]);
  WAIT_BAR(0);
  DMA_K(3,0);DMA_V(1,SLOTB);
  ROT();
  kload8(kf,kp0+sl_cur);
  WAIT_BAR(2);
  s16x4 vlo[8],vhi[8]; u32x4 pw0,pw1,pw2,pw3;
  #define PKW(P,B) cvtpk_s(P[B],P[B+1])
  #define PAF(k) __builtin_bit_cast(bf16x8,pw##k)
  #define VFR(i) (bf16x8){vlo[i][0],vlo[i][1],vlo[i][2],vlo[i][3],vhi[i][0],vhi[i][1],vhi[i][2],vhi[i][3]}
  #define PIN(x) asm volatile("":"+v"(x))
  #define MX3(a,b,c) __builtin_fmaxf(__builtin_fmaxf((a),(b)),(c))
  #define GAPA(MF,A0,A1,A2,A3,W0,W1,PW) do{ MF; sacc+=A0; sacc+=A1; sacc+=A2; sacc+=A3; PIN(sacc); W0; W1; PIN(PW); SBAR(); }while(0)
  #define EX(v) __builtin_amdgcn_exp2f(v)
  #define GAPB(MF,X,B) do{ MF; X[B]=EX(X[B]); X[B+1]=EX(X[B+1]); X[B+2]=EX(X[B+2]); X[B+3]=EX(X[B+3]); PIN(X); SBAR(); }while(0)
  #define VRD(i) do{ vlo[i]=vtr(vp_+(((i)>>2)*4096+((i)&3)*1024)); vhi[i]=vtr(vp_+(((i)>>2)*4096+((i)&3)*1024+512)); }while(0)
  #define KRD(G,j) do{ if(G){ kload2(kf,kp0+sl_next,j); SBAR(); } }while(0)
  #define STEP(C0,C1,P0,P1,t,GK,GV,GL) do{ SBAR(); \
    const lds_cptr vp_=vp0+sl_prev; \
    VRD(0); SBAR(); float sacc=(P0[0]+P0[1]); \
    GAPA(C0=__builtin_amdgcn_mfma_f32_32x32x16_bf16(kf[0],qr[0],negm,0,0,0), P0[2],P0[3],P0[4],P0[5],     pw0[0]=PKW(P0,0), pw0[1]=PKW(P0,2), pw0); \
    VRD(4); SBAR(); GAPA(C1=__builtin_amdgcn_mfma_f32_32x32x16_bf16(kf[1],qr[0],negm,0,0,0), P0[6],P0[7],P0[8],P0[9],     pw0[2]=PKW(P0,4), pw0[3]=PKW(P0,6), pw0); \
    VRD(1); SBAR(); GAPA(C0=__builtin_amdgcn_mfma_f32_32x32x16_bf16(kf[2],qr[1],C0,0,0,0),   P0[10],P0[11],P0[12],P0[13], pw1[0]=PKW(P0,8), pw1[1]=PKW(P0,10), pw1); \
    VRD(5); SBAR(); GAPA(C1=__builtin_amdgcn_mfma_f32_32x32x16_bf16(kf[3],qr[1],C1,0,0,0),   P0[14],P0[15],P1[0],P1[1],   pw1[2]=PKW(P0,12),pw1[3]=PKW(P0,14), pw1); \
    VRD(2); SBAR(); GAPA(C0=__builtin_amdgcn_mfma_f32_32x32x16_bf16(kf[4],qr[2],C0,0,0,0),   P1[2],P1[3],P1[4],P1[5],     pw2[0]=PKW(P1,0), pw2[1]=PKW(P1,2), pw2); \
    VRD(6); SBAR(); GAPA(C1=__builtin_amdgcn_mfma_f32_32x32x16_bf16(kf[5],qr[2],C1,0,0,0),   P1[6],P1[7],P1[8],P1[9],     pw2[2]=PKW(P1,4), pw2[3]=PKW(P1,6), pw2); \
    VRD(3); SBAR(); GAPA(C0=__builtin_amdgcn_mfma_f32_32x32x16_bf16(kf[6],qr[3],C0,0,0,0),   P1[10],P1[11],P1[12],P1[13], pw3[0]=PKW(P1,8), pw3[1]=PKW(P1,10), pw3); \
    VRD(7); SBAR(); GAPA(C1=__builtin_amdgcn_mfma_f32_32x32x16_bf16(kf[7],qr[3],C1,0,0,0),   P1[14],P1[15],0.f,0.f,       pw3[2]=PKW(P1,12),pw3[3]=PKW(P1,14), pw3); \
    l_reg+=sacc; \
    if(GK){DMA_K((t)+3,sl_cur);} if(GV){DMA_V((t)+1,sl_next);} \
    ALIBI(C0,C1,t); CMASK(C0,C1,t); \
    { float a=MX3(C0[0],C0[1],C1[0]),b=MX3(C0[2],C0[3],C1[1]); a=MX3(a,C1[2],C1[3]); \
      _Pragma("unroll") for(int r=4;r<16;r+=4){a=MX3(a,C0[r],C0[r+1]);b=MX3(b,C0[r+2],C0[r+3]);a=MX3(a,C1[r],C1[r+1]);b=MX3(b,C1[r+2],C1[r+3]);} \
      float rm=__builtin_fmaxf(a,b); { auto rr=__builtin_amdgcn_permlane32_swap(__float_as_uint(rm),__float_as_uint(rm),false,false); rm=__builtin_fmaxf(__uint_as_float(rr[0]),__uint_as_float(rr[1])); } \
      resc=false; \
      if(__builtin_expect(__any(rm>(float)THRL),0)){ const float dl=__builtin_fmaxf(rm,0.f); mhat+=dl; \
        _Pragma("unroll") for(int r=0;r<16;++r){C0[r]-=dl;C1[r]-=dl;} \
        const float f=__builtin_amdgcn_exp2f(-dl); l_reg*=f; if(hi==0)wsf[r32]=f; resc=true; } } \
    SBAR(); \
    GAPB(o[0]=__builtin_amdgcn_mfma_f32_32x32x16_bf16(PAF(0),VFR(0),o[0],0,0,0), C0,0); \
    GAPB(o[1]=__builtin_amdgcn_mfma_f32_32x32x16_bf16(PAF(0),VFR(4),o[1],0,0,0), C0,4); \
    KRD(GL,0); GAPB(o[0]=__builtin_amdgcn_mfma_f32_32x32x16_bf16(PAF(1),VFR(1),o[0],0,0,0), C0,8); \
    KRD(GL,1); GAPB(o[1]=__builtin_amdgcn_mfma_f32_32x32x16_bf16(PAF(1),VFR(5),o[1],0,0,0), C0,12); \
    KRD(GL,2); GAPB(o[0]=__builtin_amdgcn_mfma_f32_32x32x16_bf16(PAF(2),VFR(2),o[0],0,0,0), C1,0); \
    KRD(GL,3); GAPB(o[1]=__builtin_amdgcn_mfma_f32_32x32x16_bf16(PAF(2),VFR(6),o[1],0,0,0), C1,4); \
    GAPB(o[0]=__builtin_amdgcn_mfma_f32_32x32x16_bf16(PAF(3),VFR(3),o[0],0,0,0), C1,8); \
    GAPB(o[1]=__builtin_amdgcn_mfma_f32_32x32x16_bf16(PAF(3),VFR(7),o[1],0,0,0), C1,12); \
    }while(0)
  int t=1;
  #undef CMASK
  #define CMASK(P0,P1,t) do{}while(0)
  for(;t+5<NT;t+=2){
    STEP(pB0,pB1,pA0,pA1,t,true,true,true);     WAIT_BAR(2); RESC(); ROT();
    STEP(pA0,pA1,pB0,pB1,t+1,true,true,true);   WAIT_BAR(2); RESC(); ROT();
  }
  #undef CMASK
  #define CMASK(P0,P1,t) do{int jb_=(t)-(NT-4); if(jb_>=0)cmask(P0,P1,jb_,qrel,hi);}while(0)
  #define ENDW(tt) do{ if((tt)+3<NT){WAIT_BAR(2);} else if((tt)+2<NT){WAIT_BAR(1);} else {WAIT_BAR(0);} }while(0)
  for(;t+1<NT;t+=2){
    STEP(pB0,pB1,pA0,pA1,t,(t+3<NT),(t+1<NT),(t+1<NT));       ENDW(t);   RESC(); ROT();
    STEP(pA0,pA1,pB0,pB1,t+1,(t+4<NT),(t+2<NT),(t+2<NT));     ENDW(t+1); RESC(); ROT();
  }
  STEP(pB0,pB1,pA0,pA1,NT-1,false,false,false); RESC();
  { float sacc=pB0[0]+pB0[1]; _Pragma("unroll") for(int r=2;r<16;++r)sacc+=pB0[r]; _Pragma("unroll") for(int r=0;r<16;++r)sacc+=pB1[r]; l_reg+=sacc;
    pw0=(u32x4){PKW(pB0,0),PKW(pB0,2),PKW(pB0,4),PKW(pB0,6)};pw1=(u32x4){PKW(pB0,8),PKW(pB0,10),PKW(pB0,12),PKW(pB0,14)};pw2=(u32x4){PKW(pB1,0),PKW(pB1,2),PKW(pB1,4),PKW(pB1,6)};pw3=(u32x4){PKW(pB1,8),PKW(pB1,10),PKW(pB1,12),PKW(pB1,14)};
    SBAR(); pv(o,vb0+sl_cur,PAF(0),PAF(1),PAF(2),PAF(3)); }
  #undef PKW
  #undef PAF
  #undef VFR
  #undef PIN
  #undef MX3
  #undef GAPA
  #undef GAPB
  #undef EX
  #undef VRD
  #undef KRD
  #undef STEP
  #undef ENDW
  {auto rr=__builtin_amdgcn_permlane32_swap(__float_as_uint(l_reg),__float_as_uint(l_reg),false,false);l_reg=__uint_as_float(rr[0])+__uint_as_float(rr[1]);}
  if(hi==0)wsf[32+r32]=l_reg;asm volatile("s_waitcnt lgkmcnt(0)":::"memory");
  float rli[16];
  #pragma unroll
  for(int r=0;r<16;++r)rli[r]=__builtin_amdgcn_rcpf(wsf[32+crow(r,hi)]);
  bf16*Ow=O+(rowbase+q0+wid*QBLK)*DM+h*D;
  { bf16*stg=(bf16*)(shm+LDS_OST)+wid*2048;
    #pragma unroll
    for(int r=0;r<16;++r){const int orow=crow(r,hi);
      #pragma unroll
      for(int d0=0;d0<2;++d0)stg[orow*64+d0*32+r32]=__float2bfloat16(o[d0][r]*rli[r]);}
    asm volatile("s_waitcnt lgkmcnt(0)":::"memory");
    #pragma unroll
    for(int i=0;i<4;++i){const int row=i*8+(lane>>3),ch=lane&7; const u32x4 v=*(const u32x4*)(stg+row*64+ch*8); ATTN_STORE16(Ow+(long)row*DM+ch*8,v);} }
  asm volatile("s_waitcnt lgkmcnt(0)\n\ts_barrier":::"memory");
  #undef ALIBI
  #undef AADD
  #undef DMA_K
  #undef DMA_V
  #undef CMASK
  #undef START
  #undef RESC
  #undef ROT
}
constexpr int ATTN_LDS_BYTES=LDS_BYTES;
struct AttnTensors { const bf16* Q; const bf16* K; const bf16* V; bf16* O; };
struct AttnUnit { int bh; int qb; };
struct StaticOrder {
  int vcu;
  __device__ __forceinline__ explicit StaticOrder(int grid,int block):vcu((block%8)*(grid/8)+block/8){}
  __device__ __forceinline__ bool next(int i,AttnUnit&u)const{ if(i>=4)return false; const int s=vcu&7; u.bh=vcu>>3; u.qb=(i==0)?s:(i==1)?15-s:(i==2)?16+s:31-s; return true; }
  __device__ __forceinline__ void a_ready(const AttnUnit&)const{}
  __device__ __forceinline__ void done(const AttnUnit&)const{}
};
template<class Sched,int THRL=8> __device__ __forceinline__ void attn_phase(char*lds,const AttnTensors&T,const Sched&S,const int wave_id){
  AttnUnit u;
  for(int i=0;S.next(i,u);++i){ S.a_ready(u); attn_unit<THRL>(u.bh/NHEAD,u.bh%NHEAD,u.qb,T.Q,T.K,T.V,T.O,lds,wave_id); S.done(u); }
}
#undef SBAR
#undef WAIT_BAR
}
constexpr int NWAVES = 8;
constexpr int BATCH = 2, T = 8192, D = 1024, FF = 2816, M = BATCH * T;
constexpr int WIN_SRC = 5648, WIN_N = 3840;
constexpr float RMS_EPS = 1e-6f, SUBLN_EPS = 1e-5f;
constexpr size_t MiB = 1u << 20;
constexpr size_t WS_SSQA = 1 * MiB, WS_SSQB = 2 * MiB, WS_DNCD = 3 * MiB;
constexpr size_t WS_WG = 4 * MiB, WS_WA = 8 * MiB, WS_WB = 9 * MiB, WS_WOUT = 10 * MiB;
constexpr size_t WS_XB = 12 * MiB;
constexpr size_t WS_H = 44 * MiB;
constexpr size_t WS_WGU1 = 232 * MiB, WS_WD1 = 243 * MiB, WS_WIN = 248 * MiB + 512 * 1024;
constexpr size_t WS_PRE = 44 * MiB, WS_Z = 92 * MiB, WS_QO = 108 * MiB, WS_KD = 140 * MiB, WS_VD = 156 * MiB, WS_AB = 172 * MiB;
constexpr size_t WS_DN = 173 * MiB;
constexpr size_t WS_ODN = 44 * MiB, WS_AA = 60 * MiB, WS_ABB = 76 * MiB;
constexpr size_t WS_WGU2 = 173 * MiB, WS_WD2 = 184 * MiB;
constexpr size_t WS_YA = 190 * MiB, WS_YB = 222 * MiB, WS_MG = 108 * MiB;
constexpr size_t WS_END = 256 * MiB;
constexpr int DN_REC = 40960;
static_assert(WS_DN + (size_t)2048 * DN_REC <= WS_END && WS_WIN + (size_t)WIN_N * D * 2 <= WS_END && WS_YB + (size_t)M * D * 2 <= WS_END, "d_ws map");

constexpr int RING_OFF = 0, RING_BYTES = 147456;
constexpr int MISC_OFF = 147456, LDS_BYTES = 147456 + 256;

#define LAS __attribute__((address_space(3)))
typedef unsigned short bf16;
typedef unsigned v4u __attribute__((ext_vector_type(4)));
typedef float f32x4 __attribute__((ext_vector_type(4)));
typedef float f32x16 __attribute__((ext_vector_type(16)));
typedef short bf16x8 __attribute__((ext_vector_type(8)));
#define LDSFENCE() asm volatile("s_waitcnt lgkmcnt(0)" ::: "memory")
__device__ __forceinline__ unsigned f2bf(float f) { unsigned u = __builtin_bit_cast(unsigned, f); return (u + 0x7fffu + ((u >> 16) & 1u)) >> 16; }
__device__ __forceinline__ unsigned pk2(float lo, float hi) { return f2bf(lo) | (f2bf(hi) << 16); }
__device__ __forceinline__ float bflo(unsigned w) { return __uint_as_float(w << 16); }
__device__ __forceinline__ float bfhi(unsigned w) { return __uint_as_float(w & 0xffff0000u); }
__device__ __forceinline__ float wave_sum(float v) {
#pragma unroll
    for (int o = 1; o < 64; o <<= 1) v += __shfl_xor(v, o);
    return v;
}

#define GAS __attribute__((address_space(1)))
typedef GAS unsigned gu32;
#define RLX_AGENT __ATOMIC_RELAXED, __HIP_MEMORY_SCOPE_AGENT
constexpr size_t WS_CTL = 0, CTL_ZERO_BYTES = 65536;
constexpr int CW_BAR = 1024;
#define XB_TMO      128
#define XB_XCNT(j)  (256  + 64 * (j))
#define XB_XSUB(j)  (1280 + 64 * (j))
#define XB_XGEN(j)  (2304 + 64 * (j))
#define XB_TOP      3328
#define XB_TOPGEN   3392
#define XCD_BAR_WORDS 3456
#define XB_SPIN_CAP (1u << 18)

__device__ __forceinline__ unsigned xb_ld(unsigned* p)              { return __hip_atomic_load(p, __ATOMIC_RELAXED, __HIP_MEMORY_SCOPE_AGENT); }
__device__ __forceinline__ unsigned xb_add(unsigned* p, unsigned v) { return __hip_atomic_fetch_add(p, v, __ATOMIC_RELAXED, __HIP_MEMORY_SCOPE_AGENT); }
__device__ __forceinline__ unsigned xb_xcc_id() { return (unsigned)__builtin_amdgcn_s_getreg((3 << 11) | 20) & 0xFu; }
#define XB_SPIN(cond, bar) do { unsigned _sp = 0; while (cond) { __builtin_amdgcn_s_sleep(1); \
    if ((++_sp & 255u) == 0u) { if (xb_ld(&(bar)[XB_TMO])) break; if (_sp > XB_SPIN_CAP) { atomicAdd(&(bar)[XB_TMO], 1u); break; } } } } while (0)

struct XcdBarrier {
    unsigned* bar; unsigned x; int wave;
    volatile LAS unsigned* st;
};

__device__ __forceinline__ XcdBarrier xcd_barrier_post(unsigned* bar, volatile LAS unsigned* st, int wave) {
    XcdBarrier b; b.bar = bar; b.x = xb_xcc_id(); b.st = st; b.wave = wave;
    if (wave == 0 && lane_id() == 0) (void)xb_add(&bar[XB_XCNT(b.x)], 1u);
    return b;
}
__device__ __forceinline__ void xcd_barrier_complete(unsigned* bar, unsigned x, unsigned& nloc, unsigned& nx) {
    const unsigned G = gridDim.x * gridDim.y * gridDim.z;
    unsigned sum, cnt, mine, sp = 0u;
    for (;;) {
        sum = 0u; cnt = 0u; mine = 0u;
#pragma unroll
        for (unsigned j = 0; j < 16; ++j) { const unsigned c = xb_ld(&bar[XB_XCNT(j)]); sum += c; cnt += (c > 0u) ? 1u : 0u; mine = (j == x) ? c : mine; }
        if (sum == G) break;
        __builtin_amdgcn_s_sleep(1);
        if ((++sp & 255u) == 0u) { if (xb_ld(&bar[XB_TMO])) break; if (sp > XB_SPIN_CAP) { atomicAdd(&bar[XB_TMO], 1u); break; } }
    }
    nloc = mine > 0u ? mine : 1u; nx = cnt > 0u ? cnt : 1u;
}

__device__ __forceinline__ void xcd_barrier(const XcdBarrier& b) {
    asm volatile("s_waitcnt vmcnt(0)" ::: "memory");
    __syncthreads();
    if (b.wave == 0 && lane_id() == 0) {
        unsigned* bar = b.bar;
        __builtin_amdgcn_s_waitcnt(0);
        unsigned nloc = b.st[0], nx = b.st[1];
        if (nloc == 0u) { xcd_barrier_complete(bar, b.x, nloc, nx); b.st[0] = nloc; b.st[1] = nx; }
        const unsigned old = xb_add(&bar[XB_XSUB(b.x)], 1u);
        const unsigned gen = old / nloc;
        if (old + 1u == (gen + 1u) * nloc) {
            __builtin_amdgcn_fence(__ATOMIC_RELEASE, "agent");
            asm volatile("s_waitcnt vmcnt(0)" ::: "memory");
            const unsigned og = xb_add(&bar[XB_TOP], 1u);
            const unsigned tg = og / nx;
            if (og + 1u == (tg + 1u) * nx) xb_add(&bar[XB_TOPGEN], 1u);
            else XB_SPIN(xb_ld(&bar[XB_TOPGEN]) == tg, bar);
            __builtin_amdgcn_fence(__ATOMIC_ACQUIRE, "agent");
            xb_add(&bar[XB_XGEN(b.x)], 1u);
            asm volatile("s_waitcnt vmcnt(0)" ::: "memory");
        } else {
            XB_SPIN(xb_ld(&bar[XB_XGEN(b.x)]) == gen, bar);
            __builtin_amdgcn_fence(__ATOMIC_ACQUIRE, "agent");
            asm volatile("s_waitcnt vmcnt(0)" ::: "memory");
        }
    }
    __syncthreads();
}

struct Ctx {
    const float* const* in; float* out; unsigned char* ws;
    LAS unsigned char* lds; int wave, G, vcu;
};

__device__ __forceinline__ void conv_item(const float* W, int ldw, int scol0, int nvalid, const float* gain, bf16* WT, int K, int drow0, int k0, LAS float* scr, int lane) {
#pragma unroll 8
    for (int i = 0; i < 32; ++i) { const int kk = 2 * i + (lane >> 5), n = lane & 31; float v = (n < nvalid) ? W[(size_t)(k0 + kk) * ldw + scol0 + n] : 0.f; if (gain) v *= gain[k0 + kk]; scr[kk * 33 + n] = v; }
    LDSFENCE();
    const int c = lane & 7;
#pragma unroll
    for (int j = 0; j < 4; ++j) { const int n = (lane >> 3) + 8 * j; const LAS float* s = scr + (8 * c) * 33 + n;
        v4u o; o.x = pk2(s[0 * 33], s[1 * 33]); o.y = pk2(s[2 * 33], s[3 * 33]); o.z = pk2(s[4 * 33], s[5 * 33]); o.w = pk2(s[6 * 33], s[7 * 33]);
        *(v4u*)(WT + (size_t)(drow0 + n) * K + k0 + 8 * c) = o; }
    LDSFENCE();
}
__device__ __forceinline__ void conv_gu(const float* wg, const float* wu, const float* gain, bf16* WT, int it, LAS float* scr, int lane) {
    const int db = it >> 4, kb = it & 15, tile = db >> 3, w = db & 7;
    conv_item(w < 4 ? wg : wu, FF, 128 * tile + 32 * (w & 3), 32, gain, WT, D, 32 * db, 64 * kb, scr, lane);
}
__device__ __forceinline__ void conv_plain(const float* W, int K, int N, bf16* WT, int it, LAS float* scr, int lane) {
    const int nkb = K / 64, db = it / nkb, kb = it % nkb;
    conv_item(W, N, 32 * db, 32, nullptr, WT, K, 32 * db, 64 * kb, scr, lane);
}
__device__ __forceinline__ void conv_win(const float* W, const float* gain, bf16* WT, int it, LAS float* scr, int lane) {
    const int db = it >> 4, kb = it & 15, d0 = 32 * db; int sc, nv = 32;
    if (d0 < 2048) sc = d0; else if (d0 < 3584) sc = d0 + 16; else if (d0 == 3584) { sc = 2048; nv = 16; } else { sc = 0; nv = 0; }
    conv_item(W, WIN_SRC, sc, nv, gain, WT, D, d0, 64 * kb, scr, lane);
}
__device__ __forceinline__ void conv_wg(const float* W, const float* gain, bf16* WT, int it, LAS float* scr, int lane) {
    const int db = it >> 4, kb = it & 15, tile = db >> 3, w = db & 7;
    conv_item(W, WIN_SRC, 3600 + (w < 4 ? 0 : 1024) + 128 * tile + 32 * (w & 3), 32, gain, WT, D, 32 * db, 64 * kb, scr, lane);
}

__device__ __forceinline__ void p0_prologue(Ctx& F) {
    const int lane = lane_id();
    LAS float* scr = (LAS float*)(F.lds + RING_OFF + F.wave * 17408);
    const int gw = F.vcu * NWAVES + F.wave, NGW = F.G * NWAVES;
    bf16* ws16 = (bf16*)F.ws;
    constexpr int I_GU = 176 * 16, I_DN = 32 * 44, I_WIN = 120 * 16, I_WG = 64 * 16, I_AB = 32 * 8, I_WO = 32 * 16;
    constexpr int NIT = I_GU + I_DN + I_WIN + I_WG + 2 * I_AB + I_WO;
    for (int it = gw; it < NIT; it += NGW) {
        int r = it;
        if (r < I_GU) { conv_gu(F.in[2], F.in[3], F.in[1], (bf16*)(F.ws + WS_WGU1), r, scr, lane); continue; } r -= I_GU;
        if (r < I_DN) { conv_plain(F.in[4], FF, D, (bf16*)(F.ws + WS_WD1), r, scr, lane); continue; } r -= I_DN;
        if (r < I_WIN) { conv_win(F.in[6], F.in[5], (bf16*)(F.ws + WS_WIN), r, scr, lane); continue; } r -= I_WIN;
        if (r < I_WG) { conv_wg(F.in[6], F.in[5], (bf16*)(F.ws + WS_WG), r, scr, lane); continue; } r -= I_WG;
        if (r < I_AB) { conv_plain(F.in[16], 512, D, (bf16*)(F.ws + WS_WA), r, scr, lane); continue; } r -= I_AB;
        if (r < I_AB) { conv_plain(F.in[17], 512, D, (bf16*)(F.ws + WS_WB), r, scr, lane); continue; } r -= I_AB;
        conv_plain(F.in[18], D, D, (bf16*)(F.ws + WS_WOUT), r, scr, lane);
    }
    (void)ws16;
    const float* x = F.in[0]; bf16* xb = (bf16*)(F.ws + WS_XB); float* ssq = (float*)(F.ws + WS_SSQA);
    for (int m = gw; m < M; m += NGW) {
        const f32x4* xr = (const f32x4*)(x + (size_t)m * D) + lane; unsigned long long* o8 = (unsigned long long*)(xb + (size_t)m * D) + lane;
        float s = 0.f;
#pragma unroll
        for (int j = 0; j < 4; ++j) { const f32x4 v = xr[64 * j]; s += (v.x * v.x + v.y * v.y) + (v.z * v.z + v.w * v.w);
            o8[64 * j] = (unsigned long long)pk2(v.x, v.y) | ((unsigned long long)pk2(v.z, v.w) << 32); }
        s = wave_sum(s);
        if (lane < 16) ssq[(size_t)m * 16 + lane] = (lane == 0) ? s : 0.f;
    }
}
__device__ __forceinline__ void conv_ffn2(Ctx& F) {
    const int lane = lane_id();
    LAS float* scr = (LAS float*)(F.lds + RING_OFF + F.wave * 17408);
    const int gw = F.vcu * NWAVES + F.wave, NGW = F.G * NWAVES;
    constexpr int I_GU = 176 * 16, I_DN = 32 * 44;
    for (int it = gw; it < I_GU + I_DN; it += NGW) {
        if (it < I_GU) conv_gu(F.in[20], F.in[21], F.in[19], (bf16*)(F.ws + WS_WGU2), it, scr, lane);
        else conv_plain(F.in[22], FF, D, (bf16*)(F.ws + WS_WD2), it - I_GU, scr, lane);
    }
}

__device__ __forceinline__ float silu_acc(float v) { return v / (1.0f + __expf(-v)); }
typedef unsigned u32x2 __attribute__((ext_vector_type(2)));
__device__ __forceinline__ void dn_conv_l1(const bf16* PRE, const float* cw, long row0, int tin0, int colbase, int r, int hh, float (&y)[2][4][8]) {
#pragma unroll
    for (int s = 0; s < 4; ++s) {
        const int ch0 = colbase + 16 * s + 4 * hh;
        f32x4 wl[4], wh[4];
#pragma unroll
        for (int j = 0; j < 4; ++j) { wl[j] = *(const f32x4*)(cw + j * 1536 + ch0); wh[j] = *(const f32x4*)(cw + j * 1536 + ch0 + 8); }
#pragma unroll
        for (int i = 0; i < 2; ++i) { const int tok = r + 32 * i, tin = tin0 + tok; const long row = row0 + tok;
            float a[8];
#pragma unroll
            for (int e = 0; e < 8; ++e) a[e] = 0.f;
#pragma unroll
            for (int j = 0; j < 4; ++j) { u32x2 lo = (u32x2){0u, 0u}, hi = (u32x2){0u, 0u};
                if (tin - 3 + j >= 0) { const bf16* p = PRE + (size_t)(row - 3 + j) * 1536 + ch0; lo = *(const u32x2*)p; hi = *(const u32x2*)(p + 8); }
                a[0] += wl[j][0] * bflo(lo.x); a[1] += wl[j][1] * bfhi(lo.x); a[2] += wl[j][2] * bflo(lo.y); a[3] += wl[j][3] * bfhi(lo.y);
                a[4] += wh[j][0] * bflo(hi.x); a[5] += wh[j][1] * bfhi(hi.x); a[6] += wh[j][2] * bflo(hi.y); a[7] += wh[j][3] * bfhi(hi.y); }
#pragma unroll
            for (int e = 0; e < 8; ++e) { y[i][s][e] = silu_acc(a[e]); asm volatile("" : "+v"(y[i][s][e])); } }
        __builtin_amdgcn_sched_barrier(0);
    }
}
__device__ __forceinline__ bf16x8 pack8f(const float (&v)[8], float sc) {
    v4u o; o.x = pk2(v[0] * sc, v[1] * sc); o.y = pk2(v[2] * sc, v[3] * sc); o.z = pk2(v[4] * sc, v[5] * sc); o.w = pk2(v[6] * sc, v[7] * sc);
    return __builtin_bit_cast(bf16x8, o);
}
__device__ __forceinline__ v4u pack8acc(const f32x16& X, int kq) {
    v4u o; o.x = pk2(X[8 * kq], X[8 * kq + 1]); o.y = pk2(X[8 * kq + 2], X[8 * kq + 3]); o.z = pk2(X[8 * kq + 4], X[8 * kq + 5]); o.w = pk2(X[8 * kq + 6], X[8 * kq + 7]);
    return o;
}
__device__ __forceinline__ void write_xt(LAS unsigned short* XT, const bf16x8 (&fr)[2][4], const float (&sc)[2], int r, int hh) {
#pragma unroll
    for (int i = 0; i < 2; ++i)
#pragma unroll
        for (int s = 0; s < 4; ++s) { const v4u w = __builtin_bit_cast(v4u, fr[i][s]);
#pragma unroll
            for (int e = 0; e < 8; ++e) { const unsigned ww = w[e >> 1]; const float v = ((e & 1) ? bfhi(ww) : bflo(ww)) * sc[i];
                XT[(16 * s + 8 * (e >> 2) + 4 * hh + (e & 3)) * 72 + r + 32 * i] = (unsigned short)f2bf(v); } }
}
__device__ __forceinline__ float lane_bcast(float v, int l) { return __uint_as_float((unsigned)__builtin_amdgcn_readlane((int)__float_as_uint(v), l)); }

__device__ __forceinline__ void dn_prep_chunk(Ctx& F, int ch, LAS unsigned char* scrb, int opq  ) {
    int lane_ = lane_id();
    const int lane = lane_, r = lane & 31, hh = lane >> 5;
    const int n = ch & 127, h = (ch >> 7) & 7, b = ch >> 10;
    const long row0 = (long)b * T + 64 * n; const int tin0 = 64 * n;
    const bf16* PRE = (const bf16*)(F.ws + WS_PRE); const float* AB = (const float*)(F.ws + WS_AB); const float* cw = F.in[7];
    unsigned char* rec = F.ws + WS_DN + (size_t)ch * DN_REC;
    LAS float* At = (LAS float*)scrb; LAS unsigned short* TT = (LAS unsigned short*)scrb; LAS unsigned short* XT = (LAS unsigned short*)(scrb + 9216);
    float gc, betac;
    { const float al = AB[(size_t)(row0 + lane) * 16 + h], bl = AB[(size_t)(row0 + lane) * 16 + 8 + h];
      const float xs = al + F.in[9][h];
      const float sp = fmaxf(xs, 0.f) + log1pf(expf(-fabsf(xs)));
      gc = -expf(F.in[8][h]) * sp; betac = 1.0f / (1.0f + expf(-bl));
#pragma unroll
      for (int o = 1; o < 64; o <<= 1) { const float t = __shfl_up(gc, o); if (lane >= o) gc += t; } }
    const float gl = lane_bcast(gc, 63);
    float gct[2], bet[2];
#pragma unroll
    for (int i = 0; i < 2; ++i) { gct[i] = __shfl(gc, r + 32 * i); bet[i] = __shfl(betac, r + 32 * i); }
    bf16x8 kf[2][4];
#pragma unroll
    for (int i = 0; i < 2; ++i)
#pragma unroll
        for (int s = 0; s < 4; ++s) kf[i][s] = (bf16x8){0, 0, 0, 0, 0, 0, 0, 0};
    if (opq > 0) { int lane = lane_; asm volatile("" : "+v"(lane)); const int r = lane & 31, hh = lane >> 5;
      float y[2][4][8]; dn_conv_l1(PRE, cw, row0, tin0, 512 + h * 64, r, hh, y);
#pragma unroll
      for (int i = 0; i < 2; ++i) { float ss = 0.f;
#pragma unroll
          for (int s = 0; s < 4; ++s)
#pragma unroll
              for (int e = 0; e < 8; ++e) ss += y[i][s][e] * y[i][s][e];
          ss += __shfl_xor(ss, 32); const float rn = 1.0f / sqrtf(ss + 1e-6f);
#pragma unroll
          for (int s = 0; s < 4; ++s) { kf[i][s] = pack8f(y[i][s], rn); asm volatile("" : "+v"(kf[i][s])); } } }
    __builtin_amdgcn_sched_barrier(0);
    if (opq > 1) { int lane = lane_; asm volatile("" : "+v"(lane)); const int r = lane & 31, hh = lane >> 5;
      float sc[2] = {expf(gl - gct[0]), expf(gl - gct[1])};
      write_xt(XT, kf, sc, r, hh);
      LDSFENCE();
#pragma unroll
      for (int id = 0; id < 2; ++id)
#pragma unroll
          for (int ks = 0; ks < 4; ++ks) { const int d = r + 32 * id; const LAS unsigned short* p = XT + d * 72 + 16 * ks + 4 * hh;
              const u32x2 lo = *(const LAS u32x2*)p, hi = *(const LAS u32x2*)(p + 8);
              *(v4u*)(rec + 24576 + d * 128 + (ks * 2 + hh) * 16) = (v4u){lo.x, lo.y, hi.x, hi.y}; }
      LDSFENCE(); }
    __builtin_amdgcn_sched_barrier(0);
#ifndef SKQ
    if (opq > 2) {
        int lane = lane_; asm volatile("" : "+v"(lane)); const int r = lane & 31, hh = lane >> 5;
        bf16x8 qf[2][4];
        { float y[2][4][8]; dn_conv_l1(PRE, cw, row0, tin0, h * 64, r, hh, y);
#pragma unroll
          for (int i = 0; i < 2; ++i) { float ss = 0.f;
#pragma unroll
              for (int s = 0; s < 4; ++s)
#pragma unroll
                  for (int e = 0; e < 8; ++e) ss += y[i][s][e] * y[i][s][e];
              ss += __shfl_xor(ss, 32); const float rn = 0.125f / sqrtf(ss + 1e-6f); const float eg = expf(gct[i]);
#pragma unroll
              for (int s = 0; s < 4; ++s) { qf[i][s] = pack8f(y[i][s], rn);
                  *(bf16x8*)(rec + 8192 + (r + 32 * i) * 128 + (s * 2 + hh) * 16) = pack8f(y[i][s], rn * eg); asm volatile("" : "+v"(qf[i][s])); } } }
        __builtin_amdgcn_sched_barrier(0);
#pragma unroll
        for (int is = 0; is < 2; ++is) {
            float gcr[16];
#pragma unroll
            for (int g = 0; g < 16; ++g) gcr[g] = __shfl(gc, 32 * is + (g & 3) + 8 * (g >> 2) + 4 * hh);
#pragma unroll
            for (int ic = 0; ic < 2; ++ic) {
                if (is == 1 && ic == 0) {
#pragma unroll
                    for (int kq = 0; kq < 2; ++kq) *(v4u*)(rec + 16384 + r * 128 + ((2 + kq) * 2 + hh) * 16) = (v4u){0u, 0u, 0u, 0u};
#pragma unroll
                    for (int g = 0; g < 16; ++g) At[(32 + (g & 3) + 8 * (g >> 2) + 4 * hh) * 68 + r] = 0.f;
                    continue;
                }
                f32x16 pt, pk;
#pragma unroll
                for (int g = 0; g < 16; ++g) { pt[g] = 0.f; pk[g] = 0.f; }
#pragma unroll
                for (int ks = 0; ks < 4; ++ks) { pt = __builtin_amdgcn_mfma_f32_32x32x16_bf16(kf[is][ks], qf[ic][ks], pt, 0, 0, 0); pk = __builtin_amdgcn_mfma_f32_32x32x16_bf16(kf[is][ks], kf[ic][ks], pk, 0, 0, 0); }
                const int ccol = 32 * ic + r;
#pragma unroll
                for (int g = 0; g < 16; ++g) { const int srow = 32 * is + (g & 3) + 8 * (g >> 2) + 4 * hh; const float dec = expf(fminf(gct[ic] - gcr[g], 0.f));
                    pt[g] = (srow <= ccol) ? pt[g] * dec : 0.f;
                    At[srow * 68 + ccol] = (srow < ccol) ? bet[ic] * pk[g] * dec : 0.f; }
#pragma unroll
                for (int kq = 0; kq < 2; ++kq) *(v4u*)(rec + 16384 + ccol * 128 + ((2 * is + kq) * 2 + hh) * 16) = pack8acc(pt, kq);
                __builtin_amdgcn_sched_barrier(0);
            }
        }
    }
    LDSFENCE();
#endif
    __builtin_amdgcn_sched_barrier(0);
#ifndef SKS
    if (opq > 3) {
        int lane = lane_; asm volatile("" : "+v"(lane)); const int r = lane & 31, hh = lane >> 5;
        float t[64];
#pragma unroll
        for (int k = 0; k < 64; ++k) t[k] = (k == lane) ? 1.0f : 0.0f;
#pragma unroll
        for (int j = 62; j >= 0; --j) { float acc = 0.f;
#pragma unroll
            for (int k4 = (j + 1) & ~3; k4 < 64; k4 += 4) { const f32x4 x = *(const volatile LAS f32x4*)(At + j * 68 + k4);
#pragma unroll
                for (int i = 0; i < 4; ++i) if (k4 + i > j) acc += t[k4 + i] * x[i]; }
            t[j] -= acc; asm volatile("" : "+v"(t[j])); }
        LDSFENCE();
#pragma unroll
        for (int i = 0; i < 8; ++i) { v4u o; o.x = pk2(t[8 * i], t[8 * i + 1]); o.y = pk2(t[8 * i + 2], t[8 * i + 3]); o.z = pk2(t[8 * i + 4], t[8 * i + 5]); o.w = pk2(t[8 * i + 6], t[8 * i + 7]);
            *(LAS v4u*)(TT + lane * 72 + 8 * i) = o; }
    }
#endif
    __builtin_amdgcn_sched_barrier(0);
#ifndef SKW
    if (opq > 4) { int lane = lane_; asm volatile("" : "+v"(lane)); const int r = lane & 31, hh = lane >> 5;
      float sc[2] = {bet[0] * expf(gct[0]), bet[1] * expf(gct[1])};
      write_xt(XT, kf, sc, r, hh);
      LDSFENCE();
#pragma unroll
      for (int id = 0; id < 2; ++id)
#pragma unroll
          for (int ic = 0; ic < 2; ++ic) { f32x16 acc;
#pragma unroll
              for (int g = 0; g < 16; ++g) acc[g] = 0.f;
#pragma unroll
              for (int ks = 0; ks < 4; ++ks) { const bf16x8 af = *(const LAS bf16x8*)(XT + (r + 32 * id) * 72 + 16 * ks + 8 * hh), bfr = *(const LAS bf16x8*)(TT + (r + 32 * ic) * 72 + 16 * ks + 8 * hh);
                  acc = __builtin_amdgcn_mfma_f32_32x32x16_bf16(af, bfr, acc, 0, 0, 0); }
#pragma unroll
              for (int kq = 0; kq < 2; ++kq) *(v4u*)(rec + (32 * ic + r) * 128 + ((2 * id + kq) * 2 + hh) * 16) = pack8acc(acc, kq); __builtin_amdgcn_sched_barrier(0); }
      LDSFENCE(); }
    __builtin_amdgcn_sched_barrier(0);
#endif
#ifndef SKU
    if (opq > 1) { int lane = lane_; asm volatile("" : "+v"(lane)); const int r = lane & 31, hh = lane >> 5;
      bf16x8 vf[2][4];
      { float y[2][4][8]; dn_conv_l1(PRE, cw, row0, tin0, 1024 + h * 64, r, hh, y);
#pragma unroll
        for (int i = 0; i < 2; ++i)
#pragma unroll
            for (int s = 0; s < 4; ++s) { vf[i][s] = pack8f(y[i][s], bet[i]); asm volatile("" : "+v"(vf[i][s])); } }
      __builtin_amdgcn_sched_barrier(0);
      float one[2] = {1.0f, 1.0f};
      write_xt(XT, vf, one, r, hh);
      LDSFENCE();
      unsigned* U = (unsigned*)(rec + 32768);
#pragma unroll
      for (int ic = 0; ic < 2; ++ic)
#pragma unroll
          for (int ie = 0; ie < 2; ++ie) { f32x16 acc;
#pragma unroll
              for (int g = 0; g < 16; ++g) acc[g] = 0.f;
#pragma unroll
              for (int ks = 0; ks < 4; ++ks) { const bf16x8 af = *(const LAS bf16x8*)(TT + (r + 32 * ic) * 72 + 16 * ks + 8 * hh), bfr = *(const LAS bf16x8*)(XT + (r + 32 * ie) * 72 + 16 * ks + 8 * hh);
                  acc = __builtin_amdgcn_mfma_f32_32x32x16_bf16(af, bfr, acc, 0, 0, 0); }
#pragma unroll
              for (int gp = 0; gp < 8; ++gp) U[((ie * 2 + ic) * 8 + gp) * 64 + lane] = pk2(acc[2 * gp], acc[2 * gp + 1]); __builtin_amdgcn_sched_barrier(0); }
      LDSFENCE(); }
#endif
    if (lane == 0) ((float*)(F.ws + WS_DNCD))[ch] = expf(gl);
}

__device__ __forceinline__ bf16x8 pack8(const f32x16& X, int s) {
    v4u o; o.x = pg8::cvt_pk_bf16(X[8 * s], X[8 * s + 1]); o.y = pg8::cvt_pk_bf16(X[8 * s + 2], X[8 * s + 3]); o.z = pg8::cvt_pk_bf16(X[8 * s + 4], X[8 * s + 5]); o.w = pg8::cvt_pk_bf16(X[8 * s + 6], X[8 * s + 7]);
    return __builtin_bit_cast(bf16x8, o);
}
__device__ __forceinline__ void dn_scan(Ctx& F, int sw) {
    const int lane = lane_id(), r = lane & 31, hh = lane >> 5;
    const int bh = sw >> 1, sl = sw & 1, b = bh >> 3, h = bh & 7;
    const float* CD = (const float*)(F.ws + WS_DNCD) + bh * 128;
    bf16* ODN = (bf16*)(F.ws + WS_ODN);
    f32x16 S0, S1;
#pragma unroll
    for (int i = 0; i < 16; ++i) { S0[i] = 0.f; S1[i] = 0.f; }
    for (int n = 0; n < 128; ++n) {
        const unsigned char* rec = F.ws + WS_DN + ((size_t)bh * 128 + n) * DN_REC;
        const unsigned char* fb = rec + r * 128 + hh * 16;
        bf16x8 w[2][4], qd[2][4], at[2][4], kt[2][4];
#pragma unroll
        for (int i = 0; i < 2; ++i)
#pragma unroll
            for (int ks = 0; ks < 4; ++ks) { const int o = i * 4096 + ks * 32;
                w[i][ks] = *(const bf16x8*)(fb + o); qd[i][ks] = *(const bf16x8*)(fb + 8192 + o); at[i][ks] = *(const bf16x8*)(fb + 16384 + o); kt[i][ks] = *(const bf16x8*)(fb + 24576 + o); }
        const unsigned* up = (const unsigned*)(rec + 32768) + (sl * 2) * 8 * 64 + lane;
        unsigned uw[2][8];
#pragma unroll
        for (int i = 0; i < 2; ++i)
#pragma unroll
            for (int gp = 0; gp < 8; ++gp) uw[i][gp] = up[(i * 8 + gp) * 64];
        const float cd = CD[n];
        bf16x8 sb[4]; sb[0] = pack8(S0, 0); sb[1] = pack8(S0, 1); sb[2] = pack8(S1, 0); sb[3] = pack8(S1, 1);
        f32x16 ws[2], qs[2];
#pragma unroll
        for (int i = 0; i < 2; ++i) {
#pragma unroll
            for (int g = 0; g < 16; ++g) { ws[i][g] = 0.f; qs[i][g] = 0.f; }
#pragma unroll
            for (int ks = 0; ks < 4; ++ks) { ws[i] = __builtin_amdgcn_mfma_f32_32x32x16_bf16(w[i][ks], sb[ks], ws[i], 0, 0, 0); qs[i] = __builtin_amdgcn_mfma_f32_32x32x16_bf16(qd[i][ks], sb[ks], qs[i], 0, 0, 0); }
        }
#pragma unroll
        for (int i = 0; i < 2; ++i)
#pragma unroll
            for (int gp = 0; gp < 8; ++gp) { ws[i][2 * gp] = bflo(uw[i][gp]) - ws[i][2 * gp]; ws[i][2 * gp + 1] = bfhi(uw[i][gp]) - ws[i][2 * gp + 1]; }
        bf16x8 vb[4]; vb[0] = pack8(ws[0], 0); vb[1] = pack8(ws[0], 1); vb[2] = pack8(ws[1], 0); vb[3] = pack8(ws[1], 1);
#pragma unroll
        for (int g = 0; g < 16; ++g) { S0[g] *= cd; S1[g] *= cd; }
#pragma unroll
        for (int ks = 0; ks < 4; ++ks) {
            qs[0] = __builtin_amdgcn_mfma_f32_32x32x16_bf16(at[0][ks], vb[ks], qs[0], 0, 0, 0);
            qs[1] = __builtin_amdgcn_mfma_f32_32x32x16_bf16(at[1][ks], vb[ks], qs[1], 0, 0, 0);
            S0 = __builtin_amdgcn_mfma_f32_32x32x16_bf16(kt[0][ks], vb[ks], S0, 0, 0, 0);
            S1 = __builtin_amdgcn_mfma_f32_32x32x16_bf16(kt[1][ks], vb[ks], S1, 0, 0, 0);
        }
        bf16* orow = ODN + ((size_t)b * T + 64 * n) * 512 + h * 64 + 32 * sl + r;
#pragma unroll
        for (int i = 0; i < 2; ++i)
#pragma unroll
            for (int g = 0; g < 16; ++g) { const int c = 32 * i + (g & 3) + 8 * (g >> 2) + 4 * hh; orow[(size_t)c * 512] = (bf16)f2bf(qs[i][g]); }
    }
}

__device__ __forceinline__ void finalize_rows(Ctx& F) {
    const int gw = F.vcu * NWAVES + F.wave, NGW = F.G * NWAVES, lane = lane_id();
    const bf16* ODN = (const bf16*)(F.ws + WS_ODN); const bf16* Z = (const bf16*)(F.ws + WS_Z); const bf16* QO = (const bf16*)(F.ws + WS_QO);
    bf16* AA = (bf16*)(F.ws + WS_AA); bf16* ABB = (bf16*)(F.ws + WS_ABB);
    float s1 = 0.f, s2 = 0.f;
    { const float a = F.in[11][lane] * F.in[12][lane], bq = F.in[13][lane] * F.in[14][lane]; s1 = wave_sum(a); s2 = wave_sum(bq); }
    const float lam_init = 0.2f;
    const float lam = expf(s1) - expf(s2) + lam_init;
    float gdn[8], gsub[8];
#pragma unroll
    for (int e = 0; e < 8; ++e) { gdn[e] = F.in[10][(lane & 7) * 8 + e]; gsub[e] = F.in[15][(lane & 15) * 8 + e] * (1.0f - lam_init); }
    for (int m = gw; m < M; m += NGW) {
        { const v4u ov = *(const v4u*)(ODN + (size_t)m * 512 + lane * 8), zv = *(const v4u*)(Z + (size_t)m * 512 + lane * 8);
          float o[8], z[8]; float ss = 0.f;
#pragma unroll
          for (int e = 0; e < 4; ++e) { o[2 * e] = bflo(ov[e]); o[2 * e + 1] = bfhi(ov[e]); z[2 * e] = bflo(zv[e]); z[2 * e + 1] = bfhi(zv[e]); }
#pragma unroll
          for (int e = 0; e < 8; ++e) ss += o[e] * o[e];
          ss += __shfl_xor(ss, 1); ss += __shfl_xor(ss, 2); ss += __shfl_xor(ss, 4);
          const float rn = 1.0f / sqrtf(ss * (1.0f / 64.0f) + RMS_EPS);
          float y[8];
#pragma unroll
          for (int e = 0; e < 8; ++e) y[e] = o[e] * rn * gdn[e] * silu_acc(z[e]);
          v4u w; w.x = pk2(y[0], y[1]); w.y = pk2(y[2], y[3]); w.z = pk2(y[4], y[5]); w.w = pk2(y[6], y[7]);
          *(v4u*)(AA + (size_t)m * 512 + lane * 8) = w; }
        { const int hd = lane >> 4, e0 = (lane & 15) * 8;
          const v4u a1 = *(const v4u*)(QO + (size_t)m * 1024 + hd * 256 + e0), a2 = *(const v4u*)(QO + (size_t)m * 1024 + hd * 256 + 128 + e0);
          float o[8]; float ss = 0.f;
#pragma unroll
          for (int e = 0; e < 4; ++e) { o[2 * e] = bflo(a1[e]) - lam * bflo(a2[e]); o[2 * e + 1] = bfhi(a1[e]) - lam * bfhi(a2[e]); }
#pragma unroll
          for (int e = 0; e < 8; ++e) ss += o[e] * o[e];
          ss += __shfl_xor(ss, 1); ss += __shfl_xor(ss, 2); ss += __shfl_xor(ss, 4); ss += __shfl_xor(ss, 8);
          const float rn = 1.0f / sqrtf(ss * (1.0f / 128.0f) + SUBLN_EPS);
          float y[8];
#pragma unroll
          for (int e = 0; e < 8; ++e) y[e] = o[e] * rn * gsub[e];
          v4u w; w.x = pk2(y[0], y[1]); w.y = pk2(y[2], y[3]); w.z = pk2(y[4], y[5]); w.w = pk2(y[6], y[7]);
          *(v4u*)(ABB + (size_t)m * 512 + hd * 128 + e0) = w; }
    }
}
__device__ __forceinline__ void final_norm_rows(Ctx& F) {
    const int lane = lane_id();
    const int gw = F.vcu * NWAVES + F.wave, NGW = F.G * NWAVES;
    const f32x4* gp = (const f32x4*)F.in[23] + lane; f32x4 gg[4];
#pragma unroll
    for (int j = 0; j < 4; ++j) gg[j] = gp[64 * j];
    for (int m = gw; m < M; m += NGW) {
        f32x4* xr = (f32x4*)(F.out + (size_t)m * D) + lane; f32x4 v[4]; float s = 0.f;
#pragma unroll
        for (int j = 0; j < 4; ++j) { v[j] = xr[64 * j]; s += (v[j].x * v[j].x + v[j].y * v[j].y) + (v[j].z * v[j].z + v[j].w * v[j].w); }
        const float rn = 1.0f / sqrtf(wave_sum(s) * (1.0f / D) + RMS_EPS);
#pragma unroll
        for (int j = 0; j < 4; ++j) xr[64 * j] = v[j] * rn * gg[j];
    }
}

constexpr int N_PHASES = 14;
struct Args { const float* in[24]; float* out; unsigned char* ws; int ph_lo, ph_hi; };
__global__ void __launch_bounds__(NWAVES * 64, 2) mk_fwd(Args args) {
    extern __shared__ __attribute__((aligned(16))) unsigned char lds[];
    Ctx F;
    F.in = args.in;
    F.out = args.out; F.ws = args.ws;
    F.lds = (LAS unsigned char*)lds;
    F.wave = __builtin_amdgcn_readfirstlane((int)threadIdx.x >> 6);
    F.G = gridDim.x; { const int bx = blockIdx.x; F.vcu = (F.G % 8 == 0) ? (bx % 8) * (F.G / 8) + bx / 8 : bx; }
    const int lo = args.ph_lo, hi = args.ph_hi;
    { volatile LAS unsigned* misc = (volatile LAS unsigned*)(F.lds + MISC_OFF); if (F.wave == 0) misc[lane_id()] = 0u; }
    __syncthreads();
    XcdBarrier bar = xcd_barrier_post((unsigned*)(args.ws + WS_CTL) + CW_BAR, (volatile LAS unsigned*)(F.lds + MISC_OFF) + 8, F.wave);
    if (lo < -7) cg::this_grid().sync();
    unsigned char* ws = F.ws;
    typedef pg8::bf16_t pb;
#ifndef PH_MASK
#define PH_MASK 0x3fff
#endif
#define IN(k) (((PH_MASK >> (k)) & 1) && lo <= (k) && (k) < hi)
#define SEAM(k) do { if (IN(k) && IN((k) + 1)) xcd_barrier(bar); } while (0)

    if (IN(0)) { p0_prologue(F); } SEAM(0);
    if (IN(1)) { pg8::Gemm g{(const pb*)(ws + WS_XB), (const pb*)(ws + WS_WGU1), M, 2 * FF, D}; pg8::StaticOrder S; S.init(M, 2 * FF, F.G, (int)blockIdx.x);
        pg8::EpiSwiGLU E{(pb*)(ws + WS_H), FF, (const float*)(ws + WS_SSQA), RMS_EPS};
        pg8::gemm_phase<pg8::EpiSwiGLU, pg8::StaticOrder, true, true>(F.lds + RING_OFF, g, S, E, F.wave); } SEAM(1);
    if (IN(2)) { pg8::Gemm g{(const pb*)(ws + WS_H), (const pb*)(ws + WS_WD1), M, D, FF}; pg8::StaticOrder S; S.init(M, D, F.G, (int)blockIdx.x);
        pg8::EpiResid E{F.in[0], F.out, (pb*)(ws + WS_XB), (float*)(ws + WS_SSQB), 0.5f};
        pg8::gemm_phase<pg8::EpiResid, pg8::StaticOrder, true, true>(F.lds + RING_OFF, g, S, E, F.wave); } SEAM(2);
    if (IN(3)) { pg8::Gemm g{(const pb*)(ws + WS_XB), (const pb*)(ws + WS_WIN), M, WIN_N, D}; pg8::StaticOrder S; S.init(M, WIN_N, F.G, (int)blockIdx.x);
        pg8::EpiWin E{(pb*)(ws + WS_PRE), (pb*)(ws + WS_Z), (pb*)(ws + WS_QO), (pb*)(ws + WS_KD), (pb*)(ws + WS_VD), (float*)(ws + WS_AB), (const float*)(ws + WS_SSQB), RMS_EPS, attn_body::C2};
        pg8::gemm_phase<pg8::EpiWin, pg8::StaticOrder, true, true>(F.lds + RING_OFF, g, S, E, F.wave); } SEAM(3);
    if (IN(4)) { LAS unsigned char* scr = F.lds + RING_OFF + F.wave * 18432; const int gw = F.vcu * NWAVES + F.wave, NGW = F.G * NWAVES;
        for (int ch = gw; ch < 2048; ch += NGW) dn_prep_chunk(F, ch, scr, hi); } SEAM(4);
    if (IN(5)) { const attn_body::AttnTensors AT{(const attn_body::bf16*)(ws + WS_QO), (const attn_body::bf16*)(ws + WS_KD), (const attn_body::bf16*)(ws + WS_VD), (attn_body::bf16*)(ws + WS_QO)};
        const attn_body::StaticOrder S((int)F.G, (int)blockIdx.x);
        attn_body::attn_phase<attn_body::StaticOrder>((char*)lds + RING_OFF, AT, S, F.wave); } SEAM(5);
    if (IN(6)) { const int gw = F.wave * F.G + F.vcu; if (gw < 32) dn_scan(F, gw); } SEAM(6);
    if (IN(7)) { finalize_rows(F); conv_ffn2(F); } SEAM(7);
    if (IN(8)) { pg8::StaticOrder S; S.init(M, D, F.G, (int)blockIdx.x);
        { pg8::Gemm g{(const pb*)(ws + WS_AA), (const pb*)(ws + WS_WA), M, D, 512}; pg8::EpiStoreBf16 E{(pb*)(ws + WS_YA), D};
          pg8::gemm_phase<pg8::EpiStoreBf16, pg8::StaticOrder, true, true>(F.lds + RING_OFF, g, S, E, F.wave); }
        { pg8::Gemm g{(const pb*)(ws + WS_ABB), (const pb*)(ws + WS_WB), M, D, 512}; pg8::EpiStoreBf16 E{(pb*)(ws + WS_YB), D};
          pg8::gemm_phase<pg8::EpiStoreBf16, pg8::StaticOrder, true, true>(F.lds + RING_OFF, g, S, E, F.wave); } } SEAM(8);
    if (IN(9)) { pg8::Gemm g{(const pb*)(ws + WS_XB), (const pb*)(ws + WS_WG), M, 2 * D, D}; pg8::StaticOrder S; S.init(M, 2 * D, F.G, (int)blockIdx.x);
        pg8::EpiGateMerge E{(const pb*)(ws + WS_YA), (const pb*)(ws + WS_YB), (pb*)(ws + WS_MG), (const float*)(ws + WS_SSQB), RMS_EPS};
        pg8::gemm_phase<pg8::EpiGateMerge, pg8::StaticOrder, true, true>(F.lds + RING_OFF, g, S, E, F.wave); } SEAM(9);
    if (IN(10)) { pg8::Gemm g{(const pb*)(ws + WS_MG), (const pb*)(ws + WS_WOUT), M, D, D}; pg8::StaticOrder S; S.init(M, D, F.G, (int)blockIdx.x);
        pg8::EpiResid E{F.out, F.out, (pb*)(ws + WS_XB), (float*)(ws + WS_SSQA), 1.0f};
        pg8::gemm_phase<pg8::EpiResid, pg8::StaticOrder, true, true>(F.lds + RING_OFF, g, S, E, F.wave); } SEAM(10);
    if (IN(11)) { pg8::Gemm g{(const pb*)(ws + WS_XB), (const pb*)(ws + WS_WGU2), M, 2 * FF, D}; pg8::StaticOrder S; S.init(M, 2 * FF, F.G, (int)blockIdx.x);
        pg8::EpiSwiGLU E{(pb*)(ws + WS_H), FF, (const float*)(ws + WS_SSQA), RMS_EPS};
        pg8::gemm_phase<pg8::EpiSwiGLU, pg8::StaticOrder, true, true>(F.lds + RING_OFF, g, S, E, F.wave); } SEAM(11);
    if (IN(12)) { pg8::Gemm g{(const pb*)(ws + WS_H), (const pb*)(ws + WS_WD2), M, D, FF}; pg8::StaticOrder S; S.init(M, D, F.G, (int)blockIdx.x);
        pg8::EpiResid E{F.out, F.out, (pb*)(ws + WS_XB), (float*)(ws + WS_SSQB), 0.5f};
        pg8::gemm_phase<pg8::EpiResid, pg8::StaticOrder, true, true>(F.lds + RING_OFF, g, S, E, F.wave); } SEAM(12);
    if (IN(13)) { final_norm_rows(F); }
#undef IN
#undef SEAM
}

#ifndef MK_N_LAUNCHES
#define MK_N_LAUNCHES 14
#endif
extern "C" void kernel_launch(void* const* d_in, const int* in_sizes, int n_in, void* d_out, int out_size, void* d_ws, size_t ws_size, hipStream_t stream) {
    static int grid = 0;
    if (grid == 0) {
        if (n_in != 24 || in_sizes[0] != M * D || out_size != M * D || ws_size < WS_END) { fprintf(stderr, "kernel_launch: unexpected shapes (n_in %d, in0 %d, out %d, ws %zu)\n", n_in, n_in > 0 ? in_sizes[0] : -1, out_size, ws_size); grid = -1; return; }
        int dev = 0, cus = 0, per_cu = 0;
        if (hipGetDevice(&dev) != hipSuccess || hipDeviceGetAttribute(&cus, hipDeviceAttributeMultiprocessorCount, dev) != hipSuccess) { grid = -1; return; }
        if (hipFuncSetAttribute((const void*)mk_fwd, hipFuncAttributeMaxDynamicSharedMemorySize, LDS_BYTES) != hipSuccess) { fprintf(stderr, "kernel_launch: hipFuncSetAttribute failed\n"); grid = -1; return; }
        if (hipOccupancyMaxActiveBlocksPerMultiprocessor(&per_cu, (const void*)mk_fwd, NWAVES * 64, LDS_BYTES) != hipSuccess || per_cu < 1) { fprintf(stderr, "kernel_launch: occupancy query says %d\n", per_cu); per_cu = 1; }
        (void)hipGetLastError();
        grid = cus;
    }
    if (grid < 0) return;
    if (hipMemsetAsync((char*)d_ws + WS_CTL, 0, CTL_ZERO_BYTES, stream) != hipSuccess) { fprintf(stderr, "kernel_launch: hipMemsetAsync failed\n"); return; }
    Args a{};
    for (int i = 0; i < 24; ++i) a.in[i] = (const float*)d_in[i];
    a.out = (float*)d_out; a.ws = (unsigned char*)d_ws;
#if MK_N_LAUNCHES == 1
    a.ph_lo = 0; a.ph_hi = N_PHASES;
    void* kargs[] = {&a};
    hipError_t e = hipLaunchCooperativeKernel((const void*)mk_fwd, dim3(grid), dim3(NWAVES * 64), kargs, LDS_BYTES, stream);
    if (e != hipSuccess) fprintf(stderr, "kernel_launch: cooperative launch failed: %s (grid %d)\n", hipGetErrorString(e), grid);
#else
    for (int p = 0; p < N_PHASES; ++p) { a.ph_lo = p; a.ph_hi = p + 1; hipLaunchKernelGGL(mk_fwd, dim3(grid), dim3(NWAVES * 64), LDS_BYTES, stream, a); }
#endif
}
```

```cpp
#include <hip/hip_runtime.h>
#include <hip/hip_cooperative_groups.h>
#include <cstdio>
#include <cstdint>
namespace cg = cooperative_groups;
__device__ __forceinline__ int lane_id() { int l = (int)__builtin_amdgcn_mbcnt_hi(~0u, __builtin_amdgcn_mbcnt_lo(~0u, 0u)); asm volatile("" : "+v"(l)); return l; }
namespace pg8 {
#define PG8_LAS __attribute__((address_space(3)))
typedef unsigned short bf16_t;
typedef short bf16x8 __attribute__((ext_vector_type(8)));
typedef float f32x4 __attribute__((ext_vector_type(4)));
typedef unsigned u32x4 __attribute__((ext_vector_type(4)));
constexpr int BM = 256, BK = 64, HALF = 128, HTB = HALF * BK * 2  , STAGE_BYTES = 8 * HTB, NXCD = 8, WGM = 8;

__host__ __device__ __forceinline__ int lds_byte(int r, int c) { const int st = (r >> 4) * 2 + (c >> 5), rr = r & 15, cc = c & 31, ob = rr * 64 + cc * 2; return st * 1024 + (ob ^ (((ob >> 9) & 1) << 5)); }
__host__ __device__ __forceinline__ void stage_rc(int b, int& R, int& C) { const int st = b / 1024, sb = b % 1024, swz = sb ^ (((sb >> 9) & 1) << 5); R = (st >> 1) * 16 + swz / 64; C = (st & 1) * 32 + (swz % 64) / 2; }
__host__ __device__ __forceinline__ int perm32(int rho) { const int n = rho >> 4, i = rho & 15; return 8 * (i >> 2) + 4 * n + (i & 3); }

struct Unit { int pm, pn; };
struct Gemm { const bf16_t* A; const bf16_t* Bt; int M, N, K; };

struct StaticOrder {
    int nM, nN, nwg, G, c;
    __host__ __device__ void init(int M, int N, int G_, int c_) { nM = M / BM; nN = N / BM; nwg = nM * nN; G = G_; c = c_; }
    __host__ __device__ bool next(int i, Unit& u) const {
        const long L = (long)i * G + c; if (L >= nwg) return false;
        int wgid = (int)L; { const int q = nwg / NXCD, r = nwg % NXCD, xcd = wgid % NXCD, off = wgid / NXCD; wgid = (xcd < r ? xcd * (q + 1) : r * (q + 1) + (xcd - r) * q) + off; }
        const int nig = WGM * nN, gid = wgid / nig, fm = gid * WGM, gsz = (nM - fm) < WGM ? (nM - fm) : WGM;
        u.pm = fm + ((wgid % nig) % gsz); u.pn = (wgid % nig) / gsz; return true;
    }
    __device__ __forceinline__ void a_ready(const Unit&) const {}
    __device__ __forceinline__ void done(const Unit&) const {}
};

__device__ __forceinline__ unsigned cvt_pk_bf16(float lo, float hi) { unsigned r; asm volatile("v_cvt_pk_bf16_f32 %0, %1, %2" : "=v"(r) : "v"(lo), "v"(hi)); return r; }
__device__ __forceinline__ float fast_sigmoid(float v) { return __builtin_amdgcn_rcpf(1.0f + __builtin_amdgcn_exp2f(-1.4426950408889634f * v)); }
__device__ __forceinline__ float fast_silu(float v) { return v * fast_sigmoid(v); }
__device__ __forceinline__ void load_rs(float (&rs)[2][4], const float* ssq, int row0, float eps) {
#pragma unroll
    for (int ai = 0; ai < 2; ++ai)
#pragma unroll
        for (int m = 0; m < 4; ++m) { const f32x4* p = (const f32x4*)(ssq + (size_t)(row0 + ai * HALF + m * 16) * 16); const f32x4 a = p[0], b = p[1], c = p[2], d = p[3];
            const float s = ((a[0] + a[1]) + (a[2] + a[3])) + ((b[0] + b[1]) + (b[2] + b[3])) + ((c[0] + c[1]) + (c[2] + c[3])) + ((d[0] + d[1]) + (d[2] + d[3]));
            rs[ai][m] = 1.0f / sqrtf(s * (1.0f / 1024.0f) + eps); }
}
struct EpiSwiGLU {
    static constexpr bool PERM = true, AFTER_DRAIN = false;
    bf16_t* H; int ldh; const float* ssq; float eps;
    __device__ __forceinline__ void operator()(const f32x4 (&acc)[2][2][4][2], const Unit& u, int wr, int wc, int fr, int fq) const {
        const int row0 = u.pm * BM + wr * 64 + fr, col0 = u.pn * HALF + wc * 32 + 8 * fq;
        float rs[2][4]; load_rs(rs, ssq, row0, eps);
#pragma unroll
        for (int ai = 0; ai < 2; ++ai)
#pragma unroll
            for (int m = 0; m < 4; ++m) { bf16_t* rowp = H + (size_t)(row0 + ai * HALF + m * 16) * ldh + col0; const float s = rs[ai][m];
                float h[8];
#pragma unroll
                for (int n = 0; n < 2; ++n)
#pragma unroll
                    for (int j = 0; j < 4; ++j) h[n * 4 + j] = fast_silu(acc[ai][0][m][n][j] * s) * (acc[ai][1][m][n][j] * s);
                u32x4 w; w.x = cvt_pk_bf16(h[0], h[1]); w.y = cvt_pk_bf16(h[2], h[3]); w.z = cvt_pk_bf16(h[4], h[5]); w.w = cvt_pk_bf16(h[6], h[7]);
                *(u32x4*)rowp = w; }
    }
};
struct EpiResid {
    static constexpr bool PERM = false, AFTER_DRAIN = false;
    const float* base; float* out; bf16_t* xb; float* ssq_out; float scale;
    __device__ __forceinline__ void operator()(const f32x4 (&acc)[2][2][4][2], const Unit& u, int wr, int wc, int fr, int fq) const {
        typedef unsigned u32x2v __attribute__((ext_vector_type(2)));
        const int row0 = u.pm * BM + wr * 64 + fr, col0 = u.pn * BM + wc * 32 + 4 * fq;
#pragma unroll
        for (int ai = 0; ai < 2; ++ai)
#pragma unroll
            for (int m = 0; m < 4; ++m) { const int row = row0 + ai * HALF + m * 16; const size_t off = (size_t)row * 1024 + col0; float ss = 0.f;
#pragma unroll
                for (int bj = 0; bj < 2; ++bj)
#pragma unroll
                    for (int n = 0; n < 2; ++n) { const f32x4 bs = *(const f32x4*)(base + off + bj * HALF + n * 16); const f32x4 o = bs + acc[ai][bj][m][n] * scale;
                        *(f32x4*)(out + off + bj * HALF + n * 16) = o; ss += (o[0] * o[0] + o[1] * o[1]) + (o[2] * o[2] + o[3] * o[3]);
                        u32x2v w; w.x = cvt_pk_bf16(o[0], o[1]); w.y = cvt_pk_bf16(o[2], o[3]); *(u32x2v*)(xb + off + bj * HALF + n * 16) = w; }
                ss += __shfl_xor(ss, 16); ss += __shfl_xor(ss, 32);
                if (fq == 0) ssq_out[(size_t)row * 16 + u.pn * 4 + wc] = ss; }
    }
};
struct EpiStoreBf16 {
    static constexpr bool PERM = true, AFTER_DRAIN = false;
    bf16_t* O; int ldc;
    __device__ __forceinline__ void operator()(const f32x4 (&acc)[2][2][4][2], const Unit& u, int wr, int wc, int fr, int fq) const {
        const int row0 = u.pm * BM + wr * 64 + fr, col0 = u.pn * BM + wc * 32 + 8 * fq;
#pragma unroll
        for (int ai = 0; ai < 2; ++ai)
#pragma unroll
            for (int m = 0; m < 4; ++m) { bf16_t* rowp = O + (size_t)(row0 + ai * HALF + m * 16) * ldc + col0;
#pragma unroll
                for (int bj = 0; bj < 2; ++bj) { const f32x4 v0 = acc[ai][bj][m][0], v1 = acc[ai][bj][m][1];
                    u32x4 w; w.x = cvt_pk_bf16(v0[0], v0[1]); w.y = cvt_pk_bf16(v0[2], v0[3]); w.z = cvt_pk_bf16(v1[0], v1[1]); w.w = cvt_pk_bf16(v1[2], v1[3]);
                    *(u32x4*)(rowp + bj * HALF) = w; } }
    }
};
struct EpiWin {
    static constexpr bool PERM = true, AFTER_DRAIN = false;
    bf16_t *PRE, *Z, *QO, *KD, *VD; float* AB; const float* ssq; float eps, qscale;
    __device__ __forceinline__ void operator()(const f32x4 (&acc)[2][2][4][2], const Unit& u, int wr, int wc, int fr, int fq) const {
        const int row0 = u.pm * BM + wr * 64 + fr, cl0 = wc * 32 + 8 * fq, pn = u.pn;
        float rs[2][4]; load_rs(rs, ssq, row0, eps);
        if (pn == 14) {
            if (wc == 0 && fq < 2) {
#pragma unroll
                for (int ai = 0; ai < 2; ++ai)
#pragma unroll
                    for (int m = 0; m < 4; ++m) { float* rowp = AB + (size_t)(row0 + ai * HALF + m * 16) * 16 + 8 * fq; const float s = rs[ai][m];
                        *(f32x4*)rowp = acc[ai][0][m][0] * s; *(f32x4*)(rowp + 4) = acc[ai][0][m][1] * s; }
            }
            return;
        }
        bf16_t* base; int ld, cb; float sc = 1.f; bool dup = false;
        if (pn < 6) { base = PRE; ld = 1536; cb = pn * 256; }
        else if (pn < 8) { base = Z; ld = 512; cb = (pn - 6) * 256; }
        else if (pn < 10) { base = QO; ld = 1024; cb = (pn - 8) * 256; sc = qscale; dup = true; }
        else if (pn < 12) { base = KD; ld = 512; cb = (pn - 10) * 256; }
        else { base = VD; ld = 512; cb = (pn - 12) * 256; }
#pragma unroll
        for (int ai = 0; ai < 2; ++ai)
#pragma unroll
            for (int m = 0; m < 4; ++m) { const float s = rs[ai][m] * sc; bf16_t* rowp = base + (size_t)(row0 + ai * HALF + m * 16) * ld;
#pragma unroll
                for (int bj = 0; bj < 2; ++bj) { const f32x4 v0 = acc[ai][bj][m][0] * s, v1 = acc[ai][bj][m][1] * s;
                    u32x4 w; w.x = cvt_pk_bf16(v0[0], v0[1]); w.y = cvt_pk_bf16(v0[2], v0[3]); w.z = cvt_pk_bf16(v1[0], v1[1]); w.w = cvt_pk_bf16(v1[2], v1[3]);
                    const int c = cb + bj * HALF + cl0;
                    if (dup) { const int qc = ((c >> 6) * 2) * 64 + (c & 63); *(u32x4*)(rowp + qc) = w; *(u32x4*)(rowp + qc + 64) = w; }
                    else *(u32x4*)(rowp + c) = w; } }
    }
};
struct EpiGateMerge {
    static constexpr bool PERM = true, AFTER_DRAIN = false;
    const bf16_t *YA, *YB; bf16_t* MG; const float* ssq; float eps;
    __device__ __forceinline__ void operator()(const f32x4 (&acc)[2][2][4][2], const Unit& u, int wr, int wc, int fr, int fq) const {
        const int row0 = u.pm * BM + wr * 64 + fr, col0 = u.pn * HALF + wc * 32 + 8 * fq;
        float rs[2][4]; load_rs(rs, ssq, row0, eps);
#pragma unroll
        for (int ai = 0; ai < 2; ++ai)
#pragma unroll
            for (int m = 0; m < 4; ++m) { const size_t off = (size_t)(row0 + ai * HALF + m * 16) * 1024 + col0; const float s = rs[ai][m];
                const u32x4 ya = *(const u32x4*)(YA + off), yb = *(const u32x4*)(YB + off);
                float o[8];
#pragma unroll
                for (int n = 0; n < 2; ++n)
#pragma unroll
                    for (int j = 0; j < 4; ++j) { const int e = n * 4 + j; const unsigned wa = ya[e >> 1], wb = yb[e >> 1];
                        const float fa = __uint_as_float((e & 1) ? (wa & 0xffff0000u) : (wa << 16)), fb = __uint_as_float((e & 1) ? (wb & 0xffff0000u) : (wb << 16));
                        o[e] = fast_sigmoid(acc[ai][0][m][n][j] * s) * fa + fast_sigmoid(acc[ai][1][m][n][j] * s) * fb; }
                u32x4 w; w.x = cvt_pk_bf16(o[0], o[1]); w.y = cvt_pk_bf16(o[2], o[3]); w.z = cvt_pk_bf16(o[4], o[5]); w.w = cvt_pk_bf16(o[6], o[7]);
                *(u32x4*)(MG + off) = w; }
    }
};

template <class Epi, class Sched, bool ALIGN_EPI = false, bool SP2 = false>
__device__ __forceinline__ void gemm_phase(PG8_LAS unsigned char* lds, const Gemm g, const Sched& S, const Epi& E, const int wave_id) {
    const int wid = wave_id, lane = lane_id(), tid = wid * 64 + lane, wr = wid >> 2, wc = wid & 3, fr = lane & 15, fq = lane >> 4;
    const int K = g.K, nt = K / BK;
    unsigned voffA[2], voffB[2];
#pragma unroll
    for (int i = 0; i < 2; ++i) { int R, C; stage_rc(tid * 16 + i * 8192, R, C); const int Rb = Epi::PERM ? ((R & ~31) + perm32(R & 31)) : R;
        voffA[i] = (unsigned)(R * K + C) * 2u; voffB[i] = (unsigned)(Rb * K + C) * 2u; }
    const size_t kstep = (size_t)(BK * 2);
    const size_t hstep = (size_t)HALF * K * 2;
    const size_t tstep = 2 * hstep;
    const unsigned ldsw = (unsigned)wid * 1024u;
    const int aoff = lds_byte(wr * 64 + fr, fq * 8), boff = lds_byte(wc * 32 + fr, fq * 8);
#define PG8_SA(b, h) (((b) * 2 + (h)) * HTB)
#define PG8_SB(b, h) ((4 + (b) * 2 + (h)) * HTB)
#define PG8_STAGE(bufoff, gbase, voff) do { _Pragma("unroll") for (int _i = 0; _i < 2; ++_i) \
        __builtin_amdgcn_global_load_lds((const unsigned*)((const char*)(gbase) + (voff)[_i]), (PG8_LAS unsigned*)(lds + (bufoff) + ldsw + _i * 8192), 16, 0, 0); } while (0)
#define PG8_LDA(dst, b, h) do { _Pragma("unroll") for (int m = 0; m < 4; ++m) _Pragma("unroll") for (int k = 0; k < 2; ++k) dst[m][k] = *(const PG8_LAS bf16x8*)(lds + PG8_SA(b, h) + aoff + m * 2048 + k * 1024); } while (0)
#define PG8_LDB(dst, b, h) do { _Pragma("unroll") for (int n = 0; n < 2; ++n) _Pragma("unroll") for (int k = 0; k < 2; ++k) dst[n][k] = *(const PG8_LAS bf16x8*)(lds + PG8_SB(b, h) + boff + n * 2048 + k * 1024); } while (0)
#define PG8_MMA(ai, bj, At, Bt) do { __builtin_amdgcn_s_setprio(1); _Pragma("unroll") for (int m = 0; m < 4; ++m) _Pragma("unroll") for (int n = 0; n < 2; ++n) _Pragma("unroll") for (int k = 0; k < 2; ++k) \
        acc[ai][bj][m][n] = __builtin_amdgcn_mfma_f32_16x16x32_bf16(Bt[n][k], At[m][k], acc[ai][bj][m][n], 0, 0, 0); __builtin_amdgcn_s_setprio(0); } while (0)
#define PG8_WAIT_V(n) asm volatile("s_waitcnt vmcnt(" #n ")" ::: "memory")
#define PG8_WAIT_L(n) asm volatile("s_waitcnt lgkmcnt(" #n ")" ::: "memory")
#define PG8_BAR __builtin_amdgcn_s_barrier()
#define PG8_SCHED __builtin_amdgcn_sched_barrier(0)
    Unit cur, nxt; int ui = 0;
    if (!S.next(0, cur)) return;
    f32x4 acc[2][2][4][2];
#pragma unroll
    for (int a = 0; a < 2; ++a)
#pragma unroll
        for (int b = 0; b < 2; ++b)
#pragma unroll
            for (int m = 0; m < 4; ++m)
#pragma unroll
                for (int n = 0; n < 2; ++n) acc[a][b][m][n] = (f32x4){0.f, 0.f, 0.f, 0.f};
    bf16x8 At[4][2], B0[2][2], B1[2][2];
    const char* cA = (const char*)g.A + (size_t)cur.pm * tstep; const char* cB = (const char*)g.Bt + (size_t)cur.pn * tstep;
    S.a_ready(cur);
    if constexpr (SP2) {
        PG8_STAGE(PG8_SB(0, 0), cB, voffB); PG8_STAGE(PG8_SB(0, 1), cB + hstep, voffB); PG8_STAGE(PG8_SA(0, 0), cA, voffA); PG8_STAGE(PG8_SA(0, 1), cA + hstep, voffA);
        if (wr == 1) PG8_BAR;
        PG8_WAIT_V(2); PG8_BAR;
        PG8_STAGE(PG8_SB(1, 0), cB + kstep, voffB); PG8_STAGE(PG8_SA(1, 0), cA + kstep, voffA); PG8_STAGE(PG8_SB(1, 1), cB + hstep + kstep, voffB);
        PG8_WAIT_V(6); PG8_BAR;
    } else {
        PG8_STAGE(PG8_SB(0, 0), cB, voffB); PG8_STAGE(PG8_SA(0, 0), cA, voffA); PG8_STAGE(PG8_SB(0, 1), cB + hstep, voffB); PG8_STAGE(PG8_SA(0, 1), cA + hstep, voffA);
        if (wr == 1) PG8_BAR;
        PG8_WAIT_V(4); PG8_BAR;
        PG8_STAGE(PG8_SB(1, 0), cB + kstep, voffB); PG8_STAGE(PG8_SA(1, 0), cA + kstep, voffA); PG8_STAGE(PG8_SB(1, 1), cB + hstep + kstep, voffB);
        PG8_WAIT_V(6); PG8_BAR;
    }
    for (;;) {
        const bool has_next = S.next(ui + 1, nxt);
        const char* nA = has_next ? (const char*)g.A + (size_t)nxt.pm * tstep : cA; const char* nB = has_next ? (const char*)g.Bt + (size_t)nxt.pn * tstep : cB;
        for (int t = 0; t < nt; t += 2) {
            const bool last = (t == nt - 2);
            const char* a1 = cA + (size_t)(t + 1) * kstep;
            const char* a2 = last ? nA : cA + (size_t)(t + 2) * kstep; const char* b2 = last ? nB : cB + (size_t)(t + 2) * kstep;
            const char* a3 = a2 + kstep; const char* b3 = b2 + kstep;
            if (last && has_next) S.a_ready(nxt);
            if constexpr (SP2) {
            PG8_LDB(B0, 0, 0); PG8_LDB(B1, 0, 1); PG8_SCHED; PG8_LDA(At, 0, 0); PG8_STAGE(PG8_SA(1, 1), a1 + hstep, voffA);
            PG8_WAIT_V(8); PG8_WAIT_L(0); PG8_BAR; PG8_MMA(0, 0, At, B0); PG8_MMA(0, 1, At, B1); PG8_BAR; PG8_SCHED;
            PG8_LDA(At, 0, 1); PG8_STAGE(PG8_SB(0, 0), b2, voffB); PG8_STAGE(PG8_SB(0, 1), b2 + hstep, voffB); PG8_STAGE(PG8_SA(0, 0), a2, voffA);
            PG8_WAIT_V(8); PG8_WAIT_L(0); PG8_BAR; PG8_MMA(1, 0, At, B0); PG8_MMA(1, 1, At, B1); PG8_BAR; PG8_SCHED;
            PG8_LDB(B0, 1, 0); PG8_LDB(B1, 1, 1); PG8_SCHED; PG8_LDA(At, 1, 0); PG8_STAGE(PG8_SA(0, 1), a2 + hstep, voffA);
            PG8_WAIT_V(8); PG8_WAIT_L(0); PG8_BAR; PG8_MMA(0, 0, At, B0); PG8_MMA(0, 1, At, B1); PG8_BAR; PG8_SCHED;
            PG8_LDA(At, 1, 1); PG8_STAGE(PG8_SB(1, 0), b3, voffB); PG8_STAGE(PG8_SB(1, 1), b3 + hstep, voffB); PG8_STAGE(PG8_SA(1, 0), a3, voffA);
            PG8_WAIT_V(8); PG8_WAIT_L(0); PG8_BAR; PG8_MMA(1, 0, At, B0); PG8_MMA(1, 1, At, B1); PG8_BAR; PG8_SCHED;
            } else {
            PG8_LDB(B0, 0, 0); PG8_SCHED; PG8_LDA(At, 0, 0); PG8_STAGE(PG8_SA(1, 1), a1 + hstep, voffA);
            PG8_WAIT_L(8); PG8_BAR; PG8_WAIT_L(0); PG8_MMA(0, 0, At, B0); PG8_BAR; PG8_SCHED;
            PG8_LDB(B1, 0, 1); PG8_STAGE(PG8_SB(0, 0), b2, voffB);
            PG8_BAR; PG8_WAIT_L(0); PG8_MMA(0, 1, At, B1); PG8_BAR;
            PG8_LDA(At, 0, 1); PG8_STAGE(PG8_SA(0, 0), a2, voffA);
            PG8_BAR; PG8_WAIT_L(0); PG8_MMA(1, 0, At, B0); PG8_BAR; PG8_SCHED;
            PG8_STAGE(PG8_SB(0, 1), b2 + hstep, voffB);
            PG8_WAIT_V(6); PG8_BAR; PG8_MMA(1, 1, At, B1); PG8_BAR;
            PG8_LDB(B0, 1, 0); PG8_SCHED; PG8_LDA(At, 1, 0); PG8_STAGE(PG8_SA(0, 1), a2 + hstep, voffA);
            PG8_WAIT_L(8); PG8_BAR; PG8_WAIT_L(0); PG8_MMA(0, 0, At, B0); PG8_BAR; PG8_SCHED;
            PG8_LDB(B1, 1, 1); PG8_STAGE(PG8_SB(1, 0), b3, voffB);
            PG8_BAR; PG8_WAIT_L(0); PG8_MMA(0, 1, At, B1); PG8_BAR;
            PG8_LDA(At, 1, 1); PG8_STAGE(PG8_SA(1, 0), a3, voffA);
            PG8_BAR; PG8_WAIT_L(0); PG8_MMA(1, 0, At, B0); PG8_BAR; PG8_SCHED;
            PG8_STAGE(PG8_SB(1, 1), b3 + hstep, voffB);
            PG8_WAIT_V(6); PG8_BAR; PG8_MMA(1, 1, At, B1); PG8_BAR;
            }
        }
        if constexpr (ALIGN_EPI) { if (wr == 0) PG8_BAR; }
        if constexpr (!Epi::AFTER_DRAIN) { E(acc, cur, wr, wc, fr, fq); S.done(cur); }
        if (!has_next) break;
#pragma unroll
        for (int a = 0; a < 2; ++a)
#pragma unroll
            for (int b = 0; b < 2; ++b)
#pragma unroll
                for (int m = 0; m < 4; ++m)
#pragma unroll
                    for (int n = 0; n < 2; ++n) acc[a][b][m][n] = (f32x4){0.f, 0.f, 0.f, 0.f};
        cur = nxt; cA = nA; cB = nB; ++ui;
        if constexpr (ALIGN_EPI) { if (wr == 1) PG8_BAR; }
    }
    PG8_WAIT_V(0);
    if constexpr (!ALIGN_EPI) { if (wr == 0) PG8_BAR; }
    PG8_BAR;
    if constexpr (Epi::AFTER_DRAIN) { E.fused(acc, cur, wr, wc, fr, fq, lds, wid, lane); S.done(cur); }
#undef PG8_SA
#undef PG8_SB
#undef PG8_STAGE
#undef PG8_LDA
#undef PG8_LDB
#undef PG8_MMA
#undef PG8_WAIT_V
#undef PG8_WAIT_L
#undef PG8_BAR
#undef PG8_SCHED
}
}
#include <hip/hip_bf16.h>
#include <cmath>
namespace attn_body {
using bf16=__hip_bfloat16;
using bf16x8=__attribute__((ext_vector_type(8)))short;
using s16x4=__attribute__((ext_vector_type(4)))short;
using f32x16=__attribute__((ext_vector_type(16)))float;
using u32x4=__attribute__((ext_vector_type(4)))unsigned;
constexpr int BATCH=2,NHEAD=16,SEQ=8192,D=64,DM=NHEAD*D,KP=512;
constexpr int NW=8,QBLK=32,QB=QBLK*NW,KVBLK=64,NQB=SEQ/QB;
constexpr int ATTN_PITCH=DM, ATTN_UNIT_ROWS=QB;
__device__ __forceinline__ int crow(int r,int hi){return (r&3)+8*(r>>2)+4*hi;}
#define SBAR() __builtin_amdgcn_sched_barrier(0)
__device__ __forceinline__ void cmask(f32x16&p0,f32x16&p1,int jb,int qrel,int hi){
  const float NEG=-INFINITY; int lim=qrel-64*jb-4*hi; asm volatile("":"+v"(lim));
  #pragma unroll
  for(int r=0;r<16;++r){const int cr=(r&3)+8*(r>>2); if(cr>lim)p0[r]=NEG; if(cr+32>lim)p1[r]=NEG;}
}

constexpr int NSLOT=3, SLOTB=8192;
constexpr int LDS_K=0, LDS_V=NSLOT*SLOTB, LDS_WS=2*NSLOT*SLOTB, LDS_OST=LDS_WS+NW*64*4, LDS_BYTES=LDS_OST+NW*4096;
constexpr float C2=0.125f*1.4426950408889634f;
__device__ __forceinline__ void glds16(const void*gsrc,unsigned lds_dst){unsigned keep;
  asm volatile("s_mov_b32 %0, m0\n\ts_mov_b32 m0, %2\n\ts_nop 0\n\tglobal_load_lds_dwordx4 %1, off\n\ts_mov_b32 m0, %0":"=&s"(keep):"v"(gsrc),"s"(lds_dst):"memory");}
__device__ __forceinline__ float max3f(float a,float b,float c){float r;asm("v_max3_f32 %0, %1, %2, %3":"=v"(r):"v"(a),"v"(b),"v"(c));return r;}
__device__ __forceinline__ float max2f(float a,float b){float r;asm("v_max_f32_e32 %0, %1, %2":"=v"(r):"v"(a),"v"(b));return r;}
__device__ __forceinline__ float fadd_s(float a,float b){float r;asm("v_add_f32_e32 %0, %1, %2":"=v"(r):"v"(a),"v"(b));return r;}
__device__ __forceinline__ float fsub_s(float a,float b){float r;asm("v_sub_f32_e32 %0, %1, %2":"=v"(r):"v"(a),"v"(b));return r;}
typedef float f32x2_t __attribute__((ext_vector_type(2))); typedef __bf16 bf16x2_t __attribute__((ext_vector_type(2)));
__device__ __forceinline__ unsigned cvtpk_s(float lo,float hi){f32x2_t v={lo,hi};bf16x2_t b=__builtin_convertvector(v,bf16x2_t);return __builtin_bit_cast(unsigned,b);}
#define WAIT_BAR(N) asm volatile("s_waitcnt vmcnt(" #N ") lgkmcnt(0)\n\ts_barrier":::"memory")

__device__ __forceinline__ void qkt(f32x16&p0,f32x16&p1,const char*Kslot,const bf16x8*qr,const f32x16&negm,int r32,int hi){
  const char*kb=Kslot+hi*1024+r32*16;
  #pragma unroll
  for(int d0=0;d0<4;++d0){
    const bf16x8 b0=*reinterpret_cast<const bf16x8*>(kb+d0*2048);
    const bf16x8 b1=*reinterpret_cast<const bf16x8*>(kb+d0*2048+512);
    if(d0==0){p0=__builtin_amdgcn_mfma_f32_32x32x16_bf16(b0,qr[0],negm,0,0,0);p1=__builtin_amdgcn_mfma_f32_32x32x16_bf16(b1,qr[0],negm,0,0,0);}
    else{p0=__builtin_amdgcn_mfma_f32_32x32x16_bf16(b0,qr[d0],p0,0,0,0);p1=__builtin_amdgcn_mfma_f32_32x32x16_bf16(b1,qr[d0],p1,0,0,0);}}
}
typedef __attribute__((address_space(3))) const char* lds_cptr;
typedef short v4i16_t __attribute__((ext_vector_type(4)));
__device__ __forceinline__ void kload8(bf16x8*kf,lds_cptr kp){
  kf[0]=*(const __attribute__((address_space(3))) bf16x8*)(kp);      kf[1]=*(const __attribute__((address_space(3))) bf16x8*)(kp+512);
  kf[2]=*(const __attribute__((address_space(3))) bf16x8*)(kp+2048); kf[3]=*(const __attribute__((address_space(3))) bf16x8*)(kp+2560);
  kf[4]=*(const __attribute__((address_space(3))) bf16x8*)(kp+4096); kf[5]=*(const __attribute__((address_space(3))) bf16x8*)(kp+4608);
  kf[6]=*(const __attribute__((address_space(3))) bf16x8*)(kp+6144); kf[7]=*(const __attribute__((address_space(3))) bf16x8*)(kp+6656);
}
__device__ __forceinline__ void kload2(bf16x8*kf,lds_cptr kp,int j){ kf[2*j]=*(const __attribute__((address_space(3))) bf16x8*)(kp+j*2048); kf[2*j+1]=*(const __attribute__((address_space(3))) bf16x8*)(kp+j*2048+512); }
__device__ __forceinline__ s16x4 vtr(lds_cptr p){ return __builtin_bit_cast(s16x4,__builtin_amdgcn_ds_read_tr16_b64_v4i16((__attribute__((address_space(3))) v4i16_t*)p)); }
__device__ __forceinline__ float rowmax(const f32x16&p0,const f32x16&p1){
  float a=max3f(p0[0],p0[1],p1[0]),b=max3f(p0[2],p0[3],p1[1]);a=max3f(a,p1[2],p1[3]);
  #pragma unroll
  for(int r=4;r<16;r+=4){a=max3f(a,p0[r],p0[r+1]);b=max3f(b,p0[r+2],p0[r+3]);a=max3f(a,p1[r],p1[r+1]);b=max3f(b,p1[r+2],p1[r+3]);}
  const float m=max2f(a,b);
  auto rr=__builtin_amdgcn_permlane32_swap(__float_as_uint(m),__float_as_uint(m),false,false);
  return max2f(__uint_as_float(rr[0]),__uint_as_float(rr[1]));
}
__device__ __forceinline__ void pv(f32x16*o,int vb,bf16x8 pa0,bf16x8 pa1,bf16x8 pa2,bf16x8 pa3){
  #pragma unroll
  for(int d0=0;d0<2;++d0){s16x4 lo[4],hi[4];
    #pragma unroll
    for(int ks=0;ks<4;++ks){
      asm volatile("ds_read_b64_tr_b16 %0,%1 offset:%c2":"=&v"(lo[ks]):"v"(vb),"i"(d0*4096+ks*1024):"memory");
      asm volatile("ds_read_b64_tr_b16 %0,%1 offset:%c2":"=&v"(hi[ks]):"v"(vb),"i"(d0*4096+ks*1024+512):"memory");}
    asm volatile("s_waitcnt lgkmcnt(0)":::"memory");SBAR();
    #define PK(k) (bf16x8){lo[k][0],lo[k][1],lo[k][2],lo[k][3],hi[k][0],hi[k][1],hi[k][2],hi[k][3]}
    o[d0]=__builtin_amdgcn_mfma_f32_32x32x16_bf16(pa0,PK(0),o[d0],0,0,0);
    o[d0]=__builtin_amdgcn_mfma_f32_32x32x16_bf16(pa1,PK(1),o[d0],0,0,0);
    o[d0]=__builtin_amdgcn_mfma_f32_32x32x16_bf16(pa2,PK(2),o[d0],0,0,0);
    o[d0]=__builtin_amdgcn_mfma_f32_32x32x16_bf16(pa3,PK(3),o[d0],0,0,0);
    #undef PK
  }
}

#ifndef ATTN_STORE16
#define ATTN_STORE16(p,v) (*(u32x4*)(p)=(v))
#endif
template<int THRL> __device__ __forceinline__ void attn_unit(int b,int h,int qb,const bf16*Q,const bf16*__restrict__ K,const bf16*__restrict__ V,bf16*O,char*shm,const int wave_id){
  const int wid=wave_id,lane=lane_id(),tid=wid*64+lane,r32=lane&31,hi=lane>>5;
  const long rowbase=(long)b*SEQ; const int q0=qb*QB;
  const bf16*Qw=Q+(rowbase+q0+wid*QBLK)*DM+h*D;
  const bf16*Kh=K+rowbase*KP+(h>>1)*D,*Vh=V+rowbase*KP+(h>>2)*128+(h&1)*D;
  const unsigned lds0=(unsigned)(uintptr_t)shm;
  float*wsf=(float*)(shm+LDS_WS)+wid*64;
  const bf16*ksrc=Kh+(long)lane*KP+wid*8;
  const bf16*vsrc=Vh+(long)(16*(wid&3)+(lane>>2))*KP+(wid>>2)*32+(lane&3)*8;
  const unsigned kdst=lds0+LDS_K+wid*1024, vdst=lds0+LDS_V+wid*1024;
  #define DMA_K(t,slot) glds16(ksrc+(long)(t)*KVBLK*KP,(unsigned)__builtin_amdgcn_readfirstlane(kdst+(slot)))
  #define DMA_V(t,slot) glds16(vsrc+(long)(t)*KVBLK*KP,(unsigned)__builtin_amdgcn_readfirstlane(vdst+(slot)))
  const int vb0=(int)(lds0+LDS_V)+((lane>>4)&1)*32+(lane&3)*8+(4*hi+((lane&15)>>2))*64;
  const char*Kbase=shm+LDS_K; bf16x8 kf[8];
  const lds_cptr shm3=(lds_cptr)shm; const lds_cptr kp0=shm3+LDS_K+hi*1024+r32*16; const lds_cptr vp0=shm3+LDS_V+((lane>>4)&1)*32+(lane&3)*8+(4*hi+((lane&15)>>2))*64;
  const int NT=(q0+QB)/KVBLK;
  DMA_K(0,0);DMA_V(0,0);DMA_K(1,SLOTB);
  bf16x8 qr[4];
  #pragma unroll
  for(int d0=0;d0<4;++d0)qr[d0]=*reinterpret_cast<const bf16x8*>(&Qw[(long)r32*DM+d0*16+hi*8]);
  float mhat=0.f,l_reg=0.f;f32x16 o[2];o[0]=f32x16{};o[1]=f32x16{};const f32x16 negm=f32x16{};
  const int qrel=wid*QBLK+r32;
  const unsigned slb_=0x3eb8aa3bu-((unsigned)__builtin_amdgcn_readfirstlane(h>>2)<<24); const float sl2=__uint_as_float(slb_);
  const float qposf=(float)(q0+qrel-4*hi);
  const float s1_=sl2, s8_=__uint_as_float(slb_+(3u<<23)), s32_=__uint_as_float(slb_+(5u<<23));
  #define AADD(d,a,sv) asm volatile("v_add_f32_e32 %0, %1, %2":"=v"(d):"s"(sv),"v"(a))
  #define ALIBI(P0,P1,t) do{ float bq_=__builtin_fmaf(sl2,((float)(64*(t))-qposf),-mhat); \
    _Pragma("unroll") for(int q_=0;q_<4;++q_){ float b0_=bq_,b1_,b2_,b3_,c_; AADD(b1_,b0_,s1_); AADD(b2_,b1_,s1_); AADD(b3_,b2_,s1_); \
      P0[4*q_]+=b0_; P0[4*q_+1]+=b1_; P0[4*q_+2]+=b2_; P0[4*q_+3]+=b3_; \
      AADD(c_,b0_,s32_); P1[4*q_]+=c_; AADD(c_,b1_,s32_); P1[4*q_+1]+=c_; AADD(c_,b2_,s32_); P1[4*q_+2]+=c_; AADD(c_,b3_,s32_); P1[4*q_+3]+=c_; \
      if(q_<3){ AADD(bq_,b0_,s8_); } } }while(0)
  #define CMASK(P0,P1,t) do{int jb_=(t)-(NT-4); if(jb_>=0)cmask(P0,P1,jb_,qrel,hi);}while(0)
  bool resc=false;
  #define START(P0,P1) do{ const float rm=rowmax(P0,P1); resc=false; \
    { const float dl=rm; mhat=fadd_s(mhat,dl); \
      _Pragma("unroll") for(int r=0;r<16;++r){P0[r]=fsub_s(P0[r],dl);P1[r]=fsub_s(P1[r],dl);} \
      } \
    _Pragma("unroll") for(int r=0;r<16;++r)P0[r]=__builtin_amdgcn_exp2f(P0[r]); }while(0)
  #define RESC() do{ if(resc){ asm volatile("s_waitcnt lgkmcnt(0)":::"memory"); \
      _Pragma("unroll") for(int d_=0;d_<2;++d_) _Pragma("unroll") for(int r=0;r<16;++r)o[d_][r]*=wsf[crow(r,hi)]; } }while(0)
  f32x16 pA0,pA1,pB0,pB1;
  int sl_prev=0,sl_cur=0,sl_next=SLOTB;
  #define ROT() do{sl_prev=sl_cur;sl_cur=sl_next;sl_next=(sl_next==(NSLOT-1)*SLOTB)?0:sl_next+SLOTB;}while(0)
  DMA_K(2,2*SLOTB);
  WAIT_BAR(3);
  qkt(pA0,pA1,Kbase,qr,negm,r32,hi);asm volatile("s_nop 15\n\ts_nop 7":"+v"(pA0),"+v"(pA1));ALIBI(pA0,pA1,0);CMASK(pA0,pA1,0);
  START(pA0,pA1);
  _Pragma("unroll") for(int r=0;r<16;++r)pA1[r]=__builtin_amdgcn_exp2f(pA1[r]);
  WAIT_BAR(0);
  DMA_K(3,0);DMA_V(1,SLOTB);
  ROT();
  kload8(kf,kp0+sl_cur);
  WAIT_BAR(2);
  s16x4 vlo[8],vhi[8]; u32x4 pw0,pw1,pw2,pw3;
  #define PKW(P,B) cvtpk_s(P[B],P[B+1])
  #define PAF(k) __builtin_bit_cast(bf16x8,pw##k)
  #define VFR(i) (bf16x8){vlo[i][0],vlo[i][1],vlo[i][2],vlo[i][3],vhi[i][0],vhi[i][1],vhi[i][2],vhi[i][3]}
  #define PIN(x) asm volatile("":"+v"(x))
  #define MX3(a,b,c) __builtin_fmaxf(__builtin_fmaxf((a),(b)),(c))
  #define GAPA(MF,A0,A1,A2,A3,W0,W1,PW) do{ MF; sacc+=A0; sacc+=A1; sacc+=A2; sacc+=A3; PIN(sacc); W0; W1; PIN(PW); SBAR(); }while(0)
  #define EX(v) __builtin_amdgcn_exp2f(v)
  #define GAPB(MF,X,B) do{ MF; X[B]=EX(X[B]); X[B+1]=EX(X[B+1]); X[B+2]=EX(X[B+2]); X[B+3]=EX(X[B+3]); PIN(X); SBAR(); }while(0)
  #define VRD(i) do{ vlo[i]=vtr(vp_+(((i)>>2)*4096+((i)&3)*1024)); vhi[i]=vtr(vp_+(((i)>>2)*4096+((i)&3)*1024+512)); }while(0)
  #define KRD(G,j) do{ if(G){ kload2(kf,kp0+sl_next,j); SBAR(); } }while(0)
  #define STEP(C0,C1,P0,P1,t,GK,GV,GL) do{ SBAR(); \
    const lds_cptr vp_=vp0+sl_prev; \
    VRD(0); SBAR(); float sacc=(P0[0]+P0[1]); \
    GAPA(C0=__builtin_amdgcn_mfma_f32_32x32x16_bf16(kf[0],qr[0],negm,0,0,0), P0[2],P0[3],P0[4],P0[5],     pw0[0]=PKW(P0,0), pw0[1]=PKW(P0,2), pw0); \
    VRD(4); SBAR(); GAPA(C1=__builtin_amdgcn_mfma_f32_32x32x16_bf16(kf[1],qr[0],negm,0,0,0), P0[6],P0[7],P0[8],P0[9],     pw0[2]=PKW(P0,4), pw0[3]=PKW(P0,6), pw0); \
    VRD(1); SBAR(); GAPA(C0=__builtin_amdgcn_mfma_f32_32x32x16_bf16(kf[2],qr[1],C0,0,0,0),   P0[10],P0[11],P0[12],P0[13], pw1[0]=PKW(P0,8), pw1[1]=PKW(P0,10), pw1); \
    VRD(5); SBAR(); GAPA(C1=__builtin_amdgcn_mfma_f32_32x32x16_bf16(kf[3],qr[1],C1,0,0,0),   P0[14],P0[15],P1[0],P1[1],   pw1[2]=PKW(P0,12),pw1[3]=PKW(P0,14), pw1); \
    VRD(2); SBAR(); GAPA(C0=__builtin_amdgcn_mfma_f32_32x32x16_bf16(kf[4],qr[2],C0,0,0,0),   P1[2],P1[3],P1[4],P1[5],     pw2[0]=PKW(P1,0), pw2[1]=PKW(P1,2), pw2); \
    VRD(6); SBAR(); GAPA(C1=__builtin_amdgcn_mfma_f32_32x32x16_bf16(kf[5],qr[2],C1,0,0,0),   P1[6],P1[7],P1[8],P1[9],     pw2[2]=PKW(P1,4), pw2[3]=PKW(P1,6), pw2); \
    VRD(3); SBAR(); GAPA(C0=__builtin_amdgcn_mfma_f32_32x32x16_bf16(kf[6],qr[3],C0,0,0,0),   P1[10],P1[11],P1[12],P1[13], pw3[0]=PKW(P1,8), pw3[1]=PKW(P1,10), pw3); \
    VRD(7); SBAR(); GAPA(C1=__builtin_amdgcn_mfma_f32_32x32x16_bf16(kf[7],qr[3],C1,0,0,0),   P1[14],P1[15],0.f,0.f,       pw3[2]=PKW(P1,12),pw3[3]=PKW(P1,14), pw3); \
    l_reg+=sacc; \
    if(GK){DMA_K((t)+3,sl_cur);} if(GV){DMA_V((t)+1,sl_next);} \
    ALIBI(C0,C1,t); CMASK(C0,C1,t); \
    { float a=MX3(C0[0],C0[1],C1[0]),b=MX3(C0[2],C0[3],C1[1]); a=MX3(a,C1[2],C1[3]); \
      _Pragma("unroll") for(int r=4;r<16;r+=4){a=MX3(a,C0[r],C0[r+1]);b=MX3(b,C0[r+2],C0[r+3]);a=MX3(a,C1[r],C1[r+1]);b=MX3(b,C1[r+2],C1[r+3]);} \
      float rm=__builtin_fmaxf(a,b); { auto rr=__builtin_amdgcn_permlane32_swap(__float_as_uint(rm),__float_as_uint(rm),false,false); rm=__builtin_fmaxf(__uint_as_float(rr[0]),__uint_as_float(rr[1])); } \
      resc=false; \
      if(__builtin_expect(__any(rm>(float)THRL),0)){ const float dl=__builtin_fmaxf(rm,0.f); mhat+=dl; \
        _Pragma("unroll") for(int r=0;r<16;++r){C0[r]-=dl;C1[r]-=dl;} \
        const float f=__builtin_amdgcn_exp2f(-dl); l_reg*=f; if(hi==0)wsf[r32]=f; resc=true; } } \
    SBAR(); \
    GAPB(o[0]=__builtin_amdgcn_mfma_f32_32x32x16_bf16(PAF(0),VFR(0),o[0],0,0,0), C0,0); \
    GAPB(o[1]=__builtin_amdgcn_mfma_f32_32x32x16_bf16(PAF(0),VFR(4),o[1],0,0,0), C0,4); \
    KRD(GL,0); GAPB(o[0]=__builtin_amdgcn_mfma_f32_32x32x16_bf16(PAF(1),VFR(1),o[0],0,0,0), C0,8); \
    KRD(GL,1); GAPB(o[1]=__builtin_amdgcn_mfma_f32_32x32x16_bf16(PAF(1),VFR(5),o[1],0,0,0), C0,12); \
    KRD(GL,2); GAPB(o[0]=__builtin_amdgcn_mfma_f32_32x32x16_bf16(PAF(2),VFR(2),o[0],0,0,0), C1,0); \
    KRD(GL,3); GAPB(o[1]=__builtin_amdgcn_mfma_f32_32x32x16_bf16(PAF(2),VFR(6),o[1],0,0,0), C1,4); \
    GAPB(o[0]=__builtin_amdgcn_mfma_f32_32x32x16_bf16(PAF(3),VFR(3),o[0],0,0,0), C1,8); \
    GAPB(o[1]=__builtin_amdgcn_mfma_f32_32x32x16_bf16(PAF(3),VFR(7),o[1],0,0,0), C1,12); \
    }while(0)
  int t=1;
  #undef CMASK
  #define CMASK(P0,P1,t) do{}while(0)
  for(;t+5<NT;t+=2){
    STEP(pB0,pB1,pA0,pA1,t,true,true,true);     WAIT_BAR(2); RESC(); ROT();
    STEP(pA0,pA1,pB0,pB1,t+1,true,true,true);   WAIT_BAR(2); RESC(); ROT();
  }
  #undef CMASK
  #define CMASK(P0,P1,t) do{int jb_=(t)-(NT-4); if(jb_>=0)cmask(P0,P1,jb_,qrel,hi);}while(0)
  #define ENDW(tt) do{ if((tt)+3<NT){WAIT_BAR(2);} else if((tt)+2<NT){WAIT_BAR(1);} else {WAIT_BAR(0);} }while(0)
  for(;t+1<NT;t+=2){
    STEP(pB0,pB1,pA0,pA1,t,(t+3<NT),(t+1<NT),(t+1<NT));       ENDW(t);   RESC(); ROT();
    STEP(pA0,pA1,pB0,pB1,t+1,(t+4<NT),(t+2<NT),(t+2<NT));     ENDW(t+1); RESC(); ROT();
  }
  STEP(pB0,pB1,pA0,pA1,NT-1,false,false,false); RESC();
  { float sacc=pB0[0]+pB0[1]; _Pragma("unroll") for(int r=2;r<16;++r)sacc+=pB0[r]; _Pragma("unroll") for(int r=0;r<16;++r)sacc+=pB1[r]; l_reg+=sacc;
    pw0=(u32x4){PKW(pB0,0),PKW(pB0,2),PKW(pB0,4),PKW(pB0,6)};pw1=(u32x4){PKW(pB0,8),PKW(pB0,10),PKW(pB0,12),PKW(pB0,14)};pw2=(u32x4){PKW(pB1,0),PKW(pB1,2),PKW(pB1,4),PKW(pB1,6)};pw3=(u32x4){PKW(pB1,8),PKW(pB1,10),PKW(pB1,12),PKW(pB1,14)};
    SBAR(); pv(o,vb0+sl_cur,PAF(0),PAF(1),PAF(2),PAF(3)); }
  #undef PKW
  #undef PAF
  #undef VFR
  #undef PIN
  #undef MX3
  #undef GAPA
  #undef GAPB
  #undef EX
  #undef VRD
  #undef KRD
  #undef STEP
  #undef ENDW
  {auto rr=__builtin_amdgcn_permlane32_swap(__float_as_uint(l_reg),__float_as_uint(l_reg),false,false);l_reg=__uint_as_float(rr[0])+__uint_as_float(rr[1]);}
  if(hi==0)wsf[32+r32]=l_reg;asm volatile("s_waitcnt lgkmcnt(0)":::"memory");
  float rli[16];
  #pragma unroll
  for(int r=0;r<16;++r)rli[r]=__builtin_amdgcn_rcpf(wsf[32+crow(r,hi)]);
  bf16*Ow=O+(rowbase+q0+wid*QBLK)*DM+h*D;
  { bf16*stg=(bf16*)(shm+LDS_OST)+wid*2048;
    #pragma unroll
    for(int r=0;r<16;++r){const int orow=crow(r,hi);
      #pragma unroll
      for(int d0=0;d0<2;++d0)stg[orow*64+d0*32+r32]=__float2bfloat16(o[d0][r]*rli[r]);}
    asm volatile("s_waitcnt lgkmcnt(0)":::"memory");
    #pragma unroll
    for(int i=0;i<4;++i){const int row=i*8+(lane>>3),ch=lane&7; const u32x4 v=*(const u32x4*)(stg+row*64+ch*8); ATTN_STORE16(Ow+(long)row*DM+ch*8,v);} }
  asm volatile("s_waitcnt lgkmcnt(0)\n\ts_barrier":::"memory");
  #undef ALIBI
  #undef AADD
  #undef DMA_K
  #undef DMA_V
  #undef CMASK
  #undef START
  #undef RESC
  #undef ROT
}
constexpr int ATTN_LDS_BYTES=LDS_BYTES;
struct AttnTensors { const bf16* Q; const bf16* K; const bf16* V; bf16* O; };
struct AttnUnit { int bh; int qb; };
struct StaticOrder {
  int vcu;
  __device__ __forceinline__ explicit StaticOrder(int grid,int block):vcu((block%8)*(grid/8)+block/8){}
  __device__ __forceinline__ bool next(int i,AttnUnit&u)const{ if(i>=4)return false; const int s=vcu&7; u.bh=vcu>>3; u.qb=(i==0)?s:(i==1)?15-s:(i==2)?16+s:31-s; return true; }
  __device__ __forceinline__ void a_ready(const AttnUnit&)const{}
  __device__ __forceinline__ void done(const AttnUnit&)const{}
};
template<class Sched,int THRL=8> __device__ __forceinline__ void attn_phase(char*lds,const AttnTensors&T,const Sched&S,const int wave_id){
  AttnUnit u;
  for(int i=0;S.next(i,u);++i){ S.a_ready(u); attn_unit<THRL>(u.bh/NHEAD,u.bh%NHEAD,u.qb,T.Q,T.K,T.V,T.O,lds,wave_id); S.done(u); }
}
#undef SBAR
#undef WAIT_BAR
}
constexpr int NWAVES = 8;
constexpr int BATCH = 2, T = 8192, D = 1024, FF = 2816, M = BATCH * T;
constexpr int WIN_SRC = 5648, WIN_N = 3840;
constexpr float RMS_EPS = 1e-6f, SUBLN_EPS = 1e-5f;
constexpr size_t MiB = 1u << 20;
constexpr size_t WS_SSQA = 1 * MiB, WS_SSQB = 2 * MiB, WS_DNCD = 3 * MiB;
constexpr size_t WS_WG = 4 * MiB, WS_WA = 8 * MiB, WS_WB = 9 * MiB, WS_WOUT = 10 * MiB;
constexpr size_t WS_XB = 12 * MiB;
constexpr size_t WS_H = 44 * MiB;
constexpr size_t WS_WGU1 = 232 * MiB, WS_WD1 = 243 * MiB, WS_WIN = 248 * MiB + 512 * 1024;
constexpr size_t WS_PRE = 44 * MiB, WS_Z = 92 * MiB, WS_QO = 108 * MiB, WS_KD = 140 * MiB, WS_VD = 156 * MiB, WS_AB = 172 * MiB;
constexpr size_t WS_DN = 173 * MiB;
constexpr size_t WS_ODN = 44 * MiB, WS_AA = 60 * MiB, WS_ABB = 76 * MiB;
constexpr size_t WS_WGU2 = 173 * MiB, WS_WD2 = 184 * MiB;
constexpr size_t WS_YA = 190 * MiB, WS_YB = 222 * MiB, WS_MG = 108 * MiB;
constexpr size_t WS_END = 256 * MiB;
constexpr int DN_REC = 40960;
static_assert(WS_DN + (size_t)2048 * DN_REC <= WS_END && WS_WIN + (size_t)WIN_N * D * 2 <= WS_END && WS_YB + (size_t)M * D * 2 <= WS_END, "d_ws map");

constexpr int RING_OFF = 0, RING_BYTES = 147456;
constexpr int MISC_OFF = 147456, LDS_BYTES = 147456 + 256;

#define LAS __attribute__((address_space(3)))
typedef unsigned short bf16;
typedef unsigned v4u __attribute__((ext_vector_type(4)));
typedef float f32x4 __attribute__((ext_vector_type(4)));
typedef float f32x16 __attribute__((ext_vector_type(16)));
typedef short bf16x8 __attribute__((ext_vector_type(8)));
#define LDSFENCE() asm volatile("s_waitcnt lgkmcnt(0)" ::: "memory")
__device__ __forceinline__ unsigned f2bf(float f) { unsigned u = __builtin_bit_cast(unsigned, f); return (u + 0x7fffu + ((u >> 16) & 1u)) >> 16; }
__device__ __forceinline__ unsigned pk2(float lo, float hi) { return f2bf(lo) | (f2bf(hi) << 16); }
__device__ __forceinline__ float bflo(unsigned w) { return __uint_as_float(w << 16); }
__device__ __forceinline__ float bfhi(unsigned w) { return __uint_as_float(w & 0xffff0000u); }
__device__ __forceinline__ float wave_sum(float v) {
#pragma unroll
    for (int o = 1; o < 64; o <<= 1) v += __shfl_xor(v, o);
    return v;
}

#define GAS __attribute__((address_space(1)))
typedef GAS unsigned gu32;
#define RLX_AGENT __ATOMIC_RELAXED, __HIP_MEMORY_SCOPE_AGENT
constexpr size_t WS_CTL = 0, CTL_ZERO_BYTES = 65536;
constexpr int CW_BAR = 1024;
#define XB_TMO      128
#define XB_XCNT(j)  (256  + 64 * (j))
#define XB_XSUB(j)  (1280 + 64 * (j))
#define XB_XGEN(j)  (2304 + 64 * (j))
#define XB_TOP      3328
#define XB_TOPGEN   3392
#define XCD_BAR_WORDS 3456
#define XB_SPIN_CAP (1u << 18)

__device__ __forceinline__ unsigned xb_ld(unsigned* p)              { return __hip_atomic_load(p, __ATOMIC_RELAXED, __HIP_MEMORY_SCOPE_AGENT); }
__device__ __forceinline__ unsigned xb_add(unsigned* p, unsigned v) { return __hip_atomic_fetch_add(p, v, __ATOMIC_RELAXED, __HIP_MEMORY_SCOPE_AGENT); }
__device__ __forceinline__ unsigned xb_xcc_id() { return (unsigned)__builtin_amdgcn_s_getreg((3 << 11) | 20) & 0xFu; }
#define XB_SPIN(cond, bar) do { unsigned _sp = 0; while (cond) { __builtin_amdgcn_s_sleep(1); \
    if ((++_sp & 255u) == 0u) { if (xb_ld(&(bar)[XB_TMO])) break; if (_sp > XB_SPIN_CAP) { atomicAdd(&(bar)[XB_TMO], 1u); break; } } } } while (0)

struct XcdBarrier {
    unsigned* bar; unsigned x; int wave;
    volatile LAS unsigned* st;
};

__device__ __forceinline__ XcdBarrier xcd_barrier_post(unsigned* bar, volatile LAS unsigned* st, int wave) {
    XcdBarrier b; b.bar = bar; b.x = xb_xcc_id(); b.st = st; b.wave = wave;
    if (wave == 0 && lane_id() == 0) (void)xb_add(&bar[XB_XCNT(b.x)], 1u);
    return b;
}
__device__ __forceinline__ void xcd_barrier_complete(unsigned* bar, unsigned x, unsigned& nloc, unsigned& nx) {
    const unsigned G = gridDim.x * gridDim.y * gridDim.z;
    unsigned sum, cnt, mine, sp = 0u;
    for (;;) {
        sum = 0u; cnt = 0u; mine = 0u;
#pragma unroll
        for (unsigned j = 0; j < 16; ++j) { const unsigned c = xb_ld(&bar[XB_XCNT(j)]); sum += c; cnt += (c > 0u) ? 1u : 0u; mine = (j == x) ? c : mine; }
        if (sum == G) break;
        __builtin_amdgcn_s_sleep(1);
        if ((++sp & 255u) == 0u) { if (xb_ld(&bar[XB_TMO])) break; if (sp > XB_SPIN_CAP) { atomicAdd(&bar[XB_TMO], 1u); break; } }
    }
    nloc = mine > 0u ? mine : 1u; nx = cnt > 0u ? cnt : 1u;
}

__device__ __forceinline__ void xcd_barrier(const XcdBarrier& b) {
    asm volatile("s_waitcnt vmcnt(0)" ::: "memory");
    __syncthreads();
    if (b.wave == 0 && lane_id() == 0) {
        unsigned* bar = b.bar;
        __builtin_amdgcn_s_waitcnt(0);
        unsigned nloc = b.st[0], nx = b.st[1];
        if (nloc == 0u) { xcd_barrier_complete(bar, b.x, nloc, nx); b.st[0] = nloc; b.st[1] = nx; }
        const unsigned old = xb_add(&bar[XB_XSUB(b.x)], 1u);
        const unsigned gen = old / nloc;
        if (old + 1u == (gen + 1u) * nloc) {
            __builtin_amdgcn_fence(__ATOMIC_RELEASE, "agent");
            asm volatile("s_waitcnt vmcnt(0)" ::: "memory");
            const unsigned og = xb_add(&bar[XB_TOP], 1u);
            const unsigned tg = og / nx;
            if (og + 1u == (tg + 1u) * nx) xb_add(&bar[XB_TOPGEN], 1u);
            else XB_SPIN(xb_ld(&bar[XB_TOPGEN]) == tg, bar);
            __builtin_amdgcn_fence(__ATOMIC_ACQUIRE, "agent");
            xb_add(&bar[XB_XGEN(b.x)], 1u);
            asm volatile("s_waitcnt vmcnt(0)" ::: "memory");
        } else {
            XB_SPIN(xb_ld(&bar[XB_XGEN(b.x)]) == gen, bar);
            __builtin_amdgcn_fence(__ATOMIC_ACQUIRE, "agent");
            asm volatile("s_waitcnt vmcnt(0)" ::: "memory");
        }
    }
    __syncthreads();
}

struct Ctx {
    const float* const* in; float* out; unsigned char* ws;
    LAS unsigned char* lds; int wave, G, vcu;
};

__device__ __forceinline__ void conv_item(const float* W, int ldw, int scol0, int nvalid, const float* gain, bf16* WT, int K, int drow0, int k0, LAS float* scr, int lane) {
#pragma unroll 8
    for (int i = 0; i < 32; ++i) { const int kk = 2 * i + (lane >> 5), n = lane & 31; float v = (n < nvalid) ? W[(size_t)(k0 + kk) * ldw + scol0 + n] : 0.f; if (gain) v *= gain[k0 + kk]; scr[kk * 33 + n] = v; }
    LDSFENCE();
    const int c = lane & 7;
#pragma unroll
    for (int j = 0; j < 4; ++j) { const int n = (lane >> 3) + 8 * j; const LAS float* s = scr + (8 * c) * 33 + n;
        v4u o; o.x = pk2(s[0 * 33], s[1 * 33]); o.y = pk2(s[2 * 33], s[3 * 33]); o.z = pk2(s[4 * 33], s[5 * 33]); o.w = pk2(s[6 * 33], s[7 * 33]);
        *(v4u*)(WT + (size_t)(drow0 + n) * K + k0 + 8 * c) = o; }
    LDSFENCE();
}
__device__ __forceinline__ void conv_gu(const float* wg, const float* wu, const float* gain, bf16* WT, int it, LAS float* scr, int lane) {
    const int db = it >> 4, kb = it & 15, tile = db >> 3, w = db & 7;
    conv_item(w < 4 ? wg : wu, FF, 128 * tile + 32 * (w & 3), 32, gain, WT, D, 32 * db, 64 * kb, scr, lane);
}
__device__ __forceinline__ void conv_plain(const float* W, int K, int N, bf16* WT, int it, LAS float* scr, int lane) {
    const int nkb = K / 64, db = it / nkb, kb = it % nkb;
    conv_item(W, N, 32 * db, 32, nullptr, WT, K, 32 * db, 64 * kb, scr, lane);
}
__device__ __forceinline__ void conv_win(const float* W, const float* gain, bf16* WT, int it, LAS float* scr, int lane) {
    const int db = it >> 4, kb = it & 15, d0 = 32 * db; int sc, nv = 32;
    if (d0 < 2048) sc = d0; else if (d0 < 3584) sc = d0 + 16; else if (d0 == 3584) { sc = 2048; nv = 16; } else { sc = 0; nv = 0; }
    conv_item(W, WIN_SRC, sc, nv, gain, WT, D, d0, 64 * kb, scr, lane);
}
__device__ __forceinline__ void conv_wg(const float* W, const float* gain, bf16* WT, int it, LAS float* scr, int lane) {
    const int db = it >> 4, kb = it & 15, tile = db >> 3, w = db & 7;
    conv_item(W, WIN_SRC, 3600 + (w < 4 ? 0 : 1024) + 128 * tile + 32 * (w & 3), 32, gain, WT, D, 32 * db, 64 * kb, scr, lane);
}

__device__ __forceinline__ void p0_prologue(Ctx& F) {
    const int lane = lane_id();
    LAS float* scr = (LAS float*)(F.lds + RING_OFF + F.wave * 17408);
    const int gw = F.vcu * NWAVES + F.wave, NGW = F.G * NWAVES;
    bf16* ws16 = (bf16*)F.ws;
    constexpr int I_GU = 176 * 16, I_DN = 32 * 44, I_WIN = 120 * 16, I_WG = 64 * 16, I_AB = 32 * 8, I_WO = 32 * 16;
    constexpr int NIT = I_GU + I_DN + I_WIN + I_WG + 2 * I_AB + I_WO;
    for (int it = gw; it < NIT; it += NGW) {
        int r = it;
        if (r < I_GU) { conv_gu(F.in[2], F.in[3], F.in[1], (bf16*)(F.ws + WS_WGU1), r, scr, lane); continue; } r -= I_GU;
        if (r < I_DN) { conv_plain(F.in[4], FF, D, (bf16*)(F.ws + WS_WD1), r, scr, lane); continue; } r -= I_DN;
        if (r < I_WIN) { conv_win(F.in[6], F.in[5], (bf16*)(F.ws + WS_WIN), r, scr, lane); continue; } r -= I_WIN;
        if (r < I_WG) { conv_wg(F.in[6], F.in[5], (bf16*)(F.ws + WS_WG), r, scr, lane); continue; } r -= I_WG;
        if (r < I_AB) { conv_plain(F.in[16], 512, D, (bf16*)(F.ws + WS_WA), r, scr, lane); continue; } r -= I_AB;
        if (r < I_AB) { conv_plain(F.in[17], 512, D, (bf16*)(F.ws + WS_WB), r, scr, lane); continue; } r -= I_AB;
        conv_plain(F.in[18], D, D, (bf16*)(F.ws + WS_WOUT), r, scr, lane);
    }
    (void)ws16;
    const float* x = F.in[0]; bf16* xb = (bf16*)(F.ws + WS_XB); float* ssq = (float*)(F.ws + WS_SSQA);
    for (int m = gw; m < M; m += NGW) {
        const f32x4* xr = (const f32x4*)(x + (size_t)m * D) + lane; unsigned long long* o8 = (unsigned long long*)(xb + (size_t)m * D) + lane;
        float s = 0.f;
#pragma unroll
        for (int j = 0; j < 4; ++j) { const f32x4 v = xr[64 * j]; s += (v.x * v.x + v.y * v.y) + (v.z * v.z + v.w * v.w);
            o8[64 * j] = (unsigned long long)pk2(v.x, v.y) | ((unsigned long long)pk2(v.z, v.w) << 32); }
        s = wave_sum(s);
        if (lane < 16) ssq[(size_t)m * 16 + lane] = (lane == 0) ? s : 0.f;
    }
}
__device__ __forceinline__ void conv_ffn2(Ctx& F) {
    const int lane = lane_id();
    LAS float* scr = (LAS float*)(F.lds + RING_OFF + F.wave * 17408);
    const int gw = F.vcu * NWAVES + F.wave, NGW = F.G * NWAVES;
    constexpr int I_GU = 176 * 16, I_DN = 32 * 44;
    for (int it = gw; it < I_GU + I_DN; it += NGW) {
        if (it < I_GU) conv_gu(F.in[20], F.in[21], F.in[19], (bf16*)(F.ws + WS_WGU2), it, scr, lane);
        else conv_plain(F.in[22], FF, D, (bf16*)(F.ws + WS_WD2), it - I_GU, scr, lane);
    }
}

__device__ __forceinline__ float silu_acc(float v) { return v / (1.0f + __expf(-v)); }
typedef unsigned u32x2 __attribute__((ext_vector_type(2)));
__device__ __forceinline__ void dn_conv_l1(const bf16* PRE, const float* cw, long row0, int tin0, int colbase, int r, int hh, float (&y)[2][4][8]) {
#pragma unroll
    for (int s = 0; s < 4; ++s) {
        const int ch0 = colbase + 16 * s + 4 * hh;
        f32x4 wl[4], wh[4];
#pragma unroll
        for (int j = 0; j < 4; ++j) { wl[j] = *(const f32x4*)(cw + j * 1536 + ch0); wh[j] = *(const f32x4*)(cw + j * 1536 + ch0 + 8); }
#pragma unroll
        for (int i = 0; i < 2; ++i) { const int tok = r + 32 * i, tin = tin0 + tok; const long row = row0 + tok;
            float a[8];
#pragma unroll
            for (int e = 0; e < 8; ++e) a[e] = 0.f;
#pragma unroll
            for (int j = 0; j < 4; ++j) { u32x2 lo = (u32x2){0u, 0u}, hi = (u32x2){0u, 0u};
                if (tin - 3 + j >= 0) { const bf16* p = PRE + (size_t)(row - 3 + j) * 1536 + ch0; lo = *(const u32x2*)p; hi = *(const u32x2*)(p + 8); }
                a[0] += wl[j][0] * bflo(lo.x); a[1] += wl[j][1] * bfhi(lo.x); a[2] += wl[j][2] * bflo(lo.y); a[3] += wl[j][3] * bfhi(lo.y);
                a[4] += wh[j][0] * bflo(hi.x); a[5] += wh[j][1] * bfhi(hi.x); a[6] += wh[j][2] * bflo(hi.y); a[7] += wh[j][3] * bfhi(hi.y); }
#pragma unroll
            for (int e = 0; e < 8; ++e) { y[i][s][e] = silu_acc(a[e]); asm volatile("" : "+v"(y[i][s][e])); } }
        __builtin_amdgcn_sched_barrier(0);
    }
}
__device__ __forceinline__ bf16x8 pack8f(const float (&v)[8], float sc) {
    v4u o; o.x = pk2(v[0] * sc, v[1] * sc); o.y = pk2(v[2] * sc, v[3] * sc); o.z = pk2(v[4] * sc, v[5] * sc); o.w = pk2(v[6] * sc, v[7] * sc);
    return __builtin_bit_cast(bf16x8, o);
}
__device__ __forceinline__ v4u pack8acc(const f32x16& X, int kq) {
    v4u o; o.x = pk2(X[8 * kq], X[8 * kq + 1]); o.y = pk2(X[8 * kq + 2], X[8 * kq + 3]); o.z = pk2(X[8 * kq + 4], X[8 * kq + 5]); o.w = pk2(X[8 * kq + 6], X[8 * kq + 7]);
    return o;
}
__device__ __forceinline__ void write_xt(LAS unsigned short* XT, const bf16x8 (&fr)[2][4], const float (&sc)[2], int r, int hh) {
#pragma unroll
    for (int i = 0; i < 2; ++i)
#pragma unroll
        for (int s = 0; s < 4; ++s) { const v4u w = __builtin_bit_cast(v4u, fr[i][s]);
#pragma unroll
            for (int e = 0; e < 8; ++e) { const unsigned ww = w[e >> 1]; const float v = ((e & 1) ? bfhi(ww) : bflo(ww)) * sc[i];
                XT[(16 * s + 8 * (e >> 2) + 4 * hh + (e & 3)) * 72 + r + 32 * i] = (unsigned short)f2bf(v); } }
}
__device__ __forceinline__ float lane_bcast(float v, int l) { return __uint_as_float((unsigned)__builtin_amdgcn_readlane((int)__float_as_uint(v), l)); }

__device__ __forceinline__ void dn_prep_chunk(Ctx& F, int ch, LAS unsigned char* scrb, int opq  ) {
    int lane_ = lane_id();
    const int lane = lane_, r = lane & 31, hh = lane >> 5;
    const int n = ch & 127, h = (ch >> 7) & 7, b = ch >> 10;
    const long row0 = (long)b * T + 64 * n; const int tin0 = 64 * n;
    const bf16* PRE = (const bf16*)(F.ws + WS_PRE); const float* AB = (const float*)(F.ws + WS_AB); const float* cw = F.in[7];
    unsigned char* rec = F.ws + WS_DN + (size_t)ch * DN_REC;
    LAS float* At = (LAS float*)scrb; LAS unsigned short* TT = (LAS unsigned short*)scrb; LAS unsigned short* XT = (LAS unsigned short*)(scrb + 9216);
    float gc, betac;
    { const float al = AB[(size_t)(row0 + lane) * 16 + h], bl = AB[(size_t)(row0 + lane) * 16 + 8 + h];
      const float xs = al + F.in[9][h];
      const float sp = fmaxf(xs, 0.f) + log1pf(expf(-fabsf(xs)));
      gc = -expf(F.in[8][h]) * sp; betac = 1.0f / (1.0f + expf(-bl));
#pragma unroll
      for (int o = 1; o < 64; o <<= 1) { const float t = __shfl_up(gc, o); if (lane >= o) gc += t; } }
    const float gl = lane_bcast(gc, 63);
    float gct[2], bet[2];
#pragma unroll
    for (int i = 0; i < 2; ++i) { gct[i] = __shfl(gc, r + 32 * i); bet[i] = __shfl(betac, r + 32 * i); }
    bf16x8 kf[2][4];
#pragma unroll
    for (int i = 0; i < 2; ++i)
#pragma unroll
        for (int s = 0; s < 4; ++s) kf[i][s] = (bf16x8){0, 0, 0, 0, 0, 0, 0, 0};
    if (opq > 0) { int lane = lane_; asm volatile("" : "+v"(lane)); const int r = lane & 31, hh = lane >> 5;
      float y[2][4][8]; dn_conv_l1(PRE, cw, row0, tin0, 512 + h * 64, r, hh, y);
#pragma unroll
      for (int i = 0; i < 2; ++i) { float ss = 0.f;
#pragma unroll
          for (int s = 0; s < 4; ++s)
#pragma unroll
              for (int e = 0; e < 8; ++e) ss += y[i][s][e] * y[i][s][e];
          ss += __shfl_xor(ss, 32); const float rn = 1.0f / sqrtf(ss + 1e-6f);
#pragma unroll
          for (int s = 0; s < 4; ++s) { kf[i][s] = pack8f(y[i][s], rn); asm volatile("" : "+v"(kf[i][s])); } } }
    __builtin_amdgcn_sched_barrier(0);
    if (opq > 1) { int lane = lane_; asm volatile("" : "+v"(lane)); const int r = lane & 31, hh = lane >> 5;
      float sc[2] = {expf(gl - gct[0]), expf(gl - gct[1])};
      write_xt(XT, kf, sc, r, hh);
      LDSFENCE();
#pragma unroll
      for (int id = 0; id < 2; ++id)
#pragma unroll
          for (int ks = 0; ks < 4; ++ks) { const int d = r + 32 * id; const LAS unsigned short* p = XT + d * 72 + 16 * ks + 4 * hh;
              const u32x2 lo = *(const LAS u32x2*)p, hi = *(const LAS u32x2*)(p + 8);
              *(v4u*)(rec + 24576 + d * 128 + (ks * 2 + hh) * 16) = (v4u){lo.x, lo.y, hi.x, hi.y}; }
      LDSFENCE(); }
    __builtin_amdgcn_sched_barrier(0);
#ifndef SKQ
    if (opq > 2) {
        int lane = lane_; asm volatile("" : "+v"(lane)); const int r = lane & 31, hh = lane >> 5;
        bf16x8 qf[2][4];
        { float y[2][4][8]; dn_conv_l1(PRE, cw, row0, tin0, h * 64, r, hh, y);
#pragma unroll
          for (int i = 0; i < 2; ++i) { float ss = 0.f;
#pragma unroll
              for (int s = 0; s < 4; ++s)
#pragma unroll
                  for (int e = 0; e < 8; ++e) ss += y[i][s][e] * y[i][s][e];
              ss += __shfl_xor(ss, 32); const float rn = 0.125f / sqrtf(ss + 1e-6f); const float eg = expf(gct[i]);
#pragma unroll
              for (int s = 0; s < 4; ++s) { qf[i][s] = pack8f(y[i][s], rn);
                  *(bf16x8*)(rec + 8192 + (r + 32 * i) * 128 + (s * 2 + hh) * 16) = pack8f(y[i][s], rn * eg); asm volatile("" : "+v"(qf[i][s])); } } }
        __builtin_amdgcn_sched_barrier(0);
#pragma unroll
        for (int is = 0; is < 2; ++is) {
            float gcr[16];
#pragma unroll
            for (int g = 0; g < 16; ++g) gcr[g] = __shfl(gc, 32 * is + (g & 3) + 8 * (g >> 2) + 4 * hh);
#pragma unroll
            for (int ic = 0; ic < 2; ++ic) {
                if (is == 1 && ic == 0) {
#pragma unroll
                    for (int kq = 0; kq < 2; ++kq) *(v4u*)(rec + 16384 + r * 128 + ((2 + kq) * 2 + hh) * 16) = (v4u){0u, 0u, 0u, 0u};
#pragma unroll
                    for (int g = 0; g < 16; ++g) At[(32 + (g & 3) + 8 * (g >> 2) + 4 * hh) * 68 + r] = 0.f;
                    continue;
                }
                f32x16 pt, pk;
#pragma unroll
                for (int g = 0; g < 16; ++g) { pt[g] = 0.f; pk[g] = 0.f; }
#pragma unroll
                for (int ks = 0; ks < 4; ++ks) { pt = __builtin_amdgcn_mfma_f32_32x32x16_bf16(kf[is][ks], qf[ic][ks], pt, 0, 0, 0); pk = __builtin_amdgcn_mfma_f32_32x32x16_bf16(kf[is][ks], kf[ic][ks], pk, 0, 0, 0); }
                const int ccol = 32 * ic + r;
#pragma unroll
                for (int g = 0; g < 16; ++g) { const int srow = 32 * is + (g & 3) + 8 * (g >> 2) + 4 * hh; const float dec = expf(fminf(gct[ic] - gcr[g], 0.f));
                    pt[g] = (srow <= ccol) ? pt[g] * dec : 0.f;
                    At[srow * 68 + ccol] = (srow < ccol) ? bet[ic] * pk[g] * dec : 0.f; }
#pragma unroll
                for (int kq = 0; kq < 2; ++kq) *(v4u*)(rec + 16384 + ccol * 128 + ((2 * is + kq) * 2 + hh) * 16) = pack8acc(pt, kq);
                __builtin_amdgcn_sched_barrier(0);
            }
        }
    }
    LDSFENCE();
#endif
    __builtin_amdgcn_sched_barrier(0);
#ifndef SKS
    if (opq > 3) {
        int lane = lane_; asm volatile("" : "+v"(lane)); const int r = lane & 31, hh = lane >> 5;
        float t[64];
#pragma unroll
        for (int k = 0; k < 64; ++k) t[k] = (k == lane) ? 1.0f : 0.0f;
#pragma unroll
        for (int j = 62; j >= 0; --j) { float acc = 0.f;
#pragma unroll
            for (int k4 = (j + 1) & ~3; k4 < 64; k4 += 4) { const f32x4 x = *(const volatile LAS f32x4*)(At + j * 68 + k4);
#pragma unroll
                for (int i = 0; i < 4; ++i) if (k4 + i > j) acc += t[k4 + i] * x[i]; }
            t[j] -= acc; asm volatile("" : "+v"(t[j])); }
        LDSFENCE();
#pragma unroll
        for (int i = 0; i < 8; ++i) { v4u o; o.x = pk2(t[8 * i], t[8 * i + 1]); o.y = pk2(t[8 * i + 2], t[8 * i + 3]); o.z = pk2(t[8 * i + 4], t[8 * i + 5]); o.w = pk2(t[8 * i + 6], t[8 * i + 7]);
            *(LAS v4u*)(TT + lane * 72 + 8 * i) = o; }
    }
#endif
    __builtin_amdgcn_sched_barrier(0);
#ifndef SKW
    if (opq > 4) { int lane = lane_; asm volatile("" : "+v"(lane)); const int r = lane & 31, hh = lane >> 5;
      float sc[2] = {bet[0] * expf(gct[0]), bet[1] * expf(gct[1])};
      write_xt(XT, kf, sc, r, hh);
      LDSFENCE();
#pragma unroll
      for (int id = 0; id < 2; ++id)
#pragma unroll
          for (int ic = 0; ic < 2; ++ic) { f32x16 acc;
#pragma unroll
              for (int g = 0; g < 16; ++g) acc[g] = 0.f;
#pragma unroll
              for (int ks = 0; ks < 4; ++ks) { const bf16x8 af = *(const LAS bf16x8*)(XT + (r + 32 * id) * 72 + 16 * ks + 8 * hh), bfr = *(const LAS bf16x8*)(TT + (r + 32 * ic) * 72 + 16 * ks + 8 * hh);
                  acc = __builtin_amdgcn_mfma_f32_32x32x16_bf16(af, bfr, acc, 0, 0, 0); }
#pragma unroll
              for (int kq = 0; kq < 2; ++kq) *(v4u*)(rec + (32 * ic + r) * 128 + ((2 * id + kq) * 2 + hh) * 16) = pack8acc(acc, kq); __builtin_amdgcn_sched_barrier(0); }
      LDSFENCE(); }
    __builtin_amdgcn_sched_barrier(0);
#endif
#ifndef SKU
    if (opq > 1) { int lane = lane_; asm volatile("" : "+v"(lane)); const int r = lane & 31, hh = lane >> 5;
      bf16x8 vf[2][4];
      { float y[2][4][8]; dn_conv_l1(PRE, cw, row0, tin0, 1024 + h * 64, r, hh, y);
#pragma unroll
        for (int i = 0; i < 2; ++i)
#pragma unroll
            for (int s = 0; s < 4; ++s) { vf[i][s] = pack8f(y[i][s], bet[i]); asm volatile("" : "+v"(vf[i][s])); } }
      __builtin_amdgcn_sched_barrier(0);
      float one[2] = {1.0f, 1.0f};
      write_xt(XT, vf, one, r, hh);
      LDSFENCE();
      unsigned* U = (unsigned*)(rec + 32768);
#pragma unroll
      for (int ic = 0; ic < 2; ++ic)
#pragma unroll
          for (int ie = 0; ie < 2; ++ie) { f32x16 acc;
#pragma unroll
              for (int g = 0; g < 16; ++g) acc[g] = 0.f;
#pragma unroll
              for (int ks = 0; ks < 4; ++ks) { const bf16x8 af = *(const LAS bf16x8*)(TT + (r + 32 * ic) * 72 + 16 * ks + 8 * hh), bfr = *(const LAS bf16x8*)(XT + (r + 32 * ie) * 72 + 16 * ks + 8 * hh);
                  acc = __builtin_amdgcn_mfma_f32_32x32x16_bf16(af, bfr, acc, 0, 0, 0); }
#pragma unroll
              for (int gp = 0; gp < 8; ++gp) U[((ie * 2 + ic) * 8 + gp) * 64 + lane] = pk2(acc[2 * gp], acc[2 * gp + 1]); __builtin_amdgcn_sched_barrier(0); }
      LDSFENCE(); }
#endif
    if (lane == 0) ((float*)(F.ws + WS_DNCD))[ch] = expf(gl);
}

__device__ __forceinline__ bf16x8 pack8(const f32x16& X, int s) {
    v4u o; o.x = pg8::cvt_pk_bf16(X[8 * s], X[8 * s + 1]); o.y = pg8::cvt_pk_bf16(X[8 * s + 2], X[8 * s + 3]); o.z = pg8::cvt_pk_bf16(X[8 * s + 4], X[8 * s + 5]); o.w = pg8::cvt_pk_bf16(X[8 * s + 6], X[8 * s + 7]);
    return __builtin_bit_cast(bf16x8, o);
}
__device__ __forceinline__ void dn_scan(Ctx& F, int sw) {
    const int lane = lane_id(), r = lane & 31, hh = lane >> 5;
    const int bh = sw >> 1, sl = sw & 1, b = bh >> 3, h = bh & 7;
    const float* CD = (const float*)(F.ws + WS_DNCD) + bh * 128;
    bf16* ODN = (bf16*)(F.ws + WS_ODN);
    f32x16 S0, S1;
#pragma unroll
    for (int i = 0; i < 16; ++i) { S0[i] = 0.f; S1[i] = 0.f; }
    for (int n = 0; n < 128; ++n) {
        const unsigned char* rec = F.ws + WS_DN + ((size_t)bh * 128 + n) * DN_REC;
        const unsigned char* fb = rec + r * 128 + hh * 16;
        bf16x8 w[2][4], qd[2][4], at[2][4], kt[2][4];
#pragma unroll
        for (int i = 0; i < 2; ++i)
#pragma unroll
            for (int ks = 0; ks < 4; ++ks) { const int o = i * 4096 + ks * 32;
                w[i][ks] = *(const bf16x8*)(fb + o); qd[i][ks] = *(const bf16x8*)(fb + 8192 + o); at[i][ks] = *(const bf16x8*)(fb + 16384 + o); kt[i][ks] = *(const bf16x8*)(fb + 24576 + o); }
        const unsigned* up = (const unsigned*)(rec + 32768) + (sl * 2) * 8 * 64 + lane;
        unsigned uw[2][8];
#pragma unroll
        for (int i = 0; i < 2; ++i)
#pragma unroll
            for (int gp = 0; gp < 8; ++gp) uw[i][gp] = up[(i * 8 + gp) * 64];
        const float cd = CD[n];
        bf16x8 sb[4]; sb[0] = pack8(S0, 0); sb[1] = pack8(S0, 1); sb[2] = pack8(S1, 0); sb[3] = pack8(S1, 1);
        f32x16 ws[2], qs[2];
#pragma unroll
        for (int i = 0; i < 2; ++i) {
#pragma unroll
            for (int g = 0; g < 16; ++g) { ws[i][g] = 0.f; qs[i][g] = 0.f; }
#pragma unroll
            for (int ks = 0; ks < 4; ++ks) { ws[i] = __builtin_amdgcn_mfma_f32_32x32x16_bf16(w[i][ks], sb[ks], ws[i], 0, 0, 0); qs[i] = __builtin_amdgcn_mfma_f32_32x32x16_bf16(qd[i][ks], sb[ks], qs[i], 0, 0, 0); }
        }
#pragma unroll
        for (int i = 0; i < 2; ++i)
#pragma unroll
            for (int gp = 0; gp < 8; ++gp) { ws[i][2 * gp] = bflo(uw[i][gp]) - ws[i][2 * gp]; ws[i][2 * gp + 1] = bfhi(uw[i][gp]) - ws[i][2 * gp + 1]; }
        bf16x8 vb[4]; vb[0] = pack8(ws[0], 0); vb[1] = pack8(ws[0], 1); vb[2] = pack8(ws[1], 0); vb[3] = pack8(ws[1], 1);
#pragma unroll
        for (int g = 0; g < 16; ++g) { S0[g] *= cd; S1[g] *= cd; }
#pragma unroll
        for (int ks = 0; ks < 4; ++ks) {
            qs[0] = __builtin_amdgcn_mfma_f32_32x32x16_bf16(at[0][ks], vb[ks], qs[0], 0, 0, 0);
            qs[1] = __builtin_amdgcn_mfma_f32_32x32x16_bf16(at[1][ks], vb[ks], qs[1], 0, 0, 0);
            S0 = __builtin_amdgcn_mfma_f32_32x32x16_bf16(kt[0][ks], vb[ks], S0, 0, 0, 0);
            S1 = __builtin_amdgcn_mfma_f32_32x32x16_bf16(kt[1][ks], vb[ks], S1, 0, 0, 0);
        }
        bf16* orow = ODN + ((size_t)b * T + 64 * n) * 512 + h * 64 + 32 * sl + r;
#pragma unroll
        for (int i = 0; i < 2; ++i)
#pragma unroll
            for (int g = 0; g < 16; ++g) { const int c = 32 * i + (g & 3) + 8 * (g >> 2) + 4 * hh; orow[(size_t)c * 512] = (bf16)f2bf(qs[i][g]); }
    }
}

__device__ __forceinline__ void finalize_rows(Ctx& F) {
    const int gw = F.vcu * NWAVES + F.wave, NGW = F.G * NWAVES, lane = lane_id();
    const bf16* ODN = (const bf16*)(F.ws + WS_ODN); const bf16* Z = (const bf16*)(F.ws + WS_Z); const bf16* QO = (const bf16*)(F.ws + WS_QO);
    bf16* AA = (bf16*)(F.ws + WS_AA); bf16* ABB = (bf16*)(F.ws + WS_ABB);
    float s1 = 0.f, s2 = 0.f;
    { const float a = F.in[11][lane] * F.in[12][lane], bq = F.in[13][lane] * F.in[14][lane]; s1 = wave_sum(a); s2 = wave_sum(bq); }
    const float lam_init = 0.2f;
    const float lam = expf(s1) - expf(s2) + lam_init;
    float gdn[8], gsub[8];
#pragma unroll
    for (int e = 0; e < 8; ++e) { gdn[e] = F.in[10][(lane & 7) * 8 + e]; gsub[e] = F.in[15][(lane & 15) * 8 + e] * (1.0f - lam_init); }
    for (int m = gw; m < M; m += NGW) {
        { const v4u ov = *(const v4u*)(ODN + (size_t)m * 512 + lane * 8), zv = *(const v4u*)(Z + (size_t)m * 512 + lane * 8);
          float o[8], z[8]; float ss = 0.f;
#pragma unroll
          for (int e = 0; e < 4; ++e) { o[2 * e] = bflo(ov[e]); o[2 * e + 1] = bfhi(ov[e]); z[2 * e] = bflo(zv[e]); z[2 * e + 1] = bfhi(zv[e]); }
#pragma unroll
          for (int e = 0; e < 8; ++e) ss += o[e] * o[e];
          ss += __shfl_xor(ss, 1); ss += __shfl_xor(ss, 2); ss += __shfl_xor(ss, 4);
          const float rn = 1.0f / sqrtf(ss * (1.0f / 64.0f) + RMS_EPS);
          float y[8];
#pragma unroll
          for (int e = 0; e < 8; ++e) y[e] = o[e] * rn * gdn[e] * silu_acc(z[e]);
          v4u w; w.x = pk2(y[0], y[1]); w.y = pk2(y[2], y[3]); w.z = pk2(y[4], y[5]); w.w = pk2(y[6], y[7]);
          *(v4u*)(AA + (size_t)m * 512 + lane * 8) = w; }
        { const int hd = lane >> 4, e0 = (lane & 15) * 8;
          const v4u a1 = *(const v4u*)(QO + (size_t)m * 1024 + hd * 256 + e0), a2 = *(const v4u*)(QO + (size_t)m * 1024 + hd * 256 + 128 + e0);
          float o[8]; float ss = 0.f;
#pragma unroll
          for (int e = 0; e < 4; ++e) { o[2 * e] = bflo(a1[e]) - lam * bflo(a2[e]); o[2 * e + 1] = bfhi(a1[e]) - lam * bfhi(a2[e]); }
#pragma unroll
          for (int e = 0; e < 8; ++e) ss += o[e] * o[e];
          ss += __shfl_xor(ss, 1); ss += __shfl_xor(ss, 2); ss += __shfl_xor(ss, 4); ss += __shfl_xor(ss, 8);
          const float rn = 1.0f / sqrtf(ss * (1.0f / 128.0f) + SUBLN_EPS);
          float y[8];
#pragma unroll
          for (int e = 0; e < 8; ++e) y[e] = o[e] * rn * gsub[e];
          v4u w; w.x = pk2(y[0], y[1]); w.y = pk2(y[2], y[3]); w.z = pk2(y[4], y[5]); w.w = pk2(y[6], y[7]);
          *(v4u*)(ABB + (size_t)m * 512 + hd * 128 + e0) = w; }
    }
}
__device__ __forceinline__ void final_norm_rows(Ctx& F) {
    const int lane = lane_id();
    const int gw = F.vcu * NWAVES + F.wave, NGW = F.G * NWAVES;
    const f32x4* gp = (const f32x4*)F.in[23] + lane; f32x4 gg[4];
#pragma unroll
    for (int j = 0; j < 4; ++j) gg[j] = gp[64 * j];
    for (int m = gw; m < M; m += NGW) {
        f32x4* xr = (f32x4*)(F.out + (size_t)m * D) + lane; f32x4 v[4]; float s = 0.f;
#pragma unroll
        for (int j = 0; j < 4; ++j) { v[j] = xr[64 * j]; s += (v[j].x * v[j].x + v[j].y * v[j].y) + (v[j].z * v[j].z + v[j].w * v[j].w); }
        const float rn = 1.0f / sqrtf(wave_sum(s) * (1.0f / D) + RMS_EPS);
#pragma unroll
        for (int j = 0; j < 4; ++j) xr[64 * j] = v[j] * rn * gg[j];
    }
}

constexpr int N_PHASES = 14;
struct Args { const float* in[24]; float* out; unsigned char* ws; int ph_lo, ph_hi; };
__global__ void __launch_bounds__(NWAVES * 64, 2) mk_fwd(Args args) {
    extern __shared__ __attribute__((aligned(16))) unsigned char lds[];
    Ctx F;
    F.in = args.in;
    F.out = args.out; F.ws = args.ws;
    F.lds = (LAS unsigned char*)lds;
    F.wave = __builtin_amdgcn_readfirstlane((int)threadIdx.x >> 6);
    F.G = gridDim.x; { const int bx = blockIdx.x; F.vcu = (F.G % 8 == 0) ? (bx % 8) * (F.G / 8) + bx / 8 : bx; }
    const int lo = args.ph_lo, hi = args.ph_hi;
    { volatile LAS unsigned* misc = (volatile LAS unsigned*)(F.lds + MISC_OFF); if (F.wave == 0) misc[lane_id()] = 0u; }
    __syncthreads();
    XcdBarrier bar = xcd_barrier_post((unsigned*)(args.ws + WS_CTL) + CW_BAR, (volatile LAS unsigned*)(F.lds + MISC_OFF) + 8, F.wave);
    if (lo < -7) cg::this_grid().sync();
    unsigned char* ws = F.ws;
    typedef pg8::bf16_t pb;
#ifndef PH_MASK
#define PH_MASK 0x3fff
#endif
#define IN(k) (((PH_MASK >> (k)) & 1) && lo <= (k) && (k) < hi)
#define SEAM(k) do { if (IN(k) && IN((k) + 1)) xcd_barrier(bar); } while (0)

    if (IN(0)) { p0_prologue(F); } SEAM(0);
    if (IN(1)) { pg8::Gemm g{(const pb*)(ws + WS_XB), (const pb*)(ws + WS_WGU1), M, 2 * FF, D}; pg8::StaticOrder S; S.init(M, 2 * FF, F.G, (int)blockIdx.x);
        pg8::EpiSwiGLU E{(pb*)(ws + WS_H), FF, (const float*)(ws + WS_SSQA), RMS_EPS};
        pg8::gemm_phase<pg8::EpiSwiGLU, pg8::StaticOrder, true, true>(F.lds + RING_OFF, g, S, E, F.wave); } SEAM(1);
    if (IN(2)) { pg8::Gemm g{(const pb*)(ws + WS_H), (const pb*)(ws + WS_WD1), M, D, FF}; pg8::StaticOrder S; S.init(M, D, F.G, (int)blockIdx.x);
        pg8::EpiResid E{F.in[0], F.out, (pb*)(ws + WS_XB), (float*)(ws + WS_SSQB), 0.5f};
        pg8::gemm_phase<pg8::EpiResid, pg8::StaticOrder, true, true>(F.lds + RING_OFF, g, S, E, F.wave); } SEAM(2);
    if (IN(3)) { pg8::Gemm g{(const pb*)(ws + WS_XB), (const pb*)(ws + WS_WIN), M, WIN_N, D}; pg8::StaticOrder S; S.init(M, WIN_N, F.G, (int)blockIdx.x);
        pg8::EpiWin E{(pb*)(ws + WS_PRE), (pb*)(ws + WS_Z), (pb*)(ws + WS_QO), (pb*)(ws + WS_KD), (pb*)(ws + WS_VD), (float*)(ws + WS_AB), (const float*)(ws + WS_SSQB), RMS_EPS, attn_body::C2};
        pg8::gemm_phase<pg8::EpiWin, pg8::StaticOrder, true, true>(F.lds + RING_OFF, g, S, E, F.wave); } SEAM(3);
    if (IN(4)) { LAS unsigned char* scr = F.lds + RING_OFF + F.wave * 18432; const int gw = F.vcu * NWAVES + F.wave, NGW = F.G * NWAVES;
        for (int ch = gw; ch < 2048; ch += NGW) dn_prep_chunk(F, ch, scr, hi); } SEAM(4);
    if (IN(5)) { const attn_body::AttnTensors AT{(const attn_body::bf16*)(ws + WS_QO), (const attn_body::bf16*)(ws + WS_KD), (const attn_body::bf16*)(ws + WS_VD), (attn_body::bf16*)(ws + WS_QO)};
        const attn_body::StaticOrder S((int)F.G, (int)blockIdx.x);
        attn_body::attn_phase<attn_body::StaticOrder>((char*)lds + RING_OFF, AT, S, F.wave); } SEAM(5);
    if (IN(6)) { const int gw = F.wave * F.G + F.vcu; if (gw < 32) dn_scan(F, gw); } SEAM(6);
    if (IN(7)) { finalize_rows(F); conv_ffn2(F); } SEAM(7);
    if (IN(8)) { pg8::StaticOrder S; S.init(M, D, F.G, (int)blockIdx.x);
        { pg8::Gemm g{(const pb*)(ws + WS_AA), (const pb*)(ws + WS_WA), M, D, 512}; pg8::EpiStoreBf16 E{(pb*)(ws + WS_YA), D};
          pg8::gemm_phase<pg8::EpiStoreBf16, pg8::StaticOrder, true, true>(F.lds + RING_OFF, g, S, E, F.wave); }
        { pg8::Gemm g{(const pb*)(ws + WS_ABB), (const pb*)(ws + WS_WB), M, D, 512}; pg8::EpiStoreBf16 E{(pb*)(ws + WS_YB), D};
          pg8::gemm_phase<pg8::EpiStoreBf16, pg8::StaticOrder, true, true>(F.lds + RING_OFF, g, S, E, F.wave); } } SEAM(8);
    if (IN(9)) { pg8::Gemm g{(const pb*)(ws + WS_XB), (const pb*)(ws + WS_WG), M, 2 * D, D}; pg8::StaticOrder S; S.init(M, 2 * D, F.G, (int)blockIdx.x);
        pg8::EpiGateMerge E{(const pb*)(ws + WS_YA), (const pb*)(ws + WS_YB), (pb*)(ws + WS_MG), (const float*)(ws + WS_SSQB), RMS_EPS};
        pg8::gemm_phase<pg8::EpiGateMerge, pg8::StaticOrder, true, true>(F.lds + RING_OFF, g, S, E, F.wave); } SEAM(9);
    if (IN(10)) { pg8::Gemm g{(const pb*)(ws + WS_MG), (const pb*)(ws + WS_WOUT), M, D, D}; pg8::StaticOrder S; S.init(M, D, F.G, (int)blockIdx.x);
        pg8::EpiResid E{F.out, F.out, (pb*)(ws + WS_XB), (float*)(ws + WS_SSQA), 1.0f};
        pg8::gemm_phase<pg8::EpiResid, pg8::StaticOrder, true, true>(F.lds + RING_OFF, g, S, E, F.wave); } SEAM(10);
    if (IN(11)) { pg8::Gemm g{(const pb*)(ws + WS_XB), (const pb*)(ws + WS_WGU2), M, 2 * FF, D}; pg8::StaticOrder S; S.init(M, 2 * FF, F.G, (int)blockIdx.x);
        pg8::EpiSwiGLU E{(pb*)(ws + WS_H), FF, (const float*)(ws + WS_SSQA), RMS_EPS};
        pg8::gemm_phase<pg8::EpiSwiGLU, pg8::StaticOrder, true, true>(F.lds + RING_OFF, g, S, E, F.wave); } SEAM(11);
    if (IN(12)) { pg8::Gemm g{(const pb*)(ws + WS_H), (const pb*)(ws + WS_WD2), M, D, FF}; pg8::StaticOrder S; S.init(M, D, F.G, (int)blockIdx.x);
        pg8::EpiResid E{F.out, F.out, (pb*)(ws + WS_XB), (float*)(ws + WS_SSQB), 0.5f};
        pg8::gemm_phase<pg8::EpiResid, pg8::StaticOrder, true, true>(F.lds + RING_OFF, g, S, E, F.wave); } SEAM(12);
    if (IN(13)) { final_norm_rows(F); }
#undef IN
#undef SEAM
}

#ifndef MK_N_LAUNCHES
#define MK_N_LAUNCHES 1
#endif
extern "C" void kernel_launch(void* const* d_in, const int* in_sizes, int n_in, void* d_out, int out_size, void* d_ws, size_t ws_size, hipStream_t stream) {
    static int grid = 0;
    if (grid == 0) {
        if (n_in != 24 || in_sizes[0] != M * D || out_size != M * D || ws_size < WS_END) { fprintf(stderr, "kernel_launch: unexpected shapes (n_in %d, in0 %d, out %d, ws %zu)\n", n_in, n_in > 0 ? in_sizes[0] : -1, out_size, ws_size); grid = -1; return; }
        int dev = 0, cus = 0, per_cu = 0;
        if (hipGetDevice(&dev) != hipSuccess || hipDeviceGetAttribute(&cus, hipDeviceAttributeMultiprocessorCount, dev) != hipSuccess) { grid = -1; return; }
        if (hipFuncSetAttribute((const void*)mk_fwd, hipFuncAttributeMaxDynamicSharedMemorySize, LDS_BYTES) != hipSuccess) { fprintf(stderr, "kernel_launch: hipFuncSetAttribute failed\n"); grid = -1; return; }
        if (hipOccupancyMaxActiveBlocksPerMultiprocessor(&per_cu, (const void*)mk_fwd, NWAVES * 64, LDS_BYTES) != hipSuccess || per_cu < 1) { fprintf(stderr, "kernel_launch: occupancy query says %d\n", per_cu); per_cu = 1; }
        (void)hipGetLastError();
        grid = cus;
    }
    if (grid < 0) return;
    if (hipMemsetAsync((char*)d_ws + WS_CTL, 0, CTL_ZERO_BYTES, stream) != hipSuccess) { fprintf(stderr, "kernel_launch: hipMemsetAsync failed\n"); return; }
    Args a{};
    for (int i = 0; i < 24; ++i) a.in[i] = (const float*)d_in[i];
    a.out = (float*)d_out; a.ws = (unsigned char*)d_ws;
#if MK_N_LAUNCHES == 1
    a.ph_lo = 0; a.ph_hi = N_PHASES;
    void* kargs[] = {&a};
    hipError_t e = hipLaunchCooperativeKernel((const void*)mk_fwd, dim3(grid), dim3(NWAVES * 64), kargs, LDS_BYTES, stream);
    if (e != hipSuccess) fprintf(stderr, "kernel_launch: cooperative launch failed: %s (grid %d)\n", hipGetErrorString(e), grid);
#else
    for (int p = 0; p < N_PHASES; ++p) { a.ph_lo = p; a.ph_hi = p + 1; hipLaunchKernelGGL(mk_fwd, dim3(grid), dim3(NWAVES * 64), LDS_BYTES, stream, a); }
#endif
}
```

```cpp
#include <hip/hip_runtime.h>
#include <hip/hip_cooperative_groups.h>
#include <cstdio>
#include <cstdint>
namespace cg = cooperative_groups;
__device__ __forceinline__ int lane_id() { int l = (int)__builtin_amdgcn_mbcnt_hi(~0u, __builtin_amdgcn_mbcnt_lo(~0u, 0u)); asm volatile("" : "+v"(l)); return l; }
namespace pg8 {
#define PG8_LAS __attribute__((address_space(3)))
typedef unsigned short bf16_t;
typedef short bf16x8 __attribute__((ext_vector_type(8)));
typedef float f32x4 __attribute__((ext_vector_type(4)));
typedef unsigned u32x4 __attribute__((ext_vector_type(4)));
constexpr int BM = 256, BK = 64, HALF = 128, HTB = HALF * BK * 2  , STAGE_BYTES = 8 * HTB, NXCD = 8, WGM = 8;

__host__ __device__ __forceinline__ int lds_byte(int r, int c) { const int st = (r >> 4) * 2 + (c >> 5), rr = r & 15, cc = c & 31, ob = rr * 64 + cc * 2; return st * 1024 + (ob ^ (((ob >> 9) & 1) << 5)); }
__host__ __device__ __forceinline__ void stage_rc(int b, int& R, int& C) { const int st = b / 1024, sb = b % 1024, swz = sb ^ (((sb >> 9) & 1) << 5); R = (st >> 1) * 16 + swz / 64; C = (st & 1) * 32 + (swz % 64) / 2; }
__host__ __device__ __forceinline__ int perm32(int rho) { const int n = rho >> 4, i = rho & 15; return 8 * (i >> 2) + 4 * n + (i & 3); }

struct Unit { int pm, pn; };
struct Gemm { const bf16_t* A; const bf16_t* Bt; int M, N, K; };

struct StaticOrder {
    int nM, nN, nwg, G, c;
    __host__ __device__ void init(int M, int N, int G_, int c_) { nM = M / BM; nN = N / BM; nwg = nM * nN; G = G_; c = c_; }
    __host__ __device__ bool next(int i, Unit& u) const {
        const long L = (long)i * G + c; if (L >= nwg) return false;
        int wgid = (int)L; { const int q = nwg / NXCD, r = nwg % NXCD, xcd = wgid % NXCD, off = wgid / NXCD; wgid = (xcd < r ? xcd * (q + 1) : r * (q + 1) + (xcd - r) * q) + off; }
        const int nig = WGM * nN, gid = wgid / nig, fm = gid * WGM, gsz = (nM - fm) < WGM ? (nM - fm) : WGM;
        u.pm = fm + ((wgid % nig) % gsz); u.pn = (wgid % nig) / gsz; return true;
    }
    __device__ __forceinline__ void a_ready(const Unit&) const {}
    __device__ __forceinline__ void done(const Unit&) const {}
};

__device__ __forceinline__ unsigned cvt_pk_bf16(float lo, float hi) { unsigned r; asm volatile("v_cvt_pk_bf16_f32 %0, %1, %2" : "=v"(r) : "v"(lo), "v"(hi)); return r; }
__device__ __forceinline__ float fast_sigmoid(float v) { return __builtin_amdgcn_rcpf(1.0f + __builtin_amdgcn_exp2f(-1.4426950408889634f * v)); }
__device__ __forceinline__ float fast_silu(float v) { return v * fast_sigmoid(v); }
__device__ __forceinline__ void load_rs(float (&rs)[2][4], const float* ssq, int row0, float eps) {
#pragma unroll
    for (int ai = 0; ai < 2; ++ai)
#pragma unroll
        for (int m = 0; m < 4; ++m) { const f32x4* p = (const f32x4*)(ssq + (size_t)(row0 + ai * HALF + m * 16) * 16); const f32x4 a = p[0], b = p[1], c = p[2], d = p[3];
            const float s = ((a[0] + a[1]) + (a[2] + a[3])) + ((b[0] + b[1]) + (b[2] + b[3])) + ((c[0] + c[1]) + (c[2] + c[3])) + ((d[0] + d[1]) + (d[2] + d[3]));
            rs[ai][m] = 1.0f / sqrtf(s * (1.0f / 1024.0f) + eps); }
}
struct EpiSwiGLU {
    static constexpr bool PERM = true, AFTER_DRAIN = false;
    bf16_t* H; int ldh; const float* ssq; float eps;
    __device__ __forceinline__ void operator()(const f32x4 (&acc)[2][2][4][2], const Unit& u, int wr, int wc, int fr, int fq) const {
        const int row0 = u.pm * BM + wr * 64 + fr, col0 = u.pn * HALF + wc * 32 + 8 * fq;
        float rs[2][4]; load_rs(rs, ssq, row0, eps);
#pragma unroll
        for (int ai = 0; ai < 2; ++ai)
#pragma unroll
            for (int m = 0; m < 4; ++m) { bf16_t* rowp = H + (size_t)(row0 + ai * HALF + m * 16) * ldh + col0; const float s = rs[ai][m];
                float h[8];
#pragma unroll
                for (int n = 0; n < 2; ++n)
#pragma unroll
                    for (int j = 0; j < 4; ++j) h[n * 4 + j] = fast_silu(acc[ai][0][m][n][j] * s) * (acc[ai][1][m][n][j] * s);
                u32x4 w; w.x = cvt_pk_bf16(h[0], h[1]); w.y = cvt_pk_bf16(h[2], h[3]); w.z = cvt_pk_bf16(h[4], h[5]); w.w = cvt_pk_bf16(h[6], h[7]);
                *(u32x4*)rowp = w; }
    }
};
struct EpiResid {
    static constexpr bool PERM = false, AFTER_DRAIN = false;
    const float* base; float* out; bf16_t* xb; float* ssq_out; float scale;
    __device__ __forceinline__ void operator()(const f32x4 (&acc)[2][2][4][2], const Unit& u, int wr, int wc, int fr, int fq) const {
        typedef unsigned u32x2v __attribute__((ext_vector_type(2)));
        const int row0 = u.pm * BM + wr * 64 + fr, col0 = u.pn * BM + wc * 32 + 4 * fq;
#pragma unroll
        for (int ai = 0; ai < 2; ++ai)
#pragma unroll
            for (int m = 0; m < 4; ++m) { const int row = row0 + ai * HALF + m * 16; const size_t off = (size_t)row * 1024 + col0; float ss = 0.f;
#pragma unroll
                for (int bj = 0; bj < 2; ++bj)
#pragma unroll
                    for (int n = 0; n < 2; ++n) { const f32x4 bs = *(const f32x4*)(base + off + bj * HALF + n * 16); const f32x4 o = bs + acc[ai][bj][m][n] * scale;
                        *(f32x4*)(out + off + bj * HALF + n * 16) = o; ss += (o[0] * o[0] + o[1] * o[1]) + (o[2] * o[2] + o[3] * o[3]);
                        u32x2v w; w.x = cvt_pk_bf16(o[0], o[1]); w.y = cvt_pk_bf16(o[2], o[3]); *(u32x2v*)(xb + off + bj * HALF + n * 16) = w; }
                ss += __shfl_xor(ss, 16); ss += __shfl_xor(ss, 32);
                if (fq == 0) ssq_out[(size_t)row * 16 + u.pn * 4 + wc] = ss; }
    }
};
struct EpiStoreBf16 {
    static constexpr bool PERM = true, AFTER_DRAIN = false;
    bf16_t* O; int ldc;
    __device__ __forceinline__ void operator()(const f32x4 (&acc)[2][2][4][2], const Unit& u, int wr, int wc, int fr, int fq) const {
        const int row0 = u.pm * BM + wr * 64 + fr, col0 = u.pn * BM + wc * 32 + 8 * fq;
#pragma unroll
        for (int ai = 0; ai < 2; ++ai)
#pragma unroll
            for (int m = 0; m < 4; ++m) { bf16_t* rowp = O + (size_t)(row0 + ai * HALF + m * 16) * ldc + col0;
#pragma unroll
                for (int bj = 0; bj < 2; ++bj) { const f32x4 v0 = acc[ai][bj][m][0], v1 = acc[ai][bj][m][1];
                    u32x4 w; w.x = cvt_pk_bf16(v0[0], v0[1]); w.y = cvt_pk_bf16(v0[2], v0[3]); w.z = cvt_pk_bf16(v1[0], v1[1]); w.w = cvt_pk_bf16(v1[2], v1[3]);
                    *(u32x4*)(rowp + bj * HALF) = w; } }
    }
};
struct EpiWin {
    static constexpr bool PERM = true, AFTER_DRAIN = false;
    bf16_t *PRE, *Z, *QO, *KD, *VD; float* AB; const float* ssq; float eps, qscale;
    __device__ __forceinline__ void operator()(const f32x4 (&acc)[2][2][4][2], const Unit& u, int wr, int wc, int fr, int fq) const {
        const int row0 = u.pm * BM + wr * 64 + fr, cl0 = wc * 32 + 8 * fq, pn = u.pn;
        float rs[2][4]; load_rs(rs, ssq, row0, eps);
        if (pn == 14) {
            if (wc == 0 && fq < 2) {
#pragma unroll
                for (int ai = 0; ai < 2; ++ai)
#pragma unroll
                    for (int m = 0; m < 4; ++m) { float* rowp = AB + (size_t)(row0 + ai * HALF + m * 16) * 16 + 8 * fq; const float s = rs[ai][m];
                        *(f32x4*)rowp = acc[ai][0][m][0] * s; *(f32x4*)(rowp + 4) = acc[ai][0][m][1] * s; }
            }
            return;
        }
        bf16_t* base; int ld, cb; float sc = 1.f; bool dup = false;
        if (pn < 6) { base = PRE; ld = 1536; cb = pn * 256; }
        else if (pn < 8) { base = Z; ld = 512; cb = (pn - 6) * 256; }
        else if (pn < 10) { base = QO; ld = 1024; cb = (pn - 8) * 256; sc = qscale; dup = true; }
        else if (pn < 12) { base = KD; ld = 512; cb = (pn - 10) * 256; }
        else { base = VD; ld = 512; cb = (pn - 12) * 256; }
#pragma unroll
        for (int ai = 0; ai < 2; ++ai)
#pragma unroll
            for (int m = 0; m < 4; ++m) { const float s = rs[ai][m] * sc; bf16_t* rowp = base + (size_t)(row0 + ai * HALF + m * 16) * ld;
#pragma unroll
                for (int bj = 0; bj < 2; ++bj) { const f32x4 v0 = acc[ai][bj][m][0] * s, v1 = acc[ai][bj][m][1] * s;
                    u32x4 w; w.x = cvt_pk_bf16(v0[0], v0[1]); w.y = cvt_pk_bf16(v0[2], v0[3]); w.z = cvt_pk_bf16(v1[0], v1[1]); w.w = cvt_pk_bf16(v1[2], v1[3]);
                    const int c = cb + bj * HALF + cl0;
                    if (dup) { const int qc = ((c >> 6) * 2) * 64 + (c & 63); *(u32x4*)(rowp + qc) = w; *(u32x4*)(rowp + qc + 64) = w; }
                    else *(u32x4*)(rowp + c) = w; } }
    }
};
struct EpiGateMerge {
    static constexpr bool PERM = true, AFTER_DRAIN = false;
    const bf16_t *YA, *YB; bf16_t* MG; const float* ssq; float eps;
    __device__ __forceinline__ void operator()(const f32x4 (&acc)[2][2][4][2], const Unit& u, int wr, int wc, int fr, int fq) const {
        const int row0 = u.pm * BM + wr * 64 + fr, col0 = u.pn * HALF + wc * 32 + 8 * fq;
        float rs[2][4]; load_rs(rs, ssq, row0, eps);
#pragma unroll
        for (int ai = 0; ai < 2; ++ai)
#pragma unroll
            for (int m = 0; m < 4; ++m) { const size_t off = (size_t)(row0 + ai * HALF + m * 16) * 1024 + col0; const float s = rs[ai][m];
                const u32x4 ya = *(const u32x4*)(YA + off), yb = *(const u32x4*)(YB + off);
                float o[8];
#pragma unroll
                for (int n = 0; n < 2; ++n)
#pragma unroll
                    for (int j = 0; j < 4; ++j) { const int e = n * 4 + j; const unsigned wa = ya[e >> 1], wb = yb[e >> 1];
                        const float fa = __uint_as_float((e & 1) ? (wa & 0xffff0000u) : (wa << 16)), fb = __uint_as_float((e & 1) ? (wb & 0xffff0000u) : (wb << 16));
                        o[e] = fast_sigmoid(acc[ai][0][m][n][j] * s) * fa + fast_sigmoid(acc[ai][1][m][n][j] * s) * fb; }
                u32x4 w; w.x = cvt_pk_bf16(o[0], o[1]); w.y = cvt_pk_bf16(o[2], o[3]); w.z = cvt_pk_bf16(o[4], o[5]); w.w = cvt_pk_bf16(o[6], o[7]);
                *(u32x4*)(MG + off) = w; }
    }
};

template <class Epi, class Sched, bool ALIGN_EPI = false, bool SP2 = false>
__device__ __forceinline__ void gemm_phase(PG8_LAS unsigned char* lds, const Gemm g, const Sched& S, const Epi& E, const int wave_id) {
    const int wid = wave_id, lane = lane_id(), tid = wid * 64 + lane, wr = wid >> 2, wc = wid & 3, fr = lane & 15, fq = lane >> 4;
    const int K = g.K, nt = K / BK;
    unsigned voffA[2], voffB[2];
#pragma unroll
    for (int i = 0; i < 2; ++i) { int R, C; stage_rc(tid * 16 + i * 8192, R, C); const int Rb = Epi::PERM ? ((R & ~31) + perm32(R & 31)) : R;
        voffA[i] = (unsigned)(R * K + C) * 2u; voffB[i] = (unsigned)(Rb * K + C) * 2u; }
    const size_t kstep = (size_t)(BK * 2);
    const size_t hstep = (size_t)HALF * K * 2;
    const size_t tstep = 2 * hstep;
    const unsigned ldsw = (unsigned)wid * 1024u;
    const int aoff = lds_byte(wr * 64 + fr, fq * 8), boff = lds_byte(wc * 32 + fr, fq * 8);
#define PG8_SA(b, h) (((b) * 2 + (h)) * HTB)
#define PG8_SB(b, h) ((4 + (b) * 2 + (h)) * HTB)
#define PG8_STAGE(bufoff, gbase, voff) do { _Pragma("unroll") for (int _i = 0; _i < 2; ++_i) \
        __builtin_amdgcn_global_load_lds((const unsigned*)((const char*)(gbase) + (voff)[_i]), (PG8_LAS unsigned*)(lds + (bufoff) + ldsw + _i * 8192), 16, 0, 0); } while (0)
#define PG8_LDA(dst, b, h) do { _Pragma("unroll") for (int m = 0; m < 4; ++m) _Pragma("unroll") for (int k = 0; k < 2; ++k) dst[m][k] = *(const PG8_LAS bf16x8*)(lds + PG8_SA(b, h) + aoff + m * 2048 + k * 1024); } while (0)
#define PG8_LDB(dst, b, h) do { _Pragma("unroll") for (int n = 0; n < 2; ++n) _Pragma("unroll") for (int k = 0; k < 2; ++k) dst[n][k] = *(const PG8_LAS bf16x8*)(lds + PG8_SB(b, h) + boff + n * 2048 + k * 1024); } while (0)
#define PG8_MMA(ai, bj, At, Bt) do { __builtin_amdgcn_s_setprio(1); _Pragma("unroll") for (int m = 0; m < 4; ++m) _Pragma("unroll") for (int n = 0; n < 2; ++n) _Pragma("unroll") for (int k = 0; k < 2; ++k) \
        acc[ai][bj][m][n] = __builtin_amdgcn_mfma_f32_16x16x32_bf16(Bt[n][k], At[m][k], acc[ai][bj][m][n], 0, 0, 0); __builtin_amdgcn_s_setprio(0); } while (0)
#define PG8_WAIT_V(n) asm volatile("s_waitcnt vmcnt(" #n ")" ::: "memory")
#define PG8_WAIT_L(n) asm volatile("s_waitcnt lgkmcnt(" #n ")" ::: "memory")
#define PG8_BAR __builtin_amdgcn_s_barrier()
#define PG8_SCHED __builtin_amdgcn_sched_barrier(0)
    Unit cur, nxt; int ui = 0;
    if (!S.next(0, cur)) return;
    f32x4 acc[2][2][4][2];
#pragma unroll
    for (int a = 0; a < 2; ++a)
#pragma unroll
        for (int b = 0; b < 2; ++b)
#pragma unroll
            for (int m = 0; m < 4; ++m)
#pragma unroll
                for (int n = 0; n < 2; ++n) acc[a][b][m][n] = (f32x4){0.f, 0.f, 0.f, 0.f};
    bf16x8 At[4][2], B0[2][2], B1[2][2];
    const char* cA = (const char*)g.A + (size_t)cur.pm * tstep; const char* cB = (const char*)g.Bt + (size_t)cur.pn * tstep;
    S.a_ready(cur);
    if constexpr (SP2) {
        PG8_STAGE(PG8_SB(0, 0), cB, voffB); PG8_STAGE(PG8_SB(0, 1), cB + hstep, voffB); PG8_STAGE(PG8_SA(0, 0), cA, voffA); PG8_STAGE(PG8_SA(0, 1), cA + hstep, voffA);
        if (wr == 1) PG8_BAR;
        PG8_WAIT_V(2); PG8_BAR;
        PG8_STAGE(PG8_SB(1, 0), cB + kstep, voffB); PG8_STAGE(PG8_SA(1, 0), cA + kstep, voffA); PG8_STAGE(PG8_SB(1, 1), cB + hstep + kstep, voffB);
        PG8_WAIT_V(6); PG8_BAR;
    } else {
        PG8_STAGE(PG8_SB(0, 0), cB, voffB); PG8_STAGE(PG8_SA(0, 0), cA, voffA); PG8_STAGE(PG8_SB(0, 1), cB + hstep, voffB); PG8_STAGE(PG8_SA(0, 1), cA + hstep, voffA);
        if (wr == 1) PG8_BAR;
        PG8_WAIT_V(4); PG8_BAR;
        PG8_STAGE(PG8_SB(1, 0), cB + kstep, voffB); PG8_STAGE(PG8_SA(1, 0), cA + kstep, voffA); PG8_STAGE(PG8_SB(1, 1), cB + hstep + kstep, voffB);
        PG8_WAIT_V(6); PG8_BAR;
    }
    for (;;) {
        const bool has_next = S.next(ui + 1, nxt);
        const char* nA = has_next ? (const char*)g.A + (size_t)nxt.pm * tstep : cA; const char* nB = has_next ? (const char*)g.Bt + (size_t)nxt.pn * tstep : cB;
        for (int t = 0; t < nt; t += 2) {
            const bool last = (t == nt - 2);
            const char* a1 = cA + (size_t)(t + 1) * kstep;
            const char* a2 = last ? nA : cA + (size_t)(t + 2) * kstep; const char* b2 = last ? nB : cB + (size_t)(t + 2) * kstep;
            const char* a3 = a2 + kstep; const char* b3 = b2 + kstep;
            if (last && has_next) S.a_ready(nxt);
            if constexpr (SP2) {
            PG8_LDB(B0, 0, 0); PG8_LDB(B1, 0, 1); PG8_SCHED; PG8_LDA(At, 0, 0); PG8_STAGE(PG8_SA(1, 1), a1 + hstep, voffA);
            PG8_WAIT_V(8); PG8_WAIT_L(0); PG8_BAR; PG8_MMA(0, 0, At, B0); PG8_MMA(0, 1, At, B1); PG8_BAR; PG8_SCHED;
            PG8_LDA(At, 0, 1); PG8_STAGE(PG8_SB(0, 0), b2, voffB); PG8_STAGE(PG8_SB(0, 1), b2 + hstep, voffB); PG8_STAGE(PG8_SA(0, 0), a2, voffA);
            PG8_WAIT_V(8); PG8_WAIT_L(0); PG8_BAR; PG8_MMA(1, 0, At, B0); PG8_MMA(1, 1, At, B1); PG8_BAR; PG8_SCHED;
            PG8_LDB(B0, 1, 0); PG8_LDB(B1, 1, 1); PG8_SCHED; PG8_LDA(At, 1, 0); PG8_STAGE(PG8_SA(0, 1), a2 + hstep, voffA);
            PG8_WAIT_V(8); PG8_WAIT_L(0); PG8_BAR; PG8_MMA(0, 0, At, B0); PG8_MMA(0, 1, At, B1); PG8_BAR; PG8_SCHED;
            PG8_LDA(At, 1, 1); PG8_STAGE(PG8_SB(1, 0), b3, voffB); PG8_STAGE(PG8_SB(1, 1), b3 + hstep, voffB); PG8_STAGE(PG8_SA(1, 0), a3, voffA);
            PG8_WAIT_V(8); PG8_WAIT_L(0); PG8_BAR; PG8_MMA(1, 0, At, B0); PG8_MMA(1, 1, At, B1); PG8_BAR; PG8_SCHED;
            } else {
            PG8_LDB(B0, 0, 0); PG8_SCHED; PG8_LDA(At, 0, 0); PG8_STAGE(PG8_SA(1, 1), a1 + hstep, voffA);
            PG8_WAIT_L(8); PG8_BAR; PG8_WAIT_L(0); PG8_MMA(0, 0, At, B0); PG8_BAR; PG8_SCHED;
            PG8_LDB(B1, 0, 1); PG8_STAGE(PG8_SB(0, 0), b2, voffB);
            PG8_BAR; PG8_WAIT_L(0); PG8_MMA(0, 1, At, B1); PG8_BAR;
            PG8_LDA(At, 0, 1); PG8_STAGE(PG8_SA(0, 0), a2, voffA);
            PG8_BAR; PG8_WAIT_L(0); PG8_MMA(1, 0, At, B0); PG8_BAR; PG8_SCHED;
            PG8_STAGE(PG8_SB(0, 1), b2 + hstep, voffB);
            PG8_WAIT_V(6); PG8_BAR; PG8_MMA(1, 1, At, B1); PG8_BAR;
            PG8_LDB(B0, 1, 0); PG8_SCHED; PG8_LDA(At, 1, 0); PG8_STAGE(PG8_SA(0, 1), a2 + hstep, voffA);
            PG8_WAIT_L(8); PG8_BAR; PG8_WAIT_L(0); PG8_MMA(0, 0, At, B0); PG8_BAR; PG8_SCHED;
            PG8_LDB(B1, 1, 1); PG8_STAGE(PG8_SB(1, 0), b3, voffB);
            PG8_BAR; PG8_WAIT_L(0); PG8_MMA(0, 1, At, B1); PG8_BAR;
            PG8_LDA(At, 1, 1); PG8_STAGE(PG8_SA(1, 0), a3, voffA);
            PG8_BAR; PG8_WAIT_L(0); PG8_MMA(1, 0, At, B0); PG8_BAR; PG8_SCHED;
            PG8_STAGE(PG8_SB(1, 1), b3 + hstep, voffB);
            PG8_WAIT_V(6); PG8_BAR; PG8_MMA(1, 1, At, B1); PG8_BAR;
            }
        }
        if constexpr (ALIGN_EPI) { if (wr == 0) PG8_BAR; }
        if constexpr (!Epi::AFTER_DRAIN) { E(acc, cur, wr, wc, fr, fq); S.done(cur); }
        if (!has_next) break;
#pragma unroll
        for (int a = 0; a < 2; ++a)
#pragma unroll
            for (int b = 0; b < 2; ++b)
#pragma unroll
                for (int m = 0; m < 4; ++m)
#pragma unroll
                    for (int n = 0; n < 2; ++n) acc[a][b][m][n] = (f32x4){0.f, 0.f, 0.f, 0.f};
        cur = nxt; cA = nA; cB = nB; ++ui;
        if constexpr (ALIGN_EPI) { if (wr == 1) PG8_BAR; }
    }
    PG8_WAIT_V(0);
    if constexpr (!ALIGN_EPI) { if (wr == 0) PG8_BAR; }
    PG8_BAR;
    if constexpr (Epi::AFTER_DRAIN) { E.fused(acc, cur, wr, wc, fr, fq, lds, wid, lane); S.done(cur); }
#undef PG8_SA
#undef PG8_SB
#undef PG8_STAGE
#undef PG8_LDA
#undef PG8_LDB
#undef PG8_MMA
#undef PG8_WAIT_V
#undef PG8_WAIT_L
#undef PG8_BAR
#undef PG8_SCHED
}
}
#include <hip/hip_bf16.h>
#include <cmath>
namespace attn_body {
using bf16=__hip_bfloat16;
using bf16x8=__attribute__((ext_vector_type(8)))short;
using s16x4=__attribute__((ext_vector_type(4)))short;
using f32x16=__attribute__((ext_vector_type(16)))float;
using u32x4=__attribute__((ext_vector_type(4)))unsigned;
constexpr int BATCH=2,NHEAD=16,SEQ=8192,D=64,DM=NHEAD*D,KP=512;
constexpr int NW=8,QBLK=32,QB=QBLK*NW,KVBLK=64,NQB=SEQ/QB;
constexpr int ATTN_PITCH=DM, ATTN_UNIT_ROWS=QB;
__device__ __forceinline__ int crow(int r,int hi){return (r&3)+8*(r>>2)+4*hi;}
#define SBAR() __builtin_amdgcn_sched_barrier(0)
__device__ __forceinline__ void cmask(f32x16&p0,f32x16&p1,int jb,int qrel,int hi){
  const float NEG=-INFINITY; int lim=qrel-64*jb-4*hi; asm volatile("":"+v"(lim));
  #pragma unroll
  for(int r=0;r<16;++r){const int cr=(r&3)+8*(r>>2); if(cr>lim)p0[r]=NEG; if(cr+32>lim)p1[r]=NEG;}
}

constexpr int NSLOT=3, SLOTB=8192;
constexpr int LDS_K=0, LDS_V=NSLOT*SLOTB, LDS_WS=2*NSLOT*SLOTB, LDS_OST=LDS_WS+NW*64*4, LDS_BYTES=LDS_OST+NW*4096;
constexpr float C2=0.125f*1.4426950408889634f;
__device__ __forceinline__ void glds16(const void*gsrc,unsigned lds_dst){unsigned keep;
  asm volatile("s_mov_b32 %0, m0\n\ts_mov_b32 m0, %2\n\ts_nop 0\n\tglobal_load_lds_dwordx4 %1, off\n\ts_mov_b32 m0, %0":"=&s"(keep):"v"(gsrc),"s"(lds_dst):"memory");}
__device__ __forceinline__ float max3f(float a,float b,float c){float r;asm("v_max3_f32 %0, %1, %2, %3":"=v"(r):"v"(a),"v"(b),"v"(c));return r;}
__device__ __forceinline__ float max2f(float a,float b){float r;asm("v_max_f32_e32 %0, %1, %2":"=v"(r):"v"(a),"v"(b));return r;}
__device__ __forceinline__ float fadd_s(float a,float b){float r;asm("v_add_f32_e32 %0, %1, %2":"=v"(r):"v"(a),"v"(b));return r;}
__device__ __forceinline__ float fsub_s(float a,float b){float r;asm("v_sub_f32_e32 %0, %1, %2":"=v"(r):"v"(a),"v"(b));return r;}
typedef float f32x2_t __attribute__((ext_vector_type(2))); typedef __bf16 bf16x2_t __attribute__((ext_vector_type(2)));
__device__ __forceinline__ unsigned cvtpk_s(float lo,float hi){f32x2_t v={lo,hi};bf16x2_t b=__builtin_convertvector(v,bf16x2_t);return __builtin_bit_cast(unsigned,b);}
#define WAIT_BAR(N) asm volatile("s_waitcnt vmcnt(" #N ") lgkmcnt(0)\n\ts_barrier":::"memory")

__device__ __forceinline__ void qkt(f32x16&p0,f32x16&p1,const char*Kslot,const bf16x8*qr,const f32x16&negm,int r32,int hi){
  const char*kb=Kslot+hi*1024+r32*16;
  #pragma unroll
  for(int d0=0;d0<4;++d0){
    const bf16x8 b0=*reinterpret_cast<const bf16x8*>(kb+d0*2048);
    const bf16x8 b1=*reinterpret_cast<const bf16x8*>(kb+d0*2048+512);
    if(d0==0){p0=__builtin_amdgcn_mfma_f32_32x32x16_bf16(b0,qr[0],negm,0,0,0);p1=__builtin_amdgcn_mfma_f32_32x32x16_bf16(b1,qr[0],negm,0,0,0);}
    else{p0=__builtin_amdgcn_mfma_f32_32x32x16_bf16(b0,qr[d0],p0,0,0,0);p1=__builtin_amdgcn_mfma_f32_32x32x16_bf16(b1,qr[d0],p1,0,0,0);}}
}
typedef __attribute__((address_space(3))) const char* lds_cptr;
typedef short v4i16_t __attribute__((ext_vector_type(4)));
__device__ __forceinline__ void kload8(bf16x8*kf,lds_cptr kp){
  kf[0]=*(const __attribute__((address_space(3))) bf16x8*)(kp);      kf[1]=*(const __attribute__((address_space(3))) bf16x8*)(kp+512);
  kf[2]=*(const __attribute__((address_space(3))) bf16x8*)(kp+2048); kf[3]=*(const __attribute__((address_space(3))) bf16x8*)(kp+2560);
  kf[4]=*(const __attribute__((address_space(3))) bf16x8*)(kp+4096); kf[5]=*(const __attribute__((address_space(3))) bf16x8*)(kp+4608);
  kf[6]=*(const __attribute__((address_space(3))) bf16x8*)(kp+6144); kf[7]=*(const __attribute__((address_space(3))) bf16x8*)(kp+6656);
}
__device__ __forceinline__ void kload2(bf16x8*kf,lds_cptr kp,int j){ kf[2*j]=*(const __attribute__((address_space(3))) bf16x8*)(kp+j*2048); kf[2*j+1]=*(const __attribute__((address_space(3))) bf16x8*)(kp+j*2048+512); }
__device__ __forceinline__ s16x4 vtr(lds_cptr p){ return __builtin_bit_cast(s16x4,__builtin_amdgcn_ds_read_tr16_b64_v4i16((__attribute__((address_space(3))) v4i16_t*)p)); }
__device__ __forceinline__ float rowmax(const f32x16&p0,const f32x16&p1){
  float a=max3f(p0[0],p0[1],p1[0]),b=max3f(p0[2],p0[3],p1[1]);a=max3f(a,p1[2],p1[3]);
  #pragma unroll
  for(int r=4;r<16;r+=4){a=max3f(a,p0[r],p0[r+1]);b=max3f(b,p0[r+2],p0[r+3]);a=max3f(a,p1[r],p1[r+1]);b=max3f(b,p1[r+2],p1[r+3]);}
  const float m=max2f(a,b);
  auto rr=__builtin_amdgcn_permlane32_swap(__float_as_uint(m),__float_as_uint(m),false,false);
  return max2f(__uint_as_float(rr[0]),__uint_as_float(rr[1]));
}
__device__ __forceinline__ void pv(f32x16*o,int vb,bf16x8 pa0,bf16x8 pa1,bf16x8 pa2,bf16x8 pa3){
  #pragma unroll
  for(int d0=0;d0<2;++d0){s16x4 lo[4],hi[4];
    #pragma unroll
    for(int ks=0;ks<4;++ks){
      asm volatile("ds_read_b64_tr_b16 %0,%1 offset:%c2":"=&v"(lo[ks]):"v"(vb),"i"(d0*4096+ks*1024):"memory");
      asm volatile("ds_read_b64_tr_b16 %0,%1 offset:%c2":"=&v"(hi[ks]):"v"(vb),"i"(d0*4096+ks*1024+512):"memory");}
    asm volatile("s_waitcnt lgkmcnt(0)":::"memory");SBAR();
    #define PK(k) (bf16x8){lo[k][0],lo[k][1],lo[k][2],lo[k][3],hi[k][0],hi[k][1],hi[k][2],hi[k][3]}
    o[d0]=__builtin_amdgcn_mfma_f32_32x32x16_bf16(pa0,PK(0),o[d0],0,0,0);
    o[d0]=__builtin_amdgcn_mfma_f32_32x32x16_bf16(pa1,PK(1),o[d0],0,0,0);
    o[d0]=__builtin_amdgcn_mfma_f32_32x32x16_bf16(pa2,PK(2),o[d0],0,0,0);
    o[d0]=__builtin_amdgcn_mfma_f32_32x32x16_bf16(pa3,PK(3),o[d0],0,0,0);
    #undef PK
  }
}

#ifndef ATTN_STORE16
#define ATTN_STORE16(p,v) (*(u32x4*)(p)=(v))
#endif
template<int THRL> __device__ __forceinline__ void attn_unit(int b,int h,int qb,const bf16*Q,const bf16*__restrict__ K,const bf16*__restrict__ V,bf16*O,char*shm,const int wave_id){
  const int wid=wave_id,lane=lane_id(),tid=wid*64+lane,r32=lane&31,hi=lane>>5;
  const long rowbase=(long)b*SEQ; const int q0=qb*QB;
  const bf16*Qw=Q+(rowbase+q0+wid*QBLK)*DM+h*D;
  const bf16*Kh=K+rowbase*KP+(h>>1)*D,*Vh=V+rowbase*KP+(h>>2)*128+(h&1)*D;
  const unsigned lds0=(unsigned)(uintptr_t)shm;
  float*wsf=(float*)(shm+LDS_WS)+wid*64;
  const bf16*ksrc=Kh+(long)lane*KP+wid*8;
  const bf16*vsrc=Vh+(long)(16*(wid&3)+(lane>>2))*KP+(wid>>2)*32+(lane&3)*8;
  const unsigned kdst=lds0+LDS_K+wid*1024, vdst=lds0+LDS_V+wid*1024;
  #define DMA_K(t,slot) glds16(ksrc+(long)(t)*KVBLK*KP,(unsigned)__builtin_amdgcn_readfirstlane(kdst+(slot)))
  #define DMA_V(t,slot) glds16(vsrc+(long)(t)*KVBLK*KP,(unsigned)__builtin_amdgcn_readfirstlane(vdst+(slot)))
  const int vb0=(int)(lds0+LDS_V)+((lane>>4)&1)*32+(lane&3)*8+(4*hi+((lane&15)>>2))*64;
  const char*Kbase=shm+LDS_K; bf16x8 kf[8];
  const lds_cptr shm3=(lds_cptr)shm; const lds_cptr kp0=shm3+LDS_K+hi*1024+r32*16; const lds_cptr vp0=shm3+LDS_V+((lane>>4)&1)*32+(lane&3)*8+(4*hi+((lane&15)>>2))*64;
  const int NT=(q0+QB)/KVBLK;
  DMA_K(0,0);DMA_V(0,0);DMA_K(1,SLOTB);
  bf16x8 qr[4];
  #pragma unroll
  for(int d0=0;d0<4;++d0)qr[d0]=*reinterpret_cast<const bf16x8*>(&Qw[(long)r32*DM+d0*16+hi*8]);
  float mhat=0.f,l_reg=0.f;f32x16 o[2];o[0]=f32x16{};o[1]=f32x16{};const f32x16 negm=f32x16{};
  const int qrel=wid*QBLK+r32;
  const unsigned slb_=0x3eb8aa3bu-((unsigned)__builtin_amdgcn_readfirstlane(h>>2)<<24); const float sl2=__uint_as_float(slb_);
  const float qposf=(float)(q0+qrel-4*hi);
  const float s1_=sl2, s8_=__uint_as_float(slb_+(3u<<23)), s32_=__uint_as_float(slb_+(5u<<23));
  #define AADD(d,a,sv) asm volatile("v_add_f32_e32 %0, %1, %2":"=v"(d):"s"(sv),"v"(a))
  #define ALIBI(P0,P1,t) do{ float bq_=__builtin_fmaf(sl2,((float)(64*(t))-qposf),-mhat); \
    _Pragma("unroll") for(int q_=0;q_<4;++q_){ float b0_=bq_,b1_,b2_,b3_,c_; AADD(b1_,b0_,s1_); AADD(b2_,b1_,s1_); AADD(b3_,b2_,s1_); \
      P0[4*q_]+=b0_; P0[4*q_+1]+=b1_; P0[4*q_+2]+=b2_; P0[4*q_+3]+=b3_; \
      AADD(c_,b0_,s32_); P1[4*q_]+=c_; AADD(c_,b1_,s32_); P1[4*q_+1]+=c_; AADD(c_,b2_,s32_); P1[4*q_+2]+=c_; AADD(c_,b3_,s32_); P1[4*q_+3]+=c_; \
      if(q_<3){ AADD(bq_,b0_,s8_); } } }while(0)
  #define CMASK(P0,P1,t) do{int jb_=(t)-(NT-4); if(jb_>=0)cmask(P0,P1,jb_,qrel,hi);}while(0)
  bool resc=false;
  #define START(P0,P1) do{ const float rm=rowmax(P0,P1); resc=false; \
    { const float dl=rm; mhat=fadd_s(mhat,dl); \
      _Pragma("unroll") for(int r=0;r<16;++r){P0[r]=fsub_s(P0[r],dl);P1[r]=fsub_s(P1[r],dl);} \
      } \
    _Pragma("unroll") for(int r=0;r<16;++r)P0[r]=__builtin_amdgcn_exp2f(P0[r]); }while(0)
  #define RESC() do{ if(resc){ asm volatile("s_waitcnt lgkmcnt(0)":::"memory"); \
      _Pragma("unroll") for(int d_=0;d_<2;++d_) _Pragma("unroll") for(int r=0;r<16;++r)o[d_][r]*=wsf[crow(r,hi)]; } }while(0)
  f32x16 pA0,pA1,pB0,pB1;
  int sl_prev=0,sl_cur=0,sl_next=SLOTB;
  #define ROT() do{sl_prev=sl_cur;sl_cur=sl_next;sl_next=(sl_next==(NSLOT-1)*SLOTB)?0:sl_next+SLOTB;}while(0)
  DMA_K(2,2*SLOTB);
  WAIT_BAR(3);
  qkt(pA0,pA1,Kbase,qr,negm,r32,hi);asm volatile("s_nop 15\n\ts_nop 7":"+v"(pA0),"+v"(pA1));ALIBI(pA0,pA1,0);CMASK(pA0,pA1,0);
  START(pA0,pA1);
  _Pragma("unroll") for(int r=0;r<16;++r)pA1[r]=__builtin_amdgcn_exp2f(pA1[r]);
  WAIT_BAR(0);
  DMA_K(3,0);DMA_V(1,SLOTB);
  ROT();
  kload8(kf,kp0+sl_cur);
  WAIT_BAR(2);
  s16x4 vlo[8],vhi[8]; u32x4 pw0,pw1,pw2,pw3;
  #define PKW(P,B) cvtpk_s(P[B],P[B+1])
  #define PAF(k) __builtin_bit_cast(bf16x8,pw##k)
  #define VFR(i) (bf16x8){vlo[i][0],vlo[i][1],vlo[i][2],vlo[i][3],vhi[i][0],vhi[i][1],vhi[i][2],vhi[i][3]}
  #define PIN(x) asm volatile("":"+v"(x))
  #define MX3(a,b,c) __builtin_fmaxf(__builtin_fmaxf((a),(b)),(c))
  #define GAPA(MF,A0,A1,A2,A3,W0,W1,PW) do{ MF; sacc+=A0; sacc+=A1; sacc+=A2; sacc+=A3; PIN(sacc); W0; W1; PIN(PW); SBAR(); }while(0)
  #define EX(v) __builtin_amdgcn_exp2f(v)
  #define GAPB(MF,X,B) do{ MF; X[B]=EX(X[B]); X[B+1]=EX(X[B+1]); X[B+2]=EX(X[B+2]); X[B+3]=EX(X[B+3]); PIN(X); SBAR(); }while(0)
  #define VRD(i) do{ vlo[i]=vtr(vp_+(((i)>>2)*4096+((i)&3)*1024)); vhi[i]=vtr(vp_+(((i)>>2)*4096+((i)&3)*1024+512)); }while(0)
  #define KRD(G,j) do{ if(G){ kload2(kf,kp0+sl_next,j); SBAR(); } }while(0)
  #define STEP(C0,C1,P0,P1,t,GK,GV,GL) do{ SBAR(); \
    const lds_cptr vp_=vp0+sl_prev; \
    VRD(0); SBAR(); float sacc=(P0[0]+P0[1]); \
    GAPA(C0=__builtin_amdgcn_mfma_f32_32x32x16_bf16(kf[0],qr[0],negm,0,0,0), P0[2],P0[3],P0[4],P0[5],     pw0[0]=PKW(P0,0), pw0[1]=PKW(P0,2), pw0); \
    VRD(4); SBAR(); GAPA(C1=__builtin_amdgcn_mfma_f32_32x32x16_bf16(kf[1],qr[0],negm,0,0,0), P0[6],P0[7],P0[8],P0[9],     pw0[2]=PKW(P0,4), pw0[3]=PKW(P0,6), pw0); \
    VRD(1); SBAR(); GAPA(C0=__builtin_amdgcn_mfma_f32_32x32x16_bf16(kf[2],qr[1],C0,0,0,0),   P0[10],P0[11],P0[12],P0[13], pw1[0]=PKW(P0,8), pw1[1]=PKW(P0,10), pw1); \
    VRD(5); SBAR(); GAPA(C1=__builtin_amdgcn_mfma_f32_32x32x16_bf16(kf[3],qr[1],C1,0,0,0),   P0[14],P0[15],P1[0],P1[1],   pw1[2]=PKW(P0,12),pw1[3]=PKW(P0,14), pw1); \
    VRD(2); SBAR(); GAPA(C0=__builtin_amdgcn_mfma_f32_32x32x16_bf16(kf[4],qr[2],C0,0,0,0),   P1[2],P1[3],P1[4],P1[5],     pw2[0]=PKW(P1,0), pw2[1]=PKW(P1,2), pw2); \
    VRD(6); SBAR(); GAPA(C1=__builtin_amdgcn_mfma_f32_32x32x16_bf16(kf[5],qr[2],C1,0,0,0),   P1[6],P1[7],P1[8],P1[9],     pw2[2]=PKW(P1,4), pw2[3]=PKW(P1,6), pw2); \
    VRD(3); SBAR(); GAPA(C0=__builtin_amdgcn_mfma_f32_32x32x16_bf16(kf[6],qr[3],C0,0,0,0),   P1[10],P1[11],P1[12],P1[13], pw3[0]=PKW(P1,8), pw3[1]=PKW(P1,10), pw3); \
    VRD(7); SBAR(); GAPA(C1=__builtin_amdgcn_mfma_f32_32x32x16_bf16(kf[7],qr[3],C1,0,0,0),   P1[14],P1[15],0.f,0.f,       pw3[2]=PKW(P1,12),pw3[3]=PKW(P1,14), pw3); \
    l_reg+=sacc; \
    if(GK){DMA_K((t)+3,sl_cur);} if(GV){DMA_V((t)+1,sl_next);} \
    ALIBI(C0,C1,t); CMASK(C0,C1,t); \
    { float a=MX3(C0[0],C0[1],C1[0]),b=MX3(C0[2],C0[3],C1[1]); a=MX3(a,C1[2],C1[3]); \
      _Pragma("unroll") for(int r=4;r<16;r+=4){a=MX3(a,C0[r],C0[r+1]);b=MX3(b,C0[r+2],C0[r+3]);a=MX3(a,C1[r],C1[r+1]);b=MX3(b,C1[r+2],C1[r+3]);} \
      float rm=__builtin_fmaxf(a,b); { auto rr=__builtin_amdgcn_permlane32_swap(__float_as_uint(rm),__float_as_uint(rm),false,false); rm=__builtin_fmaxf(__uint_as_float(rr[0]),__uint_as_float(rr[1])); } \
      resc=false; \
      if(__builtin_expect(__any(rm>(float)THRL),0)){ const float dl=__builtin_fmaxf(rm,0.f); mhat+=dl; \
        _Pragma("unroll") for(int r=0;r<16;++r){C0[r]-=dl;C1[r]-=dl;} \
        const float f=__builtin_amdgcn_exp2f(-dl); l_reg*=f; if(hi==0)wsf[r32]=f; resc=true; } } \
    SBAR(); \
    GAPB(o[0]=__builtin_amdgcn_mfma_f32_32x32x16_bf16(PAF(0),VFR(0),o[0],0,0,0), C0,0); \
    GAPB(o[1]=__builtin_amdgcn_mfma_f32_32x32x16_bf16(PAF(0),VFR(4),o[1],0,0,0), C0,4); \
    KRD(GL,0); GAPB(o[0]=__builtin_amdgcn_mfma_f32_32x32x16_bf16(PAF(1),VFR(1),o[0],0,0,0), C0,8); \
    KRD(GL,1); GAPB(o[1]=__builtin_amdgcn_mfma_f32_32x32x16_bf16(PAF(1),VFR(5),o[1],0,0,0), C0,12); \
    KRD(GL,2); GAPB(o[0]=__builtin_amdgcn_mfma_f32_32x32x16_bf16(PAF(2),VFR(2),o[0],0,0,0), C1,0); \
    KRD(GL,3); GAPB(o[1]=__builtin_amdgcn_mfma_f32_32x32x16_bf16(PAF(2),VFR(6),o[1],0,0,0), C1,4); \
    GAPB(o[0]=__builtin_amdgcn_mfma_f32_32x32x16_bf16(PAF(3),VFR(3),o[0],0,0,0), C1,8); \
    GAPB(o[1]=__builtin_amdgcn_mfma_f32_32x32x16_bf16(PAF(3),VFR(7),o[1],0,0,0), C1,12); \
    }while(0)
  int t=1;
  #undef CMASK
  #define CMASK(P0,P1,t) do{}while(0)
  for(;t+5<NT;t+=2){
    STEP(pB0,pB1,pA0,pA1,t,true,true,true);     WAIT_BAR(2); RESC(); ROT();
    STEP(pA0,pA1,pB0,pB1,t+1,true,true,true);   WAIT_BAR(2); RESC(); ROT();
  }
  #undef CMASK
  #define CMASK(P0,P1,t) do{int jb_=(t)-(NT-4); if(jb_>=0)cmask(P0,P1,jb_,qrel,hi);}while(0)
  #define ENDW(tt) do{ if((tt)+3<NT){WAIT_BAR(2);} else if((tt)+2<NT){WAIT_BAR(1);} else {WAIT_BAR(0);} }while(0)
  for(;t+1<NT;t+=2){
    STEP(pB0,pB1,pA0,pA1,t,(t+3<NT),(t+1<NT),(t+1<NT));       ENDW(t);   RESC(); ROT();
    STEP(pA0,pA1,pB0,pB1,t+1,(t+4<NT),(t+2<NT),(t+2<NT));     ENDW(t+1); RESC(); ROT();
  }
  STEP(pB0,pB1,pA0,pA1,NT-1,false,false,false); RESC();
  { float sacc=pB0[0]+pB0[1]; _Pragma("unroll") for(int r=2;r<16;++r)sacc+=pB0[r]; _Pragma("unroll") for(int r=0;r<16;++r)sacc+=pB1[r]; l_reg+=sacc;
    pw0=(u32x4){PKW(pB0,0),PKW(pB0,2),PKW(pB0,4),PKW(pB0,6)};pw1=(u32x4){PKW(pB0,8),PKW(pB0,10),PKW(pB0,12),PKW(pB0,14)};pw2=(u32x4){PKW(pB1,0),PKW(pB1,2),PKW(pB1,4),PKW(pB1,6)};pw3=(u32x4){PKW(pB1,8),PKW(pB1,10),PKW(pB1,12),PKW(pB1,14)};
    SBAR(); pv(o,vb0+sl_cur,PAF(0),PAF(1),PAF(2),PAF(3)); }
  #undef PKW
  #undef PAF
  #undef VFR
  #undef PIN
  #undef MX3
  #undef GAPA
  #undef GAPB
  #undef EX
  #undef VRD
  #undef KRD
  #undef STEP
  #undef ENDW
  {auto rr=__builtin_amdgcn_permlane32_swap(__float_as_uint(l_reg),__float_as_uint(l_reg),false,false);l_reg=__uint_as_float(rr[0])+__uint_as_float(rr[1]);}
  if(hi==0)wsf[32+r32]=l_reg;asm volatile("s_waitcnt lgkmcnt(0)":::"memory");
  float rli[16];
  #pragma unroll
  for(int r=0;r<16;++r)rli[r]=__builtin_amdgcn_rcpf(wsf[32+crow(r,hi)]);
  bf16*Ow=O+(rowbase+q0+wid*QBLK)*DM+h*D;
  { bf16*stg=(bf16*)(shm+LDS_OST)+wid*2048;
    #pragma unroll
    for(int r=0;r<16;++r){const int orow=crow(r,hi);
      #pragma unroll
      for(int d0=0;d0<2;++d0)stg[orow*64+d0*32+r32]=__float2bfloat16(o[d0][r]*rli[r]);}
    asm volatile("s_waitcnt lgkmcnt(0)":::"memory");
    #pragma unroll
    for(int i=0;i<4;++i){const int row=i*8+(lane>>3),ch=lane&7; const u32x4 v=*(const u32x4*)(stg+row*64+ch*8); ATTN_STORE16(Ow+(long)row*DM+ch*8,v);} }
  asm volatile("s_waitcnt lgkmcnt(0)\n\ts_barrier":::"memory");
  #undef ALIBI
  #undef AADD
  #undef DMA_K
  #undef DMA_V
  #undef CMASK
  #undef START
  #undef RESC
  #undef ROT
}
constexpr int ATTN_LDS_BYTES=LDS_BYTES;
struct AttnTensors { const bf16* Q; const bf16* K; const bf16* V; bf16* O; };
struct AttnUnit { int bh; int qb; };
struct StaticOrder {
  int vcu;
  __device__ __forceinline__ explicit StaticOrder(int grid,int block):vcu((block%8)*(grid/8)+block/8){}
  __device__ __forceinline__ bool next(int i,AttnUnit&u)const{ if(i>=4)return false; const int s=vcu&7; u.bh=vcu>>3; u.qb=(i==0)?s:(i==1)?15-s:(i==2)?16+s:31-s; return true; }
  __device__ __forceinline__ void a_ready(const AttnUnit&)const{}
  __device__ __forceinline__ void done(const AttnUnit&)const{}
};
struct DynOrder {
  unsigned* qctr; volatile __attribute__((address_space(3))) unsigned* slot; int xq, wave;
  __device__ __forceinline__ bool next(int,AttnUnit&u)const{
    if(wave==0&&lane_id()==0){ slot[0]=__hip_atomic_fetch_add(qctr+64*xq,1u,__ATOMIC_RELAXED,__HIP_MEMORY_SCOPE_AGENT); }
    __syncthreads(); const unsigned v=slot[0]; __syncthreads();
    if(v>=128u)return false; u.qb=31-(int)(v>>2); u.bh=4*xq+(int)(v&3u); return true; }
  __device__ __forceinline__ void a_ready(const AttnUnit&)const{}
  __device__ __forceinline__ void done(const AttnUnit&)const{}
};
template<class Sched,int THRL=8> __device__ __forceinline__ void attn_phase(char*lds,const AttnTensors&T,const Sched&S,const int wave_id){
  AttnUnit u;
  for(int i=0;S.next(i,u);++i){ S.a_ready(u); attn_unit<THRL>(u.bh/NHEAD,u.bh%NHEAD,u.qb,T.Q,T.K,T.V,T.O,lds,wave_id); S.done(u); }
}
#undef SBAR
#undef WAIT_BAR
}
constexpr int NWAVES = 8;
constexpr int BATCH = 2, T = 8192, D = 1024, FF = 2816, M = BATCH * T;
constexpr int WIN_SRC = 5648, WIN_N = 3840;
constexpr float RMS_EPS = 1e-6f, SUBLN_EPS = 1e-5f;
constexpr size_t MiB = 1u << 20;
constexpr size_t WS_SSQA = 1 * MiB, WS_SSQB = 2 * MiB, WS_DNCD = 3 * MiB;
constexpr size_t WS_WG = 4 * MiB, WS_WA = 8 * MiB, WS_WB = 9 * MiB, WS_WOUT = 10 * MiB;
constexpr size_t WS_XB = 12 * MiB;
constexpr size_t WS_H = 44 * MiB;
constexpr size_t WS_WGU1 = 232 * MiB, WS_WD1 = 243 * MiB, WS_WIN = 248 * MiB + 512 * 1024;
constexpr size_t WS_PRE = 44 * MiB, WS_Z = 92 * MiB, WS_QO = 108 * MiB, WS_KD = 140 * MiB, WS_VD = 156 * MiB, WS_AB = 172 * MiB;
constexpr size_t WS_DN = 173 * MiB;
constexpr size_t WS_ODN = 44 * MiB, WS_AA = 60 * MiB, WS_ABB = 76 * MiB;
constexpr size_t WS_WGU2 = 173 * MiB, WS_WD2 = 184 * MiB;
constexpr size_t WS_YA = 190 * MiB, WS_YB = 222 * MiB, WS_MG = 108 * MiB;
constexpr size_t WS_END = 256 * MiB;
constexpr int DN_REC = 40960;
static_assert(WS_DN + (size_t)2048 * DN_REC <= WS_END && WS_WIN + (size_t)WIN_N * D * 2 <= WS_END && WS_YB + (size_t)M * D * 2 <= WS_END, "d_ws map");

constexpr int RING_OFF = 0, RING_BYTES = 147456;
constexpr int MISC_OFF = 147456, LDS_BYTES = 147456 + 256;

#define LAS __attribute__((address_space(3)))
typedef unsigned short bf16;
typedef unsigned v4u __attribute__((ext_vector_type(4)));
typedef float f32x4 __attribute__((ext_vector_type(4)));
typedef float f32x16 __attribute__((ext_vector_type(16)));
typedef short bf16x8 __attribute__((ext_vector_type(8)));
#define LDSFENCE() asm volatile("s_waitcnt lgkmcnt(0)" ::: "memory")
__device__ __forceinline__ unsigned f2bf(float f) { unsigned u = __builtin_bit_cast(unsigned, f); return (u + 0x7fffu + ((u >> 16) & 1u)) >> 16; }
__device__ __forceinline__ unsigned pk2(float lo, float hi) { return f2bf(lo) | (f2bf(hi) << 16); }
__device__ __forceinline__ float bflo(unsigned w) { return __uint_as_float(w << 16); }
__device__ __forceinline__ float bfhi(unsigned w) { return __uint_as_float(w & 0xffff0000u); }
__device__ __forceinline__ float wave_sum(float v) {
#pragma unroll
    for (int o = 1; o < 64; o <<= 1) v += __shfl_xor(v, o);
    return v;
}

#define GAS __attribute__((address_space(1)))
typedef GAS unsigned gu32;
#define RLX_AGENT __ATOMIC_RELAXED, __HIP_MEMORY_SCOPE_AGENT
constexpr size_t WS_CTL = 0, CTL_ZERO_BYTES = 65536;
constexpr int CW_BAR = 1024, CW_ATTQ = 8192;
#define XB_TMO      128
#define XB_XCNT(j)  (256  + 64 * (j))
#define XB_XSUB(j)  (1280 + 64 * (j))
#define XB_XGEN(j)  (2304 + 64 * (j))
#define XB_TOP      3328
#define XB_TOPGEN   3392
#define XCD_BAR_WORDS 3456
#define XB_SPIN_CAP (1u << 18)

__device__ __forceinline__ unsigned xb_ld(unsigned* p)              { return __hip_atomic_load(p, __ATOMIC_RELAXED, __HIP_MEMORY_SCOPE_AGENT); }
__device__ __forceinline__ unsigned xb_add(unsigned* p, unsigned v) { return __hip_atomic_fetch_add(p, v, __ATOMIC_RELAXED, __HIP_MEMORY_SCOPE_AGENT); }
__device__ __forceinline__ unsigned xb_xcc_id() { return (unsigned)__builtin_amdgcn_s_getreg((3 << 11) | 20) & 0xFu; }
#define XB_SPIN(cond, bar) do { unsigned _sp = 0; while (cond) { __builtin_amdgcn_s_sleep(1); \
    if ((++_sp & 255u) == 0u) { if (xb_ld(&(bar)[XB_TMO])) break; if (_sp > XB_SPIN_CAP) { atomicAdd(&(bar)[XB_TMO], 1u); break; } } } } while (0)

struct XcdBarrier {
    unsigned* bar; unsigned x; int wave;
    volatile LAS unsigned* st;
};

__device__ __forceinline__ XcdBarrier xcd_barrier_post(unsigned* bar, volatile LAS unsigned* st, int wave) {
    XcdBarrier b; b.bar = bar; b.x = xb_xcc_id(); b.st = st; b.wave = wave;
    if (wave == 0 && lane_id() == 0) (void)xb_add(&bar[XB_XCNT(b.x)], 1u);
    return b;
}
__device__ __forceinline__ void xcd_barrier_complete(unsigned* bar, unsigned x, unsigned& nloc, unsigned& nx) {
    const unsigned G = gridDim.x * gridDim.y * gridDim.z;
    unsigned sum, cnt, mine, sp = 0u;
    for (;;) {
        sum = 0u; cnt = 0u; mine = 0u;
#pragma unroll
        for (unsigned j = 0; j < 16; ++j) { const unsigned c = xb_ld(&bar[XB_XCNT(j)]); sum += c; cnt += (c > 0u) ? 1u : 0u; mine = (j == x) ? c : mine; }
        if (sum == G) break;
        __builtin_amdgcn_s_sleep(1);
        if ((++sp & 255u) == 0u) { if (xb_ld(&bar[XB_TMO])) break; if (sp > XB_SPIN_CAP) { atomicAdd(&bar[XB_TMO], 1u); break; } }
    }
    nloc = mine > 0u ? mine : 1u; nx = cnt > 0u ? cnt : 1u;
}

__device__ __forceinline__ void xcd_barrier(const XcdBarrier& b) {
    asm volatile("s_waitcnt vmcnt(0)" ::: "memory");
    __syncthreads();
    if (b.wave == 0 && lane_id() == 0) {
        unsigned* bar = b.bar;
        __builtin_amdgcn_s_waitcnt(0);
        unsigned nloc = b.st[0], nx = b.st[1];
        if (nloc == 0u) { xcd_barrier_complete(bar, b.x, nloc, nx); b.st[0] = nloc; b.st[1] = nx; }
        const unsigned old = xb_add(&bar[XB_XSUB(b.x)], 1u);
        const unsigned gen = old / nloc;
        if (old + 1u == (gen + 1u) * nloc) {
            __builtin_amdgcn_fence(__ATOMIC_RELEASE, "agent");
            asm volatile("s_waitcnt vmcnt(0)" ::: "memory");
            const unsigned og = xb_add(&bar[XB_TOP], 1u);
            const unsigned tg = og / nx;
            if (og + 1u == (tg + 1u) * nx) xb_add(&bar[XB_TOPGEN], 1u);
            else XB_SPIN(xb_ld(&bar[XB_TOPGEN]) == tg, bar);
            __builtin_amdgcn_fence(__ATOMIC_ACQUIRE, "agent");
            xb_add(&bar[XB_XGEN(b.x)], 1u);
            asm volatile("s_waitcnt vmcnt(0)" ::: "memory");
        } else {
            XB_SPIN(xb_ld(&bar[XB_XGEN(b.x)]) == gen, bar);
            __builtin_amdgcn_fence(__ATOMIC_ACQUIRE, "agent");
            asm volatile("s_waitcnt vmcnt(0)" ::: "memory");
        }
    }
    __syncthreads();
}

struct Ctx {
    const float* const* in; float* out; unsigned char* ws;
    LAS unsigned char* lds; int wave, G, vcu;
};

__device__ __forceinline__ void conv_item(const float* W, int ldw, int scol0, int nvalid, const float* gain, bf16* WT, int K, int drow0, int k0, LAS float* scr, int lane) {
#pragma unroll 8
    for (int i = 0; i < 32; ++i) { const int kk = 2 * i + (lane >> 5), n = lane & 31; float v = (n < nvalid) ? W[(size_t)(k0 + kk) * ldw + scol0 + n] : 0.f; if (gain) v *= gain[k0 + kk]; scr[kk * 33 + n] = v; }
    LDSFENCE();
    const int c = lane & 7;
#pragma unroll
    for (int j = 0; j < 4; ++j) { const int n = (lane >> 3) + 8 * j; const LAS float* s = scr + (8 * c) * 33 + n;
        v4u o; o.x = pk2(s[0 * 33], s[1 * 33]); o.y = pk2(s[2 * 33], s[3 * 33]); o.z = pk2(s[4 * 33], s[5 * 33]); o.w = pk2(s[6 * 33], s[7 * 33]);
        *(v4u*)(WT + (size_t)(drow0 + n) * K + k0 + 8 * c) = o; }
    LDSFENCE();
}
__device__ __forceinline__ void conv_gu(const float* wg, const float* wu, const float* gain, bf16* WT, int it, LAS float* scr, int lane) {
    const int db = it >> 4, kb = it & 15, tile = db >> 3, w = db & 7;
    conv_item(w < 4 ? wg : wu, FF, 128 * tile + 32 * (w & 3), 32, gain, WT, D, 32 * db, 64 * kb, scr, lane);
}
__device__ __forceinline__ void conv_plain(const float* W, int K, int N, bf16* WT, int it, LAS float* scr, int lane) {
    const int nkb = K / 64, db = it / nkb, kb = it % nkb;
    conv_item(W, N, 32 * db, 32, nullptr, WT, K, 32 * db, 64 * kb, scr, lane);
}
__device__ __forceinline__ void conv_win(const float* W, const float* gain, bf16* WT, int it, LAS float* scr, int lane) {
    const int db = it >> 4, kb = it & 15, d0 = 32 * db; int sc, nv = 32;
    if (d0 < 2048) sc = d0; else if (d0 < 3584) sc = d0 + 16; else if (d0 == 3584) { sc = 2048; nv = 16; } else { sc = 0; nv = 0; }
    conv_item(W, WIN_SRC, sc, nv, gain, WT, D, d0, 64 * kb, scr, lane);
}
__device__ __forceinline__ void conv_wg(const float* W, const float* gain, bf16* WT, int it, LAS float* scr, int lane) {
    const int db = it >> 4, kb = it & 15, tile = db >> 3, w = db & 7;
    conv_item(W, WIN_SRC, 3600 + (w < 4 ? 0 : 1024) + 128 * tile + 32 * (w & 3), 32, gain, WT, D, 32 * db, 64 * kb, scr, lane);
}

__device__ __forceinline__ void p0_prologue(Ctx& F) {
    const int lane = lane_id();
    LAS float* scr = (LAS float*)(F.lds + RING_OFF + F.wave * 17408);
    const int gw = F.vcu * NWAVES + F.wave, NGW = F.G * NWAVES;
    bf16* ws16 = (bf16*)F.ws;
    constexpr int I_GU = 176 * 16, I_DN = 32 * 44, I_WIN = 120 * 16, I_WG = 64 * 16, I_AB = 32 * 8, I_WO = 32 * 16;
    constexpr int NIT = I_GU + I_DN + I_WIN + I_WG + 2 * I_AB + I_WO;
    for (int it = gw; it < NIT; it += NGW) {
        int r = it;
        if (r < I_GU) { conv_gu(F.in[2], F.in[3], F.in[1], (bf16*)(F.ws + WS_WGU1), r, scr, lane); continue; } r -= I_GU;
        if (r < I_DN) { conv_plain(F.in[4], FF, D, (bf16*)(F.ws + WS_WD1), r, scr, lane); continue; } r -= I_DN;
        if (r < I_WIN) { conv_win(F.in[6], F.in[5], (bf16*)(F.ws + WS_WIN), r, scr, lane); continue; } r -= I_WIN;
        if (r < I_WG) { conv_wg(F.in[6], F.in[5], (bf16*)(F.ws + WS_WG), r, scr, lane); continue; } r -= I_WG;
        if (r < I_AB) { conv_plain(F.in[16], 512, D, (bf16*)(F.ws + WS_WA), r, scr, lane); continue; } r -= I_AB;
        if (r < I_AB) { conv_plain(F.in[17], 512, D, (bf16*)(F.ws + WS_WB), r, scr, lane); continue; } r -= I_AB;
        conv_plain(F.in[18], D, D, (bf16*)(F.ws + WS_WOUT), r, scr, lane);
    }
    (void)ws16;
    const float* x = F.in[0]; bf16* xb = (bf16*)(F.ws + WS_XB); float* ssq = (float*)(F.ws + WS_SSQA);
    for (int m = gw; m < M; m += NGW) {
        const f32x4* xr = (const f32x4*)(x + (size_t)m * D) + lane; unsigned long long* o8 = (unsigned long long*)(xb + (size_t)m * D) + lane;
        float s = 0.f;
#pragma unroll
        for (int j = 0; j < 4; ++j) { const f32x4 v = xr[64 * j]; s += (v.x * v.x + v.y * v.y) + (v.z * v.z + v.w * v.w);
            o8[64 * j] = (unsigned long long)pk2(v.x, v.y) | ((unsigned long long)pk2(v.z, v.w) << 32); }
        s = wave_sum(s);
        if (lane < 16) ssq[(size_t)m * 16 + lane] = (lane == 0) ? s : 0.f;
    }
}
__device__ __forceinline__ void conv_ffn2(Ctx& F) {
    const int lane = lane_id();
    LAS float* scr = (LAS float*)(F.lds + RING_OFF + F.wave * 17408);
    const int gw = F.vcu * NWAVES + F.wave, NGW = F.G * NWAVES;
    constexpr int I_GU = 176 * 16, I_DN = 32 * 44;
    for (int it = gw; it < I_GU + I_DN; it += NGW) {
        if (it < I_GU) conv_gu(F.in[20], F.in[21], F.in[19], (bf16*)(F.ws + WS_WGU2), it, scr, lane);
        else conv_plain(F.in[22], FF, D, (bf16*)(F.ws + WS_WD2), it - I_GU, scr, lane);
    }
}

__device__ __forceinline__ float silu_acc(float v) { return v / (1.0f + __expf(-v)); }
typedef unsigned u32x2 __attribute__((ext_vector_type(2)));
__device__ __forceinline__ void dn_conv_l1(const bf16* PRE, const float* cw, long row0, int tin0, int colbase, int r, int hh, float (&y)[2][4][8]) {
#pragma unroll
    for (int s = 0; s < 4; ++s) {
        const int ch0 = colbase + 16 * s + 4 * hh;
        f32x4 wl[4], wh[4];
#pragma unroll
        for (int j = 0; j < 4; ++j) { wl[j] = *(const f32x4*)(cw + j * 1536 + ch0); wh[j] = *(const f32x4*)(cw + j * 1536 + ch0 + 8); }
#pragma unroll
        for (int i = 0; i < 2; ++i) { const int tok = r + 32 * i, tin = tin0 + tok; const long row = row0 + tok;
            float a[8];
#pragma unroll
            for (int e = 0; e < 8; ++e) a[e] = 0.f;
#pragma unroll
            for (int j = 0; j < 4; ++j) { u32x2 lo = (u32x2){0u, 0u}, hi = (u32x2){0u, 0u};
                if (tin - 3 + j >= 0) { const bf16* p = PRE + (size_t)(row - 3 + j) * 1536 + ch0; lo = *(const u32x2*)p; hi = *(const u32x2*)(p + 8); }
                a[0] += wl[j][0] * bflo(lo.x); a[1] += wl[j][1] * bfhi(lo.x); a[2] += wl[j][2] * bflo(lo.y); a[3] += wl[j][3] * bfhi(lo.y);
                a[4] += wh[j][0] * bflo(hi.x); a[5] += wh[j][1] * bfhi(hi.x); a[6] += wh[j][2] * bflo(hi.y); a[7] += wh[j][3] * bfhi(hi.y); }
#pragma unroll
            for (int e = 0; e < 8; ++e) { y[i][s][e] = silu_acc(a[e]); asm volatile("" : "+v"(y[i][s][e])); } }
        __builtin_amdgcn_sched_barrier(0);
    }
}
__device__ __forceinline__ bf16x8 pack8f(const float (&v)[8], float sc) {
    v4u o; o.x = pk2(v[0] * sc, v[1] * sc); o.y = pk2(v[2] * sc, v[3] * sc); o.z = pk2(v[4] * sc, v[5] * sc); o.w = pk2(v[6] * sc, v[7] * sc);
    return __builtin_bit_cast(bf16x8, o);
}
__device__ __forceinline__ v4u pack8acc(const f32x16& X, int kq) {
    v4u o; o.x = pk2(X[8 * kq], X[8 * kq + 1]); o.y = pk2(X[8 * kq + 2], X[8 * kq + 3]); o.z = pk2(X[8 * kq + 4], X[8 * kq + 5]); o.w = pk2(X[8 * kq + 6], X[8 * kq + 7]);
    return o;
}
__device__ __forceinline__ void write_xt(LAS unsigned short* XT, const bf16x8 (&fr)[2][4], const float (&sc)[2], int r, int hh) {
#pragma unroll
    for (int i = 0; i < 2; ++i)
#pragma unroll
        for (int s = 0; s < 4; ++s) { const v4u w = __builtin_bit_cast(v4u, fr[i][s]);
#pragma unroll
            for (int e = 0; e < 8; ++e) { const unsigned ww = w[e >> 1]; const float v = ((e & 1) ? bfhi(ww) : bflo(ww)) * sc[i];
                XT[(16 * s + 8 * (e >> 2) + 4 * hh + (e & 3)) * 72 + r + 32 * i] = (unsigned short)f2bf(v); } }
}
__device__ __forceinline__ float lane_bcast(float v, int l) { return __uint_as_float((unsigned)__builtin_amdgcn_readlane((int)__float_as_uint(v), l)); }

__device__ __forceinline__ void dn_prep_chunk(Ctx& F, int ch, LAS unsigned char* scrb, int opq  ) {
    int lane_ = lane_id();
    const int lane = lane_, r = lane & 31, hh = lane >> 5;
    const int n = ch & 127, h = (ch >> 7) & 7, b = ch >> 10;
    const long row0 = (long)b * T + 64 * n; const int tin0 = 64 * n;
    const bf16* PRE = (const bf16*)(F.ws + WS_PRE); const float* AB = (const float*)(F.ws + WS_AB); const float* cw = F.in[7];
    unsigned char* rec = F.ws + WS_DN + (size_t)ch * DN_REC;
    LAS float* At = (LAS float*)scrb; LAS unsigned short* TT = (LAS unsigned short*)scrb; LAS unsigned short* XT = (LAS unsigned short*)(scrb + 9216);
    float gc, betac;
    { const float al = AB[(size_t)(row0 + lane) * 16 + h], bl = AB[(size_t)(row0 + lane) * 16 + 8 + h];
      const float xs = al + F.in[9][h];
      const float sp = fmaxf(xs, 0.f) + log1pf(expf(-fabsf(xs)));
      gc = -expf(F.in[8][h]) * sp; betac = 1.0f / (1.0f + expf(-bl));
#pragma unroll
      for (int o = 1; o < 64; o <<= 1) { const float t = __shfl_up(gc, o); if (lane >= o) gc += t; } }
    const float gl = lane_bcast(gc, 63);
    float gct[2], bet[2];
#pragma unroll
    for (int i = 0; i < 2; ++i) { gct[i] = __shfl(gc, r + 32 * i); bet[i] = __shfl(betac, r + 32 * i); }
    bf16x8 kf[2][4];
#pragma unroll
    for (int i = 0; i < 2; ++i)
#pragma unroll
        for (int s = 0; s < 4; ++s) kf[i][s] = (bf16x8){0, 0, 0, 0, 0, 0, 0, 0};
    if (opq > 0) { int lane = lane_; asm volatile("" : "+v"(lane)); const int r = lane & 31, hh = lane >> 5;
      float y[2][4][8]; dn_conv_l1(PRE, cw, row0, tin0, 512 + h * 64, r, hh, y);
#pragma unroll
      for (int i = 0; i < 2; ++i) { float ss = 0.f;
#pragma unroll
          for (int s = 0; s < 4; ++s)
#pragma unroll
              for (int e = 0; e < 8; ++e) ss += y[i][s][e] * y[i][s][e];
          ss += __shfl_xor(ss, 32); const float rn = 1.0f / sqrtf(ss + 1e-6f);
#pragma unroll
          for (int s = 0; s < 4; ++s) { kf[i][s] = pack8f(y[i][s], rn); asm volatile("" : "+v"(kf[i][s])); } } }
    __builtin_amdgcn_sched_barrier(0);
    if (opq > 1) { int lane = lane_; asm volatile("" : "+v"(lane)); const int r = lane & 31, hh = lane >> 5;
      float sc[2] = {expf(gl - gct[0]), expf(gl - gct[1])};
      write_xt(XT, kf, sc, r, hh);
      LDSFENCE();
#pragma unroll
      for (int id = 0; id < 2; ++id)
#pragma unroll
          for (int ks = 0; ks < 4; ++ks) { const int d = r + 32 * id; const LAS unsigned short* p = XT + d * 72 + 16 * ks + 4 * hh;
              const u32x2 lo = *(const LAS u32x2*)p, hi = *(const LAS u32x2*)(p + 8);
              *(v4u*)(rec + 24576 + d * 128 + (ks * 2 + hh) * 16) = (v4u){lo.x, lo.y, hi.x, hi.y}; }
      LDSFENCE(); }
    __builtin_amdgcn_sched_barrier(0);
#ifndef SKQ
    if (opq > 2) {
        int lane = lane_; asm volatile("" : "+v"(lane)); const int r = lane & 31, hh = lane >> 5;
        bf16x8 qf[2][4];
        { float y[2][4][8]; dn_conv_l1(PRE, cw, row0, tin0, h * 64, r, hh, y);
#pragma unroll
          for (int i = 0; i < 2; ++i) { float ss = 0.f;
#pragma unroll
              for (int s = 0; s < 4; ++s)
#pragma unroll
                  for (int e = 0; e < 8; ++e) ss += y[i][s][e] * y[i][s][e];
              ss += __shfl_xor(ss, 32); const float rn = 0.125f / sqrtf(ss + 1e-6f); const float eg = expf(gct[i]);
#pragma unroll
              for (int s = 0; s < 4; ++s) { qf[i][s] = pack8f(y[i][s], rn);
                  *(bf16x8*)(rec + 8192 + (r + 32 * i) * 128 + (s * 2 + hh) * 16) = pack8f(y[i][s], rn * eg); asm volatile("" : "+v"(qf[i][s])); } } }
        __builtin_amdgcn_sched_barrier(0);
#pragma unroll
        for (int is = 0; is < 2; ++is) {
            float gcr[16];
#pragma unroll
            for (int g = 0; g < 16; ++g) gcr[g] = __shfl(gc, 32 * is + (g & 3) + 8 * (g >> 2) + 4 * hh);
#pragma unroll
            for (int ic = 0; ic < 2; ++ic) {
                if (is == 1 && ic == 0) {
#pragma unroll
                    for (int kq = 0; kq < 2; ++kq) *(v4u*)(rec + 16384 + r * 128 + ((2 + kq) * 2 + hh) * 16) = (v4u){0u, 0u, 0u, 0u};
#pragma unroll
                    for (int g = 0; g < 16; ++g) At[(32 + (g & 3) + 8 * (g >> 2) + 4 * hh) * 68 + r] = 0.f;
                    continue;
                }
                f32x16 pt, pk;
#pragma unroll
                for (int g = 0; g < 16; ++g) { pt[g] = 0.f; pk[g] = 0.f; }
#pragma unroll
                for (int ks = 0; ks < 4; ++ks) { pt = __builtin_amdgcn_mfma_f32_32x32x16_bf16(kf[is][ks], qf[ic][ks], pt, 0, 0, 0); pk = __builtin_amdgcn_mfma_f32_32x32x16_bf16(kf[is][ks], kf[ic][ks], pk, 0, 0, 0); }
                const int ccol = 32 * ic + r;
#pragma unroll
                for (int g = 0; g < 16; ++g) { const int srow = 32 * is + (g & 3) + 8 * (g >> 2) + 4 * hh; const float dec = expf(fminf(gct[ic] - gcr[g], 0.f));
                    pt[g] = (srow <= ccol) ? pt[g] * dec : 0.f;
                    At[srow * 68 + ccol] = (srow < ccol) ? bet[ic] * pk[g] * dec : 0.f; }
#pragma unroll
                for (int kq = 0; kq < 2; ++kq) *(v4u*)(rec + 16384 + ccol * 128 + ((2 * is + kq) * 2 + hh) * 16) = pack8acc(pt, kq);
                __builtin_amdgcn_sched_barrier(0);
            }
        }
    }
    LDSFENCE();
#endif
    __builtin_amdgcn_sched_barrier(0);
#ifndef SKS
    if (opq > 3) {
        int lane = lane_; asm volatile("" : "+v"(lane)); const int r = lane & 31, hh = lane >> 5;
        float t[64];
#pragma unroll
        for (int k = 0; k < 64; ++k) t[k] = (k == lane) ? 1.0f : 0.0f;
#pragma unroll
        for (int j = 62; j >= 0; --j) { float acc = 0.f;
#pragma unroll
            for (int k4 = (j + 1) & ~3; k4 < 64; k4 += 4) { const f32x4 x = *(const volatile LAS f32x4*)(At + j * 68 + k4);
#pragma unroll
                for (int i = 0; i < 4; ++i) if (k4 + i > j) acc += t[k4 + i] * x[i]; }
            t[j] -= acc; asm volatile("" : "+v"(t[j])); }
        LDSFENCE();
#pragma unroll
        for (int i = 0; i < 8; ++i) { v4u o; o.x = pk2(t[8 * i], t[8 * i + 1]); o.y = pk2(t[8 * i + 2], t[8 * i + 3]); o.z = pk2(t[8 * i + 4], t[8 * i + 5]); o.w = pk2(t[8 * i + 6], t[8 * i + 7]);
            *(LAS v4u*)(TT + lane * 72 + 8 * i) = o; }
    }
#endif
    __builtin_amdgcn_sched_barrier(0);
#ifndef SKW
    if (opq > 4) { int lane = lane_; asm volatile("" : "+v"(lane)); const int r = lane & 31, hh = lane >> 5;
      float sc[2] = {bet[0] * expf(gct[0]), bet[1] * expf(gct[1])};
      write_xt(XT, kf, sc, r, hh);
      LDSFENCE();
#pragma unroll
      for (int id = 0; id < 2; ++id)
#pragma unroll
          for (int ic = 0; ic < 2; ++ic) { f32x16 acc;
#pragma unroll
              for (int g = 0; g < 16; ++g) acc[g] = 0.f;
#pragma unroll
              for (int ks = 0; ks < 4; ++ks) { const bf16x8 af = *(const LAS bf16x8*)(XT + (r + 32 * id) * 72 + 16 * ks + 8 * hh), bfr = *(const LAS bf16x8*)(TT + (r + 32 * ic) * 72 + 16 * ks + 8 * hh);
                  acc = __builtin_amdgcn_mfma_f32_32x32x16_bf16(af, bfr, acc, 0, 0, 0); }
#pragma unroll
              for (int kq = 0; kq < 2; ++kq) *(v4u*)(rec + (32 * ic + r) * 128 + ((2 * id + kq) * 2 + hh) * 16) = pack8acc(acc, kq); __builtin_amdgcn_sched_barrier(0); }
      LDSFENCE(); }
    __builtin_amdgcn_sched_barrier(0);
#endif
#ifndef SKU
    if (opq > 1) { int lane = lane_; asm volatile("" : "+v"(lane)); const int r = lane & 31, hh = lane >> 5;
      bf16x8 vf[2][4];
      { float y[2][4][8]; dn_conv_l1(PRE, cw, row0, tin0, 1024 + h * 64, r, hh, y);
#pragma unroll
        for (int i = 0; i < 2; ++i)
#pragma unroll
            for (int s = 0; s < 4; ++s) { vf[i][s] = pack8f(y[i][s], bet[i]); asm volatile("" : "+v"(vf[i][s])); } }
      __builtin_amdgcn_sched_barrier(0);
      float one[2] = {1.0f, 1.0f};
      write_xt(XT, vf, one, r, hh);
      LDSFENCE();
      unsigned* U = (unsigned*)(rec + 32768);
#pragma unroll
      for (int ic = 0; ic < 2; ++ic)
#pragma unroll
          for (int ie = 0; ie < 2; ++ie) { f32x16 acc;
#pragma unroll
              for (int g = 0; g < 16; ++g) acc[g] = 0.f;
#pragma unroll
              for (int ks = 0; ks < 4; ++ks) { const bf16x8 af = *(const LAS bf16x8*)(TT + (r + 32 * ic) * 72 + 16 * ks + 8 * hh), bfr = *(const LAS bf16x8*)(XT + (r + 32 * ie) * 72 + 16 * ks + 8 * hh);
                  acc = __builtin_amdgcn_mfma_f32_32x32x16_bf16(af, bfr, acc, 0, 0, 0); }
#pragma unroll
              for (int gp = 0; gp < 8; ++gp) U[((ie * 2 + ic) * 8 + gp) * 64 + lane] = pk2(acc[2 * gp], acc[2 * gp + 1]); __builtin_amdgcn_sched_barrier(0); }
      LDSFENCE(); }
#endif
    if (lane == 0) ((float*)(F.ws + WS_DNCD))[ch] = expf(gl);
}

__device__ __forceinline__ bf16x8 pack8(const f32x16& X, int s) {
    v4u o; o.x = pg8::cvt_pk_bf16(X[8 * s], X[8 * s + 1]); o.y = pg8::cvt_pk_bf16(X[8 * s + 2], X[8 * s + 3]); o.z = pg8::cvt_pk_bf16(X[8 * s + 4], X[8 * s + 5]); o.w = pg8::cvt_pk_bf16(X[8 * s + 6], X[8 * s + 7]);
    return __builtin_bit_cast(bf16x8, o);
}
__device__ __forceinline__ void dn_scan(Ctx& F, int sw) {
    const int lane = lane_id(), r = lane & 31, hh = lane >> 5;
    const int bh = sw >> 1, sl = sw & 1, b = bh >> 3, h = bh & 7;
    const float* CD = (const float*)(F.ws + WS_DNCD) + bh * 128;
    bf16* ODN = (bf16*)(F.ws + WS_ODN);
    f32x16 S0, S1;
#pragma unroll
    for (int i = 0; i < 16; ++i) { S0[i] = 0.f; S1[i] = 0.f; }
    for (int n = 0; n < 128; ++n) {
        const unsigned char* rec = F.ws + WS_DN + ((size_t)bh * 128 + n) * DN_REC;
        const unsigned char* fb = rec + r * 128 + hh * 16;
        bf16x8 w[2][4], qd[2][4], at[2][4], kt[2][4];
#pragma unroll
        for (int i = 0; i < 2; ++i)
#pragma unroll
            for (int ks = 0; ks < 4; ++ks) { const int o = i * 4096 + ks * 32;
                w[i][ks] = *(const bf16x8*)(fb + o); qd[i][ks] = *(const bf16x8*)(fb + 8192 + o); at[i][ks] = *(const bf16x8*)(fb + 16384 + o); kt[i][ks] = *(const bf16x8*)(fb + 24576 + o); }
        const unsigned* up = (const unsigned*)(rec + 32768) + (sl * 2) * 8 * 64 + lane;
        unsigned uw[2][8];
#pragma unroll
        for (int i = 0; i < 2; ++i)
#pragma unroll
            for (int gp = 0; gp < 8; ++gp) uw[i][gp] = up[(i * 8 + gp) * 64];
        const float cd = CD[n];
        bf16x8 sb[4]; sb[0] = pack8(S0, 0); sb[1] = pack8(S0, 1); sb[2] = pack8(S1, 0); sb[3] = pack8(S1, 1);
        f32x16 ws[2], qs[2];
#pragma unroll
        for (int i = 0; i < 2; ++i) {
#pragma unroll
            for (int g = 0; g < 16; ++g) { ws[i][g] = 0.f; qs[i][g] = 0.f; }
#pragma unroll
            for (int ks = 0; ks < 4; ++ks) { ws[i] = __builtin_amdgcn_mfma_f32_32x32x16_bf16(w[i][ks], sb[ks], ws[i], 0, 0, 0); qs[i] = __builtin_amdgcn_mfma_f32_32x32x16_bf16(qd[i][ks], sb[ks], qs[i], 0, 0, 0); }
        }
#pragma unroll
        for (int i = 0; i < 2; ++i)
#pragma unroll
            for (int gp = 0; gp < 8; ++gp) { ws[i][2 * gp] = bflo(uw[i][gp]) - ws[i][2 * gp]; ws[i][2 * gp + 1] = bfhi(uw[i][gp]) - ws[i][2 * gp + 1]; }
        bf16x8 vb[4]; vb[0] = pack8(ws[0], 0); vb[1] = pack8(ws[0], 1); vb[2] = pack8(ws[1], 0); vb[3] = pack8(ws[1], 1);
#pragma unroll
        for (int g = 0; g < 16; ++g) { S0[g] *= cd; S1[g] *= cd; }
#pragma unroll
        for (int ks = 0; ks < 4; ++ks) {
            qs[0] = __builtin_amdgcn_mfma_f32_32x32x16_bf16(at[0][ks], vb[ks], qs[0], 0, 0, 0);
            qs[1] = __builtin_amdgcn_mfma_f32_32x32x16_bf16(at[1][ks], vb[ks], qs[1], 0, 0, 0);
            S0 = __builtin_amdgcn_mfma_f32_32x32x16_bf16(kt[0][ks], vb[ks], S0, 0, 0, 0);
            S1 = __builtin_amdgcn_mfma_f32_32x32x16_bf16(kt[1][ks], vb[ks], S1, 0, 0, 0);
        }
        bf16* orow = ODN + ((size_t)b * T + 64 * n) * 512 + h * 64 + 32 * sl + r;
#pragma unroll
        for (int i = 0; i < 2; ++i)
#pragma unroll
            for (int g = 0; g < 16; ++g) { const int c = 32 * i + (g & 3) + 8 * (g >> 2) + 4 * hh; orow[(size_t)c * 512] = (bf16)f2bf(qs[i][g]); }
    }
}

__device__ __forceinline__ void finalize_rows(Ctx& F) {
    const int gw = F.vcu * NWAVES + F.wave, NGW = F.G * NWAVES, lane = lane_id();
    const bf16* ODN = (const bf16*)(F.ws + WS_ODN); const bf16* Z = (const bf16*)(F.ws + WS_Z); const bf16* QO = (const bf16*)(F.ws + WS_QO);
    bf16* AA = (bf16*)(F.ws + WS_AA); bf16* ABB = (bf16*)(F.ws + WS_ABB);
    float s1 = 0.f, s2 = 0.f;
    { const float a = F.in[11][lane] * F.in[12][lane], bq = F.in[13][lane] * F.in[14][lane]; s1 = wave_sum(a); s2 = wave_sum(bq); }
    const float lam_init = 0.2f;
    const float lam = expf(s1) - expf(s2) + lam_init;
    float gdn[8], gsub[8];
#pragma unroll
    for (int e = 0; e < 8; ++e) { gdn[e] = F.in[10][(lane & 7) * 8 + e]; gsub[e] = F.in[15][(lane & 15) * 8 + e] * (1.0f - lam_init); }
    for (int m = gw; m < M; m += NGW) {
        { const v4u ov = *(const v4u*)(ODN + (size_t)m * 512 + lane * 8), zv = *(const v4u*)(Z + (size_t)m * 512 + lane * 8);
          float o[8], z[8]; float ss = 0.f;
#pragma unroll
          for (int e = 0; e < 4; ++e) { o[2 * e] = bflo(ov[e]); o[2 * e + 1] = bfhi(ov[e]); z[2 * e] = bflo(zv[e]); z[2 * e + 1] = bfhi(zv[e]); }
#pragma unroll
          for (int e = 0; e < 8; ++e) ss += o[e] * o[e];
          ss += __shfl_xor(ss, 1); ss += __shfl_xor(ss, 2); ss += __shfl_xor(ss, 4);
          const float rn = 1.0f / sqrtf(ss * (1.0f / 64.0f) + RMS_EPS);
          float y[8];
#pragma unroll
          for (int e = 0; e < 8; ++e) y[e] = o[e] * rn * gdn[e] * silu_acc(z[e]);
          v4u w; w.x = pk2(y[0], y[1]); w.y = pk2(y[2], y[3]); w.z = pk2(y[4], y[5]); w.w = pk2(y[6], y[7]);
          *(v4u*)(AA + (size_t)m * 512 + lane * 8) = w; }
        { const int hd = lane >> 4, e0 = (lane & 15) * 8;
          const v4u a1 = *(const v4u*)(QO + (size_t)m * 1024 + hd * 256 + e0), a2 = *(const v4u*)(QO + (size_t)m * 1024 + hd * 256 + 128 + e0);
          float o[8]; float ss = 0.f;
#pragma unroll
          for (int e = 0; e < 4; ++e) { o[2 * e] = bflo(a1[e]) - lam * bflo(a2[e]); o[2 * e + 1] = bfhi(a1[e]) - lam * bfhi(a2[e]); }
#pragma unroll
          for (int e = 0; e < 8; ++e) ss += o[e] * o[e];
          ss += __shfl_xor(ss, 1); ss += __shfl_xor(ss, 2); ss += __shfl_xor(ss, 4); ss += __shfl_xor(ss, 8);
          const float rn = 1.0f / sqrtf(ss * (1.0f / 128.0f) + SUBLN_EPS);
          float y[8];
#pragma unroll
          for (int e = 0; e < 8; ++e) y[e] = o[e] * rn * gsub[e];
          v4u w; w.x = pk2(y[0], y[1]); w.y = pk2(y[2], y[3]); w.z = pk2(y[4], y[5]); w.w = pk2(y[6], y[7]);
          *(v4u*)(ABB + (size_t)m * 512 + hd * 128 + e0) = w; }
    }
}
__device__ __forceinline__ void final_norm_rows(Ctx& F) {
    const int lane = lane_id();
    const int gw = F.vcu * NWAVES + F.wave, NGW = F.G * NWAVES;
    const f32x4* gp = (const f32x4*)F.in[23] + lane; f32x4 gg[4];
#pragma unroll
    for (int j = 0; j < 4; ++j) gg[j] = gp[64 * j];
    for (int m = gw; m < M; m += NGW) {
        f32x4* xr = (f32x4*)(F.out + (size_t)m * D) + lane; f32x4 v[4]; float s = 0.f;
#pragma unroll
        for (int j = 0; j < 4; ++j) { v[j] = xr[64 * j]; s += (v[j].x * v[j].x + v[j].y * v[j].y) + (v[j].z * v[j].z + v[j].w * v[j].w); }
        const float rn = 1.0f / sqrtf(wave_sum(s) * (1.0f / D) + RMS_EPS);
#pragma unroll
        for (int j = 0; j < 4; ++j) xr[64 * j] = v[j] * rn * gg[j];
    }
}

constexpr int N_PHASES = 14;
struct Args { const float* in[24]; float* out; unsigned char* ws; int ph_lo, ph_hi; };
__global__ void __launch_bounds__(NWAVES * 64, 2) mk_fwd(Args args) {
    extern __shared__ __attribute__((aligned(16))) unsigned char lds[];
    Ctx F;
    F.in = args.in;
    F.out = args.out; F.ws = args.ws;
    F.lds = (LAS unsigned char*)lds;
    F.wave = __builtin_amdgcn_readfirstlane((int)threadIdx.x >> 6);
    F.G = gridDim.x; { const int bx = blockIdx.x; F.vcu = (F.G % 8 == 0) ? (bx % 8) * (F.G / 8) + bx / 8 : bx; }
    const int lo = args.ph_lo, hi = args.ph_hi;
    { volatile LAS unsigned* misc = (volatile LAS unsigned*)(F.lds + MISC_OFF); if (F.wave == 0) misc[lane_id()] = 0u; }
    __syncthreads();
    XcdBarrier bar = xcd_barrier_post((unsigned*)(args.ws + WS_CTL) + CW_BAR, (volatile LAS unsigned*)(F.lds + MISC_OFF) + 8, F.wave);
    if (lo < -7) cg::this_grid().sync();
    unsigned char* ws = F.ws;
    typedef pg8::bf16_t pb;
#ifndef PH_MASK
#define PH_MASK 0x3fff
#endif
#define IN(k) (((PH_MASK >> (k)) & 1) && lo <= (k) && (k) < hi)
#ifndef PROBE_A
#define PROBE_A -1
#endif
#ifndef PROBE_B
#define PROBE_B -1
#endif
#define STAMP(k) do { if (PROBE_A >= 0 && blockIdx.x == 0 && F.wave == 0 && lane_id() == 0) ((volatile unsigned long long*)(args.ws + WS_CTL + 32768))[k] = __builtin_amdgcn_s_memrealtime(); } while (0)
#define SEAM(k) do { if (IN(k) && IN((k) + 1)) xcd_barrier(bar); STAMP((k) + 1); } while (0)

    STAMP(0);
    if (IN(0)) { p0_prologue(F); } SEAM(0);
    if (IN(1)) { pg8::Gemm g{(const pb*)(ws + WS_XB), (const pb*)(ws + WS_WGU1), M, 2 * FF, D}; pg8::StaticOrder S; S.init(M, 2 * FF, F.G, (int)blockIdx.x);
        pg8::EpiSwiGLU E{(pb*)(ws + WS_H), FF, (const float*)(ws + WS_SSQA), RMS_EPS};
        pg8::gemm_phase<pg8::EpiSwiGLU, pg8::StaticOrder, true, true>(F.lds + RING_OFF, g, S, E, F.wave); } SEAM(1);
    if (IN(2)) { pg8::Gemm g{(const pb*)(ws + WS_H), (const pb*)(ws + WS_WD1), M, D, FF}; pg8::StaticOrder S; S.init(M, D, F.G, (int)blockIdx.x);
        pg8::EpiResid E{F.in[0], F.out, (pb*)(ws + WS_XB), (float*)(ws + WS_SSQB), 0.5f};
        pg8::gemm_phase<pg8::EpiResid, pg8::StaticOrder, true, true>(F.lds + RING_OFF, g, S, E, F.wave); } SEAM(2);
    if (IN(3)) { pg8::Gemm g{(const pb*)(ws + WS_XB), (const pb*)(ws + WS_WIN), M, WIN_N, D}; pg8::StaticOrder S; S.init(M, WIN_N, F.G, (int)blockIdx.x);
        pg8::EpiWin E{(pb*)(ws + WS_PRE), (pb*)(ws + WS_Z), (pb*)(ws + WS_QO), (pb*)(ws + WS_KD), (pb*)(ws + WS_VD), (float*)(ws + WS_AB), (const float*)(ws + WS_SSQB), RMS_EPS, attn_body::C2};
        pg8::gemm_phase<pg8::EpiWin, pg8::StaticOrder, true, true>(F.lds + RING_OFF, g, S, E, F.wave); } SEAM(3);
    if (IN(4)) { LAS unsigned char* scr = F.lds + RING_OFF + F.wave * 18432; const int gw = F.vcu * NWAVES + F.wave, NGW = F.G * NWAVES;
        for (int ch = gw; ch < 2048; ch += NGW) dn_prep_chunk(F, ch, scr, hi); } SEAM(4);
    if (IN(5)) {
        if (blockIdx.x < 8 && F.wave < 4) dn_scan(F, (int)blockIdx.x * 4 + F.wave);
        const attn_body::AttnTensors AT{(const attn_body::bf16*)(ws + WS_QO), (const attn_body::bf16*)(ws + WS_KD), (const attn_body::bf16*)(ws + WS_VD), (attn_body::bf16*)(ws + WS_QO)};
        const attn_body::DynOrder S{(unsigned*)(ws + WS_CTL) + CW_ATTQ, (volatile LAS unsigned*)(F.lds + MISC_OFF) + 16, (int)(blockIdx.x & 7), F.wave};
        attn_body::attn_phase<attn_body::DynOrder>((char*)lds + RING_OFF, AT, S, F.wave); } SEAM(5);
    if (IN(7)) { finalize_rows(F); conv_ffn2(F); } SEAM(7);
    if (IN(8)) { pg8::StaticOrder S; S.init(M, D, F.G, (int)blockIdx.x);
        { pg8::Gemm g{(const pb*)(ws + WS_AA), (const pb*)(ws + WS_WA), M, D, 512}; pg8::EpiStoreBf16 E{(pb*)(ws + WS_YA), D};
          pg8::gemm_phase<pg8::EpiStoreBf16, pg8::StaticOrder, true, true>(F.lds + RING_OFF, g, S, E, F.wave); }
        { pg8::Gemm g{(const pb*)(ws + WS_ABB), (const pb*)(ws + WS_WB), M, D, 512}; pg8::EpiStoreBf16 E{(pb*)(ws + WS_YB), D};
          pg8::gemm_phase<pg8::EpiStoreBf16, pg8::StaticOrder, true, true>(F.lds + RING_OFF, g, S, E, F.wave); } } SEAM(8);
    if (IN(9)) { pg8::Gemm g{(const pb*)(ws + WS_XB), (const pb*)(ws + WS_WG), M, 2 * D, D}; pg8::StaticOrder S; S.init(M, 2 * D, F.G, (int)blockIdx.x);
        pg8::EpiGateMerge E{(const pb*)(ws + WS_YA), (const pb*)(ws + WS_YB), (pb*)(ws + WS_MG), (const float*)(ws + WS_SSQB), RMS_EPS};
        pg8::gemm_phase<pg8::EpiGateMerge, pg8::StaticOrder, true, true>(F.lds + RING_OFF, g, S, E, F.wave); } SEAM(9);
    if (IN(10)) { pg8::Gemm g{(const pb*)(ws + WS_MG), (const pb*)(ws + WS_WOUT), M, D, D}; pg8::StaticOrder S; S.init(M, D, F.G, (int)blockIdx.x);
        pg8::EpiResid E{F.out, F.out, (pb*)(ws + WS_XB), (float*)(ws + WS_SSQA), 1.0f};
        pg8::gemm_phase<pg8::EpiResid, pg8::StaticOrder, true, true>(F.lds + RING_OFF, g, S, E, F.wave); } SEAM(10);
    if (IN(11)) { pg8::Gemm g{(const pb*)(ws + WS_XB), (const pb*)(ws + WS_WGU2), M, 2 * FF, D}; pg8::StaticOrder S; S.init(M, 2 * FF, F.G, (int)blockIdx.x);
        pg8::EpiSwiGLU E{(pb*)(ws + WS_H), FF, (const float*)(ws + WS_SSQA), RMS_EPS};
        pg8::gemm_phase<pg8::EpiSwiGLU, pg8::StaticOrder, true, true>(F.lds + RING_OFF, g, S, E, F.wave); } SEAM(11);
    if (IN(12)) { pg8::Gemm g{(const pb*)(ws + WS_H), (const pb*)(ws + WS_WD2), M, D, FF}; pg8::StaticOrder S; S.init(M, D, F.G, (int)blockIdx.x);
        pg8::EpiResid E{F.out, F.out, (pb*)(ws + WS_XB), (float*)(ws + WS_SSQB), 0.5f};
        pg8::gemm_phase<pg8::EpiResid, pg8::StaticOrder, true, true>(F.lds + RING_OFF, g, S, E, F.wave); } SEAM(12);
    if (IN(13)) { final_norm_rows(F); } STAMP(14);
    if (PROBE_A >= 0) {
        xcd_barrier(bar);
        if (blockIdx.x == 0 && F.wave == 0) { volatile unsigned long long* ts = (volatile unsigned long long*)(args.ws + WS_CTL + 32768); const int l = lane_id();
            const float da = (float)(ts[PROBE_A + 1] - ts[PROBE_A]) * 0.01f, db = (float)(ts[PROBE_B + 1] - ts[PROBE_B]) * 0.01f;
            for (int i = l; i < 16384; i += 64) F.out[(size_t)i * 1024 + 512] = db;
            if (l == 0) F.out[0] = da; }
    }
#undef IN
#undef SEAM
}

#ifndef MK_N_LAUNCHES
#define MK_N_LAUNCHES 1
#endif
extern "C" void kernel_launch(void* const* d_in, const int* in_sizes, int n_in, void* d_out, int out_size, void* d_ws, size_t ws_size, hipStream_t stream) {
    static int grid = 0;
    if (grid == 0) {
        if (n_in != 24 || in_sizes[0] != M * D || out_size != M * D || ws_size < WS_END) { fprintf(stderr, "kernel_launch: unexpected shapes (n_in %d, in0 %d, out %d, ws %zu)\n", n_in, n_in > 0 ? in_sizes[0] : -1, out_size, ws_size); grid = -1; return; }
        int dev = 0, cus = 0, per_cu = 0;
        if (hipGetDevice(&dev) != hipSuccess || hipDeviceGetAttribute(&cus, hipDeviceAttributeMultiprocessorCount, dev) != hipSuccess) { grid = -1; return; }
        if (hipFuncSetAttribute((const void*)mk_fwd, hipFuncAttributeMaxDynamicSharedMemorySize, LDS_BYTES) != hipSuccess) { fprintf(stderr, "kernel_launch: hipFuncSetAttribute failed\n"); grid = -1; return; }
        if (hipOccupancyMaxActiveBlocksPerMultiprocessor(&per_cu, (const void*)mk_fwd, NWAVES * 64, LDS_BYTES) != hipSuccess || per_cu < 1) { fprintf(stderr, "kernel_launch: occupancy query says %d\n", per_cu); per_cu = 1; }
        (void)hipGetLastError();
        grid = cus;
    }
    if (grid < 0) return;
    if (hipMemsetAsync((char*)d_ws + WS_CTL, 0, CTL_ZERO_BYTES, stream) != hipSuccess) { fprintf(stderr, "kernel_launch: hipMemsetAsync failed\n"); return; }
    Args a{};
    for (int i = 0; i < 24; ++i) a.in[i] = (const float*)d_in[i];
    a.out = (float*)d_out; a.ws = (unsigned char*)d_ws;
#if MK_N_LAUNCHES == 1
    a.ph_lo = 0; a.ph_hi = N_PHASES;
    void* kargs[] = {&a};
    hipError_t e = hipLaunchCooperativeKernel((const void*)mk_fwd, dim3(grid), dim3(NWAVES * 64), kargs, LDS_BYTES, stream);
    if (e != hipSuccess) fprintf(stderr, "kernel_launch: cooperative launch failed: %s (grid %d)\n", hipGetErrorString(e), grid);
#else
    for (int p = 0; p < N_PHASES; ++p) { a.ph_lo = p; a.ph_hi = p + 1; hipLaunchKernelGGL(mk_fwd, dim3(grid), dim3(NWAVES * 64), LDS_BYTES, stream, a); }
#endif
}
```

```cpp
#include <hip/hip_runtime.h>
#include <hip/hip_cooperative_groups.h>
#include <cstdio>
#include <cstdint>
namespace cg = cooperative_groups;
__device__ __forceinline__ int lane_id() { int l = (int)__builtin_amdgcn_mbcnt_hi(~0u, __builtin_amdgcn_mbcnt_lo(~0u, 0u)); asm volatile("" : "+v"(l)); return l; }
namespace pg8 {
#define PG8_LAS __attribute__((address_space(3)))
typedef unsigned short bf16_t;
typedef short bf16x8 __attribute__((ext_vector_type(8)));
typedef float f32x4 __attribute__((ext_vector_type(4)));
typedef unsigned u32x4 __attribute__((ext_vector_type(4)));
constexpr int BM = 256, BK = 64, HALF = 128, HTB = HALF * BK * 2  , STAGE_BYTES = 8 * HTB, NXCD = 8, WGM = 8;

__host__ __device__ __forceinline__ int lds_byte(int r, int c) { const int st = (r >> 4) * 2 + (c >> 5), rr = r & 15, cc = c & 31, ob = rr * 64 + cc * 2; return st * 1024 + (ob ^ (((ob >> 9) & 1) << 5)); }
__host__ __device__ __forceinline__ void stage_rc(int b, int& R, int& C) { const int st = b / 1024, sb = b % 1024, swz = sb ^ (((sb >> 9) & 1) << 5); R = (st >> 1) * 16 + swz / 64; C = (st & 1) * 32 + (swz % 64) / 2; }
__host__ __device__ __forceinline__ int perm32(int rho) { const int n = rho >> 4, i = rho & 15; return 8 * (i >> 2) + 4 * n + (i & 3); }

struct Unit { int pm, pn; };
struct Gemm { const bf16_t* A; const bf16_t* Bt; int M, N, K; };

struct StaticOrder {
    int nM, nN, nwg, G, c;
    __host__ __device__ void init(int M, int N, int G_, int c_) { nM = M / BM; nN = N / BM; nwg = nM * nN; G = G_; c = c_; }
    __host__ __device__ bool next(int i, Unit& u) const {
        const long L = (long)i * G + c; if (L >= nwg) return false;
        int wgid = (int)L; { const int q = nwg / NXCD, r = nwg % NXCD, xcd = wgid % NXCD, off = wgid / NXCD; wgid = (xcd < r ? xcd * (q + 1) : r * (q + 1) + (xcd - r) * q) + off; }
        const int nig = WGM * nN, gid = wgid / nig, fm = gid * WGM, gsz = (nM - fm) < WGM ? (nM - fm) : WGM;
        u.pm = fm + ((wgid % nig) % gsz); u.pn = (wgid % nig) / gsz; return true;
    }
    __device__ __forceinline__ void a_ready(const Unit&) const {}
    __device__ __forceinline__ void done(const Unit&) const {}
};

__device__ __forceinline__ unsigned cvt_pk_bf16(float lo, float hi) { unsigned r; asm volatile("v_cvt_pk_bf16_f32 %0, %1, %2" : "=v"(r) : "v"(lo), "v"(hi)); return r; }
__device__ __forceinline__ float fast_sigmoid(float v) { return __builtin_amdgcn_rcpf(1.0f + __builtin_amdgcn_exp2f(-1.4426950408889634f * v)); }
__device__ __forceinline__ float fast_silu(float v) { return v * fast_sigmoid(v); }
__device__ __forceinline__ void load_rs(float (&rs)[2][4], const float* ssq, int row0, float eps) {
#pragma unroll
    for (int ai = 0; ai < 2; ++ai)
#pragma unroll
        for (int m = 0; m < 4; ++m) { const f32x4* p = (const f32x4*)(ssq + (size_t)(row0 + ai * HALF + m * 16) * 16); const f32x4 a = p[0], b = p[1], c = p[2], d = p[3];
            const float s = ((a[0] + a[1]) + (a[2] + a[3])) + ((b[0] + b[1]) + (b[2] + b[3])) + ((c[0] + c[1]) + (c[2] + c[3])) + ((d[0] + d[1]) + (d[2] + d[3]));
            rs[ai][m] = 1.0f / sqrtf(s * (1.0f / 1024.0f) + eps); }
}
struct EpiSwiGLU {
    static constexpr bool PERM = true, AFTER_DRAIN = false;
    bf16_t* H; int ldh; const float* ssq; float eps;
    __device__ __forceinline__ void operator()(const f32x4 (&acc)[2][2][4][2], const Unit& u, int wr, int wc, int fr, int fq) const {
        const int row0 = u.pm * BM + wr * 64 + fr, col0 = u.pn * HALF + wc * 32 + 8 * fq;
        float rs[2][4]; load_rs(rs, ssq, row0, eps);
#pragma unroll
        for (int ai = 0; ai < 2; ++ai)
#pragma unroll
            for (int m = 0; m < 4; ++m) { bf16_t* rowp = H + (size_t)(row0 + ai * HALF + m * 16) * ldh + col0; const float s = rs[ai][m];
                float h[8];
#pragma unroll
                for (int n = 0; n < 2; ++n)
#pragma unroll
                    for (int j = 0; j < 4; ++j) h[n * 4 + j] = fast_silu(acc[ai][0][m][n][j] * s) * (acc[ai][1][m][n][j] * s);
                u32x4 w; w.x = cvt_pk_bf16(h[0], h[1]); w.y = cvt_pk_bf16(h[2], h[3]); w.z = cvt_pk_bf16(h[4], h[5]); w.w = cvt_pk_bf16(h[6], h[7]);
                *(u32x4*)rowp = w; }
    }
};
struct EpiResid {
    static constexpr bool PERM = false, AFTER_DRAIN = false;
    const float* base; float* out; bf16_t* xb; float* ssq_out; float scale;
    __device__ __forceinline__ void operator()(const f32x4 (&acc)[2][2][4][2], const Unit& u, int wr, int wc, int fr, int fq) const {
        typedef unsigned u32x2v __attribute__((ext_vector_type(2)));
        const int row0 = u.pm * BM + wr * 64 + fr, col0 = u.pn * BM + wc * 32 + 4 * fq;
#pragma unroll
        for (int ai = 0; ai < 2; ++ai)
#pragma unroll
            for (int m = 0; m < 4; ++m) { const int row = row0 + ai * HALF + m * 16; const size_t off = (size_t)row * 1024 + col0; float ss = 0.f;
#pragma unroll
                for (int bj = 0; bj < 2; ++bj)
#pragma unroll
                    for (int n = 0; n < 2; ++n) { const f32x4 bs = *(const f32x4*)(base + off + bj * HALF + n * 16); const f32x4 o = bs + acc[ai][bj][m][n] * scale;
                        *(f32x4*)(out + off + bj * HALF + n * 16) = o; ss += (o[0] * o[0] + o[1] * o[1]) + (o[2] * o[2] + o[3] * o[3]);
                        u32x2v w; w.x = cvt_pk_bf16(o[0], o[1]); w.y = cvt_pk_bf16(o[2], o[3]); *(u32x2v*)(xb + off + bj * HALF + n * 16) = w; }
                ss += __shfl_xor(ss, 16); ss += __shfl_xor(ss, 32);
                if (fq == 0) ssq_out[(size_t)row * 16 + u.pn * 4 + wc] = ss; }
    }
};
struct EpiStoreBf16 {
    static constexpr bool PERM = true, AFTER_DRAIN = false;
    bf16_t* O; int ldc;
    __device__ __forceinline__ void operator()(const f32x4 (&acc)[2][2][4][2], const Unit& u, int wr, int wc, int fr, int fq) const {
        const int row0 = u.pm * BM + wr * 64 + fr, col0 = u.pn * BM + wc * 32 + 8 * fq;
#pragma unroll
        for (int ai = 0; ai < 2; ++ai)
#pragma unroll
            for (int m = 0; m < 4; ++m) { bf16_t* rowp = O + (size_t)(row0 + ai * HALF + m * 16) * ldc + col0;
#pragma unroll
                for (int bj = 0; bj < 2; ++bj) { const f32x4 v0 = acc[ai][bj][m][0], v1 = acc[ai][bj][m][1];
                    u32x4 w; w.x = cvt_pk_bf16(v0[0], v0[1]); w.y = cvt_pk_bf16(v0[2], v0[3]); w.z = cvt_pk_bf16(v1[0], v1[1]); w.w = cvt_pk_bf16(v1[2], v1[3]);
                    *(u32x4*)(rowp + bj * HALF) = w; } }
    }
};
struct EpiWin {
    static constexpr bool PERM = true, AFTER_DRAIN = false;
    bf16_t *PRE, *Z, *QO, *KD, *VD; float* AB; const float* ssq; float eps, qscale;
    __device__ __forceinline__ void operator()(const f32x4 (&acc)[2][2][4][2], const Unit& u, int wr, int wc, int fr, int fq) const {
        const int row0 = u.pm * BM + wr * 64 + fr, cl0 = wc * 32 + 8 * fq, pn = u.pn;
        float rs[2][4]; load_rs(rs, ssq, row0, eps);
        if (pn == 14) {
            if (wc == 0 && fq < 2) {
#pragma unroll
                for (int ai = 0; ai < 2; ++ai)
#pragma unroll
                    for (int m = 0; m < 4; ++m) { float* rowp = AB + (size_t)(row0 + ai * HALF + m * 16) * 16 + 8 * fq; const float s = rs[ai][m];
                        *(f32x4*)rowp = acc[ai][0][m][0] * s; *(f32x4*)(rowp + 4) = acc[ai][0][m][1] * s; }
            }
            return;
        }
        bf16_t* base; int ld, cb; float sc = 1.f; bool dup = false;
        if (pn < 6) { base = PRE; ld = 1536; cb = pn * 256; }
        else if (pn < 8) { base = Z; ld = 512; cb = (pn - 6) * 256; }
        else if (pn < 10) { base = QO; ld = 1024; cb = (pn - 8) * 256; sc = qscale; dup = true; }
        else if (pn < 12) { base = KD; ld = 512; cb = (pn - 10) * 256; }
        else { base = VD; ld = 512; cb = (pn - 12) * 256; }
#pragma unroll
        for (int ai = 0; ai < 2; ++ai)
#pragma unroll
            for (int m = 0; m < 4; ++m) { const float s = rs[ai][m] * sc; bf16_t* rowp = base + (size_t)(row0 + ai * HALF + m * 16) * ld;
#pragma unroll
                for (int bj = 0; bj < 2; ++bj) { const f32x4 v0 = acc[ai][bj][m][0] * s, v1 = acc[ai][bj][m][1] * s;
                    u32x4 w; w.x = cvt_pk_bf16(v0[0], v0[1]); w.y = cvt_pk_bf16(v0[2], v0[3]); w.z = cvt_pk_bf16(v1[0], v1[1]); w.w = cvt_pk_bf16(v1[2], v1[3]);
                    const int c = cb + bj * HALF + cl0;
                    if (dup) { const int qc = ((c >> 6) * 2) * 64 + (c & 63); *(u32x4*)(rowp + qc) = w; *(u32x4*)(rowp + qc + 64) = w; }
                    else *(u32x4*)(rowp + c) = w; } }
    }
};
struct EpiGateMerge {
    static constexpr bool PERM = true, AFTER_DRAIN = false;
    const bf16_t *YA, *YB; bf16_t* MG; const float* ssq; float eps;
    __device__ __forceinline__ void operator()(const f32x4 (&acc)[2][2][4][2], const Unit& u, int wr, int wc, int fr, int fq) const {
        const int row0 = u.pm * BM + wr * 64 + fr, col0 = u.pn * HALF + wc * 32 + 8 * fq;
        float rs[2][4]; load_rs(rs, ssq, row0, eps);
#pragma unroll
        for (int ai = 0; ai < 2; ++ai)
#pragma unroll
            for (int m = 0; m < 4; ++m) { const size_t off = (size_t)(row0 + ai * HALF + m * 16) * 1024 + col0; const float s = rs[ai][m];
                const u32x4 ya = *(const u32x4*)(YA + off), yb = *(const u32x4*)(YB + off);
                float o[8];
#pragma unroll
                for (int n = 0; n < 2; ++n)
#pragma unroll
                    for (int j = 0; j < 4; ++j) { const int e = n * 4 + j; const unsigned wa = ya[e >> 1], wb = yb[e >> 1];
                        const float fa = __uint_as_float((e & 1) ? (wa & 0xffff0000u) : (wa << 16)), fb = __uint_as_float((e & 1) ? (wb & 0xffff0000u) : (wb << 16));
                        o[e] = fast_sigmoid(acc[ai][0][m][n][j] * s) * fa + fast_sigmoid(acc[ai][1][m][n][j] * s) * fb; }
                u32x4 w; w.x = cvt_pk_bf16(o[0], o[1]); w.y = cvt_pk_bf16(o[2], o[3]); w.z = cvt_pk_bf16(o[4], o[5]); w.w = cvt_pk_bf16(o[6], o[7]);
                *(u32x4*)(MG + off) = w; }
    }
};

template <class Epi, class Sched, bool ALIGN_EPI = false, bool SP2 = false>
__device__ __forceinline__ void gemm_phase(PG8_LAS unsigned char* lds, const Gemm g, const Sched& S, const Epi& E, const int wave_id) {
    const int wid = wave_id, lane = lane_id(), tid = wid * 64 + lane, wr = wid >> 2, wc = wid & 3, fr = lane & 15, fq = lane >> 4;
    const int K = g.K, nt = K / BK;
    unsigned voffA[2], voffB[2];
#pragma unroll
    for (int i = 0; i < 2; ++i) { int R, C; stage_rc(tid * 16 + i * 8192, R, C); const int Rb = Epi::PERM ? ((R & ~31) + perm32(R & 31)) : R;
        voffA[i] = (unsigned)(R * K + C) * 2u; voffB[i] = (unsigned)(Rb * K + C) * 2u; }
    const size_t kstep = (size_t)(BK * 2);
    const size_t hstep = (size_t)HALF * K * 2;
    const size_t tstep = 2 * hstep;
    const unsigned ldsw = (unsigned)wid * 1024u;
    const int aoff = lds_byte(wr * 64 + fr, fq * 8), boff = lds_byte(wc * 32 + fr, fq * 8);
#define PG8_SA(b, h) (((b) * 2 + (h)) * HTB)
#define PG8_SB(b, h) ((4 + (b) * 2 + (h)) * HTB)
#define PG8_STAGE(bufoff, gbase, voff) do { _Pragma("unroll") for (int _i = 0; _i < 2; ++_i) \
        __builtin_amdgcn_global_load_lds((const unsigned*)((const char*)(gbase) + (voff)[_i]), (PG8_LAS unsigned*)(lds + (bufoff) + ldsw + _i * 8192), 16, 0, 0); } while (0)
#define PG8_LDA(dst, b, h) do { _Pragma("unroll") for (int m = 0; m < 4; ++m) _Pragma("unroll") for (int k = 0; k < 2; ++k) dst[m][k] = *(const PG8_LAS bf16x8*)(lds + PG8_SA(b, h) + aoff + m * 2048 + k * 1024); } while (0)
#define PG8_LDB(dst, b, h) do { _Pragma("unroll") for (int n = 0; n < 2; ++n) _Pragma("unroll") for (int k = 0; k < 2; ++k) dst[n][k] = *(const PG8_LAS bf16x8*)(lds + PG8_SB(b, h) + boff + n * 2048 + k * 1024); } while (0)
#define PG8_MMA(ai, bj, At, Bt) do { __builtin_amdgcn_s_setprio(1); _Pragma("unroll") for (int m = 0; m < 4; ++m) _Pragma("unroll") for (int n = 0; n < 2; ++n) _Pragma("unroll") for (int k = 0; k < 2; ++k) \
        acc[ai][bj][m][n] = __builtin_amdgcn_mfma_f32_16x16x32_bf16(Bt[n][k], At[m][k], acc[ai][bj][m][n], 0, 0, 0); __builtin_amdgcn_s_setprio(0); } while (0)
#define PG8_WAIT_V(n) asm volatile("s_waitcnt vmcnt(" #n ")" ::: "memory")
#define PG8_WAIT_L(n) asm volatile("s_waitcnt lgkmcnt(" #n ")" ::: "memory")
#define PG8_BAR __builtin_amdgcn_s_barrier()
#define PG8_SCHED __builtin_amdgcn_sched_barrier(0)
    Unit cur, nxt; int ui = 0;
    if (!S.next(0, cur)) return;
    f32x4 acc[2][2][4][2];
#pragma unroll
    for (int a = 0; a < 2; ++a)
#pragma unroll
        for (int b = 0; b < 2; ++b)
#pragma unroll
            for (int m = 0; m < 4; ++m)
#pragma unroll
                for (int n = 0; n < 2; ++n) acc[a][b][m][n] = (f32x4){0.f, 0.f, 0.f, 0.f};
    bf16x8 At[4][2], B0[2][2], B1[2][2];
    const char* cA = (const char*)g.A + (size_t)cur.pm * tstep; const char* cB = (const char*)g.Bt + (size_t)cur.pn * tstep;
    S.a_ready(cur);
    if constexpr (SP2) {
        PG8_STAGE(PG8_SB(0, 0), cB, voffB); PG8_STAGE(PG8_SB(0, 1), cB + hstep, voffB); PG8_STAGE(PG8_SA(0, 0), cA, voffA); PG8_STAGE(PG8_SA(0, 1), cA + hstep, voffA);
        if (wr == 1) PG8_BAR;
        PG8_WAIT_V(2); PG8_BAR;
        PG8_STAGE(PG8_SB(1, 0), cB + kstep, voffB); PG8_STAGE(PG8_SA(1, 0), cA + kstep, voffA); PG8_STAGE(PG8_SB(1, 1), cB + hstep + kstep, voffB);
        PG8_WAIT_V(6); PG8_BAR;
    } else {
        PG8_STAGE(PG8_SB(0, 0), cB, voffB); PG8_STAGE(PG8_SA(0, 0), cA, voffA); PG8_STAGE(PG8_SB(0, 1), cB + hstep, voffB); PG8_STAGE(PG8_SA(0, 1), cA + hstep, voffA);
        if (wr == 1) PG8_BAR;
        PG8_WAIT_V(4); PG8_BAR;
        PG8_STAGE(PG8_SB(1, 0), cB + kstep, voffB); PG8_STAGE(PG8_SA(1, 0), cA + kstep, voffA); PG8_STAGE(PG8_SB(1, 1), cB + hstep + kstep, voffB);
        PG8_WAIT_V(6); PG8_BAR;
    }
    for (;;) {
        const bool has_next = S.next(ui + 1, nxt);
        const char* nA = has_next ? (const char*)g.A + (size_t)nxt.pm * tstep : cA; const char* nB = has_next ? (const char*)g.Bt + (size_t)nxt.pn * tstep : cB;
        for (int t = 0; t < nt; t += 2) {
            const bool last = (t == nt - 2);
            const char* a1 = cA + (size_t)(t + 1) * kstep;
            const char* a2 = last ? nA : cA + (size_t)(t + 2) * kstep; const char* b2 = last ? nB : cB + (size_t)(t + 2) * kstep;
            const char* a3 = a2 + kstep; const char* b3 = b2 + kstep;
            if (last && has_next) S.a_ready(nxt);
            if constexpr (SP2) {
            PG8_LDB(B0, 0, 0); PG8_LDB(B1, 0, 1); PG8_SCHED; PG8_LDA(At, 0, 0); PG8_STAGE(PG8_SA(1, 1), a1 + hstep, voffA);
            PG8_WAIT_V(8); PG8_WAIT_L(0); PG8_BAR; PG8_MMA(0, 0, At, B0); PG8_MMA(0, 1, At, B1); PG8_BAR; PG8_SCHED;
            PG8_LDA(At, 0, 1); PG8_STAGE(PG8_SB(0, 0), b2, voffB); PG8_STAGE(PG8_SB(0, 1), b2 + hstep, voffB); PG8_STAGE(PG8_SA(0, 0), a2, voffA);
            PG8_WAIT_V(8); PG8_WAIT_L(0); PG8_BAR; PG8_MMA(1, 0, At, B0); PG8_MMA(1, 1, At, B1); PG8_BAR; PG8_SCHED;
            PG8_LDB(B0, 1, 0); PG8_LDB(B1, 1, 1); PG8_SCHED; PG8_LDA(At, 1, 0); PG8_STAGE(PG8_SA(0, 1), a2 + hstep, voffA);
            PG8_WAIT_V(8); PG8_WAIT_L(0); PG8_BAR; PG8_MMA(0, 0, At, B0); PG8_MMA(0, 1, At, B1); PG8_BAR; PG8_SCHED;
            PG8_LDA(At, 1, 1); PG8_STAGE(PG8_SB(1, 0), b3, voffB); PG8_STAGE(PG8_SB(1, 1), b3 + hstep, voffB); PG8_STAGE(PG8_SA(1, 0), a3, voffA);
            PG8_WAIT_V(8); PG8_WAIT_L(0); PG8_BAR; PG8_MMA(1, 0, At, B0); PG8_MMA(1, 1, At, B1); PG8_BAR; PG8_SCHED;
            } else {
            PG8_LDB(B0, 0, 0); PG8_SCHED; PG8_LDA(At, 0, 0); PG8_STAGE(PG8_SA(1, 1), a1 + hstep, voffA);
            PG8_WAIT_L(8); PG8_BAR; PG8_WAIT_L(0); PG8_MMA(0, 0, At, B0); PG8_BAR; PG8_SCHED;
            PG8_LDB(B1, 0, 1); PG8_STAGE(PG8_SB(0, 0), b2, voffB);
            PG8_BAR; PG8_WAIT_L(0); PG8_MMA(0, 1, At, B1); PG8_BAR;
            PG8_LDA(At, 0, 1); PG8_STAGE(PG8_SA(0, 0), a2, voffA);
            PG8_BAR; PG8_WAIT_L(0); PG8_MMA(1, 0, At, B0); PG8_BAR; PG8_SCHED;
            PG8_STAGE(PG8_SB(0, 1), b2 + hstep, voffB);
            PG8_WAIT_V(6); PG8_BAR; PG8_MMA(1, 1, At, B1); PG8_BAR;
            PG8_LDB(B0, 1, 0); PG8_SCHED; PG8_LDA(At, 1, 0); PG8_STAGE(PG8_SA(0, 1), a2 + hstep, voffA);
            PG8_WAIT_L(8); PG8_BAR; PG8_WAIT_L(0); PG8_MMA(0, 0, At, B0); PG8_BAR; PG8_SCHED;
            PG8_LDB(B1, 1, 1); PG8_STAGE(PG8_SB(1, 0), b3, voffB);
            PG8_BAR; PG8_WAIT_L(0); PG8_MMA(0, 1, At, B1); PG8_BAR;
            PG8_LDA(At, 1, 1); PG8_STAGE(PG8_SA(1, 0), a3, voffA);
            PG8_BAR; PG8_WAIT_L(0); PG8_MMA(1, 0, At, B0); PG8_BAR; PG8_SCHED;
            PG8_STAGE(PG8_SB(1, 1), b3 + hstep, voffB);
            PG8_WAIT_V(6); PG8_BAR; PG8_MMA(1, 1, At, B1); PG8_BAR;
            }
        }
        if constexpr (ALIGN_EPI) { if (wr == 0) PG8_BAR; }
        if constexpr (!Epi::AFTER_DRAIN) { E(acc, cur, wr, wc, fr, fq); S.done(cur); }
        if (!has_next) break;
#pragma unroll
        for (int a = 0; a < 2; ++a)
#pragma unroll
            for (int b = 0; b < 2; ++b)
#pragma unroll
                for (int m = 0; m < 4; ++m)
#pragma unroll
                    for (int n = 0; n < 2; ++n) acc[a][b][m][n] = (f32x4){0.f, 0.f, 0.f, 0.f};
        cur = nxt; cA = nA; cB = nB; ++ui;
        if constexpr (ALIGN_EPI) { if (wr == 1) PG8_BAR; }
    }
    PG8_WAIT_V(0);
    if constexpr (!ALIGN_EPI) { if (wr == 0) PG8_BAR; }
    PG8_BAR;
    if constexpr (Epi::AFTER_DRAIN) { E.fused(acc, cur, wr, wc, fr, fq, lds, wid, lane); S.done(cur); }
#undef PG8_SA
#undef PG8_SB
#undef PG8_STAGE
#undef PG8_LDA
#undef PG8_LDB
#undef PG8_MMA
#undef PG8_WAIT_V
#undef PG8_WAIT_L
#undef PG8_BAR
#undef PG8_SCHED
}
}
#include <hip/hip_bf16.h>
#include <cmath>
namespace attn_body {
using bf16=__hip_bfloat16;
using bf16x8=__attribute__((ext_vector_type(8)))short;
using s16x4=__attribute__((ext_vector_type(4)))short;
using f32x16=__attribute__((ext_vector_type(16)))float;
using u32x4=__attribute__((ext_vector_type(4)))unsigned;
constexpr int BATCH=2,NHEAD=16,SEQ=8192,D=64,DM=NHEAD*D,KP=512;
constexpr int NW=8,QBLK=32,QB=QBLK*NW,KVBLK=64,NQB=SEQ/QB;
constexpr int ATTN_PITCH=DM, ATTN_UNIT_ROWS=QB;
__device__ __forceinline__ int crow(int r,int hi){return (r&3)+8*(r>>2)+4*hi;}
#define SBAR() __builtin_amdgcn_sched_barrier(0)
__device__ __forceinline__ void cmask(f32x16&p0,f32x16&p1,int jb,int qrel,int hi){
  const float NEG=-INFINITY; int lim=qrel-64*jb-4*hi; asm volatile("":"+v"(lim));
  #pragma unroll
  for(int r=0;r<16;++r){const int cr=(r&3)+8*(r>>2); if(cr>lim)p0[r]=NEG; if(cr+32>lim)p1[r]=NEG;}
}

constexpr int NSLOT=3, SLOTB=8192;
constexpr int LDS_K=0, LDS_V=NSLOT*SLOTB, LDS_WS=2*NSLOT*SLOTB, LDS_OST=LDS_WS+NW*64*4, LDS_BYTES=LDS_OST+NW*4096;
constexpr float C2=0.125f*1.4426950408889634f;
__device__ __forceinline__ void glds16(const void*gsrc,unsigned lds_dst){unsigned keep;
  asm volatile("s_mov_b32 %0, m0\n\ts_mov_b32 m0, %2\n\ts_nop 0\n\tglobal_load_lds_dwordx4 %1, off\n\ts_mov_b32 m0, %0":"=&s"(keep):"v"(gsrc),"s"(lds_dst):"memory");}
__device__ __forceinline__ float max3f(float a,float b,float c){float r;asm("v_max3_f32 %0, %1, %2, %3":"=v"(r):"v"(a),"v"(b),"v"(c));return r;}
__device__ __forceinline__ float max2f(float a,float b){float r;asm("v_max_f32_e32 %0, %1, %2":"=v"(r):"v"(a),"v"(b));return r;}
__device__ __forceinline__ float fadd_s(float a,float b){float r;asm("v_add_f32_e32 %0, %1, %2":"=v"(r):"v"(a),"v"(b));return r;}
__device__ __forceinline__ float fsub_s(float a,float b){float r;asm("v_sub_f32_e32 %0, %1, %2":"=v"(r):"v"(a),"v"(b));return r;}
typedef float f32x2_t __attribute__((ext_vector_type(2))); typedef __bf16 bf16x2_t __attribute__((ext_vector_type(2)));
__device__ __forceinline__ unsigned cvtpk_s(float lo,float hi){f32x2_t v={lo,hi};bf16x2_t b=__builtin_convertvector(v,bf16x2_t);return __builtin_bit_cast(unsigned,b);}
#define WAIT_BAR(N) asm volatile("s_waitcnt vmcnt(" #N ") lgkmcnt(0)\n\ts_barrier":::"memory")

__device__ __forceinline__ void qkt(f32x16&p0,f32x16&p1,const char*Kslot,const bf16x8*qr,const f32x16&negm,int r32,int hi){
  const char*kb=Kslot+hi*1024+r32*16;
  #pragma unroll
  for(int d0=0;d0<4;++d0){
    const bf16x8 b0=*reinterpret_cast<const bf16x8*>(kb+d0*2048);
    const bf16x8 b1=*reinterpret_cast<const bf16x8*>(kb+d0*2048+512);
    if(d0==0){p0=__builtin_amdgcn_mfma_f32_32x32x16_bf16(b0,qr[0],negm,0,0,0);p1=__builtin_amdgcn_mfma_f32_32x32x16_bf16(b1,qr[0],negm,0,0,0);}
    else{p0=__builtin_amdgcn_mfma_f32_32x32x16_bf16(b0,qr[d0],p0,0,0,0);p1=__builtin_amdgcn_mfma_f32_32x32x16_bf16(b1,qr[d0],p1,0,0,0);}}
}
typedef __attribute__((address_space(3))) const char* lds_cptr;
typedef short v4i16_t __attribute__((ext_vector_type(4)));
__device__ __forceinline__ void kload8(bf16x8*kf,lds_cptr kp){
  kf[0]=*(const __attribute__((address_space(3))) bf16x8*)(kp);      kf[1]=*(const __attribute__((address_space(3))) bf16x8*)(kp+512);
  kf[2]=*(const __attribute__((address_space(3))) bf16x8*)(kp+2048); kf[3]=*(const __attribute__((address_space(3))) bf16x8*)(kp+2560);
  kf[4]=*(const __attribute__((address_space(3))) bf16x8*)(kp+4096); kf[5]=*(const __attribute__((address_space(3))) bf16x8*)(kp+4608);
  kf[6]=*(const __attribute__((address_space(3))) bf16x8*)(kp+6144); kf[7]=*(const __attribute__((address_space(3))) bf16x8*)(kp+6656);
}
__device__ __forceinline__ void kload2(bf16x8*kf,lds_cptr kp,int j){ kf[2*j]=*(const __attribute__((address_space(3))) bf16x8*)(kp+j*2048); kf[2*j+1]=*(const __attribute__((address_space(3))) bf16x8*)(kp+j*2048+512); }
__device__ __forceinline__ s16x4 vtr(lds_cptr p){ return __builtin_bit_cast(s16x4,__builtin_amdgcn_ds_read_tr16_b64_v4i16((__attribute__((address_space(3))) v4i16_t*)p)); }
__device__ __forceinline__ float rowmax(const f32x16&p0,const f32x16&p1){
  float a=max3f(p0[0],p0[1],p1[0]),b=max3f(p0[2],p0[3],p1[1]);a=max3f(a,p1[2],p1[3]);
  #pragma unroll
  for(int r=4;r<16;r+=4){a=max3f(a,p0[r],p0[r+1]);b=max3f(b,p0[r+2],p0[r+3]);a=max3f(a,p1[r],p1[r+1]);b=max3f(b,p1[r+2],p1[r+3]);}
  const float m=max2f(a,b);
  auto rr=__builtin_amdgcn_permlane32_swap(__float_as_uint(m),__float_as_uint(m),false,false);
  return max2f(__uint_as_float(rr[0]),__uint_as_float(rr[1]));
}
__device__ __forceinline__ void pv(f32x16*o,int vb,bf16x8 pa0,bf16x8 pa1,bf16x8 pa2,bf16x8 pa3){
  #pragma unroll
  for(int d0=0;d0<2;++d0){s16x4 lo[4],hi[4];
    #pragma unroll
    for(int ks=0;ks<4;++ks){
      asm volatile("ds_read_b64_tr_b16 %0,%1 offset:%c2":"=&v"(lo[ks]):"v"(vb),"i"(d0*4096+ks*1024):"memory");
      asm volatile("ds_read_b64_tr_b16 %0,%1 offset:%c2":"=&v"(hi[ks]):"v"(vb),"i"(d0*4096+ks*1024+512):"memory");}
    asm volatile("s_waitcnt lgkmcnt(0)":::"memory");SBAR();
    #define PK(k) (bf16x8){lo[k][0],lo[k][1],lo[k][2],lo[k][3],hi[k][0],hi[k][1],hi[k][2],hi[k][3]}
    o[d0]=__builtin_amdgcn_mfma_f32_32x32x16_bf16(pa0,PK(0),o[d0],0,0,0);
    o[d0]=__builtin_amdgcn_mfma_f32_32x32x16_bf16(pa1,PK(1),o[d0],0,0,0);
    o[d0]=__builtin_amdgcn_mfma_f32_32x32x16_bf16(pa2,PK(2),o[d0],0,0,0);
    o[d0]=__builtin_amdgcn_mfma_f32_32x32x16_bf16(pa3,PK(3),o[d0],0,0,0);
    #undef PK
  }
}

#ifndef ATTN_STORE16
#define ATTN_STORE16(p,v) (*(u32x4*)(p)=(v))
#endif
template<int THRL> __device__ __forceinline__ void attn_unit(int b,int h,int qb,const bf16*Q,const bf16*__restrict__ K,const bf16*__restrict__ V,bf16*O,char*shm,const int wave_id){
  const int wid=wave_id,lane=lane_id(),tid=wid*64+lane,r32=lane&31,hi=lane>>5;
  const long rowbase=(long)b*SEQ; const int q0=qb*QB;
  const bf16*Qw=Q+(rowbase+q0+wid*QBLK)*DM+h*D;
  const bf16*Kh=K+rowbase*KP+(h>>1)*D,*Vh=V+rowbase*KP+(h>>2)*128+(h&1)*D;
  const unsigned lds0=(unsigned)(uintptr_t)shm;
  float*wsf=(float*)(shm+LDS_WS)+wid*64;
  const bf16*ksrc=Kh+(long)lane*KP+wid*8;
  const bf16*vsrc=Vh+(long)(16*(wid&3)+(lane>>2))*KP+(wid>>2)*32+(lane&3)*8;
  const unsigned kdst=lds0+LDS_K+wid*1024, vdst=lds0+LDS_V+wid*1024;
  #define DMA_K(t,slot) glds16(ksrc+(long)(t)*KVBLK*KP,(unsigned)__builtin_amdgcn_readfirstlane(kdst+(slot)))
  #define DMA_V(t,slot) glds16(vsrc+(long)(t)*KVBLK*KP,(unsigned)__builtin_amdgcn_readfirstlane(vdst+(slot)))
  const int vb0=(int)(lds0+LDS_V)+((lane>>4)&1)*32+(lane&3)*8+(4*hi+((lane&15)>>2))*64;
  const char*Kbase=shm+LDS_K; bf16x8 kf[8];
  const lds_cptr shm3=(lds_cptr)shm; const lds_cptr kp0=shm3+LDS_K+hi*1024+r32*16; const lds_cptr vp0=shm3+LDS_V+((lane>>4)&1)*32+(lane&3)*8+(4*hi+((lane&15)>>2))*64;
  const int NT=(q0+QB)/KVBLK;
  DMA_K(0,0);DMA_V(0,0);DMA_K(1,SLOTB);
  bf16x8 qr[4];
  #pragma unroll
  for(int d0=0;d0<4;++d0)qr[d0]=*reinterpret_cast<const bf16x8*>(&Qw[(long)r32*DM+d0*16+hi*8]);
  float mhat=0.f,l_reg=0.f;f32x16 o[2];o[0]=f32x16{};o[1]=f32x16{};const f32x16 negm=f32x16{};
  const int qrel=wid*QBLK+r32;
  const unsigned slb_=0x3eb8aa3bu-((unsigned)__builtin_amdgcn_readfirstlane(h>>2)<<24); const float sl2=__uint_as_float(slb_);
  const float qposf=(float)(q0+qrel-4*hi);
  const float s1_=sl2, s8_=__uint_as_float(slb_+(3u<<23)), s32_=__uint_as_float(slb_+(5u<<23));
  #define AADD(d,a,sv) asm volatile("v_add_f32_e32 %0, %1, %2":"=v"(d):"s"(sv),"v"(a))
  #define ALIBI(P0,P1,t) do{ float bq_=__builtin_fmaf(sl2,((float)(64*(t))-qposf),-mhat); \
    _Pragma("unroll") for(int q_=0;q_<4;++q_){ float b0_=bq_,b1_,b2_,b3_,c_; AADD(b1_,b0_,s1_); AADD(b2_,b1_,s1_); AADD(b3_,b2_,s1_); \
      P0[4*q_]+=b0_; P0[4*q_+1]+=b1_; P0[4*q_+2]+=b2_; P0[4*q_+3]+=b3_; \
      AADD(c_,b0_,s32_); P1[4*q_]+=c_; AADD(c_,b1_,s32_); P1[4*q_+1]+=c_; AADD(c_,b2_,s32_); P1[4*q_+2]+=c_; AADD(c_,b3_,s32_); P1[4*q_+3]+=c_; \
      if(q_<3){ AADD(bq_,b0_,s8_); } } }while(0)
  #define CMASK(P0,P1,t) do{int jb_=(t)-(NT-4); if(jb_>=0)cmask(P0,P1,jb_,qrel,hi);}while(0)
  bool resc=false;
  #define START(P0,P1) do{ const float rm=rowmax(P0,P1); resc=false; \
    { const float dl=rm; mhat=fadd_s(mhat,dl); \
      _Pragma("unroll") for(int r=0;r<16;++r){P0[r]=fsub_s(P0[r],dl);P1[r]=fsub_s(P1[r],dl);} \
      } \
    _Pragma("unroll") for(int r=0;r<16;++r)P0[r]=__builtin_amdgcn_exp2f(P0[r]); }while(0)
  #define RESC() do{ if(resc){ asm volatile("s_waitcnt lgkmcnt(0)":::"memory"); \
      _Pragma("unroll") for(int d_=0;d_<2;++d_) _Pragma("unroll") for(int r=0;r<16;++r)o[d_][r]*=wsf[crow(r,hi)]; } }while(0)
  f32x16 pA0,pA1,pB0,pB1;
  int sl_prev=0,sl_cur=0,sl_next=SLOTB;
  #define ROT() do{sl_prev=sl_cur;sl_cur=sl_next;sl_next=(sl_next==(NSLOT-1)*SLOTB)?0:sl_next+SLOTB;}while(0)
  DMA_K(2,2*SLOTB);
  WAIT_BAR(3);
  qkt(pA0,pA1,Kbase,qr,negm,r32,hi);asm volatile("s_nop 15\n\ts_nop 7":"+v"(pA0),"+v"(pA1));ALIBI(pA0,pA1,0);CMASK(pA0,pA1,0);
  START(pA0,pA1);
  _Pragma("unroll") for(int r=0;r<16;++r)pA1[r]=__builtin_amdgcn_exp2f(pA1[r]);
  WAIT_BAR(0);
  DMA_K(3,0);DMA_V(1,SLOTB);
  ROT();
  kload8(kf,kp0+sl_cur);
  WAIT_BAR(2);
  s16x4 vlo[8],vhi[8]; u32x4 pw0,pw1,pw2,pw3;
  #define PKW(P,B) cvtpk_s(P[B],P[B+1])
  #define PAF(k) __builtin_bit_cast(bf16x8,pw##k)
  #define VFR(i) (bf16x8){vlo[i][0],vlo[i][1],vlo[i][2],vlo[i][3],vhi[i][0],vhi[i][1],vhi[i][2],vhi[i][3]}
  #define PIN(x) asm volatile("":"+v"(x))
  #define MX3(a,b,c) __builtin_fmaxf(__builtin_fmaxf((a),(b)),(c))
  #define GAPA(MF,A0,A1,A2,A3,W0,W1,PW) do{ MF; sacc+=A0; sacc+=A1; sacc+=A2; sacc+=A3; PIN(sacc); W0; W1; PIN(PW); SBAR(); }while(0)
  #define EX(v) __builtin_amdgcn_exp2f(v)
  #define GAPB(MF,X,B) do{ MF; X[B]=EX(X[B]); X[B+1]=EX(X[B+1]); X[B+2]=EX(X[B+2]); X[B+3]=EX(X[B+3]); PIN(X); SBAR(); }while(0)
  #define VRD(i) do{ vlo[i]=vtr(vp_+(((i)>>2)*4096+((i)&3)*1024)); vhi[i]=vtr(vp_+(((i)>>2)*4096+((i)&3)*1024+512)); }while(0)
  #define KRD(G,j) do{ if(G){ kload2(kf,kp0+sl_next,j); SBAR(); } }while(0)
  #define STEP(C0,C1,P0,P1,t,GK,GV,GL) do{ SBAR(); \
    const lds_cptr vp_=vp0+sl_prev; \
    VRD(0); SBAR(); float sacc=(P0[0]+P0[1]); \
    GAPA(C0=__builtin_amdgcn_mfma_f32_32x32x16_bf16(kf[0],qr[0],negm,0,0,0), P0[2],P0[3],P0[4],P0[5],     pw0[0]=PKW(P0,0), pw0[1]=PKW(P0,2), pw0); \
    VRD(4); SBAR(); GAPA(C1=__builtin_amdgcn_mfma_f32_32x32x16_bf16(kf[1],qr[0],negm,0,0,0), P0[6],P0[7],P0[8],P0[9],     pw0[2]=PKW(P0,4), pw0[3]=PKW(P0,6), pw0); \
    VRD(1); SBAR(); GAPA(C0=__builtin_amdgcn_mfma_f32_32x32x16_bf16(kf[2],qr[1],C0,0,0,0),   P0[10],P0[11],P0[12],P0[13], pw1[0]=PKW(P0,8), pw1[1]=PKW(P0,10), pw1); \
    VRD(5); SBAR(); GAPA(C1=__builtin_amdgcn_mfma_f32_32x32x16_bf16(kf[3],qr[1],C1,0,0,0),   P0[14],P0[15],P1[0],P1[1],   pw1[2]=PKW(P0,12),pw1[3]=PKW(P0,14), pw1); \
    VRD(2); SBAR(); GAPA(C0=__builtin_amdgcn_mfma_f32_32x32x16_bf16(kf[4],qr[2],C0,0,0,0),   P1[2],P1[3],P1[4],P1[5],     pw2[0]=PKW(P1,0), pw2[1]=PKW(P1,2), pw2); \
    VRD(6); SBAR(); GAPA(C1=__builtin_amdgcn_mfma_f32_32x32x16_bf16(kf[5],qr[2],C1,0,0,0),   P1[6],P1[7],P1[8],P1[9],     pw2[2]=PKW(P1,4), pw2[3]=PKW(P1,6), pw2); \
    VRD(3); SBAR(); GAPA(C0=__builtin_amdgcn_mfma_f32_32x32x16_bf16(kf[6],qr[3],C0,0,0,0),   P1[10],P1[11],P1[12],P1[13], pw3[0]=PKW(P1,8), pw3[1]=PKW(P1,10), pw3); \
    VRD(7); SBAR(); GAPA(C1=__builtin_amdgcn_mfma_f32_32x32x16_bf16(kf[7],qr[3],C1,0,0,0),   P1[14],P1[15],0.f,0.f,       pw3[2]=PKW(P1,12),pw3[3]=PKW(P1,14), pw3); \
    l_reg+=sacc; \
    if(GK){DMA_K((t)+3,sl_cur);} if(GV){DMA_V((t)+1,sl_next);} \
    ALIBI(C0,C1,t); CMASK(C0,C1,t); \
    { float a=MX3(C0[0],C0[1],C1[0]),b=MX3(C0[2],C0[3],C1[1]); a=MX3(a,C1[2],C1[3]); \
      _Pragma("unroll") for(int r=4;r<16;r+=4){a=MX3(a,C0[r],C0[r+1]);b=MX3(b,C0[r+2],C0[r+3]);a=MX3(a,C1[r],C1[r+1]);b=MX3(b,C1[r+2],C1[r+3]);} \
      float rm=__builtin_fmaxf(a,b); { auto rr=__builtin_amdgcn_permlane32_swap(__float_as_uint(rm),__float_as_uint(rm),false,false); rm=__builtin_fmaxf(__uint_as_float(rr[0]),__uint_as_float(rr[1])); } \
      resc=false; \
      if(__builtin_expect(__any(rm>(float)THRL),0)){ const float dl=__builtin_fmaxf(rm,0.f); mhat+=dl; \
        _Pragma("unroll") for(int r=0;r<16;++r){C0[r]-=dl;C1[r]-=dl;} \
        const float f=__builtin_amdgcn_exp2f(-dl); l_reg*=f; if(hi==0)wsf[r32]=f; resc=true; } } \
    SBAR(); \
    GAPB(o[0]=__builtin_amdgcn_mfma_f32_32x32x16_bf16(PAF(0),VFR(0),o[0],0,0,0), C0,0); \
    GAPB(o[1]=__builtin_amdgcn_mfma_f32_32x32x16_bf16(PAF(0),VFR(4),o[1],0,0,0), C0,4); \
    KRD(GL,0); GAPB(o[0]=__builtin_amdgcn_mfma_f32_32x32x16_bf16(PAF(1),VFR(1),o[0],0,0,0), C0,8); \
    KRD(GL,1); GAPB(o[1]=__builtin_amdgcn_mfma_f32_32x32x16_bf16(PAF(1),VFR(5),o[1],0,0,0), C0,12); \
    KRD(GL,2); GAPB(o[0]=__builtin_amdgcn_mfma_f32_32x32x16_bf16(PAF(2),VFR(2),o[0],0,0,0), C1,0); \
    KRD(GL,3); GAPB(o[1]=__builtin_amdgcn_mfma_f32_32x32x16_bf16(PAF(2),VFR(6),o[1],0,0,0), C1,4); \
    GAPB(o[0]=__builtin_amdgcn_mfma_f32_32x32x16_bf16(PAF(3),VFR(3),o[0],0,0,0), C1,8); \
    GAPB(o[1]=__builtin_amdgcn_mfma_f32_32x32x16_bf16(PAF(3),VFR(7),o[1],0,0,0), C1,12); \
    }while(0)
  int t=1;
  #undef CMASK
  #define CMASK(P0,P1,t) do{}while(0)
  for(;t+5<NT;t+=2){
    STEP(pB0,pB1,pA0,pA1,t,true,true,true);     WAIT_BAR(2); RESC(); ROT();
    STEP(pA0,pA1,pB0,pB1,t+1,true,true,true);   WAIT_BAR(2); RESC(); ROT();
  }
  #undef CMASK
  #define CMASK(P0,P1,t) do{int jb_=(t)-(NT-4); if(jb_>=0)cmask(P0,P1,jb_,qrel,hi);}while(0)
  #define ENDW(tt) do{ if((tt)+3<NT){WAIT_BAR(2);} else if((tt)+2<NT){WAIT_BAR(1);} else {WAIT_BAR(0);} }while(0)
  for(;t+1<NT;t+=2){
    STEP(pB0,pB1,pA0,pA1,t,(t+3<NT),(t+1<NT),(t+1<NT));       ENDW(t);   RESC(); ROT();
    STEP(pA0,pA1,pB0,pB1,t+1,(t+4<NT),(t+2<NT),(t+2<NT));     ENDW(t+1); RESC(); ROT();
  }
  STEP(pB0,pB1,pA0,pA1,NT-1,false,false,false); RESC();
  { float sacc=pB0[0]+pB0[1]; _Pragma("unroll") for(int r=2;r<16;++r)sacc+=pB0[r]; _Pragma("unroll") for(int r=0;r<16;++r)sacc+=pB1[r]; l_reg+=sacc;
    pw0=(u32x4){PKW(pB0,0),PKW(pB0,2),PKW(pB0,4),PKW(pB0,6)};pw1=(u32x4){PKW(pB0,8),PKW(pB0,10),PKW(pB0,12),PKW(pB0,14)};pw2=(u32x4){PKW(pB1,0),PKW(pB1,2),PKW(pB1,4),PKW(pB1,6)};pw3=(u32x4){PKW(pB1,8),PKW(pB1,10),PKW(pB1,12),PKW(pB1,14)};
    SBAR(); pv(o,vb0+sl_cur,PAF(0),PAF(1),PAF(2),PAF(3)); }
  #undef PKW
  #undef PAF
  #undef VFR
  #undef PIN
  #undef MX3
  #undef GAPA
  #undef GAPB
  #undef EX
  #undef VRD
  #undef KRD
  #undef STEP
  #undef ENDW
  {auto rr=__builtin_amdgcn_permlane32_swap(__float_as_uint(l_reg),__float_as_uint(l_reg),false,false);l_reg=__uint_as_float(rr[0])+__uint_as_float(rr[1]);}
  if(hi==0)wsf[32+r32]=l_reg;asm volatile("s_waitcnt lgkmcnt(0)":::"memory");
  float rli[16];
  #pragma unroll
  for(int r=0;r<16;++r)rli[r]=__builtin_amdgcn_rcpf(wsf[32+crow(r,hi)]);
  bf16*Ow=O+(rowbase+q0+wid*QBLK)*DM+h*D;
  { bf16*stg=(bf16*)(shm+LDS_OST)+wid*2048;
    #pragma unroll
    for(int r=0;r<16;++r){const int orow=crow(r,hi);
      #pragma unroll
      for(int d0=0;d0<2;++d0)stg[orow*64+d0*32+r32]=__float2bfloat16(o[d0][r]*rli[r]);}
    asm volatile("s_waitcnt lgkmcnt(0)":::"memory");
    #pragma unroll
    for(int i=0;i<4;++i){const int row=i*8+(lane>>3),ch=lane&7; const u32x4 v=*(const u32x4*)(stg+row*64+ch*8); ATTN_STORE16(Ow+(long)row*DM+ch*8,v);} }
  asm volatile("s_waitcnt lgkmcnt(0)\n\ts_barrier":::"memory");
  #undef ALIBI
  #undef AADD
  #undef DMA_K
  #undef DMA_V
  #undef CMASK
  #undef START
  #undef RESC
  #undef ROT
}
constexpr int ATTN_LDS_BYTES=LDS_BYTES;
struct AttnTensors { const bf16* Q; const bf16* K; const bf16* V; bf16* O; };
struct AttnUnit { int bh; int qb; };
struct StaticOrder {
  int vcu;
  __device__ __forceinline__ explicit StaticOrder(int grid,int block):vcu((block%8)*(grid/8)+block/8){}
  __device__ __forceinline__ bool next(int i,AttnUnit&u)const{ if(i>=4)return false; const int s=vcu&7; u.bh=vcu>>3; u.qb=(i==0)?s:(i==1)?15-s:(i==2)?16+s:31-s; return true; }
  __device__ __forceinline__ void a_ready(const AttnUnit&)const{}
  __device__ __forceinline__ void done(const AttnUnit&)const{}
};
struct DynOrder {
  unsigned* qctr; volatile __attribute__((address_space(3))) unsigned* slot; int xq, wave;
  __device__ __forceinline__ bool next(int,AttnUnit&u)const{
    if(wave==0&&lane_id()==0){ slot[0]=__hip_atomic_fetch_add(qctr+64*xq,1u,__ATOMIC_RELAXED,__HIP_MEMORY_SCOPE_AGENT); }
    __syncthreads(); const unsigned v=slot[0]; __syncthreads();
    if(v>=128u)return false; u.qb=31-(int)(v>>2); u.bh=4*xq+(int)(v&3u); return true; }
  __device__ __forceinline__ void a_ready(const AttnUnit&)const{}
  __device__ __forceinline__ void done(const AttnUnit&)const{}
};
template<class Sched,int THRL=8> __device__ __forceinline__ void attn_phase(char*lds,const AttnTensors&T,const Sched&S,const int wave_id){
  AttnUnit u;
  for(int i=0;S.next(i,u);++i){ S.a_ready(u); attn_unit<THRL>(u.bh/NHEAD,u.bh%NHEAD,u.qb,T.Q,T.K,T.V,T.O,lds,wave_id); S.done(u); }
}
#undef SBAR
#undef WAIT_BAR
}
constexpr int NWAVES = 8;
constexpr int BATCH = 2, T = 8192, D = 1024, FF = 2816, M = BATCH * T;
constexpr int WIN_SRC = 5648, WIN_N = 3840;
constexpr float RMS_EPS = 1e-6f, SUBLN_EPS = 1e-5f;
constexpr size_t MiB = 1u << 20;
constexpr size_t WS_SSQA = 1 * MiB, WS_SSQB = 2 * MiB, WS_DNCD = 3 * MiB;
constexpr size_t WS_WG = 4 * MiB, WS_WA = 8 * MiB, WS_WB = 9 * MiB, WS_WOUT = 10 * MiB;
constexpr size_t WS_XB = 12 * MiB;
constexpr size_t WS_H = 44 * MiB;
constexpr size_t WS_WGU1 = 232 * MiB, WS_WD1 = 243 * MiB, WS_WIN = 248 * MiB + 512 * 1024;
constexpr size_t WS_PRE = 44 * MiB, WS_Z = 92 * MiB, WS_QO = 108 * MiB, WS_KD = 140 * MiB, WS_VD = 156 * MiB, WS_AB = 172 * MiB;
constexpr size_t WS_DN = 173 * MiB;
constexpr size_t WS_ODN = 44 * MiB, WS_AA = 60 * MiB, WS_ABB = 76 * MiB;
constexpr size_t WS_WGU2 = 173 * MiB, WS_WD2 = 184 * MiB;
constexpr size_t WS_YA = 190 * MiB, WS_YB = 222 * MiB, WS_MG = 108 * MiB;
constexpr size_t WS_END = 256 * MiB;
constexpr int DN_REC = 40960;
static_assert(WS_DN + (size_t)2048 * DN_REC <= WS_END && WS_WIN + (size_t)WIN_N * D * 2 <= WS_END && WS_YB + (size_t)M * D * 2 <= WS_END, "d_ws map");

constexpr int RING_OFF = 0, RING_BYTES = 147456;
constexpr int MISC_OFF = 147456, LDS_BYTES = 147456 + 256;

#define LAS __attribute__((address_space(3)))
typedef unsigned short bf16;
typedef unsigned v4u __attribute__((ext_vector_type(4)));
typedef float f32x4 __attribute__((ext_vector_type(4)));
typedef float f32x16 __attribute__((ext_vector_type(16)));
typedef short bf16x8 __attribute__((ext_vector_type(8)));
#define LDSFENCE() asm volatile("s_waitcnt lgkmcnt(0)" ::: "memory")
__device__ __forceinline__ unsigned f2bf(float f) { unsigned u = __builtin_bit_cast(unsigned, f); return (u + 0x7fffu + ((u >> 16) & 1u)) >> 16; }
__device__ __forceinline__ unsigned pk2(float lo, float hi) { return f2bf(lo) | (f2bf(hi) << 16); }
__device__ __forceinline__ float bflo(unsigned w) { return __uint_as_float(w << 16); }
__device__ __forceinline__ float bfhi(unsigned w) { return __uint_as_float(w & 0xffff0000u); }
__device__ __forceinline__ float wave_sum(float v) {
#pragma unroll
    for (int o = 1; o < 64; o <<= 1) v += __shfl_xor(v, o);
    return v;
}

#define GAS __attribute__((address_space(1)))
typedef GAS unsigned gu32;
#define RLX_AGENT __ATOMIC_RELAXED, __HIP_MEMORY_SCOPE_AGENT
constexpr size_t WS_CTL = 0, CTL_ZERO_BYTES = 65536;
constexpr int CW_BAR = 1024, CW_ATTQ = 8192;
#define XB_TMO      128
#define XB_XCNT(j)  (256  + 64 * (j))
#define XB_XSUB(j)  (1280 + 64 * (j))
#define XB_XGEN(j)  (2304 + 64 * (j))
#define XB_TOP      3328
#define XB_TOPGEN   3392
#define XCD_BAR_WORDS 3456
#define XB_SPIN_CAP (1u << 18)

__device__ __forceinline__ unsigned xb_ld(unsigned* p)              { return __hip_atomic_load(p, __ATOMIC_RELAXED, __HIP_MEMORY_SCOPE_AGENT); }
__device__ __forceinline__ unsigned xb_add(unsigned* p, unsigned v) { return __hip_atomic_fetch_add(p, v, __ATOMIC_RELAXED, __HIP_MEMORY_SCOPE_AGENT); }
__device__ __forceinline__ unsigned xb_xcc_id() { return (unsigned)__builtin_amdgcn_s_getreg((3 << 11) | 20) & 0xFu; }
#define XB_SPIN(cond, bar) do { unsigned _sp = 0; while (cond) { __builtin_amdgcn_s_sleep(1); \
    if ((++_sp & 255u) == 0u) { if (xb_ld(&(bar)[XB_TMO])) break; if (_sp > XB_SPIN_CAP) { atomicAdd(&(bar)[XB_TMO], 1u); break; } } } } while (0)

struct XcdBarrier {
    unsigned* bar; unsigned x; int wave;
    volatile LAS unsigned* st;
};

__device__ __forceinline__ XcdBarrier xcd_barrier_post(unsigned* bar, volatile LAS unsigned* st, int wave) {
    XcdBarrier b; b.bar = bar; b.x = xb_xcc_id(); b.st = st; b.wave = wave;
    if (wave == 0 && lane_id() == 0) (void)xb_add(&bar[XB_XCNT(b.x)], 1u);
    return b;
}
__device__ __forceinline__ void xcd_barrier_complete(unsigned* bar, unsigned x, unsigned& nloc, unsigned& nx) {
    const unsigned G = gridDim.x * gridDim.y * gridDim.z;
    unsigned sum, cnt, mine, sp = 0u;
    for (;;) {
        sum = 0u; cnt = 0u; mine = 0u;
#pragma unroll
        for (unsigned j = 0; j < 16; ++j) { const unsigned c = xb_ld(&bar[XB_XCNT(j)]); sum += c; cnt += (c > 0u) ? 1u : 0u; mine = (j == x) ? c : mine; }
        if (sum == G) break;
        __builtin_amdgcn_s_sleep(1);
        if ((++sp & 255u) == 0u) { if (xb_ld(&bar[XB_TMO])) break; if (sp > XB_SPIN_CAP) { atomicAdd(&bar[XB_TMO], 1u); break; } }
    }
    nloc = mine > 0u ? mine : 1u; nx = cnt > 0u ? cnt : 1u;
}

__device__ __forceinline__ void xcd_barrier(const XcdBarrier& b) {
    asm volatile("s_waitcnt vmcnt(0)" ::: "memory");
    __syncthreads();
    if (b.wave == 0 && lane_id() == 0) {
        unsigned* bar = b.bar;
        __builtin_amdgcn_s_waitcnt(0);
        unsigned nloc = b.st[0], nx = b.st[1];
        if (nloc == 0u) { xcd_barrier_complete(bar, b.x, nloc, nx); b.st[0] = nloc; b.st[1] = nx; }
        const unsigned old = xb_add(&bar[XB_XSUB(b.x)], 1u);
        const unsigned gen = old / nloc;
        if (old + 1u == (gen + 1u) * nloc) {
            __builtin_amdgcn_fence(__ATOMIC_RELEASE, "agent");
            asm volatile("s_waitcnt vmcnt(0)" ::: "memory");
            const unsigned og = xb_add(&bar[XB_TOP], 1u);
            const unsigned tg = og / nx;
            if (og + 1u == (tg + 1u) * nx) xb_add(&bar[XB_TOPGEN], 1u);
            else XB_SPIN(xb_ld(&bar[XB_TOPGEN]) == tg, bar);
            __builtin_amdgcn_fence(__ATOMIC_ACQUIRE, "agent");
            xb_add(&bar[XB_XGEN(b.x)], 1u);
            asm volatile("s_waitcnt vmcnt(0)" ::: "memory");
        } else {
            XB_SPIN(xb_ld(&bar[XB_XGEN(b.x)]) == gen, bar);
            __builtin_amdgcn_fence(__ATOMIC_ACQUIRE, "agent");
            asm volatile("s_waitcnt vmcnt(0)" ::: "memory");
        }
    }
    __syncthreads();
}

struct Ctx {
    const float* const* in; float* out; unsigned char* ws;
    LAS unsigned char* lds; int wave, G, vcu;
};

__device__ __forceinline__ void conv_item(const float* W, int ldw, int scol0, int nvalid, const float* gain, bf16* WT, int K, int drow0, int k0, LAS float* scr, int lane) {
#pragma unroll 8
    for (int i = 0; i < 32; ++i) { const int kk = 2 * i + (lane >> 5), n = lane & 31; float v = (n < nvalid) ? W[(size_t)(k0 + kk) * ldw + scol0 + n] : 0.f; if (gain) v *= gain[k0 + kk]; scr[kk * 33 + n] = v; }
    LDSFENCE();
    const int c = lane & 7;
#pragma unroll
    for (int j = 0; j < 4; ++j) { const int n = (lane >> 3) + 8 * j; const LAS float* s = scr + (8 * c) * 33 + n;
        v4u o; o.x = pk2(s[0 * 33], s[1 * 33]); o.y = pk2(s[2 * 33], s[3 * 33]); o.z = pk2(s[4 * 33], s[5 * 33]); o.w = pk2(s[6 * 33], s[7 * 33]);
        *(v4u*)(WT + (size_t)(drow0 + n) * K + k0 + 8 * c) = o; }
    LDSFENCE();
}
__device__ __forceinline__ void conv_gu(const float* wg, const float* wu, const float* gain, bf16* WT, int it, LAS float* scr, int lane) {
    const int db = it >> 4, kb = it & 15, tile = db >> 3, w = db & 7;
    conv_item(w < 4 ? wg : wu, FF, 128 * tile + 32 * (w & 3), 32, gain, WT, D, 32 * db, 64 * kb, scr, lane);
}
__device__ __forceinline__ void conv_plain(const float* W, int K, int N, bf16* WT, int it, LAS float* scr, int lane) {
    const int nkb = K / 64, db = it / nkb, kb = it % nkb;
    conv_item(W, N, 32 * db, 32, nullptr, WT, K, 32 * db, 64 * kb, scr, lane);
}
__device__ __forceinline__ void conv_win(const float* W, const float* gain, bf16* WT, int it, LAS float* scr, int lane) {
    const int db = it >> 4, kb = it & 15, d0 = 32 * db; int sc, nv = 32;
    if (d0 < 2048) sc = d0; else if (d0 < 3584) sc = d0 + 16; else if (d0 == 3584) { sc = 2048; nv = 16; } else { sc = 0; nv = 0; }
    conv_item(W, WIN_SRC, sc, nv, gain, WT, D, d0, 64 * kb, scr, lane);
}
__device__ __forceinline__ void conv_wg(const float* W, const float* gain, bf16* WT, int it, LAS float* scr, int lane) {
    const int db = it >> 4, kb = it & 15, tile = db >> 3, w = db & 7;
    conv_item(W, WIN_SRC, 3600 + (w < 4 ? 0 : 1024) + 128 * tile + 32 * (w & 3), 32, gain, WT, D, 32 * db, 64 * kb, scr, lane);
}

__device__ __forceinline__ void p0_prologue(Ctx& F) {
    const int lane = lane_id();
    LAS float* scr = (LAS float*)(F.lds + RING_OFF + F.wave * 17408);
    const int gw = F.vcu * NWAVES + F.wave, NGW = F.G * NWAVES;
    bf16* ws16 = (bf16*)F.ws;
    constexpr int I_GU = 176 * 16, I_DN = 32 * 44, I_WIN = 120 * 16, I_WG = 64 * 16, I_AB = 32 * 8, I_WO = 32 * 16;
    constexpr int NIT = I_GU + I_DN + I_WIN + I_WG + 2 * I_AB + I_WO;
    for (int it = gw; it < NIT; it += NGW) {
        int r = it;
        if (r < I_GU) { conv_gu(F.in[2], F.in[3], F.in[1], (bf16*)(F.ws + WS_WGU1), r, scr, lane); continue; } r -= I_GU;
        if (r < I_DN) { conv_plain(F.in[4], FF, D, (bf16*)(F.ws + WS_WD1), r, scr, lane); continue; } r -= I_DN;
        if (r < I_WIN) { conv_win(F.in[6], F.in[5], (bf16*)(F.ws + WS_WIN), r, scr, lane); continue; } r -= I_WIN;
        if (r < I_WG) { conv_wg(F.in[6], F.in[5], (bf16*)(F.ws + WS_WG), r, scr, lane); continue; } r -= I_WG;
        if (r < I_AB) { conv_plain(F.in[16], 512, D, (bf16*)(F.ws + WS_WA), r, scr, lane); continue; } r -= I_AB;
        if (r < I_AB) { conv_plain(F.in[17], 512, D, (bf16*)(F.ws + WS_WB), r, scr, lane); continue; } r -= I_AB;
        conv_plain(F.in[18], D, D, (bf16*)(F.ws + WS_WOUT), r, scr, lane);
    }
    (void)ws16;
    const float* x = F.in[0]; bf16* xb = (bf16*)(F.ws + WS_XB); float* ssq = (float*)(F.ws + WS_SSQA);
    for (int m = gw; m < M; m += NGW) {
        const f32x4* xr = (const f32x4*)(x + (size_t)m * D) + lane; unsigned long long* o8 = (unsigned long long*)(xb + (size_t)m * D) + lane;
        float s = 0.f;
#pragma unroll
        for (int j = 0; j < 4; ++j) { const f32x4 v = xr[64 * j]; s += (v.x * v.x + v.y * v.y) + (v.z * v.z + v.w * v.w);
            o8[64 * j] = (unsigned long long)pk2(v.x, v.y) | ((unsigned long long)pk2(v.z, v.w) << 32); }
        s = wave_sum(s);
        if (lane < 16) ssq[(size_t)m * 16 + lane] = (lane == 0) ? s : 0.f;
    }
}
__device__ __forceinline__ void conv_ffn2(Ctx& F) {
    const int lane = lane_id();
    LAS float* scr = (LAS float*)(F.lds + RING_OFF + F.wave * 17408);
    const int gw = F.vcu * NWAVES + F.wave, NGW = F.G * NWAVES;
    constexpr int I_GU = 176 * 16, I_DN = 32 * 44;
    for (int it = gw; it < I_GU + I_DN; it += NGW) {
        if (it < I_GU) conv_gu(F.in[20], F.in[21], F.in[19], (bf16*)(F.ws + WS_WGU2), it, scr, lane);
        else conv_plain(F.in[22], FF, D, (bf16*)(F.ws + WS_WD2), it - I_GU, scr, lane);
    }
}

__device__ __forceinline__ float silu_acc(float v) { return v / (1.0f + __expf(-v)); }
typedef unsigned u32x2 __attribute__((ext_vector_type(2)));
__device__ __forceinline__ void dn_conv_l1(const bf16* PRE, const float* cw, long row0, int tin0, int colbase, int r, int hh, float (&y)[2][4][8]) {
#pragma unroll
    for (int s = 0; s < 4; ++s) {
        const int ch0 = colbase + 16 * s + 4 * hh;
        f32x4 wl[4], wh[4];
#pragma unroll
        for (int j = 0; j < 4; ++j) { wl[j] = *(const f32x4*)(cw + j * 1536 + ch0); wh[j] = *(const f32x4*)(cw + j * 1536 + ch0 + 8); }
#pragma unroll
        for (int i = 0; i < 2; ++i) { const int tok = r + 32 * i, tin = tin0 + tok; const long row = row0 + tok;
            float a[8];
#pragma unroll
            for (int e = 0; e < 8; ++e) a[e] = 0.f;
#pragma unroll
            for (int j = 0; j < 4; ++j) { u32x2 lo = (u32x2){0u, 0u}, hi = (u32x2){0u, 0u};
                if (tin - 3 + j >= 0) { const bf16* p = PRE + (size_t)(row - 3 + j) * 1536 + ch0; lo = *(const u32x2*)p; hi = *(const u32x2*)(p + 8); }
                a[0] += wl[j][0] * bflo(lo.x); a[1] += wl[j][1] * bfhi(lo.x); a[2] += wl[j][2] * bflo(lo.y); a[3] += wl[j][3] * bfhi(lo.y);
                a[4] += wh[j][0] * bflo(hi.x); a[5] += wh[j][1] * bfhi(hi.x); a[6] += wh[j][2] * bflo(hi.y); a[7] += wh[j][3] * bfhi(hi.y); }
#pragma unroll
            for (int e = 0; e < 8; ++e) { y[i][s][e] = silu_acc(a[e]); asm volatile("" : "+v"(y[i][s][e])); } }
        __builtin_amdgcn_sched_barrier(0);
    }
}
__device__ __forceinline__ bf16x8 pack8f(const float (&v)[8], float sc) {
    v4u o; o.x = pk2(v[0] * sc, v[1] * sc); o.y = pk2(v[2] * sc, v[3] * sc); o.z = pk2(v[4] * sc, v[5] * sc); o.w = pk2(v[6] * sc, v[7] * sc);
    return __builtin_bit_cast(bf16x8, o);
}
__device__ __forceinline__ v4u pack8acc(const f32x16& X, int kq) {
    v4u o; o.x = pk2(X[8 * kq], X[8 * kq + 1]); o.y = pk2(X[8 * kq + 2], X[8 * kq + 3]); o.z = pk2(X[8 * kq + 4], X[8 * kq + 5]); o.w = pk2(X[8 * kq + 6], X[8 * kq + 7]);
    return o;
}
__device__ __forceinline__ void write_xt(LAS unsigned short* XT, const bf16x8 (&fr)[2][4], const float (&sc)[2], int r, int hh) {
#pragma unroll
    for (int i = 0; i < 2; ++i)
#pragma unroll
        for (int s = 0; s < 4; ++s) { const v4u w = __builtin_bit_cast(v4u, fr[i][s]);
#pragma unroll
            for (int e = 0; e < 8; ++e) { const unsigned ww = w[e >> 1]; const float v = ((e & 1) ? bfhi(ww) : bflo(ww)) * sc[i];
                XT[(16 * s + 8 * (e >> 2) + 4 * hh + (e & 3)) * 72 + r + 32 * i] = (unsigned short)f2bf(v); } }
}
__device__ __forceinline__ float lane_bcast(float v, int l) { return __uint_as_float((unsigned)__builtin_amdgcn_readlane((int)__float_as_uint(v), l)); }

__device__ __forceinline__ void dn_prep_chunk(Ctx& F, int ch, LAS unsigned char* scrb, int opq  ) {
    int lane_ = lane_id();
    const int lane = lane_, r = lane & 31, hh = lane >> 5;
    const int n = ch & 127, h = (ch >> 7) & 7, b = ch >> 10;
    const long row0 = (long)b * T + 64 * n; const int tin0 = 64 * n;
    const bf16* PRE = (const bf16*)(F.ws + WS_PRE); const float* AB = (const float*)(F.ws + WS_AB); const float* cw = F.in[7];
    unsigned char* rec = F.ws + WS_DN + (size_t)ch * DN_REC;
    LAS float* At = (LAS float*)scrb; LAS unsigned short* TT = (LAS unsigned short*)scrb; LAS unsigned short* XT = (LAS unsigned short*)(scrb + 9216);
    float gc, betac;
    { const float al = AB[(size_t)(row0 + lane) * 16 + h], bl = AB[(size_t)(row0 + lane) * 16 + 8 + h];
      const float xs = al + F.in[9][h];
      const float sp = fmaxf(xs, 0.f) + log1pf(expf(-fabsf(xs)));
      gc = -expf(F.in[8][h]) * sp; betac = 1.0f / (1.0f + expf(-bl));
#pragma unroll
      for (int o = 1; o < 64; o <<= 1) { const float t = __shfl_up(gc, o); if (lane >= o) gc += t; } }
    const float gl = lane_bcast(gc, 63);
    float gct[2], bet[2];
#pragma unroll
    for (int i = 0; i < 2; ++i) { gct[i] = __shfl(gc, r + 32 * i); bet[i] = __shfl(betac, r + 32 * i); }
    bf16x8 kf[2][4];
#pragma unroll
    for (int i = 0; i < 2; ++i)
#pragma unroll
        for (int s = 0; s < 4; ++s) kf[i][s] = (bf16x8){0, 0, 0, 0, 0, 0, 0, 0};
    if (opq > 0) { int lane = lane_; asm volatile("" : "+v"(lane)); const int r = lane & 31, hh = lane >> 5;
      float y[2][4][8]; dn_conv_l1(PRE, cw, row0, tin0, 512 + h * 64, r, hh, y);
#pragma unroll
      for (int i = 0; i < 2; ++i) { float ss = 0.f;
#pragma unroll
          for (int s = 0; s < 4; ++s)
#pragma unroll
              for (int e = 0; e < 8; ++e) ss += y[i][s][e] * y[i][s][e];
          ss += __shfl_xor(ss, 32); const float rn = 1.0f / sqrtf(ss + 1e-6f);
#pragma unroll
          for (int s = 0; s < 4; ++s) { kf[i][s] = pack8f(y[i][s], rn); asm volatile("" : "+v"(kf[i][s])); } } }
    __builtin_amdgcn_sched_barrier(0);
    if (opq > 1) { int lane = lane_; asm volatile("" : "+v"(lane)); const int r = lane & 31, hh = lane >> 5;
      float sc[2] = {expf(gl - gct[0]), expf(gl - gct[1])};
      write_xt(XT, kf, sc, r, hh);
      LDSFENCE();
#pragma unroll
      for (int id = 0; id < 2; ++id)
#pragma unroll
          for (int ks = 0; ks < 4; ++ks) { const int d = r + 32 * id; const LAS unsigned short* p = XT + d * 72 + 16 * ks + 4 * hh;
              const u32x2 lo = *(const LAS u32x2*)p, hi = *(const LAS u32x2*)(p + 8);
              *(v4u*)(rec + 24576 + d * 128 + (ks * 2 + hh) * 16) = (v4u){lo.x, lo.y, hi.x, hi.y}; }
      LDSFENCE(); }
    __builtin_amdgcn_sched_barrier(0);
#ifndef SKQ
    if (opq > 2) {
        int lane = lane_; asm volatile("" : "+v"(lane)); const int r = lane & 31, hh = lane >> 5;
        bf16x8 qf[2][4];
        { float y[2][4][8]; dn_conv_l1(PRE, cw, row0, tin0, h * 64, r, hh, y);
#pragma unroll
          for (int i = 0; i < 2; ++i) { float ss = 0.f;
#pragma unroll
              for (int s = 0; s < 4; ++s)
#pragma unroll
                  for (int e = 0; e < 8; ++e) ss += y[i][s][e] * y[i][s][e];
              ss += __shfl_xor(ss, 32); const float rn = 0.125f / sqrtf(ss + 1e-6f); const float eg = expf(gct[i]);
#pragma unroll
              for (int s = 0; s < 4; ++s) { qf[i][s] = pack8f(y[i][s], rn);
                  *(bf16x8*)(rec + 8192 + (r + 32 * i) * 128 + (s * 2 + hh) * 16) = pack8f(y[i][s], rn * eg); asm volatile("" : "+v"(qf[i][s])); } } }
        __builtin_amdgcn_sched_barrier(0);
#pragma unroll
        for (int is = 0; is < 2; ++is) {
            float gcr[16];
#pragma unroll
            for (int g = 0; g < 16; ++g) gcr[g] = __shfl(gc, 32 * is + (g & 3) + 8 * (g >> 2) + 4 * hh);
#pragma unroll
            for (int ic = 0; ic < 2; ++ic) {
                if (is == 1 && ic == 0) {
#pragma unroll
                    for (int kq = 0; kq < 2; ++kq) *(v4u*)(rec + 16384 + r * 128 + ((2 + kq) * 2 + hh) * 16) = (v4u){0u, 0u, 0u, 0u};
#pragma unroll
                    for (int g = 0; g < 16; ++g) At[(32 + (g & 3) + 8 * (g >> 2) + 4 * hh) * 68 + r] = 0.f;
                    continue;
                }
                f32x16 pt, pk;
#pragma unroll
                for (int g = 0; g < 16; ++g) { pt[g] = 0.f; pk[g] = 0.f; }
#pragma unroll
                for (int ks = 0; ks < 4; ++ks) { pt = __builtin_amdgcn_mfma_f32_32x32x16_bf16(kf[is][ks], qf[ic][ks], pt, 0, 0, 0); pk = __builtin_amdgcn_mfma_f32_32x32x16_bf16(kf[is][ks], kf[ic][ks], pk, 0, 0, 0); }
                const int ccol = 32 * ic + r;
#pragma unroll
                for (int g = 0; g < 16; ++g) { const int srow = 32 * is + (g & 3) + 8 * (g >> 2) + 4 * hh; const float dec = expf(fminf(gct[ic] - gcr[g], 0.f));
                    pt[g] = (srow <= ccol) ? pt[g] * dec : 0.f;
                    At[srow * 68 + ccol] = (srow < ccol) ? bet[ic] * pk[g] * dec : 0.f; }
#pragma unroll
                for (int kq = 0; kq < 2; ++kq) *(v4u*)(rec + 16384 + ccol * 128 + ((2 * is + kq) * 2 + hh) * 16) = pack8acc(pt, kq);
                __builtin_amdgcn_sched_barrier(0);
            }
        }
    }
    LDSFENCE();
#endif
    __builtin_amdgcn_sched_barrier(0);
#ifndef SKS
    if (opq > 3) {
        int lane = lane_; asm volatile("" : "+v"(lane)); const int r = lane & 31, hh = lane >> 5;
        float t[64];
#pragma unroll
        for (int k = 0; k < 64; ++k) t[k] = (k == lane) ? 1.0f : 0.0f;
#pragma unroll
        for (int j = 62; j >= 0; --j) { float acc = 0.f;
#pragma unroll
            for (int k4 = (j + 1) & ~3; k4 < 64; k4 += 4) { const f32x4 x = *(const volatile LAS f32x4*)(At + j * 68 + k4);
#pragma unroll
                for (int i = 0; i < 4; ++i) if (k4 + i > j) acc += t[k4 + i] * x[i]; }
            t[j] -= acc; asm volatile("" : "+v"(t[j])); }
        LDSFENCE();
#pragma unroll
        for (int i = 0; i < 8; ++i) { v4u o; o.x = pk2(t[8 * i], t[8 * i + 1]); o.y = pk2(t[8 * i + 2], t[8 * i + 3]); o.z = pk2(t[8 * i + 4], t[8 * i + 5]); o.w = pk2(t[8 * i + 6], t[8 * i + 7]);
            *(LAS v4u*)(TT + lane * 72 + 8 * i) = o; }
    }
#endif
    __builtin_amdgcn_sched_barrier(0);
#ifndef SKW
    if (opq > 4) { int lane = lane_; asm volatile("" : "+v"(lane)); const int r = lane & 31, hh = lane >> 5;
      float sc[2] = {bet[0] * expf(gct[0]), bet[1] * expf(gct[1])};
      write_xt(XT, kf, sc, r, hh);
      LDSFENCE();
#pragma unroll
      for (int id = 0; id < 2; ++id)
#pragma unroll
          for (int ic = 0; ic < 2; ++ic) { f32x16 acc;
#pragma unroll
              for (int g = 0; g < 16; ++g) acc[g] = 0.f;
#pragma unroll
              for (int ks = 0; ks < 4; ++ks) { const bf16x8 af = *(const LAS bf16x8*)(XT + (r + 32 * id) * 72 + 16 * ks + 8 * hh), bfr = *(const LAS bf16x8*)(TT + (r + 32 * ic) * 72 + 16 * ks + 8 * hh);
                  acc = __builtin_amdgcn_mfma_f32_32x32x16_bf16(af, bfr, acc, 0, 0, 0); }
#pragma unroll
              for (int kq = 0; kq < 2; ++kq) *(v4u*)(rec + (32 * ic + r) * 128 + ((2 * id + kq) * 2 + hh) * 16) = pack8acc(acc, kq); __builtin_amdgcn_sched_barrier(0); }
      LDSFENCE(); }
    __builtin_amdgcn_sched_barrier(0);
#endif
#ifndef SKU
    if (opq > 1) { int lane = lane_; asm volatile("" : "+v"(lane)); const int r = lane & 31, hh = lane >> 5;
      bf16x8 vf[2][4];
      { float y[2][4][8]; dn_conv_l1(PRE, cw, row0, tin0, 1024 + h * 64, r, hh, y);
#pragma unroll
        for (int i = 0; i < 2; ++i)
#pragma unroll
            for (int s = 0; s < 4; ++s) { vf[i][s] = pack8f(y[i][s], bet[i]); asm volatile("" : "+v"(vf[i][s])); } }
      __builtin_amdgcn_sched_barrier(0);
      float one[2] = {1.0f, 1.0f};
      write_xt(XT, vf, one, r, hh);
      LDSFENCE();
      unsigned* U = (unsigned*)(rec + 32768);
#pragma unroll
      for (int ic = 0; ic < 2; ++ic)
#pragma unroll
          for (int ie = 0; ie < 2; ++ie) { f32x16 acc;
#pragma unroll
              for (int g = 0; g < 16; ++g) acc[g] = 0.f;
#pragma unroll
              for (int ks = 0; ks < 4; ++ks) { const bf16x8 af = *(const LAS bf16x8*)(TT + (r + 32 * ic) * 72 + 16 * ks + 8 * hh), bfr = *(const LAS bf16x8*)(XT + (r + 32 * ie) * 72 + 16 * ks + 8 * hh);
                  acc = __builtin_amdgcn_mfma_f32_32x32x16_bf16(af, bfr, acc, 0, 0, 0); }
#pragma unroll
              for (int gp = 0; gp < 8; ++gp) U[((ie * 2 + ic) * 8 + gp) * 64 + lane] = pk2(acc[2 * gp], acc[2 * gp + 1]); __builtin_amdgcn_sched_barrier(0); }
      LDSFENCE(); }
#endif
    if (lane == 0) ((float*)(F.ws + WS_DNCD))[ch] = expf(gl);
}

__device__ __forceinline__ bf16x8 pack8(const f32x16& X, int s) {
    v4u o; o.x = pg8::cvt_pk_bf16(X[8 * s], X[8 * s + 1]); o.y = pg8::cvt_pk_bf16(X[8 * s + 2], X[8 * s + 3]); o.z = pg8::cvt_pk_bf16(X[8 * s + 4], X[8 * s + 5]); o.w = pg8::cvt_pk_bf16(X[8 * s + 6], X[8 * s + 7]);
    return __builtin_bit_cast(bf16x8, o);
}
__device__ __forceinline__ void dn_scan(Ctx& F, int sw) {
    const int lane = lane_id(), r = lane & 31, hh = lane >> 5;
    const int bh = sw >> 1, sl = sw & 1, b = bh >> 3, h = bh & 7;
    const float* CD = (const float*)(F.ws + WS_DNCD) + bh * 128;
    bf16* ODN = (bf16*)(F.ws + WS_ODN);
    f32x16 S0, S1;
#pragma unroll
    for (int i = 0; i < 16; ++i) { S0[i] = 0.f; S1[i] = 0.f; }
    for (int n = 0; n < 128; ++n) {
        const unsigned char* rec = F.ws + WS_DN + ((size_t)bh * 128 + n) * DN_REC;
        const unsigned char* fb = rec + r * 128 + hh * 16;
        bf16x8 w[2][4], qd[2][4], at[2][4], kt[2][4];
#pragma unroll
        for (int i = 0; i < 2; ++i)
#pragma unroll
            for (int ks = 0; ks < 4; ++ks) { const int o = i * 4096 + ks * 32;
                w[i][ks] = *(const bf16x8*)(fb + o); qd[i][ks] = *(const bf16x8*)(fb + 8192 + o); at[i][ks] = *(const bf16x8*)(fb + 16384 + o); kt[i][ks] = *(const bf16x8*)(fb + 24576 + o); }
        const unsigned* up = (const unsigned*)(rec + 32768) + (sl * 2) * 8 * 64 + lane;
        unsigned uw[2][8];
#pragma unroll
        for (int i = 0; i < 2; ++i)
#pragma unroll
            for (int gp = 0; gp < 8; ++gp) uw[i][gp] = up[(i * 8 + gp) * 64];
        const float cd = CD[n];
        bf16x8 sb[4]; sb[0] = pack8(S0, 0); sb[1] = pack8(S0, 1); sb[2] = pack8(S1, 0); sb[3] = pack8(S1, 1);
        f32x16 ws[2], qs[2];
#pragma unroll
        for (int i = 0; i < 2; ++i) {
#pragma unroll
            for (int g = 0; g < 16; ++g) { ws[i][g] = 0.f; qs[i][g] = 0.f; }
#pragma unroll
            for (int ks = 0; ks < 4; ++ks) { ws[i] = __builtin_amdgcn_mfma_f32_32x32x16_bf16(w[i][ks], sb[ks], ws[i], 0, 0, 0); qs[i] = __builtin_amdgcn_mfma_f32_32x32x16_bf16(qd[i][ks], sb[ks], qs[i], 0, 0, 0); }
        }
#pragma unroll
        for (int i = 0; i < 2; ++i)
#pragma unroll
            for (int gp = 0; gp < 8; ++gp) { ws[i][2 * gp] = bflo(uw[i][gp]) - ws[i][2 * gp]; ws[i][2 * gp + 1] = bfhi(uw[i][gp]) - ws[i][2 * gp + 1]; }
        bf16x8 vb[4]; vb[0] = pack8(ws[0], 0); vb[1] = pack8(ws[0], 1); vb[2] = pack8(ws[1], 0); vb[3] = pack8(ws[1], 1);
#pragma unroll
        for (int g = 0; g < 16; ++g) { S0[g] *= cd; S1[g] *= cd; }
#pragma unroll
        for (int ks = 0; ks < 4; ++ks) {
            qs[0] = __builtin_amdgcn_mfma_f32_32x32x16_bf16(at[0][ks], vb[ks], qs[0], 0, 0, 0);
            qs[1] = __builtin_amdgcn_mfma_f32_32x32x16_bf16(at[1][ks], vb[ks], qs[1], 0, 0, 0);
            S0 = __builtin_amdgcn_mfma_f32_32x32x16_bf16(kt[0][ks], vb[ks], S0, 0, 0, 0);
            S1 = __builtin_amdgcn_mfma_f32_32x32x16_bf16(kt[1][ks], vb[ks], S1, 0, 0, 0);
        }
        bf16* orow = ODN + ((size_t)b * T + 64 * n) * 512 + h * 64 + 32 * sl + r;
#pragma unroll
        for (int i = 0; i < 2; ++i)
#pragma unroll
            for (int g = 0; g < 16; ++g) { const int c = 32 * i + (g & 3) + 8 * (g >> 2) + 4 * hh; orow[(size_t)c * 512] = (bf16)f2bf(qs[i][g]); }
    }
}

constexpr int SC_SLOT = 4 * 9216 + 8192, SC_NPIECE = DN_REC / 16, SC_LANES = 6 * 64, SC_PPL = (SC_NPIECE + SC_LANES - 1) / SC_LANES;
static_assert(3 * SC_SLOT <= RING_BYTES, "scan ring fits the phase scratch");
__device__ __forceinline__ int sc_piece_off(int p) { return p < 2048 ? (p >> 9) * 9216 + ((p & 511) >> 3) * 144 + (p & 7) * 16 : 36864 + (p - 2048) * 16; }
__device__ __forceinline__ void dn_scan_block(Ctx& F, int bh) {
    const int lane = lane_id(), wave = F.wave;
    LAS unsigned char* ring = F.lds + RING_OFF;
    const unsigned char* recs = F.ws + WS_DN + (size_t)bh * 128 * DN_REC;
#define SC_BAR() asm volatile("s_waitcnt vmcnt(0) lgkmcnt(0)\n\ts_barrier" ::: "memory")
    if (wave >= 2) {
        const int ll = (wave - 2) * 64 + lane; v4u d[SC_PPL];
#pragma unroll 1
        for (int n0 = 0; n0 < 2; ++n0) {
#pragma unroll
            for (int j = 0; j < SC_PPL; ++j) { const int p = ll + j * SC_LANES; if (p < SC_NPIECE) d[j] = *(const v4u*)(recs + (size_t)n0 * DN_REC + p * 16); }
#pragma unroll
            for (int j = 0; j < SC_PPL; ++j) { const int p = ll + j * SC_LANES; if (p < SC_NPIECE) *(LAS v4u*)(ring + n0 * SC_SLOT + sc_piece_off(p)) = d[j]; }
        }
#pragma unroll
        for (int j = 0; j < SC_PPL; ++j) { const int p = ll + j * SC_LANES; if (p < SC_NPIECE) d[j] = *(const v4u*)(recs + (size_t)2 * DN_REC + p * 16); }
        asm volatile("s_waitcnt lgkmcnt(0)\n\ts_barrier" ::: "memory");
        int slot = 2;
#pragma unroll 1
        for (int n = 0; n < 128; ++n) {
            if (n + 2 < 128) {
#pragma unroll
                for (int j = 0; j < SC_PPL; ++j) { const int p = ll + j * SC_LANES; if (p < SC_NPIECE) *(LAS v4u*)(ring + slot * SC_SLOT + sc_piece_off(p)) = d[j]; }
            }
            if (n + 3 < 128) {
#pragma unroll
                for (int j = 0; j < SC_PPL; ++j) { const int p = ll + j * SC_LANES; if (p < SC_NPIECE) d[j] = *(const v4u*)(recs + (size_t)(n + 3) * DN_REC + p * 16); }
            }
            slot = (slot == 2) ? 0 : slot + 1;
            asm volatile("s_waitcnt lgkmcnt(0)\n\ts_barrier" ::: "memory");
            if (n + 3 < 128) asm volatile("s_waitcnt vmcnt(0)" ::: "memory");
        }
    } else {
        const int r = lane & 31, hh = lane >> 5, sl = wave, b = bh >> 3, h = bh & 7;
        const float* CD = (const float*)(F.ws + WS_DNCD) + bh * 128;
        bf16* ODN = (bf16*)(F.ws + WS_ODN);
        f32x16 S0, S1;
#pragma unroll
        for (int i = 0; i < 16; ++i) { S0[i] = 0.f; S1[i] = 0.f; }
        float cd = CD[0];
        asm volatile("s_waitcnt lgkmcnt(0)\n\ts_barrier" ::: "memory");
        int slot = 0;
#pragma unroll 1
        for (int n = 0; n < 128; ++n) {
            const LAS unsigned char* sb_ = ring + slot * SC_SLOT; const LAS unsigned char* fb = sb_ + r * 144 + hh * 16;
            const float cdn = CD[n + 1 < 128 ? n + 1 : n];
            bf16x8 w[2][4], qd[2][4];
#pragma unroll
            for (int i = 0; i < 2; ++i)
#pragma unroll
                for (int ks = 0; ks < 4; ++ks) { const int o = i * 32 * 144 + ks * 32; w[i][ks] = *(const LAS bf16x8*)(fb + o); qd[i][ks] = *(const LAS bf16x8*)(fb + 9216 + o); }
            bf16x8 sb[4]; sb[0] = pack8(S0, 0); sb[1] = pack8(S0, 1); sb[2] = pack8(S1, 0); sb[3] = pack8(S1, 1);
            f32x16 ws[2], qs[2];
#pragma unroll
            for (int i = 0; i < 2; ++i) {
#pragma unroll
                for (int g = 0; g < 16; ++g) { ws[i][g] = 0.f; qs[i][g] = 0.f; }
#pragma unroll
                for (int ks = 0; ks < 4; ++ks) { ws[i] = __builtin_amdgcn_mfma_f32_32x32x16_bf16(w[i][ks], sb[ks], ws[i], 0, 0, 0); qs[i] = __builtin_amdgcn_mfma_f32_32x32x16_bf16(qd[i][ks], sb[ks], qs[i], 0, 0, 0); }
            }
            bf16x8 at[2][4], kt[2][4];
#pragma unroll
            for (int i = 0; i < 2; ++i)
#pragma unroll
                for (int ks = 0; ks < 4; ++ks) { const int o = i * 32 * 144 + ks * 32; at[i][ks] = *(const LAS bf16x8*)(fb + 2 * 9216 + o); kt[i][ks] = *(const LAS bf16x8*)(fb + 3 * 9216 + o); }
            const LAS unsigned* up = (const LAS unsigned*)(sb_ + 36864) + (sl * 2) * 8 * 64 + lane;
#pragma unroll
            for (int i = 0; i < 2; ++i)
#pragma unroll
                for (int gp = 0; gp < 8; ++gp) { const unsigned uw = up[(i * 8 + gp) * 64]; ws[i][2 * gp] = bflo(uw) - ws[i][2 * gp]; ws[i][2 * gp + 1] = bfhi(uw) - ws[i][2 * gp + 1]; }
            bf16x8 vb[4]; vb[0] = pack8(ws[0], 0); vb[1] = pack8(ws[0], 1); vb[2] = pack8(ws[1], 0); vb[3] = pack8(ws[1], 1);
#pragma unroll
            for (int g = 0; g < 16; ++g) { S0[g] *= cd; S1[g] *= cd; }
#pragma unroll
            for (int ks = 0; ks < 4; ++ks) {
                S0 = __builtin_amdgcn_mfma_f32_32x32x16_bf16(kt[0][ks], vb[ks], S0, 0, 0, 0);
                S1 = __builtin_amdgcn_mfma_f32_32x32x16_bf16(kt[1][ks], vb[ks], S1, 0, 0, 0);
                qs[0] = __builtin_amdgcn_mfma_f32_32x32x16_bf16(at[0][ks], vb[ks], qs[0], 0, 0, 0);
                qs[1] = __builtin_amdgcn_mfma_f32_32x32x16_bf16(at[1][ks], vb[ks], qs[1], 0, 0, 0);
            }
            bf16* orow = ODN + ((size_t)b * T + 64 * n) * 512 + h * 64 + 32 * sl + r;
#pragma unroll
            for (int i = 0; i < 2; ++i)
#pragma unroll
                for (int g = 0; g < 16; ++g) { const int c = 32 * i + (g & 3) + 8 * (g >> 2) + 4 * hh; orow[(size_t)c * 512] = (bf16)f2bf(qs[i][g]); }
            cd = cdn; slot = (slot == 2) ? 0 : slot + 1;
            asm volatile("s_waitcnt lgkmcnt(0)\n\ts_barrier" ::: "memory");
        }
    }
    SC_BAR();
#undef SC_BAR
}

__device__ __forceinline__ void finalize_rows(Ctx& F) {
    const int gw = F.vcu * NWAVES + F.wave, NGW = F.G * NWAVES, lane = lane_id();
    const bf16* ODN = (const bf16*)(F.ws + WS_ODN); const bf16* Z = (const bf16*)(F.ws + WS_Z); const bf16* QO = (const bf16*)(F.ws + WS_QO);
    bf16* AA = (bf16*)(F.ws + WS_AA); bf16* ABB = (bf16*)(F.ws + WS_ABB);
    float s1 = 0.f, s2 = 0.f;
    { const float a = F.in[11][lane] * F.in[12][lane], bq = F.in[13][lane] * F.in[14][lane]; s1 = wave_sum(a); s2 = wave_sum(bq); }
    const float lam_init = 0.2f;
    const float lam = expf(s1) - expf(s2) + lam_init;
    float gdn[8], gsub[8];
#pragma unroll
    for (int e = 0; e < 8; ++e) { gdn[e] = F.in[10][(lane & 7) * 8 + e]; gsub[e] = F.in[15][(lane & 15) * 8 + e] * (1.0f - lam_init); }
    for (int m = gw; m < M; m += NGW) {
        { const v4u ov = *(const v4u*)(ODN + (size_t)m * 512 + lane * 8), zv = *(const v4u*)(Z + (size_t)m * 512 + lane * 8);
          float o[8], z[8]; float ss = 0.f;
#pragma unroll
          for (int e = 0; e < 4; ++e) { o[2 * e] = bflo(ov[e]); o[2 * e + 1] = bfhi(ov[e]); z[2 * e] = bflo(zv[e]); z[2 * e + 1] = bfhi(zv[e]); }
#pragma unroll
          for (int e = 0; e < 8; ++e) ss += o[e] * o[e];
          ss += __shfl_xor(ss, 1); ss += __shfl_xor(ss, 2); ss += __shfl_xor(ss, 4);
          const float rn = 1.0f / sqrtf(ss * (1.0f / 64.0f) + RMS_EPS);
          float y[8];
#pragma unroll
          for (int e = 0; e < 8; ++e) y[e] = o[e] * rn * gdn[e] * silu_acc(z[e]);
          v4u w; w.x = pk2(y[0], y[1]); w.y = pk2(y[2], y[3]); w.z = pk2(y[4], y[5]); w.w = pk2(y[6], y[7]);
          *(v4u*)(AA + (size_t)m * 512 + lane * 8) = w; }
        { const int hd = lane >> 4, e0 = (lane & 15) * 8;
          const v4u a1 = *(const v4u*)(QO + (size_t)m * 1024 + hd * 256 + e0), a2 = *(const v4u*)(QO + (size_t)m * 1024 + hd * 256 + 128 + e0);
          float o[8]; float ss = 0.f;
#pragma unroll
          for (int e = 0; e < 4; ++e) { o[2 * e] = bflo(a1[e]) - lam * bflo(a2[e]); o[2 * e + 1] = bfhi(a1[e]) - lam * bfhi(a2[e]); }
#pragma unroll
          for (int e = 0; e < 8; ++e) ss += o[e] * o[e];
          ss += __shfl_xor(ss, 1); ss += __shfl_xor(ss, 2); ss += __shfl_xor(ss, 4); ss += __shfl_xor(ss, 8);
          const float rn = 1.0f / sqrtf(ss * (1.0f / 128.0f) + SUBLN_EPS);
          float y[8];
#pragma unroll
          for (int e = 0; e < 8; ++e) y[e] = o[e] * rn * gsub[e];
          v4u w; w.x = pk2(y[0], y[1]); w.y = pk2(y[2], y[3]); w.z = pk2(y[4], y[5]); w.w = pk2(y[6], y[7]);
          *(v4u*)(ABB + (size_t)m * 512 + hd * 128 + e0) = w; }
    }
}
__device__ __forceinline__ void final_norm_rows(Ctx& F) {
    const int lane = lane_id();
    const int gw = F.vcu * NWAVES + F.wave, NGW = F.G * NWAVES;
    const f32x4* gp = (const f32x4*)F.in[23] + lane; f32x4 gg[4];
#pragma unroll
    for (int j = 0; j < 4; ++j) gg[j] = gp[64 * j];
    for (int m = gw; m < M; m += NGW) {
        f32x4* xr = (f32x4*)(F.out + (size_t)m * D) + lane; f32x4 v[4]; float s = 0.f;
#pragma unroll
        for (int j = 0; j < 4; ++j) { v[j] = xr[64 * j]; s += (v[j].x * v[j].x + v[j].y * v[j].y) + (v[j].z * v[j].z + v[j].w * v[j].w); }
        const float rn = 1.0f / sqrtf(wave_sum(s) * (1.0f / D) + RMS_EPS);
#pragma unroll
        for (int j = 0; j < 4; ++j) xr[64 * j] = v[j] * rn * gg[j];
    }
}

constexpr int N_PHASES = 14;
struct Args { const float* in[24]; float* out; unsigned char* ws; int ph_lo, ph_hi; };
__global__ void __launch_bounds__(NWAVES * 64, 2) mk_fwd(Args args) {
    extern __shared__ __attribute__((aligned(16))) unsigned char lds[];
    Ctx F;
    F.in = args.in;
    F.out = args.out; F.ws = args.ws;
    F.lds = (LAS unsigned char*)lds;
    F.wave = __builtin_amdgcn_readfirstlane((int)threadIdx.x >> 6);
    F.G = gridDim.x; { const int bx = blockIdx.x; F.vcu = (F.G % 8 == 0) ? (bx % 8) * (F.G / 8) + bx / 8 : bx; }
    const int lo = args.ph_lo, hi = args.ph_hi;
    { volatile LAS unsigned* misc = (volatile LAS unsigned*)(F.lds + MISC_OFF); if (F.wave == 0) misc[lane_id()] = 0u; }
    __syncthreads();
    XcdBarrier bar = xcd_barrier_post((unsigned*)(args.ws + WS_CTL) + CW_BAR, (volatile LAS unsigned*)(F.lds + MISC_OFF) + 8, F.wave);
    if (lo < -7) cg::this_grid().sync();
    unsigned char* ws = F.ws;
    typedef pg8::bf16_t pb;
#ifndef PH_MASK
#define PH_MASK 0x3fff
#endif
#define IN(k) (((PH_MASK >> (k)) & 1) && lo <= (k) && (k) < hi)
#ifndef PROBE_A
#define PROBE_A -1
#endif
#ifndef PROBE_B
#define PROBE_B -1
#endif
#define STAMP(k) do { if (PROBE_A >= 0 && blockIdx.x == 0 && F.wave == 0 && lane_id() == 0) ((volatile unsigned long long*)(args.ws + WS_CTL + 32768))[k] = __builtin_amdgcn_s_memrealtime(); } while (0)
#define SEAM(k) do { if (IN(k) && IN((k) + 1)) xcd_barrier(bar); STAMP((k) + 1); } while (0)

    STAMP(0);
    if (IN(0)) { p0_prologue(F); } SEAM(0);
    if (IN(1)) { pg8::Gemm g{(const pb*)(ws + WS_XB), (const pb*)(ws + WS_WGU1), M, 2 * FF, D}; pg8::StaticOrder S; S.init(M, 2 * FF, F.G, (int)blockIdx.x);
        pg8::EpiSwiGLU E{(pb*)(ws + WS_H), FF, (const float*)(ws + WS_SSQA), RMS_EPS};
        pg8::gemm_phase<pg8::EpiSwiGLU, pg8::StaticOrder, true, true>(F.lds + RING_OFF, g, S, E, F.wave); } SEAM(1);
    if (IN(2)) { pg8::Gemm g{(const pb*)(ws + WS_H), (const pb*)(ws + WS_WD1), M, D, FF}; pg8::StaticOrder S; S.init(M, D, F.G, (int)blockIdx.x);
        pg8::EpiResid E{F.in[0], F.out, (pb*)(ws + WS_XB), (float*)(ws + WS_SSQB), 0.5f};
        pg8::gemm_phase<pg8::EpiResid, pg8::StaticOrder, true, true>(F.lds + RING_OFF, g, S, E, F.wave); } SEAM(2);
    if (IN(3)) { pg8::Gemm g{(const pb*)(ws + WS_XB), (const pb*)(ws + WS_WIN), M, WIN_N, D}; pg8::StaticOrder S; S.init(M, WIN_N, F.G, (int)blockIdx.x);
        pg8::EpiWin E{(pb*)(ws + WS_PRE), (pb*)(ws + WS_Z), (pb*)(ws + WS_QO), (pb*)(ws + WS_KD), (pb*)(ws + WS_VD), (float*)(ws + WS_AB), (const float*)(ws + WS_SSQB), RMS_EPS, attn_body::C2};
        pg8::gemm_phase<pg8::EpiWin, pg8::StaticOrder, true, true>(F.lds + RING_OFF, g, S, E, F.wave); } SEAM(3);
    if (IN(4)) { LAS unsigned char* scr = F.lds + RING_OFF + F.wave * 18432; const int gw = F.vcu * NWAVES + F.wave, NGW = F.G * NWAVES;
        for (int ch = gw; ch < 2048; ch += NGW) dn_prep_chunk(F, ch, scr, hi); } SEAM(4);
    if (IN(5)) {
        if (blockIdx.x < 16) dn_scan_block(F, (int)blockIdx.x);
        const attn_body::AttnTensors AT{(const attn_body::bf16*)(ws + WS_QO), (const attn_body::bf16*)(ws + WS_KD), (const attn_body::bf16*)(ws + WS_VD), (attn_body::bf16*)(ws + WS_QO)};
        const attn_body::DynOrder S{(unsigned*)(ws + WS_CTL) + CW_ATTQ, (volatile LAS unsigned*)(F.lds + MISC_OFF) + 16, (int)(blockIdx.x & 7), F.wave};
        attn_body::attn_phase<attn_body::DynOrder>((char*)lds + RING_OFF, AT, S, F.wave); } SEAM(5);
    if (IN(7)) { finalize_rows(F); conv_ffn2(F); } SEAM(7);
    if (IN(8)) { pg8::StaticOrder S; S.init(M, D, F.G, (int)blockIdx.x);
        { pg8::Gemm g{(const pb*)(ws + WS_AA), (const pb*)(ws + WS_WA), M, D, 512}; pg8::EpiStoreBf16 E{(pb*)(ws + WS_YA), D};
          pg8::gemm_phase<pg8::EpiStoreBf16, pg8::StaticOrder, true, true>(F.lds + RING_OFF, g, S, E, F.wave); }
        { pg8::Gemm g{(const pb*)(ws + WS_ABB), (const pb*)(ws + WS_WB), M, D, 512}; pg8::EpiStoreBf16 E{(pb*)(ws + WS_YB), D};
          pg8::gemm_phase<pg8::EpiStoreBf16, pg8::StaticOrder, true, true>(F.lds + RING_OFF, g, S, E, F.wave); } } SEAM(8);
    if (IN(9)) { pg8::Gemm g{(const pb*)(ws + WS_XB), (const pb*)(ws + WS_WG), M, 2 * D, D}; pg8::StaticOrder S; S.init(M, 2 * D, F.G, (int)blockIdx.x);
        pg8::EpiGateMerge E{(const pb*)(ws + WS_YA), (const pb*)(ws + WS_YB), (pb*)(ws + WS_MG), (const float*)(ws + WS_SSQB), RMS_EPS};
        pg8::gemm_phase<pg8::EpiGateMerge, pg8::StaticOrder, true, true>(F.lds + RING_OFF, g, S, E, F.wave); } SEAM(9);
    if (IN(10)) { pg8::Gemm g{(const pb*)(ws + WS_MG), (const pb*)(ws + WS_WOUT), M, D, D}; pg8::StaticOrder S; S.init(M, D, F.G, (int)blockIdx.x);
        pg8::EpiResid E{F.out, F.out, (pb*)(ws + WS_XB), (float*)(ws + WS_SSQA), 1.0f};
        pg8::gemm_phase<pg8::EpiResid, pg8::StaticOrder, true, true>(F.lds + RING_OFF, g, S, E, F.wave); } SEAM(10);
    if (IN(11)) { pg8::Gemm g{(const pb*)(ws + WS_XB), (const pb*)(ws + WS_WGU2), M, 2 * FF, D}; pg8::StaticOrder S; S.init(M, 2 * FF, F.G, (int)blockIdx.x);
        pg8::EpiSwiGLU E{(pb*)(ws + WS_H), FF, (const float*)(ws + WS_SSQA), RMS_EPS};
        pg8::gemm_phase<pg8::EpiSwiGLU, pg8::StaticOrder, true, true>(F.lds + RING_OFF, g, S, E, F.wave); } SEAM(11);
    if (IN(12)) { pg8::Gemm g{(const pb*)(ws + WS_H), (const pb*)(ws + WS_WD2), M, D, FF}; pg8::StaticOrder S; S.init(M, D, F.G, (int)blockIdx.x);
        pg8::EpiResid E{F.out, F.out, (pb*)(ws + WS_XB), (float*)(ws + WS_SSQB), 0.5f};
        pg8::gemm_phase<pg8::EpiResid, pg8::StaticOrder, true, true>(F.lds + RING_OFF, g, S, E, F.wave); } SEAM(12);
    if (IN(13)) { final_norm_rows(F); } STAMP(14);
    if (PROBE_A >= 0) {
        xcd_barrier(bar);
        if (blockIdx.x == 0 && F.wave == 0) { volatile unsigned long long* ts = (volatile unsigned long long*)(args.ws + WS_CTL + 32768); const int l = lane_id();
            const float da = (float)(ts[PROBE_A + 1] - ts[PROBE_A]) * 0.01f, db = (float)(ts[PROBE_B + 1] - ts[PROBE_B]) * 0.01f;
            for (int i = l; i < 16384; i += 64) F.out[(size_t)i * 1024 + 512] = db;
            if (l == 0) F.out[0] = da; }
    }
#undef IN
#undef SEAM
}

#ifndef MK_N_LAUNCHES
#define MK_N_LAUNCHES 1
#endif
extern "C" void kernel_launch(void* const* d_in, const int* in_sizes, int n_in, void* d_out, int out_size, void* d_ws, size_t ws_size, hipStream_t stream) {
    static int grid = 0;
    if (grid == 0) {
        if (n_in != 24 || in_sizes[0] != M * D || out_size != M * D || ws_size < WS_END) { fprintf(stderr, "kernel_launch: unexpected shapes (n_in %d, in0 %d, out %d, ws %zu)\n", n_in, n_in > 0 ? in_sizes[0] : -1, out_size, ws_size); grid = -1; return; }
        int dev = 0, cus = 0, per_cu = 0;
        if (hipGetDevice(&dev) != hipSuccess || hipDeviceGetAttribute(&cus, hipDeviceAttributeMultiprocessorCount, dev) != hipSuccess) { grid = -1; return; }
        if (hipFuncSetAttribute((const void*)mk_fwd, hipFuncAttributeMaxDynamicSharedMemorySize, LDS_BYTES) != hipSuccess) { fprintf(stderr, "kernel_launch: hipFuncSetAttribute failed\n"); grid = -1; return; }
        if (hipOccupancyMaxActiveBlocksPerMultiprocessor(&per_cu, (const void*)mk_fwd, NWAVES * 64, LDS_BYTES) != hipSuccess || per_cu < 1) { fprintf(stderr, "kernel_launch: occupancy query says %d\n", per_cu); per_cu = 1; }
        (void)hipGetLastError();
        grid = cus;
    }
    if (grid < 0) return;
    if (hipMemsetAsync((char*)d_ws + WS_CTL, 0, CTL_ZERO_BYTES, stream) != hipSuccess) { fprintf(stderr, "kernel_launch: hipMemsetAsync failed\n"); return; }
    Args a{};
    for (int i = 0; i < 24; ++i) a.in[i] = (const float*)d_in[i];
    a.out = (float*)d_out; a.ws = (unsigned char*)d_ws;
#if MK_N_LAUNCHES == 1
    a.ph_lo = 0; a.ph_hi = N_PHASES;
    void* kargs[] = {&a};
    hipError_t e = hipLaunchCooperativeKernel((const void*)mk_fwd, dim3(grid), dim3(NWAVES * 64), kargs, LDS_BYTES, stream);
    if (e != hipSuccess) fprintf(stderr, "kernel_launch: cooperative launch failed: %s (grid %d)\n", hipGetErrorString(e), grid);
#else
    for (int p = 0; p < N_PHASES; ++p) { a.ph_lo = p; a.ph_hi = p + 1; hipLaunchKernelGGL(mk_fwd, dim3(grid), dim3(NWAVES * 64), LDS_BYTES, stream, a); }
#endif
}
```

```cpp
#include <hip/hip_runtime.h>
#include <hip/hip_cooperative_groups.h>
#include <cstdio>
#include <cstdint>
namespace cg = cooperative_groups;
__device__ __forceinline__ int lane_id() { int l = (int)__builtin_amdgcn_mbcnt_hi(~0u, __builtin_amdgcn_mbcnt_lo(~0u, 0u)); asm volatile("" : "+v"(l)); return l; }
namespace pg8 {
#define PG8_LAS __attribute__((address_space(3)))
typedef unsigned short bf16_t;
typedef short bf16x8 __attribute__((ext_vector_type(8)));
typedef float f32x4 __attribute__((ext_vector_type(4)));
typedef unsigned u32x4 __attribute__((ext_vector_type(4)));
constexpr int BM = 256, BK = 64, HALF = 128, HTB = HALF * BK * 2  , STAGE_BYTES = 8 * HTB, NXCD = 8, WGM = 8;

__host__ __device__ __forceinline__ int lds_byte(int r, int c) { const int st = (r >> 4) * 2 + (c >> 5), rr = r & 15, cc = c & 31, ob = rr * 64 + cc * 2; return st * 1024 + (ob ^ (((ob >> 9) & 1) << 5)); }
__host__ __device__ __forceinline__ void stage_rc(int b, int& R, int& C) { const int st = b / 1024, sb = b % 1024, swz = sb ^ (((sb >> 9) & 1) << 5); R = (st >> 1) * 16 + swz / 64; C = (st & 1) * 32 + (swz % 64) / 2; }
__host__ __device__ __forceinline__ int perm32(int rho) { const int n = rho >> 4, i = rho & 15; return 8 * (i >> 2) + 4 * n + (i & 3); }

struct Unit { int pm, pn; };
struct Gemm { const bf16_t* A; const bf16_t* Bt; int M, N, K; };

struct StaticOrder {
    int nM, nN, nwg, G, c;
    __host__ __device__ void init(int M, int N, int G_, int c_) { nM = M / BM; nN = N / BM; nwg = nM * nN; G = G_; c = c_; }
    __host__ __device__ bool next(int i, Unit& u) const {
        const long L = (long)i * G + c; if (L >= nwg) return false;
        int wgid = (int)L; { const int q = nwg / NXCD, r = nwg % NXCD, xcd = wgid % NXCD, off = wgid / NXCD; wgid = (xcd < r ? xcd * (q + 1) : r * (q + 1) + (xcd - r) * q) + off; }
        const int nig = WGM * nN, gid = wgid / nig, fm = gid * WGM, gsz = (nM - fm) < WGM ? (nM - fm) : WGM;
        u.pm = fm + ((wgid % nig) % gsz); u.pn = (wgid % nig) / gsz; return true;
    }
    __device__ __forceinline__ void a_ready(const Unit&) const {}
    __device__ __forceinline__ void done(const Unit&) const {}
};

__device__ __forceinline__ unsigned cvt_pk_bf16(float lo, float hi) { unsigned r; asm volatile("v_cvt_pk_bf16_f32 %0, %1, %2" : "=v"(r) : "v"(lo), "v"(hi)); return r; }
__device__ __forceinline__ float fast_sigmoid(float v) { return __builtin_amdgcn_rcpf(1.0f + __builtin_amdgcn_exp2f(-1.4426950408889634f * v)); }
__device__ __forceinline__ float fast_silu(float v) { return v * fast_sigmoid(v); }
__device__ __forceinline__ void load_rs(float (&rs)[2][4], const float* ssq, int row0, float eps) {
#pragma unroll
    for (int ai = 0; ai < 2; ++ai)
#pragma unroll
        for (int m = 0; m < 4; ++m) { const f32x4* p = (const f32x4*)(ssq + (size_t)(row0 + ai * HALF + m * 16) * 16); const f32x4 a = p[0], b = p[1], c = p[2], d = p[3];
            const float s = ((a[0] + a[1]) + (a[2] + a[3])) + ((b[0] + b[1]) + (b[2] + b[3])) + ((c[0] + c[1]) + (c[2] + c[3])) + ((d[0] + d[1]) + (d[2] + d[3]));
            rs[ai][m] = 1.0f / sqrtf(s * (1.0f / 1024.0f) + eps); }
}
struct EpiSwiGLU {
    static constexpr bool PERM = true, AFTER_DRAIN = false;
    bf16_t* H; int ldh; const float* ssq; float eps;
    __device__ __forceinline__ void operator()(const f32x4 (&acc)[2][2][4][2], const Unit& u, int wr, int wc, int fr, int fq) const {
        const int row0 = u.pm * BM + wr * 64 + fr, col0 = u.pn * HALF + wc * 32 + 8 * fq;
        float rs[2][4]; load_rs(rs, ssq, row0, eps);
#pragma unroll
        for (int ai = 0; ai < 2; ++ai)
#pragma unroll
            for (int m = 0; m < 4; ++m) { bf16_t* rowp = H + (size_t)(row0 + ai * HALF + m * 16) * ldh + col0; const float s = rs[ai][m];
                float h[8];
#pragma unroll
                for (int n = 0; n < 2; ++n)
#pragma unroll
                    for (int j = 0; j < 4; ++j) h[n * 4 + j] = fast_silu(acc[ai][0][m][n][j] * s) * (acc[ai][1][m][n][j] * s);
                u32x4 w; w.x = cvt_pk_bf16(h[0], h[1]); w.y = cvt_pk_bf16(h[2], h[3]); w.z = cvt_pk_bf16(h[4], h[5]); w.w = cvt_pk_bf16(h[6], h[7]);
                *(u32x4*)rowp = w; }
    }
};
struct EpiResid {
    static constexpr bool PERM = false, AFTER_DRAIN = false;
    const float* base; float* out; bf16_t* xb; float* ssq_out; float scale;
    __device__ __forceinline__ void operator()(const f32x4 (&acc)[2][2][4][2], const Unit& u, int wr, int wc, int fr, int fq) const {
        typedef unsigned u32x2v __attribute__((ext_vector_type(2)));
        const int row0 = u.pm * BM + wr * 64 + fr, col0 = u.pn * BM + wc * 32 + 4 * fq;
#pragma unroll
        for (int ai = 0; ai < 2; ++ai)
#pragma unroll
            for (int m = 0; m < 4; ++m) { const int row = row0 + ai * HALF + m * 16; const size_t off = (size_t)row * 1024 + col0; float ss = 0.f;
#pragma unroll
                for (int bj = 0; bj < 2; ++bj)
#pragma unroll
                    for (int n = 0; n < 2; ++n) { const f32x4 bs = *(const f32x4*)(base + off + bj * HALF + n * 16); const f32x4 o = bs + acc[ai][bj][m][n] * scale;
                        *(f32x4*)(out + off + bj * HALF + n * 16) = o; ss += (o[0] * o[0] + o[1] * o[1]) + (o[2] * o[2] + o[3] * o[3]);
                        u32x2v w; w.x = cvt_pk_bf16(o[0], o[1]); w.y = cvt_pk_bf16(o[2], o[3]); *(u32x2v*)(xb + off + bj * HALF + n * 16) = w; }
                ss += __shfl_xor(ss, 16); ss += __shfl_xor(ss, 32);
                if (fq == 0) ssq_out[(size_t)row * 16 + u.pn * 4 + wc] = ss; }
    }
};
struct EpiStoreBf16 {
    static constexpr bool PERM = true, AFTER_DRAIN = false;
    bf16_t* O; int ldc;
    __device__ __forceinline__ void operator()(const f32x4 (&acc)[2][2][4][2], const Unit& u, int wr, int wc, int fr, int fq) const {
        const int row0 = u.pm * BM + wr * 64 + fr, col0 = u.pn * BM + wc * 32 + 8 * fq;
#pragma unroll
        for (int ai = 0; ai < 2; ++ai)
#pragma unroll
            for (int m = 0; m < 4; ++m) { bf16_t* rowp = O + (size_t)(row0 + ai * HALF + m * 16) * ldc + col0;
#pragma unroll
                for (int bj = 0; bj < 2; ++bj) { const f32x4 v0 = acc[ai][bj][m][0], v1 = acc[ai][bj][m][1];
                    u32x4 w; w.x = cvt_pk_bf16(v0[0], v0[1]); w.y = cvt_pk_bf16(v0[2], v0[3]); w.z = cvt_pk_bf16(v1[0], v1[1]); w.w = cvt_pk_bf16(v1[2], v1[3]);
                    *(u32x4*)(rowp + bj * HALF) = w; } }
    }
};
struct EpiWin {
    static constexpr bool PERM = true, AFTER_DRAIN = false;
    bf16_t *PRE, *Z, *QO, *KD, *VD; float* AB; const float* ssq; float eps, qscale;
    __device__ __forceinline__ void operator()(const f32x4 (&acc)[2][2][4][2], const Unit& u, int wr, int wc, int fr, int fq) const {
        const int row0 = u.pm * BM + wr * 64 + fr, cl0 = wc * 32 + 8 * fq, pn = u.pn;
        float rs[2][4]; load_rs(rs, ssq, row0, eps);
        if (pn == 14) {
            if (wc == 0 && fq < 2) {
#pragma unroll
                for (int ai = 0; ai < 2; ++ai)
#pragma unroll
                    for (int m = 0; m < 4; ++m) { float* rowp = AB + (size_t)(row0 + ai * HALF + m * 16) * 16 + 8 * fq; const float s = rs[ai][m];
                        *(f32x4*)rowp = acc[ai][0][m][0] * s; *(f32x4*)(rowp + 4) = acc[ai][0][m][1] * s; }
            }
            return;
        }
        bf16_t* base; int ld, cb; float sc = 1.f; bool dup = false;
        if (pn < 6) { base = PRE; ld = 1536; cb = pn * 256; }
        else if (pn < 8) { base = Z; ld = 512; cb = (pn - 6) * 256; }
        else if (pn < 10) { base = QO; ld = 1024; cb = (pn - 8) * 256; sc = qscale; dup = true; }
        else if (pn < 12) { base = KD; ld = 512; cb = (pn - 10) * 256; }
        else { base = VD; ld = 512; cb = (pn - 12) * 256; }
#pragma unroll
        for (int ai = 0; ai < 2; ++ai)
#pragma unroll
            for (int m = 0; m < 4; ++m) { const float s = rs[ai][m] * sc; bf16_t* rowp = base + (size_t)(row0 + ai * HALF + m * 16) * ld;
#pragma unroll
                for (int bj = 0; bj < 2; ++bj) { const f32x4 v0 = acc[ai][bj][m][0] * s, v1 = acc[ai][bj][m][1] * s;
                    u32x4 w; w.x = cvt_pk_bf16(v0[0], v0[1]); w.y = cvt_pk_bf16(v0[2], v0[3]); w.z = cvt_pk_bf16(v1[0], v1[1]); w.w = cvt_pk_bf16(v1[2], v1[3]);
                    const int c = cb + bj * HALF + cl0;
                    if (dup) { const int qc = ((c >> 6) * 2) * 64 + (c & 63); *(u32x4*)(rowp + qc) = w; *(u32x4*)(rowp + qc + 64) = w; }
                    else *(u32x4*)(rowp + c) = w; } }
    }
};
struct EpiGateMerge {
    static constexpr bool PERM = true, AFTER_DRAIN = false;
    const bf16_t *YA, *YB; bf16_t* MG; const float* ssq; float eps;
    __device__ __forceinline__ void operator()(const f32x4 (&acc)[2][2][4][2], const Unit& u, int wr, int wc, int fr, int fq) const {
        const int row0 = u.pm * BM + wr * 64 + fr, col0 = u.pn * HALF + wc * 32 + 8 * fq;
        float rs[2][4]; load_rs(rs, ssq, row0, eps);
#pragma unroll
        for (int ai = 0; ai < 2; ++ai)
#pragma unroll
            for (int m = 0; m < 4; ++m) { const size_t off = (size_t)(row0 + ai * HALF + m * 16) * 1024 + col0; const float s = rs[ai][m];
                const u32x4 ya = *(const u32x4*)(YA + off), yb = *(const u32x4*)(YB + off);
                float o[8];
#pragma unroll
                for (int n = 0; n < 2; ++n)
#pragma unroll
                    for (int j = 0; j < 4; ++j) { const int e = n * 4 + j; const unsigned wa = ya[e >> 1], wb = yb[e >> 1];
                        const float fa = __uint_as_float((e & 1) ? (wa & 0xffff0000u) : (wa << 16)), fb = __uint_as_float((e & 1) ? (wb & 0xffff0000u) : (wb << 16));
                        o[e] = fast_sigmoid(acc[ai][0][m][n][j] * s) * fa + fast_sigmoid(acc[ai][1][m][n][j] * s) * fb; }
                u32x4 w; w.x = cvt_pk_bf16(o[0], o[1]); w.y = cvt_pk_bf16(o[2], o[3]); w.z = cvt_pk_bf16(o[4], o[5]); w.w = cvt_pk_bf16(o[6], o[7]);
                *(u32x4*)(MG + off) = w; }
    }
};

template <class Epi, class Sched, bool ALIGN_EPI = false, bool SP2 = false>
__device__ __forceinline__ void gemm_phase(PG8_LAS unsigned char* lds, const Gemm g, const Sched& S, const Epi& E, const int wave_id) {
    const int wid = wave_id, lane = lane_id(), tid = wid * 64 + lane, wr = wid >> 2, wc = wid & 3, fr = lane & 15, fq = lane >> 4;
    const int K = g.K, nt = K / BK;
    unsigned voffA[2], voffB[2];
#pragma unroll
    for (int i = 0; i < 2; ++i) { int R, C; stage_rc(tid * 16 + i * 8192, R, C); const int Rb = Epi::PERM ? ((R & ~31) + perm32(R & 31)) : R;
        voffA[i] = (unsigned)(R * K + C) * 2u; voffB[i] = (unsigned)(Rb * K + C) * 2u; }
    const size_t kstep = (size_t)(BK * 2);
    const size_t hstep = (size_t)HALF * K * 2;
    const size_t tstep = 2 * hstep;
    const unsigned ldsw = (unsigned)wid * 1024u;
    const int aoff = lds_byte(wr * 64 + fr, fq * 8), boff = lds_byte(wc * 32 + fr, fq * 8);
#define PG8_SA(b, h) (((b) * 2 + (h)) * HTB)
#define PG8_SB(b, h) ((4 + (b) * 2 + (h)) * HTB)
#define PG8_STAGE(bufoff, gbase, voff) do { _Pragma("unroll") for (int _i = 0; _i < 2; ++_i) \
        __builtin_amdgcn_global_load_lds((const unsigned*)((const char*)(gbase) + (voff)[_i]), (PG8_LAS unsigned*)(lds + (bufoff) + ldsw + _i * 8192), 16, 0, 0); } while (0)
#define PG8_LDA(dst, b, h) do { _Pragma("unroll") for (int m = 0; m < 4; ++m) _Pragma("unroll") for (int k = 0; k < 2; ++k) dst[m][k] = *(const PG8_LAS bf16x8*)(lds + PG8_SA(b, h) + aoff + m * 2048 + k * 1024); } while (0)
#define PG8_LDB(dst, b, h) do { _Pragma("unroll") for (int n = 0; n < 2; ++n) _Pragma("unroll") for (int k = 0; k < 2; ++k) dst[n][k] = *(const PG8_LAS bf16x8*)(lds + PG8_SB(b, h) + boff + n * 2048 + k * 1024); } while (0)
#define PG8_MMA(ai, bj, At, Bt) do { __builtin_amdgcn_s_setprio(1); _Pragma("unroll") for (int m = 0; m < 4; ++m) _Pragma("unroll") for (int n = 0; n < 2; ++n) _Pragma("unroll") for (int k = 0; k < 2; ++k) \
        acc[ai][bj][m][n] = __builtin_amdgcn_mfma_f32_16x16x32_bf16(Bt[n][k], At[m][k], acc[ai][bj][m][n], 0, 0, 0); __builtin_amdgcn_s_setprio(0); } while (0)
#define PG8_WAIT_V(n) asm volatile("s_waitcnt vmcnt(" #n ")" ::: "memory")
#define PG8_WAIT_L(n) asm volatile("s_waitcnt lgkmcnt(" #n ")" ::: "memory")
#define PG8_BAR __builtin_amdgcn_s_barrier()
#define PG8_SCHED __builtin_amdgcn_sched_barrier(0)
    Unit cur, nxt; int ui = 0;
    if (!S.next(0, cur)) return;
    f32x4 acc[2][2][4][2];
#pragma unroll
    for (int a = 0; a < 2; ++a)
#pragma unroll
        for (int b = 0; b < 2; ++b)
#pragma unroll
            for (int m = 0; m < 4; ++m)
#pragma unroll
                for (int n = 0; n < 2; ++n) acc[a][b][m][n] = (f32x4){0.f, 0.f, 0.f, 0.f};
    bf16x8 At[4][2], B0[2][2], B1[2][2];
    const char* cA = (const char*)g.A + (size_t)cur.pm * tstep; const char* cB = (const char*)g.Bt + (size_t)cur.pn * tstep;
    S.a_ready(cur);
    if constexpr (SP2) {
        PG8_STAGE(PG8_SB(0, 0), cB, voffB); PG8_STAGE(PG8_SB(0, 1), cB + hstep, voffB); PG8_STAGE(PG8_SA(0, 0), cA, voffA); PG8_STAGE(PG8_SA(0, 1), cA + hstep, voffA);
        if (wr == 1) PG8_BAR;
        PG8_WAIT_V(2); PG8_BAR;
        PG8_STAGE(PG8_SB(1, 0), cB + kstep, voffB); PG8_STAGE(PG8_SA(1, 0), cA + kstep, voffA); PG8_STAGE(PG8_SB(1, 1), cB + hstep + kstep, voffB);
        PG8_WAIT_V(6); PG8_BAR;
    } else {
        PG8_STAGE(PG8_SB(0, 0), cB, voffB); PG8_STAGE(PG8_SA(0, 0), cA, voffA); PG8_STAGE(PG8_SB(0, 1), cB + hstep, voffB); PG8_STAGE(PG8_SA(0, 1), cA + hstep, voffA);
        if (wr == 1) PG8_BAR;
        PG8_WAIT_V(4); PG8_BAR;
        PG8_STAGE(PG8_SB(1, 0), cB + kstep, voffB); PG8_STAGE(PG8_SA(1, 0), cA + kstep, voffA); PG8_STAGE(PG8_SB(1, 1), cB + hstep + kstep, voffB);
        PG8_WAIT_V(6); PG8_BAR;
    }
    for (;;) {
        const bool has_next = S.next(ui + 1, nxt);
        const char* nA = has_next ? (const char*)g.A + (size_t)nxt.pm * tstep : cA; const char* nB = has_next ? (const char*)g.Bt + (size_t)nxt.pn * tstep : cB;
        for (int t = 0; t < nt; t += 2) {
            const bool last = (t == nt - 2);
            const char* a1 = cA + (size_t)(t + 1) * kstep;
            const char* a2 = last ? nA : cA + (size_t)(t + 2) * kstep; const char* b2 = last ? nB : cB + (size_t)(t + 2) * kstep;
            const char* a3 = a2 + kstep; const char* b3 = b2 + kstep;
            if (last && has_next) S.a_ready(nxt);
            if constexpr (SP2) {
            PG8_LDB(B0, 0, 0); PG8_LDB(B1, 0, 1); PG8_SCHED; PG8_LDA(At, 0, 0); PG8_STAGE(PG8_SA(1, 1), a1 + hstep, voffA);
            PG8_WAIT_V(8); PG8_WAIT_L(0); PG8_BAR; PG8_MMA(0, 0, At, B0); PG8_MMA(0, 1, At, B1); PG8_BAR; PG8_SCHED;
            PG8_LDA(At, 0, 1); PG8_STAGE(PG8_SB(0, 0), b2, voffB); PG8_STAGE(PG8_SB(0, 1), b2 + hstep, voffB); PG8_STAGE(PG8_SA(0, 0), a2, voffA);
            PG8_WAIT_V(8); PG8_WAIT_L(0); PG8_BAR; PG8_MMA(1, 0, At, B0); PG8_MMA(1, 1, At, B1); PG8_BAR; PG8_SCHED;
            PG8_LDB(B0, 1, 0); PG8_LDB(B1, 1, 1); PG8_SCHED; PG8_LDA(At, 1, 0); PG8_STAGE(PG8_SA(0, 1), a2 + hstep, voffA);
            PG8_WAIT_V(8); PG8_WAIT_L(0); PG8_BAR; PG8_MMA(0, 0, At, B0); PG8_MMA(0, 1, At, B1); PG8_BAR; PG8_SCHED;
            PG8_LDA(At, 1, 1); PG8_STAGE(PG8_SB(1, 0), b3, voffB); PG8_STAGE(PG8_SB(1, 1), b3 + hstep, voffB); PG8_STAGE(PG8_SA(1, 0), a3, voffA);
            PG8_WAIT_V(8); PG8_WAIT_L(0); PG8_BAR; PG8_MMA(1, 0, At, B0); PG8_MMA(1, 1, At, B1); PG8_BAR; PG8_SCHED;
            } else {
            PG8_LDB(B0, 0, 0); PG8_SCHED; PG8_LDA(At, 0, 0); PG8_STAGE(PG8_SA(1, 1), a1 + hstep, voffA);
            PG8_WAIT_L(8); PG8_BAR; PG8_WAIT_L(0); PG8_MMA(0, 0, At, B0); PG8_BAR; PG8_SCHED;
            PG8_LDB(B1, 0, 1); PG8_STAGE(PG8_SB(0, 0), b2, voffB);
            PG8_BAR; PG8_WAIT_L(0); PG8_MMA(0, 1, At, B1); PG8_BAR;
            PG8_LDA(At, 0, 1); PG8_STAGE(PG8_SA(0, 0), a2, voffA);
            PG8_BAR; PG8_WAIT_L(0); PG8_MMA(1, 0, At, B0); PG8_BAR; PG8_SCHED;
            PG8_STAGE(PG8_SB(0, 1), b2 + hstep, voffB);
            PG8_WAIT_V(6); PG8_BAR; PG8_MMA(1, 1, At, B1); PG8_BAR;
            PG8_LDB(B0, 1, 0); PG8_SCHED; PG8_LDA(At, 1, 0); PG8_STAGE(PG8_SA(0, 1), a2 + hstep, voffA);
            PG8_WAIT_L(8); PG8_BAR; PG8_WAIT_L(0); PG8_MMA(0, 0, At, B0); PG8_BAR; PG8_SCHED;
            PG8_LDB(B1, 1, 1); PG8_STAGE(PG8_SB(1, 0), b3, voffB);
            PG8_BAR; PG8_WAIT_L(0); PG8_MMA(0, 1, At, B1); PG8_BAR;
            PG8_LDA(At, 1, 1); PG8_STAGE(PG8_SA(1, 0), a3, voffA);
            PG8_BAR; PG8_WAIT_L(0); PG8_MMA(1, 0, At, B0); PG8_BAR; PG8_SCHED;
            PG8_STAGE(PG8_SB(1, 1), b3 + hstep, voffB);
            PG8_WAIT_V(6); PG8_BAR; PG8_MMA(1, 1, At, B1); PG8_BAR;
            }
        }
        if constexpr (ALIGN_EPI) { if (wr == 0) PG8_BAR; }
        if constexpr (!Epi::AFTER_DRAIN) { E(acc, cur, wr, wc, fr, fq); S.done(cur); }
        if (!has_next) break;
#pragma unroll
        for (int a = 0; a < 2; ++a)
#pragma unroll
            for (int b = 0; b < 2; ++b)
#pragma unroll
                for (int m = 0; m < 4; ++m)
#pragma unroll
                    for (int n = 0; n < 2; ++n) acc[a][b][m][n] = (f32x4){0.f, 0.f, 0.f, 0.f};
        cur = nxt; cA = nA; cB = nB; ++ui;
        if constexpr (ALIGN_EPI) { if (wr == 1) PG8_BAR; }
    }
    PG8_WAIT_V(0);
    if constexpr (!ALIGN_EPI) { if (wr == 0) PG8_BAR; }
    PG8_BAR;
    if constexpr (Epi::AFTER_DRAIN) { E.fused(acc, cur, wr, wc, fr, fq, lds, wid, lane); S.done(cur); }
#undef PG8_SA
#undef PG8_SB
#undef PG8_STAGE
#undef PG8_LDA
#undef PG8_LDB
#undef PG8_MMA
#undef PG8_WAIT_V
#undef PG8_WAIT_L
#undef PG8_BAR
#undef PG8_SCHED
}
}
#include <hip/hip_bf16.h>
#include <cmath>
namespace attn_body {
using bf16=__hip_bfloat16;
using bf16x8=__attribute__((ext_vector_type(8)))short;
using s16x4=__attribute__((ext_vector_type(4)))short;
using f32x16=__attribute__((ext_vector_type(16)))float;
using u32x4=__attribute__((ext_vector_type(4)))unsigned;
constexpr int BATCH=2,NHEAD=16,SEQ=8192,D=64,DM=NHEAD*D,KP=512;
constexpr int NW=8,QBLK=32,QB=QBLK*NW,KVBLK=64,NQB=SEQ/QB;
constexpr int ATTN_PITCH=DM, ATTN_UNIT_ROWS=QB;
__device__ __forceinline__ int crow(int r,int hi){return (r&3)+8*(r>>2)+4*hi;}
#define SBAR() __builtin_amdgcn_sched_barrier(0)
__device__ __forceinline__ void cmask(f32x16&p0,f32x16&p1,int jb,int qrel,int hi){
  const float NEG=-INFINITY; int lim=qrel-64*jb-4*hi; asm volatile("":"+v"(lim));
  #pragma unroll
  for(int r=0;r<16;++r){const int cr=(r&3)+8*(r>>2); if(cr>lim)p0[r]=NEG; if(cr+32>lim)p1[r]=NEG;}
}

constexpr int NSLOT=3, SLOTB=8192;
constexpr int LDS_K=0, LDS_V=NSLOT*SLOTB, LDS_WS=2*NSLOT*SLOTB, LDS_OST=LDS_WS+NW*64*4, LDS_BYTES=LDS_OST+NW*4096;
constexpr float C2=0.125f*1.4426950408889634f;
__device__ __forceinline__ void glds16(const void*gsrc,unsigned lds_dst){unsigned keep;
  asm volatile("s_mov_b32 %0, m0\n\ts_mov_b32 m0, %2\n\ts_nop 0\n\tglobal_load_lds_dwordx4 %1, off\n\ts_mov_b32 m0, %0":"=&s"(keep):"v"(gsrc),"s"(lds_dst):"memory");}
__device__ __forceinline__ float max3f(float a,float b,float c){float r;asm("v_max3_f32 %0, %1, %2, %3":"=v"(r):"v"(a),"v"(b),"v"(c));return r;}
__device__ __forceinline__ float max2f(float a,float b){float r;asm("v_max_f32_e32 %0, %1, %2":"=v"(r):"v"(a),"v"(b));return r;}
__device__ __forceinline__ float fadd_s(float a,float b){float r;asm("v_add_f32_e32 %0, %1, %2":"=v"(r):"v"(a),"v"(b));return r;}
__device__ __forceinline__ float fsub_s(float a,float b){float r;asm("v_sub_f32_e32 %0, %1, %2":"=v"(r):"v"(a),"v"(b));return r;}
typedef float f32x2_t __attribute__((ext_vector_type(2))); typedef __bf16 bf16x2_t __attribute__((ext_vector_type(2)));
__device__ __forceinline__ unsigned cvtpk_s(float lo,float hi){f32x2_t v={lo,hi};bf16x2_t b=__builtin_convertvector(v,bf16x2_t);return __builtin_bit_cast(unsigned,b);}
#define WAIT_BAR(N) asm volatile("s_waitcnt vmcnt(" #N ") lgkmcnt(0)\n\ts_barrier":::"memory")

__device__ __forceinline__ void qkt(f32x16&p0,f32x16&p1,const char*Kslot,const bf16x8*qr,const f32x16&negm,int r32,int hi){
  const char*kb=Kslot+hi*1024+r32*16;
  #pragma unroll
  for(int d0=0;d0<4;++d0){
    const bf16x8 b0=*reinterpret_cast<const bf16x8*>(kb+d0*2048);
    const bf16x8 b1=*reinterpret_cast<const bf16x8*>(kb+d0*2048+512);
    if(d0==0){p0=__builtin_amdgcn_mfma_f32_32x32x16_bf16(b0,qr[0],negm,0,0,0);p1=__builtin_amdgcn_mfma_f32_32x32x16_bf16(b1,qr[0],negm,0,0,0);}
    else{p0=__builtin_amdgcn_mfma_f32_32x32x16_bf16(b0,qr[d0],p0,0,0,0);p1=__builtin_amdgcn_mfma_f32_32x32x16_bf16(b1,qr[d0],p1,0,0,0);}}
}
typedef __attribute__((address_space(3))) const char* lds_cptr;
typedef short v4i16_t __attribute__((ext_vector_type(4)));
__device__ __forceinline__ void kload8(bf16x8*kf,lds_cptr kp){
  kf[0]=*(const __attribute__((address_space(3))) bf16x8*)(kp);      kf[1]=*(const __attribute__((address_space(3))) bf16x8*)(kp+512);
  kf[2]=*(const __attribute__((address_space(3))) bf16x8*)(kp+2048); kf[3]=*(const __attribute__((address_space(3))) bf16x8*)(kp+2560);
  kf[4]=*(const __attribute__((address_space(3))) bf16x8*)(kp+4096); kf[5]=*(const __attribute__((address_space(3))) bf16x8*)(kp+4608);
  kf[6]=*(const __attribute__((address_space(3))) bf16x8*)(kp+6144); kf[7]=*(const __attribute__((address_space(3))) bf16x8*)(kp+6656);
}
__device__ __forceinline__ void kload2(bf16x8*kf,lds_cptr kp,int j){ kf[2*j]=*(const __attribute__((address_space(3))) bf16x8*)(kp+j*2048); kf[2*j+1]=*(const __attribute__((address_space(3))) bf16x8*)(kp+j*2048+512); }
__device__ __forceinline__ s16x4 vtr(lds_cptr p){ return __builtin_bit_cast(s16x4,__builtin_amdgcn_ds_read_tr16_b64_v4i16((__attribute__((address_space(3))) v4i16_t*)p)); }
__device__ __forceinline__ float rowmax(const f32x16&p0,const f32x16&p1){
  float a=max3f(p0[0],p0[1],p1[0]),b=max3f(p0[2],p0[3],p1[1]);a=max3f(a,p1[2],p1[3]);
  #pragma unroll
  for(int r=4;r<16;r+=4){a=max3f(a,p0[r],p0[r+1]);b=max3f(b,p0[r+2],p0[r+3]);a=max3f(a,p1[r],p1[r+1]);b=max3f(b,p1[r+2],p1[r+3]);}
  const float m=max2f(a,b);
  auto rr=__builtin_amdgcn_permlane32_swap(__float_as_uint(m),__float_as_uint(m),false,false);
  return max2f(__uint_as_float(rr[0]),__uint_as_float(rr[1]));
}
__device__ __forceinline__ void pv(f32x16*o,int vb,bf16x8 pa0,bf16x8 pa1,bf16x8 pa2,bf16x8 pa3){
  #pragma unroll
  for(int d0=0;d0<2;++d0){s16x4 lo[4],hi[4];
    #pragma unroll
    for(int ks=0;ks<4;++ks){
      asm volatile("ds_read_b64_tr_b16 %0,%1 offset:%c2":"=&v"(lo[ks]):"v"(vb),"i"(d0*4096+ks*1024):"memory");
      asm volatile("ds_read_b64_tr_b16 %0,%1 offset:%c2":"=&v"(hi[ks]):"v"(vb),"i"(d0*4096+ks*1024+512):"memory");}
    asm volatile("s_waitcnt lgkmcnt(0)":::"memory");SBAR();
    #define PK(k) (bf16x8){lo[k][0],lo[k][1],lo[k][2],lo[k][3],hi[k][0],hi[k][1],hi[k][2],hi[k][3]}
    o[d0]=__builtin_amdgcn_mfma_f32_32x32x16_bf16(pa0,PK(0),o[d0],0,0,0);
    o[d0]=__builtin_amdgcn_mfma_f32_32x32x16_bf16(pa1,PK(1),o[d0],0,0,0);
    o[d0]=__builtin_amdgcn_mfma_f32_32x32x16_bf16(pa2,PK(2),o[d0],0,0,0);
    o[d0]=__builtin_amdgcn_mfma_f32_32x32x16_bf16(pa3,PK(3),o[d0],0,0,0);
    #undef PK
  }
}

#ifndef ATTN_STORE16
#define ATTN_STORE16(p,v) (*(u32x4*)(p)=(v))
#endif
template<int THRL> __device__ __forceinline__ void attn_unit(int b,int h,int qb,const bf16*Q,const bf16*__restrict__ K,const bf16*__restrict__ V,bf16*O,char*shm,const int wave_id,const unsigned*nmax){
  const int wid=wave_id,lane=lane_id(),tid=wid*64+lane,r32=lane&31,hi=lane>>5;
  const long rowbase=(long)b*SEQ; const int q0=qb*QB;
  const bf16*Qw=Q+(rowbase+q0+wid*QBLK)*DM+h*D;
  int t0=0;
  { const int j=b*8+(h>>1); const float q2=__uint_as_float(__builtin_amdgcn_readfirstlane((int)nmax[j])), k2=__uint_as_float(__builtin_amdgcn_readfirstlane((int)nmax[16+j]));
    const unsigned slb0_=0x3eb8aa3bu-((unsigned)__builtin_amdgcn_readfirstlane(h>>2)<<24);
    const float B2=2.0f*sqrtf(q2*k2)*1.0001f+34.7f, dmin=B2/__uint_as_float(slb0_);
    const float tf=floorf(((float)(q0+1)-dmin)*(1.0f/64.0f)); int tt=(tf>0.f)?(int)tf:0; tt&=~1; const int tmax=(q0+QB)/KVBLK-4; t0=tt<tmax?tt:tmax; t0=__builtin_amdgcn_readfirstlane(t0); }
  const bf16*Kh=K+(rowbase+(long)t0*KVBLK)*KP+(h>>1)*D,*Vh=V+(rowbase+(long)t0*KVBLK)*KP+(h>>2)*128+(h&1)*D;
  const unsigned lds0=(unsigned)(uintptr_t)shm;
  float*wsf=(float*)(shm+LDS_WS)+wid*64;
  const bf16*ksrc=Kh+(long)lane*KP+wid*8;
  const bf16*vsrc=Vh+(long)(16*(wid&3)+(lane>>2))*KP+(wid>>2)*32+(lane&3)*8;
  const unsigned kdst=lds0+LDS_K+wid*1024, vdst=lds0+LDS_V+wid*1024;
  #define DMA_K(t,slot) glds16(ksrc+(long)(t)*KVBLK*KP,(unsigned)__builtin_amdgcn_readfirstlane(kdst+(slot)))
  #define DMA_V(t,slot) glds16(vsrc+(long)(t)*KVBLK*KP,(unsigned)__builtin_amdgcn_readfirstlane(vdst+(slot)))
  const int vb0=(int)(lds0+LDS_V)+((lane>>4)&1)*32+(lane&3)*8+(4*hi+((lane&15)>>2))*64;
  const char*Kbase=shm+LDS_K; bf16x8 kf[8];
  const lds_cptr shm3=(lds_cptr)shm; const lds_cptr kp0=shm3+LDS_K+hi*1024+r32*16; const lds_cptr vp0=shm3+LDS_V+((lane>>4)&1)*32+(lane&3)*8+(4*hi+((lane&15)>>2))*64;
  const int NT=(q0+QB)/KVBLK-t0;
  DMA_K(0,0);DMA_V(0,0);DMA_K(1,SLOTB);
  bf16x8 qr[4];
  #pragma unroll
  for(int d0=0;d0<4;++d0)qr[d0]=*reinterpret_cast<const bf16x8*>(&Qw[(long)r32*DM+d0*16+hi*8]);
  float mhat=0.f,l_reg=0.f;f32x16 o[2];o[0]=f32x16{};o[1]=f32x16{};const f32x16 negm=f32x16{};
  const int qrel=wid*QBLK+r32;
  const unsigned slb_=0x3eb8aa3bu-((unsigned)__builtin_amdgcn_readfirstlane(h>>2)<<24); const float sl2=__uint_as_float(slb_);
  const float qposf=(float)(q0+qrel-4*hi-64*t0);
  const float s1_=sl2, s8_=__uint_as_float(slb_+(3u<<23)), s32_=__uint_as_float(slb_+(5u<<23));
  #define AADD(d,a,sv) asm volatile("v_add_f32_e32 %0, %1, %2":"=v"(d):"s"(sv),"v"(a))
  #define ALIBI(P0,P1,t) do{ float bq_=__builtin_fmaf(sl2,((float)(64*(t))-qposf),-mhat); \
    _Pragma("unroll") for(int q_=0;q_<4;++q_){ float b0_=bq_,b1_,b2_,b3_,c_; AADD(b1_,b0_,s1_); AADD(b2_,b1_,s1_); AADD(b3_,b2_,s1_); \
      P0[4*q_]+=b0_; P0[4*q_+1]+=b1_; P0[4*q_+2]+=b2_; P0[4*q_+3]+=b3_; \
      AADD(c_,b0_,s32_); P1[4*q_]+=c_; AADD(c_,b1_,s32_); P1[4*q_+1]+=c_; AADD(c_,b2_,s32_); P1[4*q_+2]+=c_; AADD(c_,b3_,s32_); P1[4*q_+3]+=c_; \
      if(q_<3){ AADD(bq_,b0_,s8_); } } }while(0)
  #define CMASK(P0,P1,t) do{int jb_=(t)-(NT-4); if(jb_>=0)cmask(P0,P1,jb_,qrel,hi);}while(0)
  bool resc=false;
  #define START(P0,P1) do{ const float rm=rowmax(P0,P1); resc=false; \
    { const float dl=rm; mhat=fadd_s(mhat,dl); \
      _Pragma("unroll") for(int r=0;r<16;++r){P0[r]=fsub_s(P0[r],dl);P1[r]=fsub_s(P1[r],dl);} \
      } \
    _Pragma("unroll") for(int r=0;r<16;++r)P0[r]=__builtin_amdgcn_exp2f(P0[r]); }while(0)
  #define RESC() do{ if(resc){ asm volatile("s_waitcnt lgkmcnt(0)":::"memory"); \
      _Pragma("unroll") for(int d_=0;d_<2;++d_) _Pragma("unroll") for(int r=0;r<16;++r)o[d_][r]*=wsf[crow(r,hi)]; } }while(0)
  f32x16 pA0,pA1,pB0,pB1;
  int sl_prev=0,sl_cur=0,sl_next=SLOTB;
  #define ROT() do{sl_prev=sl_cur;sl_cur=sl_next;sl_next=(sl_next==(NSLOT-1)*SLOTB)?0:sl_next+SLOTB;}while(0)
  DMA_K(2,2*SLOTB);
  WAIT_BAR(3);
  qkt(pA0,pA1,Kbase,qr,negm,r32,hi);asm volatile("s_nop 15\n\ts_nop 7":"+v"(pA0),"+v"(pA1));ALIBI(pA0,pA1,0);CMASK(pA0,pA1,0);
  START(pA0,pA1);
  _Pragma("unroll") for(int r=0;r<16;++r)pA1[r]=__builtin_amdgcn_exp2f(pA1[r]);
  WAIT_BAR(0);
  DMA_K(3,0);DMA_V(1,SLOTB);
  ROT();
  kload8(kf,kp0+sl_cur);
  WAIT_BAR(2);
  s16x4 vlo[8],vhi[8]; u32x4 pw0,pw1,pw2,pw3;
  #define PKW(P,B) cvtpk_s(P[B],P[B+1])
  #define PAF(k) __builtin_bit_cast(bf16x8,pw##k)
  #define VFR(i) (bf16x8){vlo[i][0],vlo[i][1],vlo[i][2],vlo[i][3],vhi[i][0],vhi[i][1],vhi[i][2],vhi[i][3]}
  #define PIN(x) asm volatile("":"+v"(x))
  #define MX3(a,b,c) __builtin_fmaxf(__builtin_fmaxf((a),(b)),(c))
  #define GAPA(MF,A0,A1,A2,A3,W0,W1,PW) do{ MF; sacc+=A0; sacc+=A1; sacc+=A2; sacc+=A3; PIN(sacc); W0; W1; PIN(PW); SBAR(); }while(0)
  #define EX(v) __builtin_amdgcn_exp2f(v)
  #define GAPB(MF,X,B) do{ MF; X[B]=EX(X[B]); X[B+1]=EX(X[B+1]); X[B+2]=EX(X[B+2]); X[B+3]=EX(X[B+3]); PIN(X); SBAR(); }while(0)
  #define VRD(i) do{ vlo[i]=vtr(vp_+(((i)>>2)*4096+((i)&3)*1024)); vhi[i]=vtr(vp_+(((i)>>2)*4096+((i)&3)*1024+512)); }while(0)
  #define KRD(G,j) do{ if(G){ kload2(kf,kp0+sl_next,j); SBAR(); } }while(0)
  #define STEP(C0,C1,P0,P1,t,GK,GV,GL) do{ SBAR(); \
    const lds_cptr vp_=vp0+sl_prev; \
    VRD(0); SBAR(); float sacc=(P0[0]+P0[1]); \
    GAPA(C0=__builtin_amdgcn_mfma_f32_32x32x16_bf16(kf[0],qr[0],negm,0,0,0), P0[2],P0[3],P0[4],P0[5],     pw0[0]=PKW(P0,0), pw0[1]=PKW(P0,2), pw0); \
    VRD(4); SBAR(); GAPA(C1=__builtin_amdgcn_mfma_f32_32x32x16_bf16(kf[1],qr[0],negm,0,0,0), P0[6],P0[7],P0[8],P0[9],     pw0[2]=PKW(P0,4), pw0[3]=PKW(P0,6), pw0); \
    VRD(1); SBAR(); GAPA(C0=__builtin_amdgcn_mfma_f32_32x32x16_bf16(kf[2],qr[1],C0,0,0,0),   P0[10],P0[11],P0[12],P0[13], pw1[0]=PKW(P0,8), pw1[1]=PKW(P0,10), pw1); \
    VRD(5); SBAR(); GAPA(C1=__builtin_amdgcn_mfma_f32_32x32x16_bf16(kf[3],qr[1],C1,0,0,0),   P0[14],P0[15],P1[0],P1[1],   pw1[2]=PKW(P0,12),pw1[3]=PKW(P0,14), pw1); \
    VRD(2); SBAR(); GAPA(C0=__builtin_amdgcn_mfma_f32_32x32x16_bf16(kf[4],qr[2],C0,0,0,0),   P1[2],P1[3],P1[4],P1[5],     pw2[0]=PKW(P1,0), pw2[1]=PKW(P1,2), pw2); \
    VRD(6); SBAR(); GAPA(C1=__builtin_amdgcn_mfma_f32_32x32x16_bf16(kf[5],qr[2],C1,0,0,0),   P1[6],P1[7],P1[8],P1[9],     pw2[2]=PKW(P1,4), pw2[3]=PKW(P1,6), pw2); \
    VRD(3); SBAR(); GAPA(C0=__builtin_amdgcn_mfma_f32_32x32x16_bf16(kf[6],qr[3],C0,0,0,0),   P1[10],P1[11],P1[12],P1[13], pw3[0]=PKW(P1,8), pw3[1]=PKW(P1,10), pw3); \
    VRD(7); SBAR(); GAPA(C1=__builtin_amdgcn_mfma_f32_32x32x16_bf16(kf[7],qr[3],C1,0,0,0),   P1[14],P1[15],0.f,0.f,       pw3[2]=PKW(P1,12),pw3[3]=PKW(P1,14), pw3); \
    l_reg+=sacc; \
    if(GK){DMA_K((t)+3,sl_cur);} if(GV){DMA_V((t)+1,sl_next);} \
    ALIBI(C0,C1,t); CMASK(C0,C1,t); \
    { float a=MX3(C0[0],C0[1],C1[0]),b=MX3(C0[2],C0[3],C1[1]); a=MX3(a,C1[2],C1[3]); \
      _Pragma("unroll") for(int r=4;r<16;r+=4){a=MX3(a,C0[r],C0[r+1]);b=MX3(b,C0[r+2],C0[r+3]);a=MX3(a,C1[r],C1[r+1]);b=MX3(b,C1[r+2],C1[r+3]);} \
      float rm=__builtin_fmaxf(a,b); { auto rr=__builtin_amdgcn_permlane32_swap(__float_as_uint(rm),__float_as_uint(rm),false,false); rm=__builtin_fmaxf(__uint_as_float(rr[0]),__uint_as_float(rr[1])); } \
      resc=false; \
      if(__builtin_expect(__any(rm>(float)THRL),0)){ const float dl=__builtin_fmaxf(rm,0.f); mhat+=dl; \
        _Pragma("unroll") for(int r=0;r<16;++r){C0[r]-=dl;C1[r]-=dl;} \
        const float f=__builtin_amdgcn_exp2f(-dl); l_reg*=f; if(hi==0)wsf[r32]=f; resc=true; } } \
    SBAR(); \
    GAPB(o[0]=__builtin_amdgcn_mfma_f32_32x32x16_bf16(PAF(0),VFR(0),o[0],0,0,0), C0,0); \
    GAPB(o[1]=__builtin_amdgcn_mfma_f32_32x32x16_bf16(PAF(0),VFR(4),o[1],0,0,0), C0,4); \
    KRD(GL,0); GAPB(o[0]=__builtin_amdgcn_mfma_f32_32x32x16_bf16(PAF(1),VFR(1),o[0],0,0,0), C0,8); \
    KRD(GL,1); GAPB(o[1]=__builtin_amdgcn_mfma_f32_32x32x16_bf16(PAF(1),VFR(5),o[1],0,0,0), C0,12); \
    KRD(GL,2); GAPB(o[0]=__builtin_amdgcn_mfma_f32_32x32x16_bf16(PAF(2),VFR(2),o[0],0,0,0), C1,0); \
    KRD(GL,3); GAPB(o[1]=__builtin_amdgcn_mfma_f32_32x32x16_bf16(PAF(2),VFR(6),o[1],0,0,0), C1,4); \
    GAPB(o[0]=__builtin_amdgcn_mfma_f32_32x32x16_bf16(PAF(3),VFR(3),o[0],0,0,0), C1,8); \
    GAPB(o[1]=__builtin_amdgcn_mfma_f32_32x32x16_bf16(PAF(3),VFR(7),o[1],0,0,0), C1,12); \
    }while(0)
  int t=1;
  #undef CMASK
  #define CMASK(P0,P1,t) do{}while(0)
  for(;t+5<NT;t+=2){
    STEP(pB0,pB1,pA0,pA1,t,true,true,true);     WAIT_BAR(2); RESC(); ROT();
    STEP(pA0,pA1,pB0,pB1,t+1,true,true,true);   WAIT_BAR(2); RESC(); ROT();
  }
  #undef CMASK
  #define CMASK(P0,P1,t) do{int jb_=(t)-(NT-4); if(jb_>=0)cmask(P0,P1,jb_,qrel,hi);}while(0)
  #define ENDW(tt) do{ if((tt)+3<NT){WAIT_BAR(2);} else if((tt)+2<NT){WAIT_BAR(1);} else {WAIT_BAR(0);} }while(0)
  for(;t+1<NT;t+=2){
    STEP(pB0,pB1,pA0,pA1,t,(t+3<NT),(t+1<NT),(t+1<NT));       ENDW(t);   RESC(); ROT();
    STEP(pA0,pA1,pB0,pB1,t+1,(t+4<NT),(t+2<NT),(t+2<NT));     ENDW(t+1); RESC(); ROT();
  }
  STEP(pB0,pB1,pA0,pA1,NT-1,false,false,false); RESC();
  { float sacc=pB0[0]+pB0[1]; _Pragma("unroll") for(int r=2;r<16;++r)sacc+=pB0[r]; _Pragma("unroll") for(int r=0;r<16;++r)sacc+=pB1[r]; l_reg+=sacc;
    pw0=(u32x4){PKW(pB0,0),PKW(pB0,2),PKW(pB0,4),PKW(pB0,6)};pw1=(u32x4){PKW(pB0,8),PKW(pB0,10),PKW(pB0,12),PKW(pB0,14)};pw2=(u32x4){PKW(pB1,0),PKW(pB1,2),PKW(pB1,4),PKW(pB1,6)};pw3=(u32x4){PKW(pB1,8),PKW(pB1,10),PKW(pB1,12),PKW(pB1,14)};
    SBAR(); pv(o,vb0+sl_cur,PAF(0),PAF(1),PAF(2),PAF(3)); }
  #undef PKW
  #undef PAF
  #undef VFR
  #undef PIN
  #undef MX3
  #undef GAPA
  #undef GAPB
  #undef EX
  #undef VRD
  #undef KRD
  #undef STEP
  #undef ENDW
  {auto rr=__builtin_amdgcn_permlane32_swap(__float_as_uint(l_reg),__float_as_uint(l_reg),false,false);l_reg=__uint_as_float(rr[0])+__uint_as_float(rr[1]);}
  if(hi==0)wsf[32+r32]=l_reg;asm volatile("s_waitcnt lgkmcnt(0)":::"memory");
  float rli[16];
  #pragma unroll
  for(int r=0;r<16;++r)rli[r]=__builtin_amdgcn_rcpf(wsf[32+crow(r,hi)]);
  bf16*Ow=O+(rowbase+q0+wid*QBLK)*DM+h*D;
  { bf16*stg=(bf16*)(shm+LDS_OST)+wid*2048;
    #pragma unroll
    for(int r=0;r<16;++r){const int orow=crow(r,hi);
      #pragma unroll
      for(int d0=0;d0<2;++d0)stg[orow*64+d0*32+r32]=__float2bfloat16(o[d0][r]*rli[r]);}
    asm volatile("s_waitcnt lgkmcnt(0)":::"memory");
    #pragma unroll
    for(int i=0;i<4;++i){const int row=i*8+(lane>>3),ch=lane&7; const u32x4 v=*(const u32x4*)(stg+row*64+ch*8); ATTN_STORE16(Ow+(long)row*DM+ch*8,v);} }
  asm volatile("s_waitcnt lgkmcnt(0)\n\ts_barrier":::"memory");
  #undef ALIBI
  #undef AADD
  #undef DMA_K
  #undef DMA_V
  #undef CMASK
  #undef START
  #undef RESC
  #undef ROT
}
constexpr int ATTN_LDS_BYTES=LDS_BYTES;
struct AttnTensors { const bf16* Q; const bf16* K; const bf16* V; bf16* O; const unsigned* nmax; };
struct AttnUnit { int bh; int qb; };
struct StaticOrder {
  int vcu;
  __device__ __forceinline__ explicit StaticOrder(int grid,int block):vcu((block%8)*(grid/8)+block/8){}
  __device__ __forceinline__ bool next(int i,AttnUnit&u)const{ if(i>=4)return false; const int s=vcu&7; u.bh=vcu>>3; u.qb=(i==0)?s:(i==1)?15-s:(i==2)?16+s:31-s; return true; }
  __device__ __forceinline__ void a_ready(const AttnUnit&)const{}
  __device__ __forceinline__ void done(const AttnUnit&)const{}
};
struct DynOrder {
  unsigned* qctr; volatile __attribute__((address_space(3))) unsigned* slot; int xq, wave;
  __device__ __forceinline__ bool next(int,AttnUnit&u)const{
    if(wave==0&&lane_id()==0){ slot[0]=__hip_atomic_fetch_add(qctr+64*xq,1u,__ATOMIC_RELAXED,__HIP_MEMORY_SCOPE_AGENT); }
    __syncthreads(); const unsigned v=slot[0]; __syncthreads();
    if(v>=128u)return false; u.qb=31-(int)(v>>2); u.bh=(xq>>2)*16+(3-(int)(v&3u))*4+(xq&3); return true; }
  __device__ __forceinline__ void a_ready(const AttnUnit&)const{}
  __device__ __forceinline__ void done(const AttnUnit&)const{}
};
template<class Sched,int THRL=8> __device__ __forceinline__ void attn_phase(char*lds,const AttnTensors&T,const Sched&S,const int wave_id){
  AttnUnit u;
  for(int i=0;S.next(i,u);++i){ S.a_ready(u); attn_unit<THRL>(u.bh/NHEAD,u.bh%NHEAD,u.qb,T.Q,T.K,T.V,T.O,lds,wave_id,T.nmax); S.done(u); }
}
#undef SBAR
#undef WAIT_BAR
}
constexpr int NWAVES = 8;
constexpr int BATCH = 2, T = 8192, D = 1024, FF = 2816, M = BATCH * T;
constexpr int WIN_SRC = 5648, WIN_N = 3840;
constexpr float RMS_EPS = 1e-6f, SUBLN_EPS = 1e-5f;
constexpr size_t MiB = 1u << 20;
constexpr size_t WS_SSQA = 1 * MiB, WS_SSQB = 2 * MiB, WS_DNCD = 3 * MiB;
constexpr size_t WS_WG = 4 * MiB, WS_WA = 8 * MiB, WS_WB = 9 * MiB, WS_WOUT = 10 * MiB;
constexpr size_t WS_XB = 12 * MiB;
constexpr size_t WS_H = 44 * MiB;
constexpr size_t WS_WGU1 = 232 * MiB, WS_WD1 = 243 * MiB, WS_WIN = 248 * MiB + 512 * 1024;
constexpr size_t WS_PRE = 44 * MiB, WS_Z = 92 * MiB, WS_QO = 108 * MiB, WS_KD = 140 * MiB, WS_VD = 156 * MiB, WS_AB = 172 * MiB;
constexpr size_t WS_DN = 173 * MiB;
constexpr size_t WS_ODN = 44 * MiB, WS_AA = 60 * MiB, WS_ABB = 76 * MiB;
constexpr size_t WS_WGU2 = 173 * MiB, WS_WD2 = 184 * MiB;
constexpr size_t WS_YA = 190 * MiB, WS_YB = 222 * MiB, WS_MG = 108 * MiB;
constexpr size_t WS_END = 256 * MiB;
constexpr int DN_REC = 40960;
static_assert(WS_DN + (size_t)2048 * DN_REC <= WS_END && WS_WIN + (size_t)WIN_N * D * 2 <= WS_END && WS_YB + (size_t)M * D * 2 <= WS_END, "d_ws map");

constexpr int RING_OFF = 0, RING_BYTES = 147456;
constexpr int MISC_OFF = 147456, LDS_BYTES = 147456 + 256;

#define LAS __attribute__((address_space(3)))
typedef unsigned short bf16;
typedef unsigned v4u __attribute__((ext_vector_type(4)));
typedef float f32x4 __attribute__((ext_vector_type(4)));
typedef float f32x16 __attribute__((ext_vector_type(16)));
typedef short bf16x8 __attribute__((ext_vector_type(8)));
#define LDSFENCE() asm volatile("s_waitcnt lgkmcnt(0)" ::: "memory")
__device__ __forceinline__ unsigned f2bf(float f) { unsigned u = __builtin_bit_cast(unsigned, f); return (u + 0x7fffu + ((u >> 16) & 1u)) >> 16; }
__device__ __forceinline__ unsigned pk2(float lo, float hi) { return f2bf(lo) | (f2bf(hi) << 16); }
__device__ __forceinline__ float bflo(unsigned w) { return __uint_as_float(w << 16); }
__device__ __forceinline__ float bfhi(unsigned w) { return __uint_as_float(w & 0xffff0000u); }
__device__ __forceinline__ float wave_sum(float v) {
#pragma unroll
    for (int o = 1; o < 64; o <<= 1) v += __shfl_xor(v, o);
    return v;
}

#define GAS __attribute__((address_space(1)))
typedef GAS unsigned gu32;
#define RLX_AGENT __ATOMIC_RELAXED, __HIP_MEMORY_SCOPE_AGENT
constexpr size_t WS_CTL = 0, CTL_ZERO_BYTES = 65536;
constexpr int CW_BAR = 1024, CW_ATTQ = 8192, CW_NMAX = 12288;
#define XB_TMO      128
#define XB_XCNT(j)  (256  + 64 * (j))
#define XB_XSUB(j)  (1280 + 64 * (j))
#define XB_XGEN(j)  (2304 + 64 * (j))
#define XB_TOP      3328
#define XB_TOPGEN   3392
#define XCD_BAR_WORDS 3456
#define XB_SPIN_CAP (1u << 18)

__device__ __forceinline__ unsigned xb_ld(unsigned* p)              { return __hip_atomic_load(p, __ATOMIC_RELAXED, __HIP_MEMORY_SCOPE_AGENT); }
__device__ __forceinline__ unsigned xb_add(unsigned* p, unsigned v) { return __hip_atomic_fetch_add(p, v, __ATOMIC_RELAXED, __HIP_MEMORY_SCOPE_AGENT); }
__device__ __forceinline__ unsigned xb_xcc_id() { return (unsigned)__builtin_amdgcn_s_getreg((3 << 11) | 20) & 0xFu; }
#define XB_SPIN(cond, bar) do { unsigned _sp = 0; while (cond) { __builtin_amdgcn_s_sleep(1); \
    if ((++_sp & 255u) == 0u) { if (xb_ld(&(bar)[XB_TMO])) break; if (_sp > XB_SPIN_CAP) { atomicAdd(&(bar)[XB_TMO], 1u); break; } } } } while (0)

struct XcdBarrier {
    unsigned* bar; unsigned x; int wave;
    volatile LAS unsigned* st;
};

__device__ __forceinline__ XcdBarrier xcd_barrier_post(unsigned* bar, volatile LAS unsigned* st, int wave) {
    XcdBarrier b; b.bar = bar; b.x = xb_xcc_id(); b.st = st; b.wave = wave;
    if (wave == 0 && lane_id() == 0) (void)xb_add(&bar[XB_XCNT(b.x)], 1u);
    return b;
}
__device__ __forceinline__ void xcd_barrier_complete(unsigned* bar, unsigned x, unsigned& nloc, unsigned& nx) {
    const unsigned G = gridDim.x * gridDim.y * gridDim.z;
    unsigned sum, cnt, mine, sp = 0u;
    for (;;) {
        sum = 0u; cnt = 0u; mine = 0u;
#pragma unroll
        for (unsigned j = 0; j < 16; ++j) { const unsigned c = xb_ld(&bar[XB_XCNT(j)]); sum += c; cnt += (c > 0u) ? 1u : 0u; mine = (j == x) ? c : mine; }
        if (sum == G) break;
        __builtin_amdgcn_s_sleep(1);
        if ((++sp & 255u) == 0u) { if (xb_ld(&bar[XB_TMO])) break; if (sp > XB_SPIN_CAP) { atomicAdd(&bar[XB_TMO], 1u); break; } }
    }
    nloc = mine > 0u ? mine : 1u; nx = cnt > 0u ? cnt : 1u;
}

__device__ __forceinline__ void xcd_barrier(const XcdBarrier& b) {
    asm volatile("s_waitcnt vmcnt(0)" ::: "memory");
    __syncthreads();
    if (b.wave == 0 && lane_id() == 0) {
        unsigned* bar = b.bar;
        __builtin_amdgcn_s_waitcnt(0);
        unsigned nloc = b.st[0], nx = b.st[1];
        if (nloc == 0u) { xcd_barrier_complete(bar, b.x, nloc, nx); b.st[0] = nloc; b.st[1] = nx; }
        const unsigned old = xb_add(&bar[XB_XSUB(b.x)], 1u);
        const unsigned gen = old / nloc;
        if (old + 1u == (gen + 1u) * nloc) {
            __builtin_amdgcn_fence(__ATOMIC_RELEASE, "agent");
            asm volatile("s_waitcnt vmcnt(0)" ::: "memory");
            const unsigned og = xb_add(&bar[XB_TOP], 1u);
            const unsigned tg = og / nx;
            if (og + 1u == (tg + 1u) * nx) xb_add(&bar[XB_TOPGEN], 1u);
            else XB_SPIN(xb_ld(&bar[XB_TOPGEN]) == tg, bar);
            __builtin_amdgcn_fence(__ATOMIC_ACQUIRE, "agent");
            xb_add(&bar[XB_XGEN(b.x)], 1u);
            asm volatile("s_waitcnt vmcnt(0)" ::: "memory");
        } else {
            XB_SPIN(xb_ld(&bar[XB_XGEN(b.x)]) == gen, bar);
            __builtin_amdgcn_fence(__ATOMIC_ACQUIRE, "agent");
            asm volatile("s_waitcnt vmcnt(0)" ::: "memory");
        }
    }
    __syncthreads();
}

struct Ctx {
    const float* const* in; float* out; unsigned char* ws;
    LAS unsigned char* lds; int wave, G, vcu;
};

__device__ __forceinline__ void conv_item(const float* W, int ldw, int scol0, int nvalid, const float* gain, bf16* WT, int K, int drow0, int k0, LAS float* scr, int lane) {
#pragma unroll 8
    for (int i = 0; i < 32; ++i) { const int kk = 2 * i + (lane >> 5), n = lane & 31; float v = (n < nvalid) ? W[(size_t)(k0 + kk) * ldw + scol0 + n] : 0.f; if (gain) v *= gain[k0 + kk]; scr[kk * 33 + n] = v; }
    LDSFENCE();
    const int c = lane & 7;
#pragma unroll
    for (int j = 0; j < 4; ++j) { const int n = (lane >> 3) + 8 * j; const LAS float* s = scr + (8 * c) * 33 + n;
        v4u o; o.x = pk2(s[0 * 33], s[1 * 33]); o.y = pk2(s[2 * 33], s[3 * 33]); o.z = pk2(s[4 * 33], s[5 * 33]); o.w = pk2(s[6 * 33], s[7 * 33]);
        *(v4u*)(WT + (size_t)(drow0 + n) * K + k0 + 8 * c) = o; }
    LDSFENCE();
}
__device__ __forceinline__ void conv_gu(const float* wg, const float* wu, const float* gain, bf16* WT, int it, LAS float* scr, int lane) {
    const int db = it >> 4, kb = it & 15, tile = db >> 3, w = db & 7;
    conv_item(w < 4 ? wg : wu, FF, 128 * tile + 32 * (w & 3), 32, gain, WT, D, 32 * db, 64 * kb, scr, lane);
}
__device__ __forceinline__ void conv_plain(const float* W, int K, int N, bf16* WT, int it, LAS float* scr, int lane) {
    const int nkb = K / 64, db = it / nkb, kb = it % nkb;
    conv_item(W, N, 32 * db, 32, nullptr, WT, K, 32 * db, 64 * kb, scr, lane);
}
__device__ __forceinline__ void conv_win(const float* W, const float* gain, bf16* WT, int it, LAS float* scr, int lane) {
    const int db = it >> 4, kb = it & 15, d0 = 32 * db; int sc, nv = 32;
    if (d0 < 2048) sc = d0; else if (d0 < 3584) sc = d0 + 16; else if (d0 == 3584) { sc = 2048; nv = 16; } else { sc = 0; nv = 0; }
    conv_item(W, WIN_SRC, sc, nv, gain, WT, D, d0, 64 * kb, scr, lane);
}
__device__ __forceinline__ void conv_wg(const float* W, const float* gain, bf16* WT, int it, LAS float* scr, int lane) {
    const int db = it >> 4, kb = it & 15, tile = db >> 3, w = db & 7;
    conv_item(W, WIN_SRC, 3600 + (w < 4 ? 0 : 1024) + 128 * tile + 32 * (w & 3), 32, gain, WT, D, 32 * db, 64 * kb, scr, lane);
}

__device__ __forceinline__ void p0_prologue(Ctx& F) {
    const int lane = lane_id();
    LAS float* scr = (LAS float*)(F.lds + RING_OFF + F.wave * 17408);
    const int gw = F.vcu * NWAVES + F.wave, NGW = F.G * NWAVES;
    bf16* ws16 = (bf16*)F.ws;
    constexpr int I_GU = 176 * 16, I_DN = 32 * 44, I_WIN = 120 * 16, I_WG = 64 * 16, I_AB = 32 * 8, I_WO = 32 * 16;
    constexpr int NIT = I_GU + I_DN + I_WIN + I_WG + 2 * I_AB + I_WO;
    for (int it = gw; it < NIT; it += NGW) {
        int r = it;
        if (r < I_GU) { conv_gu(F.in[2], F.in[3], F.in[1], (bf16*)(F.ws + WS_WGU1), r, scr, lane); continue; } r -= I_GU;
        if (r < I_DN) { conv_plain(F.in[4], FF, D, (bf16*)(F.ws + WS_WD1), r, scr, lane); continue; } r -= I_DN;
        if (r < I_WIN) { conv_win(F.in[6], F.in[5], (bf16*)(F.ws + WS_WIN), r, scr, lane); continue; } r -= I_WIN;
        if (r < I_WG) { conv_wg(F.in[6], F.in[5], (bf16*)(F.ws + WS_WG), r, scr, lane); continue; } r -= I_WG;
        if (r < I_AB) { conv_plain(F.in[16], 512, D, (bf16*)(F.ws + WS_WA), r, scr, lane); continue; } r -= I_AB;
        if (r < I_AB) { conv_plain(F.in[17], 512, D, (bf16*)(F.ws + WS_WB), r, scr, lane); continue; } r -= I_AB;
        conv_plain(F.in[18], D, D, (bf16*)(F.ws + WS_WOUT), r, scr, lane);
    }
    (void)ws16;
    const float* x = F.in[0]; bf16* xb = (bf16*)(F.ws + WS_XB); float* ssq = (float*)(F.ws + WS_SSQA);
    for (int m = gw; m < M; m += NGW) {
        const f32x4* xr = (const f32x4*)(x + (size_t)m * D) + lane; unsigned long long* o8 = (unsigned long long*)(xb + (size_t)m * D) + lane;
        float s = 0.f;
#pragma unroll
        for (int j = 0; j < 4; ++j) { const f32x4 v = xr[64 * j]; s += (v.x * v.x + v.y * v.y) + (v.z * v.z + v.w * v.w);
            o8[64 * j] = (unsigned long long)pk2(v.x, v.y) | ((unsigned long long)pk2(v.z, v.w) << 32); }
        s = wave_sum(s);
        if (lane < 16) ssq[(size_t)m * 16 + lane] = (lane == 0) ? s : 0.f;
    }
}
__device__ __forceinline__ void conv_ffn2(Ctx& F) {
    const int lane = lane_id();
    LAS float* scr = (LAS float*)(F.lds + RING_OFF + F.wave * 17408);
    const int gw = F.vcu * NWAVES + F.wave, NGW = F.G * NWAVES;
    constexpr int I_GU = 176 * 16, I_DN = 32 * 44;
    for (int it = gw; it < I_GU + I_DN; it += NGW) {
        if (it < I_GU) conv_gu(F.in[20], F.in[21], F.in[19], (bf16*)(F.ws + WS_WGU2), it, scr, lane);
        else conv_plain(F.in[22], FF, D, (bf16*)(F.ws + WS_WD2), it - I_GU, scr, lane);
    }
}

__device__ __forceinline__ float silu_acc(float v) { return v / (1.0f + __expf(-v)); }
typedef unsigned u32x2 __attribute__((ext_vector_type(2)));
__device__ __forceinline__ void dn_conv_l1(const bf16* PRE, const float* cw, long row0, int tin0, int colbase, int r, int hh, float (&y)[2][4][8]) {
#pragma unroll
    for (int s = 0; s < 4; ++s) {
        const int ch0 = colbase + 16 * s + 4 * hh;
        f32x4 wl[4], wh[4];
#pragma unroll
        for (int j = 0; j < 4; ++j) { wl[j] = *(const f32x4*)(cw + j * 1536 + ch0); wh[j] = *(const f32x4*)(cw + j * 1536 + ch0 + 8); }
#pragma unroll
        for (int i = 0; i < 2; ++i) { const int tok = r + 32 * i, tin = tin0 + tok; const long row = row0 + tok;
            float a[8];
#pragma unroll
            for (int e = 0; e < 8; ++e) a[e] = 0.f;
#pragma unroll
            for (int j = 0; j < 4; ++j) { u32x2 lo = (u32x2){0u, 0u}, hi = (u32x2){0u, 0u};
                if (tin - 3 + j >= 0) { const bf16* p = PRE + (size_t)(row - 3 + j) * 1536 + ch0; lo = *(const u32x2*)p; hi = *(const u32x2*)(p + 8); }
                a[0] += wl[j][0] * bflo(lo.x); a[1] += wl[j][1] * bfhi(lo.x); a[2] += wl[j][2] * bflo(lo.y); a[3] += wl[j][3] * bfhi(lo.y);
                a[4] += wh[j][0] * bflo(hi.x); a[5] += wh[j][1] * bfhi(hi.x); a[6] += wh[j][2] * bflo(hi.y); a[7] += wh[j][3] * bfhi(hi.y); }
#pragma unroll
            for (int e = 0; e < 8; ++e) { y[i][s][e] = silu_acc(a[e]); asm volatile("" : "+v"(y[i][s][e])); } }
        __builtin_amdgcn_sched_barrier(0);
    }
}
__device__ __forceinline__ bf16x8 pack8f(const float (&v)[8], float sc) {
    v4u o; o.x = pk2(v[0] * sc, v[1] * sc); o.y = pk2(v[2] * sc, v[3] * sc); o.z = pk2(v[4] * sc, v[5] * sc); o.w = pk2(v[6] * sc, v[7] * sc);
    return __builtin_bit_cast(bf16x8, o);
}
__device__ __forceinline__ v4u pack8acc(const f32x16& X, int kq) {
    v4u o; o.x = pk2(X[8 * kq], X[8 * kq + 1]); o.y = pk2(X[8 * kq + 2], X[8 * kq + 3]); o.z = pk2(X[8 * kq + 4], X[8 * kq + 5]); o.w = pk2(X[8 * kq + 6], X[8 * kq + 7]);
    return o;
}
__device__ __forceinline__ void write_xt(LAS unsigned short* XT, const bf16x8 (&fr)[2][4], const float (&sc)[2], int r, int hh) {
#pragma unroll
    for (int i = 0; i < 2; ++i)
#pragma unroll
        for (int s = 0; s < 4; ++s) { const v4u w = __builtin_bit_cast(v4u, fr[i][s]);
#pragma unroll
            for (int e = 0; e < 8; ++e) { const unsigned ww = w[e >> 1]; const float v = ((e & 1) ? bfhi(ww) : bflo(ww)) * sc[i];
                XT[(16 * s + 8 * (e >> 2) + 4 * hh + (e & 3)) * 72 + r + 32 * i] = (unsigned short)f2bf(v); } }
}
__device__ __forceinline__ float lane_bcast(float v, int l) { return __uint_as_float((unsigned)__builtin_amdgcn_readlane((int)__float_as_uint(v), l)); }

__device__ __forceinline__ void dn_prep_chunk(Ctx& F, int ch, LAS unsigned char* scrb, int opq  ) {
    int lane_ = lane_id();
    const int lane = lane_, r = lane & 31, hh = lane >> 5;
    const int n = ch & 127, h = (ch >> 7) & 7, b = ch >> 10;
    const long row0 = (long)b * T + 64 * n; const int tin0 = 64 * n;
    const bf16* PRE = (const bf16*)(F.ws + WS_PRE); const float* AB = (const float*)(F.ws + WS_AB); const float* cw = F.in[7];
    unsigned char* rec = F.ws + WS_DN + (size_t)ch * DN_REC;
    LAS float* At = (LAS float*)scrb; LAS unsigned short* TT = (LAS unsigned short*)scrb; LAS unsigned short* XT = (LAS unsigned short*)(scrb + 9216);
    float gc, betac;
    { const float al = AB[(size_t)(row0 + lane) * 16 + h], bl = AB[(size_t)(row0 + lane) * 16 + 8 + h];
      const float xs = al + F.in[9][h];
      const float sp = fmaxf(xs, 0.f) + log1pf(expf(-fabsf(xs)));
      gc = -expf(F.in[8][h]) * sp; betac = 1.0f / (1.0f + expf(-bl));
#pragma unroll
      for (int o = 1; o < 64; o <<= 1) { const float t = __shfl_up(gc, o); if (lane >= o) gc += t; } }
    const float gl = lane_bcast(gc, 63);
    float gct[2], bet[2];
#pragma unroll
    for (int i = 0; i < 2; ++i) { gct[i] = __shfl(gc, r + 32 * i); bet[i] = __shfl(betac, r + 32 * i); }
    bf16x8 kf[2][4];
#pragma unroll
    for (int i = 0; i < 2; ++i)
#pragma unroll
        for (int s = 0; s < 4; ++s) kf[i][s] = (bf16x8){0, 0, 0, 0, 0, 0, 0, 0};
    if (opq > 0) { int lane = lane_; asm volatile("" : "+v"(lane)); const int r = lane & 31, hh = lane >> 5;
      float y[2][4][8]; dn_conv_l1(PRE, cw, row0, tin0, 512 + h * 64, r, hh, y);
#pragma unroll
      for (int i = 0; i < 2; ++i) { float ss = 0.f;
#pragma unroll
          for (int s = 0; s < 4; ++s)
#pragma unroll
              for (int e = 0; e < 8; ++e) ss += y[i][s][e] * y[i][s][e];
          ss += __shfl_xor(ss, 32); const float rn = 1.0f / sqrtf(ss + 1e-6f);
#pragma unroll
          for (int s = 0; s < 4; ++s) { kf[i][s] = pack8f(y[i][s], rn); asm volatile("" : "+v"(kf[i][s])); } } }
    __builtin_amdgcn_sched_barrier(0);
    if (opq > 1) { int lane = lane_; asm volatile("" : "+v"(lane)); const int r = lane & 31, hh = lane >> 5;
      float sc[2] = {expf(gl - gct[0]), expf(gl - gct[1])};
      write_xt(XT, kf, sc, r, hh);
      LDSFENCE();
#pragma unroll
      for (int id = 0; id < 2; ++id)
#pragma unroll
          for (int ks = 0; ks < 4; ++ks) { const int d = r + 32 * id; const LAS unsigned short* p = XT + d * 72 + 16 * ks + 4 * hh;
              const u32x2 lo = *(const LAS u32x2*)p, hi = *(const LAS u32x2*)(p + 8);
              *(v4u*)(rec + 24576 + d * 128 + (ks * 2 + hh) * 16) = (v4u){lo.x, lo.y, hi.x, hi.y}; }
      LDSFENCE(); }
    __builtin_amdgcn_sched_barrier(0);
#ifndef SKQ
    if (opq > 2) {
        int lane = lane_; asm volatile("" : "+v"(lane)); const int r = lane & 31, hh = lane >> 5;
        bf16x8 qf[2][4];
        { float y[2][4][8]; dn_conv_l1(PRE, cw, row0, tin0, h * 64, r, hh, y);
#pragma unroll
          for (int i = 0; i < 2; ++i) { float ss = 0.f;
#pragma unroll
              for (int s = 0; s < 4; ++s)
#pragma unroll
                  for (int e = 0; e < 8; ++e) ss += y[i][s][e] * y[i][s][e];
              ss += __shfl_xor(ss, 32); const float rn = 0.125f / sqrtf(ss + 1e-6f); const float eg = expf(gct[i]);
#pragma unroll
              for (int s = 0; s < 4; ++s) { qf[i][s] = pack8f(y[i][s], rn);
                  *(bf16x8*)(rec + 8192 + (r + 32 * i) * 128 + (s * 2 + hh) * 16) = pack8f(y[i][s], rn * eg); asm volatile("" : "+v"(qf[i][s])); } } }
        __builtin_amdgcn_sched_barrier(0);
#pragma unroll
        for (int is = 0; is < 2; ++is) {
            float gcr[16];
#pragma unroll
            for (int g = 0; g < 16; ++g) gcr[g] = __shfl(gc, 32 * is + (g & 3) + 8 * (g >> 2) + 4 * hh);
#pragma unroll
            for (int ic = 0; ic < 2; ++ic) {
                if (is == 1 && ic == 0) {
#pragma unroll
                    for (int kq = 0; kq < 2; ++kq) *(v4u*)(rec + 16384 + r * 128 + ((2 + kq) * 2 + hh) * 16) = (v4u){0u, 0u, 0u, 0u};
#pragma unroll
                    for (int g = 0; g < 16; ++g) At[(32 + (g & 3) + 8 * (g >> 2) + 4 * hh) * 68 + r] = 0.f;
                    continue;
                }
                f32x16 pt, pk;
#pragma unroll
                for (int g = 0; g < 16; ++g) { pt[g] = 0.f; pk[g] = 0.f; }
#pragma unroll
                for (int ks = 0; ks < 4; ++ks) { pt = __builtin_amdgcn_mfma_f32_32x32x16_bf16(kf[is][ks], qf[ic][ks], pt, 0, 0, 0); pk = __builtin_amdgcn_mfma_f32_32x32x16_bf16(kf[is][ks], kf[ic][ks], pk, 0, 0, 0); }
                const int ccol = 32 * ic + r;
#pragma unroll
                for (int g = 0; g < 16; ++g) { const int srow = 32 * is + (g & 3) + 8 * (g >> 2) + 4 * hh; const float dec = expf(fminf(gct[ic] - gcr[g], 0.f));
                    pt[g] = (srow <= ccol) ? pt[g] * dec : 0.f;
                    At[srow * 68 + ccol] = (srow < ccol) ? bet[ic] * pk[g] * dec : 0.f; }
#pragma unroll
                for (int kq = 0; kq < 2; ++kq) *(v4u*)(rec + 16384 + ccol * 128 + ((2 * is + kq) * 2 + hh) * 16) = pack8acc(pt, kq);
                __builtin_amdgcn_sched_barrier(0);
            }
        }
    }
    LDSFENCE();
#endif
    __builtin_amdgcn_sched_barrier(0);
#ifndef SKS
    if (opq > 3) {
        int lane = lane_; asm volatile("" : "+v"(lane)); const int r = lane & 31, hh = lane >> 5;
        float t[64];
#pragma unroll
        for (int k = 0; k < 64; ++k) t[k] = (k == lane) ? 1.0f : 0.0f;
#pragma unroll
        for (int j = 62; j >= 0; --j) { float acc = 0.f;
#pragma unroll
            for (int k4 = (j + 1) & ~3; k4 < 64; k4 += 4) { const f32x4 x = *(const volatile LAS f32x4*)(At + j * 68 + k4);
#pragma unroll
                for (int i = 0; i < 4; ++i) if (k4 + i > j) acc += t[k4 + i] * x[i]; }
            t[j] -= acc; asm volatile("" : "+v"(t[j])); }
        LDSFENCE();
#pragma unroll
        for (int i = 0; i < 8; ++i) { v4u o; o.x = pk2(t[8 * i], t[8 * i + 1]); o.y = pk2(t[8 * i + 2], t[8 * i + 3]); o.z = pk2(t[8 * i + 4], t[8 * i + 5]); o.w = pk2(t[8 * i + 6], t[8 * i + 7]);
            *(LAS v4u*)(TT + lane * 72 + 8 * i) = o; }
    }
#endif
    __builtin_amdgcn_sched_barrier(0);
#ifndef SKW
    if (opq > 4) { int lane = lane_; asm volatile("" : "+v"(lane)); const int r = lane & 31, hh = lane >> 5;
      float sc[2] = {bet[0] * expf(gct[0]), bet[1] * expf(gct[1])};
      write_xt(XT, kf, sc, r, hh);
      LDSFENCE();
#pragma unroll
      for (int id = 0; id < 2; ++id)
#pragma unroll
          for (int ic = 0; ic < 2; ++ic) { f32x16 acc;
#pragma unroll
              for (int g = 0; g < 16; ++g) acc[g] = 0.f;
#pragma unroll
              for (int ks = 0; ks < 4; ++ks) { const bf16x8 af = *(const LAS bf16x8*)(XT + (r + 32 * id) * 72 + 16 * ks + 8 * hh), bfr = *(const LAS bf16x8*)(TT + (r + 32 * ic) * 72 + 16 * ks + 8 * hh);
                  acc = __builtin_amdgcn_mfma_f32_32x32x16_bf16(af, bfr, acc, 0, 0, 0); }
#pragma unroll
              for (int kq = 0; kq < 2; ++kq) *(v4u*)(rec + (32 * ic + r) * 128 + ((2 * id + kq) * 2 + hh) * 16) = pack8acc(acc, kq); __builtin_amdgcn_sched_barrier(0); }
      LDSFENCE(); }
    __builtin_amdgcn_sched_barrier(0);
#endif
#ifndef SKU
    if (opq > 1) { int lane = lane_; asm volatile("" : "+v"(lane)); const int r = lane & 31, hh = lane >> 5;
      bf16x8 vf[2][4];
      { float y[2][4][8]; dn_conv_l1(PRE, cw, row0, tin0, 1024 + h * 64, r, hh, y);
#pragma unroll
        for (int i = 0; i < 2; ++i)
#pragma unroll
            for (int s = 0; s < 4; ++s) { vf[i][s] = pack8f(y[i][s], bet[i]); asm volatile("" : "+v"(vf[i][s])); } }
      __builtin_amdgcn_sched_barrier(0);
      float one[2] = {1.0f, 1.0f};
      write_xt(XT, vf, one, r, hh);
      LDSFENCE();
      unsigned* U = (unsigned*)(rec + 32768);
#pragma unroll
      for (int ic = 0; ic < 2; ++ic)
#pragma unroll
          for (int ie = 0; ie < 2; ++ie) { f32x16 acc;
#pragma unroll
              for (int g = 0; g < 16; ++g) acc[g] = 0.f;
#pragma unroll
              for (int ks = 0; ks < 4; ++ks) { const bf16x8 af = *(const LAS bf16x8*)(TT + (r + 32 * ic) * 72 + 16 * ks + 8 * hh), bfr = *(const LAS bf16x8*)(XT + (r + 32 * ie) * 72 + 16 * ks + 8 * hh);
                  acc = __builtin_amdgcn_mfma_f32_32x32x16_bf16(af, bfr, acc, 0, 0, 0); }
#pragma unroll
              for (int gp = 0; gp < 8; ++gp) U[((ie * 2 + ic) * 8 + gp) * 64 + lane] = pk2(acc[2 * gp], acc[2 * gp + 1]); __builtin_amdgcn_sched_barrier(0); }
      LDSFENCE(); }
#endif
    if (lane == 0) ((float*)(F.ws + WS_DNCD))[ch] = expf(gl);
}

__device__ __forceinline__ bf16x8 pack8(const f32x16& X, int s) {
    v4u o; o.x = pg8::cvt_pk_bf16(X[8 * s], X[8 * s + 1]); o.y = pg8::cvt_pk_bf16(X[8 * s + 2], X[8 * s + 3]); o.z = pg8::cvt_pk_bf16(X[8 * s + 4], X[8 * s + 5]); o.w = pg8::cvt_pk_bf16(X[8 * s + 6], X[8 * s + 7]);
    return __builtin_bit_cast(bf16x8, o);
}
__device__ __forceinline__ void dn_scan(Ctx& F, int sw) {
    const int lane = lane_id(), r = lane & 31, hh = lane >> 5;
    const int bh = sw >> 1, sl = sw & 1, b = bh >> 3, h = bh & 7;
    const float* CD = (const float*)(F.ws + WS_DNCD) + bh * 128;
    bf16* ODN = (bf16*)(F.ws + WS_ODN);
    f32x16 S0, S1;
#pragma unroll
    for (int i = 0; i < 16; ++i) { S0[i] = 0.f; S1[i] = 0.f; }
    for (int n = 0; n < 128; ++n) {
        const unsigned char* rec = F.ws + WS_DN + ((size_t)bh * 128 + n) * DN_REC;
        const unsigned char* fb = rec + r * 128 + hh * 16;
        bf16x8 w[2][4], qd[2][4], at[2][4], kt[2][4];
#pragma unroll
        for (int i = 0; i < 2; ++i)
#pragma unroll
            for (int ks = 0; ks < 4; ++ks) { const int o = i * 4096 + ks * 32;
                w[i][ks] = *(const bf16x8*)(fb + o); qd[i][ks] = *(const bf16x8*)(fb + 8192 + o); at[i][ks] = *(const bf16x8*)(fb + 16384 + o); kt[i][ks] = *(const bf16x8*)(fb + 24576 + o); }
        const unsigned* up = (const unsigned*)(rec + 32768) + (sl * 2) * 8 * 64 + lane;
        unsigned uw[2][8];
#pragma unroll
        for (int i = 0; i < 2; ++i)
#pragma unroll
            for (int gp = 0; gp < 8; ++gp) uw[i][gp] = up[(i * 8 + gp) * 64];
        const float cd = CD[n];
        bf16x8 sb[4]; sb[0] = pack8(S0, 0); sb[1] = pack8(S0, 1); sb[2] = pack8(S1, 0); sb[3] = pack8(S1, 1);
        f32x16 ws[2], qs[2];
#pragma unroll
        for (int i = 0; i < 2; ++i) {
#pragma unroll
            for (int g = 0; g < 16; ++g) { ws[i][g] = 0.f; qs[i][g] = 0.f; }
#pragma unroll
            for (int ks = 0; ks < 4; ++ks) { ws[i] = __builtin_amdgcn_mfma_f32_32x32x16_bf16(w[i][ks], sb[ks], ws[i], 0, 0, 0); qs[i] = __builtin_amdgcn_mfma_f32_32x32x16_bf16(qd[i][ks], sb[ks], qs[i], 0, 0, 0); }
        }
#pragma unroll
        for (int i = 0; i < 2; ++i)
#pragma unroll
            for (int gp = 0; gp < 8; ++gp) { ws[i][2 * gp] = bflo(uw[i][gp]) - ws[i][2 * gp]; ws[i][2 * gp + 1] = bfhi(uw[i][gp]) - ws[i][2 * gp + 1]; }
        bf16x8 vb[4]; vb[0] = pack8(ws[0], 0); vb[1] = pack8(ws[0], 1); vb[2] = pack8(ws[1], 0); vb[3] = pack8(ws[1], 1);
#pragma unroll
        for (int g = 0; g < 16; ++g) { S0[g] *= cd; S1[g] *= cd; }
#pragma unroll
        for (int ks = 0; ks < 4; ++ks) {
            qs[0] = __builtin_amdgcn_mfma_f32_32x32x16_bf16(at[0][ks], vb[ks], qs[0], 0, 0, 0);
            qs[1] = __builtin_amdgcn_mfma_f32_32x32x16_bf16(at[1][ks], vb[ks], qs[1], 0, 0, 0);
            S0 = __builtin_amdgcn_mfma_f32_32x32x16_bf16(kt[0][ks], vb[ks], S0, 0, 0, 0);
            S1 = __builtin_amdgcn_mfma_f32_32x32x16_bf16(kt[1][ks], vb[ks], S1, 0, 0, 0);
        }
        bf16* orow = ODN + ((size_t)b * T + 64 * n) * 512 + h * 64 + 32 * sl + r;
#pragma unroll
        for (int i = 0; i < 2; ++i)
#pragma unroll
            for (int g = 0; g < 16; ++g) { const int c = 32 * i + (g & 3) + 8 * (g >> 2) + 4 * hh; orow[(size_t)c * 512] = (bf16)f2bf(qs[i][g]); }
    }
}

constexpr int SC_SLOT = 4 * 9216 + 8192, SC_NPIECE = DN_REC / 16, SC_LANES = 6 * 64, SC_PPL = (SC_NPIECE + SC_LANES - 1) / SC_LANES;
static_assert(3 * SC_SLOT <= RING_BYTES, "scan ring fits the phase scratch");
__device__ __forceinline__ int sc_piece_off(int p) { return p < 2048 ? (p >> 9) * 9216 + ((p & 511) >> 3) * 144 + (p & 7) * 16 : 36864 + (p - 2048) * 16; }
__device__ __forceinline__ void dn_scan_block(Ctx& F, int bh) {
    const int lane = lane_id(), wave = F.wave;
    LAS unsigned char* ring = F.lds + RING_OFF;
    const unsigned char* recs = F.ws + WS_DN + (size_t)bh * 128 * DN_REC;
#define SC_BAR() asm volatile("s_waitcnt vmcnt(0) lgkmcnt(0)\n\ts_barrier" ::: "memory")
    if (wave >= 2) {
        const int ll = (wave - 2) * 64 + lane; v4u d[SC_PPL];
#pragma unroll 1
        for (int n0 = 0; n0 < 2; ++n0) {
#pragma unroll
            for (int j = 0; j < SC_PPL; ++j) { const int p = ll + j * SC_LANES; if (p < SC_NPIECE) d[j] = *(const v4u*)(recs + (size_t)n0 * DN_REC + p * 16); }
#pragma unroll
            for (int j = 0; j < SC_PPL; ++j) { const int p = ll + j * SC_LANES; if (p < SC_NPIECE) *(LAS v4u*)(ring + n0 * SC_SLOT + sc_piece_off(p)) = d[j]; }
        }
#pragma unroll
        for (int j = 0; j < SC_PPL; ++j) { const int p = ll + j * SC_LANES; if (p < SC_NPIECE) d[j] = *(const v4u*)(recs + (size_t)2 * DN_REC + p * 16); }
        asm volatile("s_waitcnt lgkmcnt(0)\n\ts_barrier" ::: "memory");
        int slot = 2;
#pragma unroll 1
        for (int n = 0; n < 128; ++n) {
            if (n + 2 < 128) {
#pragma unroll
                for (int j = 0; j < SC_PPL; ++j) { const int p = ll + j * SC_LANES; if (p < SC_NPIECE) *(LAS v4u*)(ring + slot * SC_SLOT + sc_piece_off(p)) = d[j]; }
            }
            if (n + 3 < 128) {
#pragma unroll
                for (int j = 0; j < SC_PPL; ++j) { const int p = ll + j * SC_LANES; if (p < SC_NPIECE) d[j] = *(const v4u*)(recs + (size_t)(n + 3) * DN_REC + p * 16); }
            }
            slot = (slot == 2) ? 0 : slot + 1;
            asm volatile("s_waitcnt lgkmcnt(0)\n\ts_barrier" ::: "memory");
            if (n + 3 < 128) asm volatile("s_waitcnt vmcnt(0)" ::: "memory");
        }
    } else {
        const int r = lane & 31, hh = lane >> 5, sl = wave, b = bh >> 3, h = bh & 7;
        const float* CD = (const float*)(F.ws + WS_DNCD) + bh * 128;
        bf16* ODN = (bf16*)(F.ws + WS_ODN);
        f32x16 S0, S1;
#pragma unroll
        for (int i = 0; i < 16; ++i) { S0[i] = 0.f; S1[i] = 0.f; }
        float cd = CD[0];
        asm volatile("s_waitcnt lgkmcnt(0)\n\ts_barrier" ::: "memory");
        int slot = 0;
#pragma unroll 1
        for (int n = 0; n < 128; ++n) {
            const LAS unsigned char* sb_ = ring + slot * SC_SLOT; const LAS unsigned char* fb = sb_ + r * 144 + hh * 16;
            const float cdn = CD[n + 1 < 128 ? n + 1 : n];
            bf16x8 w[2][4], qd[2][4];
#pragma unroll
            for (int i = 0; i < 2; ++i)
#pragma unroll
                for (int ks = 0; ks < 4; ++ks) { const int o = i * 32 * 144 + ks * 32; w[i][ks] = *(const LAS bf16x8*)(fb + o); qd[i][ks] = *(const LAS bf16x8*)(fb + 9216 + o); }
            bf16x8 sb[4]; sb[0] = pack8(S0, 0); sb[1] = pack8(S0, 1); sb[2] = pack8(S1, 0); sb[3] = pack8(S1, 1);
            f32x16 ws[2], qs[2];
#pragma unroll
            for (int i = 0; i < 2; ++i) {
#pragma unroll
                for (int g = 0; g < 16; ++g) { ws[i][g] = 0.f; qs[i][g] = 0.f; }
#pragma unroll
                for (int ks = 0; ks < 4; ++ks) { ws[i] = __builtin_amdgcn_mfma_f32_32x32x16_bf16(w[i][ks], sb[ks], ws[i], 0, 0, 0); qs[i] = __builtin_amdgcn_mfma_f32_32x32x16_bf16(qd[i][ks], sb[ks], qs[i], 0, 0, 0); }
            }
            bf16x8 at[2][4], kt[2][4];
#pragma unroll
            for (int i = 0; i < 2; ++i)
#pragma unroll
                for (int ks = 0; ks < 4; ++ks) { const int o = i * 32 * 144 + ks * 32; at[i][ks] = *(const LAS bf16x8*)(fb + 2 * 9216 + o); kt[i][ks] = *(const LAS bf16x8*)(fb + 3 * 9216 + o); }
            const LAS unsigned* up = (const LAS unsigned*)(sb_ + 36864) + (sl * 2) * 8 * 64 + lane;
#pragma unroll
            for (int i = 0; i < 2; ++i)
#pragma unroll
                for (int gp = 0; gp < 8; ++gp) { const unsigned uw = up[(i * 8 + gp) * 64]; ws[i][2 * gp] = bflo(uw) - ws[i][2 * gp]; ws[i][2 * gp + 1] = bfhi(uw) - ws[i][2 * gp + 1]; }
            bf16x8 vb[4]; vb[0] = pack8(ws[0], 0); vb[1] = pack8(ws[0], 1); vb[2] = pack8(ws[1], 0); vb[3] = pack8(ws[1], 1);
#pragma unroll
            for (int g = 0; g < 16; ++g) { S0[g] *= cd; S1[g] *= cd; }
#pragma unroll
            for (int ks = 0; ks < 4; ++ks) {
                S0 = __builtin_amdgcn_mfma_f32_32x32x16_bf16(kt[0][ks], vb[ks], S0, 0, 0, 0);
                S1 = __builtin_amdgcn_mfma_f32_32x32x16_bf16(kt[1][ks], vb[ks], S1, 0, 0, 0);
                qs[0] = __builtin_amdgcn_mfma_f32_32x32x16_bf16(at[0][ks], vb[ks], qs[0], 0, 0, 0);
                qs[1] = __builtin_amdgcn_mfma_f32_32x32x16_bf16(at[1][ks], vb[ks], qs[1], 0, 0, 0);
            }
            bf16* orow = ODN + ((size_t)b * T + 64 * n) * 512 + h * 64 + 32 * sl + r;
#pragma unroll
            for (int i = 0; i < 2; ++i)
#pragma unroll
                for (int g = 0; g < 16; ++g) { const int c = 32 * i + (g & 3) + 8 * (g >> 2) + 4 * hh; orow[(size_t)c * 512] = (bf16)f2bf(qs[i][g]); }
            cd = cdn; slot = (slot == 2) ? 0 : slot + 1;
            asm volatile("s_waitcnt lgkmcnt(0)\n\ts_barrier" ::: "memory");
        }
    }
    SC_BAR();
#undef SC_BAR
}

__device__ __forceinline__ void qk_norm_max(Ctx& F) {
    const int gw = F.vcu * NWAVES + F.wave, NGW = F.G * NWAVES, lane = lane_id(), j = lane >> 3;
    const bf16* QO = (const bf16*)(F.ws + WS_QO); const bf16* KD = (const bf16*)(F.ws + WS_KD);
    float mq[2] = {0.f, 0.f}, mk[2] = {0.f, 0.f};
    for (int m = gw; m < M; m += NGW) {
        const v4u qv = *(const v4u*)(QO + (size_t)m * 1024 + (2 * j) * 64 + (lane & 7) * 8), kv = *(const v4u*)(KD + (size_t)m * 512 + lane * 8);
        float sq = 0.f, sk = 0.f;
#pragma unroll
        for (int e = 0; e < 4; ++e) { const float a = bflo(qv[e]), b2 = bfhi(qv[e]), c = bflo(kv[e]), d = bfhi(kv[e]); sq += a * a + b2 * b2; sk += c * c + d * d; }
        sq += __shfl_xor(sq, 1); sq += __shfl_xor(sq, 2); sq += __shfl_xor(sq, 4);
        sk += __shfl_xor(sk, 1); sk += __shfl_xor(sk, 2); sk += __shfl_xor(sk, 4);
        const int bb = m >> 13;
        if (bb == 0) { mq[0] = fmaxf(mq[0], sq); mk[0] = fmaxf(mk[0], sk); } else { mq[1] = fmaxf(mq[1], sq); mk[1] = fmaxf(mk[1], sk); }
    }
    if ((lane & 7) == 0) { unsigned* nm = (unsigned*)(F.ws + WS_CTL) + CW_NMAX;
#pragma unroll
        for (int bb = 0; bb < 2; ++bb) { atomicMax(nm + bb * 8 + j, __float_as_uint(mq[bb])); atomicMax(nm + 16 + bb * 8 + j, __float_as_uint(mk[bb])); } }
}

__device__ __forceinline__ void finalize_rows(Ctx& F) {
    const int gw = F.vcu * NWAVES + F.wave, NGW = F.G * NWAVES, lane = lane_id();
    const bf16* ODN = (const bf16*)(F.ws + WS_ODN); const bf16* Z = (const bf16*)(F.ws + WS_Z); const bf16* QO = (const bf16*)(F.ws + WS_QO);
    bf16* AA = (bf16*)(F.ws + WS_AA); bf16* ABB = (bf16*)(F.ws + WS_ABB);
    float s1 = 0.f, s2 = 0.f;
    { const float a = F.in[11][lane] * F.in[12][lane], bq = F.in[13][lane] * F.in[14][lane]; s1 = wave_sum(a); s2 = wave_sum(bq); }
    const float lam_init = 0.2f;
    const float lam = expf(s1) - expf(s2) + lam_init;
    float gdn[8], gsub[8];
#pragma unroll
    for (int e = 0; e < 8; ++e) { gdn[e] = F.in[10][(lane & 7) * 8 + e]; gsub[e] = F.in[15][(lane & 15) * 8 + e] * (1.0f - lam_init); }
    for (int m = gw; m < M; m += NGW) {
        { const v4u ov = *(const v4u*)(ODN + (size_t)m * 512 + lane * 8), zv = *(const v4u*)(Z + (size_t)m * 512 + lane * 8);
          float o[8], z[8]; float ss = 0.f;
#pragma unroll
          for (int e = 0; e < 4; ++e) { o[2 * e] = bflo(ov[e]); o[2 * e + 1] = bfhi(ov[e]); z[2 * e] = bflo(zv[e]); z[2 * e + 1] = bfhi(zv[e]); }
#pragma unroll
          for (int e = 0; e < 8; ++e) ss += o[e] * o[e];
          ss += __shfl_xor(ss, 1); ss += __shfl_xor(ss, 2); ss += __shfl_xor(ss, 4);
          const float rn = 1.0f / sqrtf(ss * (1.0f / 64.0f) + RMS_EPS);
          float y[8];
#pragma unroll
          for (int e = 0; e < 8; ++e) y[e] = o[e] * rn * gdn[e] * silu_acc(z[e]);
          v4u w; w.x = pk2(y[0], y[1]); w.y = pk2(y[2], y[3]); w.z = pk2(y[4], y[5]); w.w = pk2(y[6], y[7]);
          *(v4u*)(AA + (size_t)m * 512 + lane * 8) = w; }
        { const int hd = lane >> 4, e0 = (lane & 15) * 8;
          const v4u a1 = *(const v4u*)(QO + (size_t)m * 1024 + hd * 256 + e0), a2 = *(const v4u*)(QO + (size_t)m * 1024 + hd * 256 + 128 + e0);
          float o[8]; float ss = 0.f;
#pragma unroll
          for (int e = 0; e < 4; ++e) { o[2 * e] = bflo(a1[e]) - lam * bflo(a2[e]); o[2 * e + 1] = bfhi(a1[e]) - lam * bfhi(a2[e]); }
#pragma unroll
          for (int e = 0; e < 8; ++e) ss += o[e] * o[e];
          ss += __shfl_xor(ss, 1); ss += __shfl_xor(ss, 2); ss += __shfl_xor(ss, 4); ss += __shfl_xor(ss, 8);
          const float rn = 1.0f / sqrtf(ss * (1.0f / 128.0f) + SUBLN_EPS);
          float y[8];
#pragma unroll
          for (int e = 0; e < 8; ++e) y[e] = o[e] * rn * gsub[e];
          v4u w; w.x = pk2(y[0], y[1]); w.y = pk2(y[2], y[3]); w.z = pk2(y[4], y[5]); w.w = pk2(y[6], y[7]);
          *(v4u*)(ABB + (size_t)m * 512 + hd * 128 + e0) = w; }
    }
}
__device__ __forceinline__ void final_norm_rows(Ctx& F) {
    const int lane = lane_id();
    const int gw = F.vcu * NWAVES + F.wave, NGW = F.G * NWAVES;
    const f32x4* gp = (const f32x4*)F.in[23] + lane; f32x4 gg[4];
#pragma unroll
    for (int j = 0; j < 4; ++j) gg[j] = gp[64 * j];
    for (int m = gw; m < M; m += NGW) {
        f32x4* xr = (f32x4*)(F.out + (size_t)m * D) + lane; f32x4 v[4]; float s = 0.f;
#pragma unroll
        for (int j = 0; j < 4; ++j) { v[j] = xr[64 * j]; s += (v[j].x * v[j].x + v[j].y * v[j].y) + (v[j].z * v[j].z + v[j].w * v[j].w); }
        const float rn = 1.0f / sqrtf(wave_sum(s) * (1.0f / D) + RMS_EPS);
#pragma unroll
        for (int j = 0; j < 4; ++j) xr[64 * j] = v[j] * rn * gg[j];
    }
}

constexpr int N_PHASES = 14;
struct Args { const float* in[24]; float* out; unsigned char* ws; int ph_lo, ph_hi; };
__global__ void __launch_bounds__(NWAVES * 64, 2) mk_fwd(Args args) {
    extern __shared__ __attribute__((aligned(16))) unsigned char lds[];
    Ctx F;
    F.in = args.in;
    F.out = args.out; F.ws = args.ws;
    F.lds = (LAS unsigned char*)lds;
    F.wave = __builtin_amdgcn_readfirstlane((int)threadIdx.x >> 6);
    F.G = gridDim.x; { const int bx = blockIdx.x; F.vcu = (F.G % 8 == 0) ? (bx % 8) * (F.G / 8) + bx / 8 : bx; }
    const int lo = args.ph_lo, hi = args.ph_hi;
    { volatile LAS unsigned* misc = (volatile LAS unsigned*)(F.lds + MISC_OFF); if (F.wave == 0) misc[lane_id()] = 0u; }
    __syncthreads();
    XcdBarrier bar = xcd_barrier_post((unsigned*)(args.ws + WS_CTL) + CW_BAR, (volatile LAS unsigned*)(F.lds + MISC_OFF) + 8, F.wave);
    if (lo < -7) cg::this_grid().sync();
    unsigned char* ws = F.ws;
    typedef pg8::bf16_t pb;
#ifndef PH_MASK
#define PH_MASK 0x3fff
#endif
#define IN(k) (((PH_MASK >> (k)) & 1) && lo <= (k) && (k) < hi)
#ifndef PROBE_A
#define PROBE_A -1
#endif
#ifndef PROBE_B
#define PROBE_B -1
#endif
#define STAMP(k) do { if (PROBE_A >= 0 && blockIdx.x == 0 && F.wave == 0 && lane_id() == 0) ((volatile unsigned long long*)(args.ws + WS_CTL + 32768))[k] = __builtin_amdgcn_s_memrealtime(); } while (0)
#define SEAM(k) do { if (IN(k) && IN((k) + 1)) xcd_barrier(bar); STAMP((k) + 1); } while (0)

    STAMP(0);
    if (IN(0)) { p0_prologue(F); } SEAM(0);
    if (IN(1)) { pg8::Gemm g{(const pb*)(ws + WS_XB), (const pb*)(ws + WS_WGU1), M, 2 * FF, D}; pg8::StaticOrder S; S.init(M, 2 * FF, F.G, (int)blockIdx.x);
        pg8::EpiSwiGLU E{(pb*)(ws + WS_H), FF, (const float*)(ws + WS_SSQA), RMS_EPS};
        pg8::gemm_phase<pg8::EpiSwiGLU, pg8::StaticOrder, true, true>(F.lds + RING_OFF, g, S, E, F.wave); } SEAM(1);
    if (IN(2)) { pg8::Gemm g{(const pb*)(ws + WS_H), (const pb*)(ws + WS_WD1), M, D, FF}; pg8::StaticOrder S; S.init(M, D, F.G, (int)blockIdx.x);
        pg8::EpiResid E{F.in[0], F.out, (pb*)(ws + WS_XB), (float*)(ws + WS_SSQB), 0.5f};
        pg8::gemm_phase<pg8::EpiResid, pg8::StaticOrder, true, true>(F.lds + RING_OFF, g, S, E, F.wave); } SEAM(2);
    if (IN(3)) { pg8::Gemm g{(const pb*)(ws + WS_XB), (const pb*)(ws + WS_WIN), M, WIN_N, D}; pg8::StaticOrder S; S.init(M, WIN_N, F.G, (int)blockIdx.x);
        pg8::EpiWin E{(pb*)(ws + WS_PRE), (pb*)(ws + WS_Z), (pb*)(ws + WS_QO), (pb*)(ws + WS_KD), (pb*)(ws + WS_VD), (float*)(ws + WS_AB), (const float*)(ws + WS_SSQB), RMS_EPS, attn_body::C2};
        pg8::gemm_phase<pg8::EpiWin, pg8::StaticOrder, true, true>(F.lds + RING_OFF, g, S, E, F.wave); } SEAM(3);
    if (IN(4)) { LAS unsigned char* scr = F.lds + RING_OFF + F.wave * 18432; const int gw = F.vcu * NWAVES + F.wave, NGW = F.G * NWAVES;
        for (int ch = gw; ch < 2048; ch += NGW) dn_prep_chunk(F, ch, scr, hi);
        qk_norm_max(F); } SEAM(4);
    if (IN(5)) {
        if (blockIdx.x < 16) dn_scan_block(F, (int)blockIdx.x);
        const attn_body::AttnTensors AT{(const attn_body::bf16*)(ws + WS_QO), (const attn_body::bf16*)(ws + WS_KD), (const attn_body::bf16*)(ws + WS_VD), (attn_body::bf16*)(ws + WS_QO), (const unsigned*)(ws + WS_CTL) + CW_NMAX};
        const attn_body::DynOrder S{(unsigned*)(ws + WS_CTL) + CW_ATTQ, (volatile LAS unsigned*)(F.lds + MISC_OFF) + 16, (int)(blockIdx.x & 7), F.wave};
        attn_body::attn_phase<attn_body::DynOrder>((char*)lds + RING_OFF, AT, S, F.wave); } SEAM(5);
    if (IN(7)) { finalize_rows(F); conv_ffn2(F); } SEAM(7);
    if (IN(8)) { pg8::StaticOrder S; S.init(M, D, F.G, (int)blockIdx.x);
        { pg8::Gemm g{(const pb*)(ws + WS_AA), (const pb*)(ws + WS_WA), M, D, 512}; pg8::EpiStoreBf16 E{(pb*)(ws + WS_YA), D};
          pg8::gemm_phase<pg8::EpiStoreBf16, pg8::StaticOrder, true, true>(F.lds + RING_OFF, g, S, E, F.wave); }
        { pg8::Gemm g{(const pb*)(ws + WS_ABB), (const pb*)(ws + WS_WB), M, D, 512}; pg8::EpiStoreBf16 E{(pb*)(ws + WS_YB), D};
          pg8::gemm_phase<pg8::EpiStoreBf16, pg8::StaticOrder, true, true>(F.lds + RING_OFF, g, S, E, F.wave); } } SEAM(8);
    if (IN(9)) { pg8::Gemm g{(const pb*)(ws + WS_XB), (const pb*)(ws + WS_WG), M, 2 * D, D}; pg8::StaticOrder S; S.init(M, 2 * D, F.G, (int)blockIdx.x);
        pg8::EpiGateMerge E{(const pb*)(ws + WS_YA), (const pb*)(ws + WS_YB), (pb*)(ws + WS_MG), (const float*)(ws + WS_SSQB), RMS_EPS};
        pg8::gemm_phase<pg8::EpiGateMerge, pg8::StaticOrder, true, true>(F.lds + RING_OFF, g, S, E, F.wave); } SEAM(9);
    if (IN(10)) { pg8::Gemm g{(const pb*)(ws + WS_MG), (const pb*)(ws + WS_WOUT), M, D, D}; pg8::StaticOrder S; S.init(M, D, F.G, (int)blockIdx.x);
        pg8::EpiResid E{F.out, F.out, (pb*)(ws + WS_XB), (float*)(ws + WS_SSQA), 1.0f};
        pg8::gemm_phase<pg8::EpiResid, pg8::StaticOrder, true, true>(F.lds + RING_OFF, g, S, E, F.wave); } SEAM(10);
    if (IN(11)) { pg8::Gemm g{(const pb*)(ws + WS_XB), (const pb*)(ws + WS_WGU2), M, 2 * FF, D}; pg8::StaticOrder S; S.init(M, 2 * FF, F.G, (int)blockIdx.x);
        pg8::EpiSwiGLU E{(pb*)(ws + WS_H), FF, (const float*)(ws + WS_SSQA), RMS_EPS};
        pg8::gemm_phase<pg8::EpiSwiGLU, pg8::StaticOrder, true, true>(F.lds + RING_OFF, g, S, E, F.wave); } SEAM(11);
    if (IN(12)) { pg8::Gemm g{(const pb*)(ws + WS_H), (const pb*)(ws + WS_WD2), M, D, FF}; pg8::StaticOrder S; S.init(M, D, F.G, (int)blockIdx.x);
        pg8::EpiResid E{F.out, F.out, (pb*)(ws + WS_XB), (float*)(ws + WS_SSQB), 0.5f};
        pg8::gemm_phase<pg8::EpiResid, pg8::StaticOrder, true, true>(F.lds + RING_OFF, g, S, E, F.wave); } SEAM(12);
    if (IN(13)) { final_norm_rows(F); } STAMP(14);
    if (PROBE_A >= 0) {
        xcd_barrier(bar);
        if (blockIdx.x == 0 && F.wave == 0) { volatile unsigned long long* ts = (volatile unsigned long long*)(args.ws + WS_CTL + 32768); const int l = lane_id();
            const float da = (float)(ts[PROBE_A + 1] - ts[PROBE_A]) * 0.01f, db = (float)(ts[PROBE_B + 1] - ts[PROBE_B]) * 0.01f;
            for (int i = l; i < 16384; i += 64) F.out[(size_t)i * 1024 + 512] = db;
            if (l == 0) F.out[0] = da; }
    }
#undef IN
#undef SEAM
}

#ifndef MK_N_LAUNCHES
#define MK_N_LAUNCHES 1
#endif
extern "C" void kernel_launch(void* const* d_in, const int* in_sizes, int n_in, void* d_out, int out_size, void* d_ws, size_t ws_size, hipStream_t stream) {
    static int grid = 0;
    if (grid == 0) {
        if (n_in != 24 || in_sizes[0] != M * D || out_size != M * D || ws_size < WS_END) { fprintf(stderr, "kernel_launch: unexpected shapes (n_in %d, in0 %d, out %d, ws %zu)\n", n_in, n_in > 0 ? in_sizes[0] : -1, out_size, ws_size); grid = -1; return; }
        int dev = 0, cus = 0, per_cu = 0;
        if (hipGetDevice(&dev) != hipSuccess || hipDeviceGetAttribute(&cus, hipDeviceAttributeMultiprocessorCount, dev) != hipSuccess) { grid = -1; return; }
        if (hipFuncSetAttribute((const void*)mk_fwd, hipFuncAttributeMaxDynamicSharedMemorySize, LDS_BYTES) != hipSuccess) { fprintf(stderr, "kernel_launch: hipFuncSetAttribute failed\n"); grid = -1; return; }
        if (hipOccupancyMaxActiveBlocksPerMultiprocessor(&per_cu, (const void*)mk_fwd, NWAVES * 64, LDS_BYTES) != hipSuccess || per_cu < 1) { fprintf(stderr, "kernel_launch: occupancy query says %d\n", per_cu); per_cu = 1; }
        (void)hipGetLastError();
        grid = cus;
    }
    if (grid < 0) return;
    if (hipMemsetAsync((char*)d_ws + WS_CTL, 0, CTL_ZERO_BYTES, stream) != hipSuccess) { fprintf(stderr, "kernel_launch: hipMemsetAsync failed\n"); return; }
    Args a{};
    for (int i = 0; i < 24; ++i) a.in[i] = (const float*)d_in[i];
    a.out = (float*)d_out; a.ws = (unsigned char*)d_ws;
#if MK_N_LAUNCHES == 1
    a.ph_lo = 0; a.ph_hi = N_PHASES;
    void* kargs[] = {&a};
    hipError_t e = hipLaunchCooperativeKernel((const void*)mk_fwd, dim3(grid), dim3(NWAVES * 64), kargs, LDS_BYTES, stream);
    if (e != hipSuccess) fprintf(stderr, "kernel_launch: cooperative launch failed: %s (grid %d)\n", hipGetErrorString(e), grid);
#else
    for (int p = 0; p < N_PHASES; ++p) { a.ph_lo = p; a.ph_hi = p + 1; hipLaunchKernelGGL(mk_fwd, dim3(grid), dim3(NWAVES * 64), LDS_BYTES, stream, a); }
#endif
}
```

```cpp
#include <hip/hip_runtime.h>
#include <hip/hip_cooperative_groups.h>
#include <cstdio>
#include <cstdint>
namespace cg = cooperative_groups;
__device__ __forceinline__ int lane_id() { int l = (int)__builtin_amdgcn_mbcnt_hi(~0u, __builtin_amdgcn_mbcnt_lo(~0u, 0u)); asm volatile("" : "+v"(l)); return l; }
namespace pg8 {
#define PG8_LAS __attribute__((address_space(3)))
typedef unsigned short bf16_t;
typedef short bf16x8 __attribute__((ext_vector_type(8)));
typedef float f32x4 __attribute__((ext_vector_type(4)));
typedef unsigned u32x4 __attribute__((ext_vector_type(4)));
constexpr int BM = 256, BK = 64, HALF = 128, HTB = HALF * BK * 2  , STAGE_BYTES = 8 * HTB, NXCD = 8, WGM = 8;

__host__ __device__ __forceinline__ int lds_byte(int r, int c) { const int st = (r >> 4) * 2 + (c >> 5), rr = r & 15, cc = c & 31, ob = rr * 64 + cc * 2; return st * 1024 + (ob ^ (((ob >> 9) & 1) << 5)); }
__host__ __device__ __forceinline__ void stage_rc(int b, int& R, int& C) { const int st = b / 1024, sb = b % 1024, swz = sb ^ (((sb >> 9) & 1) << 5); R = (st >> 1) * 16 + swz / 64; C = (st & 1) * 32 + (swz % 64) / 2; }
__host__ __device__ __forceinline__ int perm32(int rho) { const int n = rho >> 4, i = rho & 15; return 8 * (i >> 2) + 4 * n + (i & 3); }

struct Unit { int pm, pn; };
struct Gemm { const bf16_t* A; const bf16_t* Bt; int M, N, K; };

struct StaticOrder {
    int nM, nN, nwg, G, c;
    __host__ __device__ void init(int M, int N, int G_, int c_) { nM = M / BM; nN = N / BM; nwg = nM * nN; G = G_; c = c_; }
    __host__ __device__ bool next(int i, Unit& u) const {
        const long L = (long)i * G + c; if (L >= nwg) return false;
        int wgid = (int)L; { const int q = nwg / NXCD, r = nwg % NXCD, xcd = wgid % NXCD, off = wgid / NXCD; wgid = (xcd < r ? xcd * (q + 1) : r * (q + 1) + (xcd - r) * q) + off; }
        const int nig = WGM * nN, gid = wgid / nig, fm = gid * WGM, gsz = (nM - fm) < WGM ? (nM - fm) : WGM;
        u.pm = fm + ((wgid % nig) % gsz); u.pn = (wgid % nig) / gsz; return true;
    }
    __device__ __forceinline__ void a_ready(const Unit&) const {}
    __device__ __forceinline__ void done(const Unit&) const {}
};

__device__ __forceinline__ unsigned cvt_pk_bf16(float lo, float hi) { unsigned r; asm volatile("v_cvt_pk_bf16_f32 %0, %1, %2" : "=v"(r) : "v"(lo), "v"(hi)); return r; }
__device__ __forceinline__ float fast_sigmoid(float v) { return __builtin_amdgcn_rcpf(1.0f + __builtin_amdgcn_exp2f(-1.4426950408889634f * v)); }
__device__ __forceinline__ float fast_silu(float v) { return v * fast_sigmoid(v); }
__device__ __forceinline__ void load_rs(float (&rs)[2][4], const float* ssq, int row0, float eps) {
#pragma unroll
    for (int ai = 0; ai < 2; ++ai)
#pragma unroll
        for (int m = 0; m < 4; ++m) { const f32x4* p = (const f32x4*)(ssq + (size_t)(row0 + ai * HALF + m * 16) * 16); const f32x4 a = p[0], b = p[1], c = p[2], d = p[3];
            const float s = ((a[0] + a[1]) + (a[2] + a[3])) + ((b[0] + b[1]) + (b[2] + b[3])) + ((c[0] + c[1]) + (c[2] + c[3])) + ((d[0] + d[1]) + (d[2] + d[3]));
            rs[ai][m] = 1.0f / sqrtf(s * (1.0f / 1024.0f) + eps); }
}
struct EpiSwiGLU {
    static constexpr bool PERM = true, AFTER_DRAIN = false;
    bf16_t* H; int ldh; const float* ssq; float eps;
    __device__ __forceinline__ void operator()(const f32x4 (&acc)[2][2][4][2], const Unit& u, int wr, int wc, int fr, int fq) const {
        const int row0 = u.pm * BM + wr * 64 + fr, col0 = u.pn * HALF + wc * 32 + 8 * fq;
        float rs[2][4]; load_rs(rs, ssq, row0, eps);
#pragma unroll
        for (int ai = 0; ai < 2; ++ai)
#pragma unroll
            for (int m = 0; m < 4; ++m) { bf16_t* rowp = H + (size_t)(row0 + ai * HALF + m * 16) * ldh + col0; const float s = rs[ai][m];
                float h[8];
#pragma unroll
                for (int n = 0; n < 2; ++n)
#pragma unroll
                    for (int j = 0; j < 4; ++j) h[n * 4 + j] = fast_silu(acc[ai][0][m][n][j] * s) * (acc[ai][1][m][n][j] * s);
                u32x4 w; w.x = cvt_pk_bf16(h[0], h[1]); w.y = cvt_pk_bf16(h[2], h[3]); w.z = cvt_pk_bf16(h[4], h[5]); w.w = cvt_pk_bf16(h[6], h[7]);
                *(u32x4*)rowp = w; }
    }
};
struct EpiResid {
    static constexpr bool PERM = false, AFTER_DRAIN = false;
    const float* base; float* out; bf16_t* xb; float* ssq_out; float scale;
    __device__ __forceinline__ void operator()(const f32x4 (&acc)[2][2][4][2], const Unit& u, int wr, int wc, int fr, int fq) const {
        typedef unsigned u32x2v __attribute__((ext_vector_type(2)));
        const int row0 = u.pm * BM + wr * 64 + fr, col0 = u.pn * BM + wc * 32 + 4 * fq;
#pragma unroll
        for (int ai = 0; ai < 2; ++ai)
#pragma unroll
            for (int m = 0; m < 4; ++m) { const int row = row0 + ai * HALF + m * 16; const size_t off = (size_t)row * 1024 + col0; float ss = 0.f;
#pragma unroll
                for (int bj = 0; bj < 2; ++bj)
#pragma unroll
                    for (int n = 0; n < 2; ++n) { const f32x4 bs = *(const f32x4*)(base + off + bj * HALF + n * 16); const f32x4 o = bs + acc[ai][bj][m][n] * scale;
                        *(f32x4*)(out + off + bj * HALF + n * 16) = o; ss += (o[0] * o[0] + o[1] * o[1]) + (o[2] * o[2] + o[3] * o[3]);
                        u32x2v w; w.x = cvt_pk_bf16(o[0], o[1]); w.y = cvt_pk_bf16(o[2], o[3]); *(u32x2v*)(xb + off + bj * HALF + n * 16) = w; }
                ss += __shfl_xor(ss, 16); ss += __shfl_xor(ss, 32);
                if (fq == 0) ssq_out[(size_t)row * 16 + u.pn * 4 + wc] = ss; }
    }
};
struct EpiStoreBf16 {
    static constexpr bool PERM = true, AFTER_DRAIN = false;
    bf16_t* O; int ldc;
    __device__ __forceinline__ void operator()(const f32x4 (&acc)[2][2][4][2], const Unit& u, int wr, int wc, int fr, int fq) const {
        const int row0 = u.pm * BM + wr * 64 + fr, col0 = u.pn * BM + wc * 32 + 8 * fq;
#pragma unroll
        for (int ai = 0; ai < 2; ++ai)
#pragma unroll
            for (int m = 0; m < 4; ++m) { bf16_t* rowp = O + (size_t)(row0 + ai * HALF + m * 16) * ldc + col0;
#pragma unroll
                for (int bj = 0; bj < 2; ++bj) { const f32x4 v0 = acc[ai][bj][m][0], v1 = acc[ai][bj][m][1];
                    u32x4 w; w.x = cvt_pk_bf16(v0[0], v0[1]); w.y = cvt_pk_bf16(v0[2], v0[3]); w.z = cvt_pk_bf16(v1[0], v1[1]); w.w = cvt_pk_bf16(v1[2], v1[3]);
                    *(u32x4*)(rowp + bj * HALF) = w; } }
    }
};
struct EpiWin {
    static constexpr bool PERM = true, AFTER_DRAIN = false;
    bf16_t *PRE, *Z, *QO, *KD, *VD; float* AB; const float* ssq; float eps, qscale;
    __device__ __forceinline__ void operator()(const f32x4 (&acc)[2][2][4][2], const Unit& u, int wr, int wc, int fr, int fq) const {
        const int row0 = u.pm * BM + wr * 64 + fr, cl0 = wc * 32 + 8 * fq, pn = u.pn;
        float rs[2][4]; load_rs(rs, ssq, row0, eps);
        if (pn == 14) {
            if (wc == 0 && fq < 2) {
#pragma unroll
                for (int ai = 0; ai < 2; ++ai)
#pragma unroll
                    for (int m = 0; m < 4; ++m) { float* rowp = AB + (size_t)(row0 + ai * HALF + m * 16) * 16 + 8 * fq; const float s = rs[ai][m];
                        *(f32x4*)rowp = acc[ai][0][m][0] * s; *(f32x4*)(rowp + 4) = acc[ai][0][m][1] * s; }
            }
            return;
        }
        bf16_t* base; int ld, cb; float sc = 1.f; bool dup = false;
        if (pn < 6) { base = PRE; ld = 1536; cb = pn * 256; }
        else if (pn < 8) { base = Z; ld = 512; cb = (pn - 6) * 256; }
        else if (pn < 10) { base = QO; ld = 1024; cb = (pn - 8) * 256; sc = qscale; dup = true; }
        else if (pn < 12) { base = KD; ld = 512; cb = (pn - 10) * 256; }
        else { base = VD; ld = 512; cb = (pn - 12) * 256; }
#pragma unroll
        for (int ai = 0; ai < 2; ++ai)
#pragma unroll
            for (int m = 0; m < 4; ++m) { const float s = rs[ai][m] * sc; bf16_t* rowp = base + (size_t)(row0 + ai * HALF + m * 16) * ld;
#pragma unroll
                for (int bj = 0; bj < 2; ++bj) { const f32x4 v0 = acc[ai][bj][m][0] * s, v1 = acc[ai][bj][m][1] * s;
                    u32x4 w; w.x = cvt_pk_bf16(v0[0], v0[1]); w.y = cvt_pk_bf16(v0[2], v0[3]); w.z = cvt_pk_bf16(v1[0], v1[1]); w.w = cvt_pk_bf16(v1[2], v1[3]);
                    const int c = cb + bj * HALF + cl0;
                    if (dup) { const int qc = ((c >> 6) * 2) * 64 + (c & 63); *(u32x4*)(rowp + qc) = w; *(u32x4*)(rowp + qc + 64) = w; }
                    else *(u32x4*)(rowp + c) = w; } }
    }
};
struct EpiGateMerge {
    static constexpr bool PERM = true, AFTER_DRAIN = false;
    const bf16_t *YA, *YB; bf16_t* MG; const float* ssq; float eps;
    __device__ __forceinline__ void operator()(const f32x4 (&acc)[2][2][4][2], const Unit& u, int wr, int wc, int fr, int fq) const {
        const int row0 = u.pm * BM + wr * 64 + fr, col0 = u.pn * HALF + wc * 32 + 8 * fq;
        float rs[2][4]; load_rs(rs, ssq, row0, eps);
#pragma unroll
        for (int ai = 0; ai < 2; ++ai)
#pragma unroll
            for (int m = 0; m < 4; ++m) { const size_t off = (size_t)(row0 + ai * HALF + m * 16) * 1024 + col0; const float s = rs[ai][m];
                const u32x4 ya = *(const u32x4*)(YA + off), yb = *(const u32x4*)(YB + off);
                float o[8];
#pragma unroll
                for (int n = 0; n < 2; ++n)
#pragma unroll
                    for (int j = 0; j < 4; ++j) { const int e = n * 4 + j; const unsigned wa = ya[e >> 1], wb = yb[e >> 1];
                        const float fa = __uint_as_float((e & 1) ? (wa & 0xffff0000u) : (wa << 16)), fb = __uint_as_float((e & 1) ? (wb & 0xffff0000u) : (wb << 16));
                        o[e] = fast_sigmoid(acc[ai][0][m][n][j] * s) * fa + fast_sigmoid(acc[ai][1][m][n][j] * s) * fb; }
                u32x4 w; w.x = cvt_pk_bf16(o[0], o[1]); w.y = cvt_pk_bf16(o[2], o[3]); w.z = cvt_pk_bf16(o[4], o[5]); w.w = cvt_pk_bf16(o[6], o[7]);
                *(u32x4*)(MG + off) = w; }
    }
};

template <class Epi, class Sched, bool ALIGN_EPI = false, bool SP2 = false>
__device__ __forceinline__ void gemm_phase(PG8_LAS unsigned char* lds, const Gemm g, const Sched& S, const Epi& E, const int wave_id) {
    const int wid = wave_id, lane = lane_id(), tid = wid * 64 + lane, wr = wid >> 2, wc = wid & 3, fr = lane & 15, fq = lane >> 4;
    const int K = g.K, nt = K / BK;
    unsigned voffA[2], voffB[2];
#pragma unroll
    for (int i = 0; i < 2; ++i) { int R, C; stage_rc(tid * 16 + i * 8192, R, C); const int Rb = Epi::PERM ? ((R & ~31) + perm32(R & 31)) : R;
        voffA[i] = (unsigned)(R * K + C) * 2u; voffB[i] = (unsigned)(Rb * K + C) * 2u; }
    const size_t kstep = (size_t)(BK * 2);
    const size_t hstep = (size_t)HALF * K * 2;
    const size_t tstep = 2 * hstep;
    const unsigned ldsw = (unsigned)wid * 1024u;
    const int aoff = lds_byte(wr * 64 + fr, fq * 8), boff = lds_byte(wc * 32 + fr, fq * 8);
#define PG8_SA(b, h) (((b) * 2 + (h)) * HTB)
#define PG8_SB(b, h) ((4 + (b) * 2 + (h)) * HTB)
#define PG8_STAGE(bufoff, gbase, voff) do { _Pragma("unroll") for (int _i = 0; _i < 2; ++_i) \
        __builtin_amdgcn_global_load_lds((const unsigned*)((const char*)(gbase) + (voff)[_i]), (PG8_LAS unsigned*)(lds + (bufoff) + ldsw + _i * 8192), 16, 0, 0); } while (0)
#define PG8_LDA(dst, b, h) do { _Pragma("unroll") for (int m = 0; m < 4; ++m) _Pragma("unroll") for (int k = 0; k < 2; ++k) dst[m][k] = *(const PG8_LAS bf16x8*)(lds + PG8_SA(b, h) + aoff + m * 2048 + k * 1024); } while (0)
#define PG8_LDB(dst, b, h) do { _Pragma("unroll") for (int n = 0; n < 2; ++n) _Pragma("unroll") for (int k = 0; k < 2; ++k) dst[n][k] = *(const PG8_LAS bf16x8*)(lds + PG8_SB(b, h) + boff + n * 2048 + k * 1024); } while (0)
#define PG8_MMA(ai, bj, At, Bt) do { __builtin_amdgcn_s_setprio(1); _Pragma("unroll") for (int m = 0; m < 4; ++m) _Pragma("unroll") for (int n = 0; n < 2; ++n) _Pragma("unroll") for (int k = 0; k < 2; ++k) \
        acc[ai][bj][m][n] = __builtin_amdgcn_mfma_f32_16x16x32_bf16(Bt[n][k], At[m][k], acc[ai][bj][m][n], 0, 0, 0); __builtin_amdgcn_s_setprio(0); } while (0)
#define PG8_WAIT_V(n) asm volatile("s_waitcnt vmcnt(" #n ")" ::: "memory")
#define PG8_WAIT_L(n) asm volatile("s_waitcnt lgkmcnt(" #n ")" ::: "memory")
#define PG8_BAR __builtin_amdgcn_s_barrier()
#define PG8_SCHED __builtin_amdgcn_sched_barrier(0)
    Unit cur, nxt; int ui = 0;
    if (!S.next(0, cur)) return;
    f32x4 acc[2][2][4][2];
#pragma unroll
    for (int a = 0; a < 2; ++a)
#pragma unroll
        for (int b = 0; b < 2; ++b)
#pragma unroll
            for (int m = 0; m < 4; ++m)
#pragma unroll
                for (int n = 0; n < 2; ++n) acc[a][b][m][n] = (f32x4){0.f, 0.f, 0.f, 0.f};
    bf16x8 At[4][2], B0[2][2], B1[2][2];
    const char* cA = (const char*)g.A + (size_t)cur.pm * tstep; const char* cB = (const char*)g.Bt + (size_t)cur.pn * tstep;
    S.a_ready(cur);
    if constexpr (SP2) {
        PG8_STAGE(PG8_SB(0, 0), cB, voffB); PG8_STAGE(PG8_SB(0, 1), cB + hstep, voffB); PG8_STAGE(PG8_SA(0, 0), cA, voffA); PG8_STAGE(PG8_SA(0, 1), cA + hstep, voffA);
        if (wr == 1) PG8_BAR;
        PG8_WAIT_V(2); PG8_BAR;
        PG8_STAGE(PG8_SB(1, 0), cB + kstep, voffB); PG8_STAGE(PG8_SA(1, 0), cA + kstep, voffA); PG8_STAGE(PG8_SB(1, 1), cB + hstep + kstep, voffB);
        PG8_WAIT_V(6); PG8_BAR;
    } else {
        PG8_STAGE(PG8_SB(0, 0), cB, voffB); PG8_STAGE(PG8_SA(0, 0), cA, voffA); PG8_STAGE(PG8_SB(0, 1), cB + hstep, voffB); PG8_STAGE(PG8_SA(0, 1), cA + hstep, voffA);
        if (wr == 1) PG8_BAR;
        PG8_WAIT_V(4); PG8_BAR;
        PG8_STAGE(PG8_SB(1, 0), cB + kstep, voffB); PG8_STAGE(PG8_SA(1, 0), cA + kstep, voffA); PG8_STAGE(PG8_SB(1, 1), cB + hstep + kstep, voffB);
        PG8_WAIT_V(6); PG8_BAR;
    }
    for (;;) {
        const bool has_next = S.next(ui + 1, nxt);
        const char* nA = has_next ? (const char*)g.A + (size_t)nxt.pm * tstep : cA; const char* nB = has_next ? (const char*)g.Bt + (size_t)nxt.pn * tstep : cB;
        for (int t = 0; t < nt; t += 2) {
            const bool last = (t == nt - 2);
            const char* a1 = cA + (size_t)(t + 1) * kstep;
            const char* a2 = last ? nA : cA + (size_t)(t + 2) * kstep; const char* b2 = last ? nB : cB + (size_t)(t + 2) * kstep;
            const char* a3 = a2 + kstep; const char* b3 = b2 + kstep;
            if (last && has_next) S.a_ready(nxt);
            if constexpr (SP2) {
            PG8_LDB(B0, 0, 0); PG8_LDB(B1, 0, 1); PG8_SCHED; PG8_LDA(At, 0, 0); PG8_STAGE(PG8_SA(1, 1), a1 + hstep, voffA);
            PG8_WAIT_V(8); PG8_WAIT_L(0); PG8_BAR; PG8_MMA(0, 0, At, B0); PG8_MMA(0, 1, At, B1); PG8_BAR; PG8_SCHED;
            PG8_LDA(At, 0, 1); PG8_STAGE(PG8_SB(0, 0), b2, voffB); PG8_STAGE(PG8_SB(0, 1), b2 + hstep, voffB); PG8_STAGE(PG8_SA(0, 0), a2, voffA);
            PG8_WAIT_V(8); PG8_WAIT_L(0); PG8_BAR; PG8_MMA(1, 0, At, B0); PG8_MMA(1, 1, At, B1); PG8_BAR; PG8_SCHED;
            PG8_LDB(B0, 1, 0); PG8_LDB(B1, 1, 1); PG8_SCHED; PG8_LDA(At, 1, 0); PG8_STAGE(PG8_SA(0, 1), a2 + hstep, voffA);
            PG8_WAIT_V(8); PG8_WAIT_L(0); PG8_BAR; PG8_MMA(0, 0, At, B0); PG8_MMA(0, 1, At, B1); PG8_BAR; PG8_SCHED;
            PG8_LDA(At, 1, 1); PG8_STAGE(PG8_SB(1, 0), b3, voffB); PG8_STAGE(PG8_SB(1, 1), b3 + hstep, voffB); PG8_STAGE(PG8_SA(1, 0), a3, voffA);
            PG8_WAIT_V(8); PG8_WAIT_L(0); PG8_BAR; PG8_MMA(1, 0, At, B0); PG8_MMA(1, 1, At, B1); PG8_BAR; PG8_SCHED;
            } else {
            PG8_LDB(B0, 0, 0); PG8_SCHED; PG8_LDA(At, 0, 0); PG8_STAGE(PG8_SA(1, 1), a1 + hstep, voffA);
            PG8_WAIT_L(8); PG8_BAR; PG8_WAIT_L(0); PG8_MMA(0, 0, At, B0); PG8_BAR; PG8_SCHED;
            PG8_LDB(B1, 0, 1); PG8_STAGE(PG8_SB(0, 0), b2, voffB);
            PG8_BAR; PG8_WAIT_L(0); PG8_MMA(0, 1, At, B1); PG8_BAR;
            PG8_LDA(At, 0, 1); PG8_STAGE(PG8_SA(0, 0), a2, voffA);
            PG8_BAR; PG8_WAIT_L(0); PG8_MMA(1, 0, At, B0); PG8_BAR; PG8_SCHED;
            PG8_STAGE(PG8_SB(0, 1), b2 + hstep, voffB);
            PG8_WAIT_V(6); PG8_BAR; PG8_MMA(1, 1, At, B1); PG8_BAR;
            PG8_LDB(B0, 1, 0); PG8_SCHED; PG8_LDA(At, 1, 0); PG8_STAGE(PG8_SA(0, 1), a2 + hstep, voffA);
            PG8_WAIT_L(8); PG8_BAR; PG8_WAIT_L(0); PG8_MMA(0, 0, At, B0); PG8_BAR; PG8_SCHED;
            PG8_LDB(B1, 1, 1); PG8_STAGE(PG8_SB(1, 0), b3, voffB);
            PG8_BAR; PG8_WAIT_L(0); PG8_MMA(0, 1, At, B1); PG8_BAR;
            PG8_LDA(At, 1, 1); PG8_STAGE(PG8_SA(1, 0), a3, voffA);
            PG8_BAR; PG8_WAIT_L(0); PG8_MMA(1, 0, At, B0); PG8_BAR; PG8_SCHED;
            PG8_STAGE(PG8_SB(1, 1), b3 + hstep, voffB);
            PG8_WAIT_V(6); PG8_BAR; PG8_MMA(1, 1, At, B1); PG8_BAR;
            }
        }
        if constexpr (ALIGN_EPI) { if (wr == 0) PG8_BAR; }
        if constexpr (!Epi::AFTER_DRAIN) { E(acc, cur, wr, wc, fr, fq); S.done(cur); }
        if (!has_next) break;
#pragma unroll
        for (int a = 0; a < 2; ++a)
#pragma unroll
            for (int b = 0; b < 2; ++b)
#pragma unroll
                for (int m = 0; m < 4; ++m)
#pragma unroll
                    for (int n = 0; n < 2; ++n) acc[a][b][m][n] = (f32x4){0.f, 0.f, 0.f, 0.f};
        cur = nxt; cA = nA; cB = nB; ++ui;
        if constexpr (ALIGN_EPI) { if (wr == 1) PG8_BAR; }
    }
    PG8_WAIT_V(0);
    if constexpr (!ALIGN_EPI) { if (wr == 0) PG8_BAR; }
    PG8_BAR;
    if constexpr (Epi::AFTER_DRAIN) { E.fused(acc, cur, wr, wc, fr, fq, lds, wid, lane); S.done(cur); }
#undef PG8_SA
#undef PG8_SB
#undef PG8_STAGE
#undef PG8_LDA
#undef PG8_LDB
#undef PG8_MMA
#undef PG8_WAIT_V
#undef PG8_WAIT_L
#undef PG8_BAR
#undef PG8_SCHED
}
}
#include <hip/hip_bf16.h>
#include <cmath>
namespace attn_body {
using bf16=__hip_bfloat16;
using bf16x8=__attribute__((ext_vector_type(8)))short;
using s16x4=__attribute__((ext_vector_type(4)))short;
using f32x16=__attribute__((ext_vector_type(16)))float;
using u32x4=__attribute__((ext_vector_type(4)))unsigned;
constexpr int BATCH=2,NHEAD=16,SEQ=8192,D=64,DM=NHEAD*D,KP=512;
constexpr int NW=8,QBLK=32,QB=QBLK*NW,KVBLK=64,NQB=SEQ/QB;
constexpr int ATTN_PITCH=DM, ATTN_UNIT_ROWS=QB;
__device__ __forceinline__ int crow(int r,int hi){return (r&3)+8*(r>>2)+4*hi;}
#define SBAR() __builtin_amdgcn_sched_barrier(0)
__device__ __forceinline__ void cmask(f32x16&p0,f32x16&p1,int jb,int qrel,int hi){
  const float NEG=-INFINITY; int lim=qrel-64*jb-4*hi; asm volatile("":"+v"(lim));
  #pragma unroll
  for(int r=0;r<16;++r){const int cr=(r&3)+8*(r>>2); if(cr>lim)p0[r]=NEG; if(cr+32>lim)p1[r]=NEG;}
}

constexpr int NSLOT=3, SLOTB=8192;
constexpr int LDS_K=0, LDS_V=NSLOT*SLOTB, LDS_WS=2*NSLOT*SLOTB, LDS_OST=LDS_WS+NW*64*4, LDS_BYTES=LDS_OST+NW*4096;
constexpr float C2=0.125f*1.4426950408889634f;
__device__ __forceinline__ void glds16(const void*gsrc,unsigned lds_dst){unsigned keep;
  asm volatile("s_mov_b32 %0, m0\n\ts_mov_b32 m0, %2\n\ts_nop 0\n\tglobal_load_lds_dwordx4 %1, off\n\ts_mov_b32 m0, %0":"=&s"(keep):"v"(gsrc),"s"(lds_dst):"memory");}
__device__ __forceinline__ float max3f(float a,float b,float c){float r;asm("v_max3_f32 %0, %1, %2, %3":"=v"(r):"v"(a),"v"(b),"v"(c));return r;}
__device__ __forceinline__ float max2f(float a,float b){float r;asm("v_max_f32_e32 %0, %1, %2":"=v"(r):"v"(a),"v"(b));return r;}
__device__ __forceinline__ float fadd_s(float a,float b){float r;asm("v_add_f32_e32 %0, %1, %2":"=v"(r):"v"(a),"v"(b));return r;}
__device__ __forceinline__ float fsub_s(float a,float b){float r;asm("v_sub_f32_e32 %0, %1, %2":"=v"(r):"v"(a),"v"(b));return r;}
typedef float f32x2_t __attribute__((ext_vector_type(2))); typedef __bf16 bf16x2_t __attribute__((ext_vector_type(2)));
__device__ __forceinline__ unsigned cvtpk_s(float lo,float hi){f32x2_t v={lo,hi};bf16x2_t b=__builtin_convertvector(v,bf16x2_t);return __builtin_bit_cast(unsigned,b);}
#define WAIT_BAR(N) asm volatile("s_waitcnt vmcnt(" #N ") lgkmcnt(0)\n\ts_barrier":::"memory")

__device__ __forceinline__ void qkt(f32x16&p0,f32x16&p1,const char*Kslot,const bf16x8*qr,const f32x16&negm,int r32,int hi){
  const char*kb=Kslot+hi*1024+r32*16;
  #pragma unroll
  for(int d0=0;d0<4;++d0){
    const bf16x8 b0=*reinterpret_cast<const bf16x8*>(kb+d0*2048);
    const bf16x8 b1=*reinterpret_cast<const bf16x8*>(kb+d0*2048+512);
    if(d0==0){p0=__builtin_amdgcn_mfma_f32_32x32x16_bf16(b0,qr[0],negm,0,0,0);p1=__builtin_amdgcn_mfma_f32_32x32x16_bf16(b1,qr[0],negm,0,0,0);}
    else{p0=__builtin_amdgcn_mfma_f32_32x32x16_bf16(b0,qr[d0],p0,0,0,0);p1=__builtin_amdgcn_mfma_f32_32x32x16_bf16(b1,qr[d0],p1,0,0,0);}}
}
typedef __attribute__((address_space(3))) const char* lds_cptr;
typedef short v4i16_t __attribute__((ext_vector_type(4)));
__device__ __forceinline__ void kload8(bf16x8*kf,lds_cptr kp){
  kf[0]=*(const __attribute__((address_space(3))) bf16x8*)(kp);      kf[1]=*(const __attribute__((address_space(3))) bf16x8*)(kp+512);
  kf[2]=*(const __attribute__((address_space(3))) bf16x8*)(kp+2048); kf[3]=*(const __attribute__((address_space(3))) bf16x8*)(kp+2560);
  kf[4]=*(const __attribute__((address_space(3))) bf16x8*)(kp+4096); kf[5]=*(const __attribute__((address_space(3))) bf16x8*)(kp+4608);
  kf[6]=*(const __attribute__((address_space(3))) bf16x8*)(kp+6144); kf[7]=*(const __attribute__((address_space(3))) bf16x8*)(kp+6656);
}
__device__ __forceinline__ void kload2(bf16x8*kf,lds_cptr kp,int j){ kf[2*j]=*(const __attribute__((address_space(3))) bf16x8*)(kp+j*2048); kf[2*j+1]=*(const __attribute__((address_space(3))) bf16x8*)(kp+j*2048+512); }
__device__ __forceinline__ s16x4 vtr(lds_cptr p){ return __builtin_bit_cast(s16x4,__builtin_amdgcn_ds_read_tr16_b64_v4i16((__attribute__((address_space(3))) v4i16_t*)p)); }
__device__ __forceinline__ float rowmax(const f32x16&p0,const f32x16&p1){
  float a=max3f(p0[0],p0[1],p1[0]),b=max3f(p0[2],p0[3],p1[1]);a=max3f(a,p1[2],p1[3]);
  #pragma unroll
  for(int r=4;r<16;r+=4){a=max3f(a,p0[r],p0[r+1]);b=max3f(b,p0[r+2],p0[r+3]);a=max3f(a,p1[r],p1[r+1]);b=max3f(b,p1[r+2],p1[r+3]);}
  const float m=max2f(a,b);
  auto rr=__builtin_amdgcn_permlane32_swap(__float_as_uint(m),__float_as_uint(m),false,false);
  return max2f(__uint_as_float(rr[0]),__uint_as_float(rr[1]));
}
__device__ __forceinline__ void pv(f32x16*o,int vb,bf16x8 pa0,bf16x8 pa1,bf16x8 pa2,bf16x8 pa3){
  #pragma unroll
  for(int d0=0;d0<2;++d0){s16x4 lo[4],hi[4];
    #pragma unroll
    for(int ks=0;ks<4;++ks){
      asm volatile("ds_read_b64_tr_b16 %0,%1 offset:%c2":"=&v"(lo[ks]):"v"(vb),"i"(d0*4096+ks*1024):"memory");
      asm volatile("ds_read_b64_tr_b16 %0,%1 offset:%c2":"=&v"(hi[ks]):"v"(vb),"i"(d0*4096+ks*1024+512):"memory");}
    asm volatile("s_waitcnt lgkmcnt(0)":::"memory");SBAR();
    #define PK(k) (bf16x8){lo[k][0],lo[k][1],lo[k][2],lo[k][3],hi[k][0],hi[k][1],hi[k][2],hi[k][3]}
    o[d0]=__builtin_amdgcn_mfma_f32_32x32x16_bf16(pa0,PK(0),o[d0],0,0,0);
    o[d0]=__builtin_amdgcn_mfma_f32_32x32x16_bf16(pa1,PK(1),o[d0],0,0,0);
    o[d0]=__builtin_amdgcn_mfma_f32_32x32x16_bf16(pa2,PK(2),o[d0],0,0,0);
    o[d0]=__builtin_amdgcn_mfma_f32_32x32x16_bf16(pa3,PK(3),o[d0],0,0,0);
    #undef PK
  }
}

#ifndef ATTN_STORE16
#define ATTN_STORE16(p,v) (*(u32x4*)(p)=(v))
#endif
template<int THRL> __device__ __forceinline__ void attn_unit(int b,int h,int qb,const bf16*Q,const bf16*__restrict__ K,const bf16*__restrict__ V,bf16*O,char*shm,const int wave_id,const unsigned*nmax){
  const int wid=wave_id,lane=lane_id(),tid=wid*64+lane,r32=lane&31,hi=lane>>5;
  const long rowbase=(long)b*SEQ; const int q0=qb*QB;
  const bf16*Qw=Q+(rowbase+q0+wid*QBLK)*DM+h*D;
  int t0=0;
  { const int j=b*8+(h>>1); const float q2=__uint_as_float(__builtin_amdgcn_readfirstlane((int)nmax[j])), k2=__uint_as_float(__builtin_amdgcn_readfirstlane((int)nmax[16+j]));
    const unsigned slb0_=0x3eb8aa3bu-((unsigned)__builtin_amdgcn_readfirstlane(h>>2)<<24);
    const float B2=2.0f*sqrtf(q2*k2)*1.0001f+34.7f, dmin=B2/__uint_as_float(slb0_);
    const float tf=floorf(((float)(q0+1)-dmin)*(1.0f/64.0f)); int tt=(tf>0.f)?(int)tf:0; tt&=~1; const int tmax=(q0+QB)/KVBLK-4; t0=tt<tmax?tt:tmax; t0=__builtin_amdgcn_readfirstlane(t0); }
  const bf16*Kh=K+(rowbase+(long)t0*KVBLK)*KP+(h>>1)*D,*Vh=V+(rowbase+(long)t0*KVBLK)*KP+(h>>2)*128+(h&1)*D;
  const unsigned lds0=(unsigned)(uintptr_t)shm;
  float*wsf=(float*)(shm+LDS_WS)+wid*64;
  const bf16*ksrc=Kh+(long)lane*KP+wid*8;
  const bf16*vsrc=Vh+(long)(16*(wid&3)+(lane>>2))*KP+(wid>>2)*32+(lane&3)*8;
  const unsigned kdst=lds0+LDS_K+wid*1024, vdst=lds0+LDS_V+wid*1024;
  #define DMA_K(t,slot) glds16(ksrc+(long)(t)*KVBLK*KP,(unsigned)__builtin_amdgcn_readfirstlane(kdst+(slot)))
  #define DMA_V(t,slot) glds16(vsrc+(long)(t)*KVBLK*KP,(unsigned)__builtin_amdgcn_readfirstlane(vdst+(slot)))
  const int vb0=(int)(lds0+LDS_V)+((lane>>4)&1)*32+(lane&3)*8+(4*hi+((lane&15)>>2))*64;
  const char*Kbase=shm+LDS_K; bf16x8 kf[8];
  const lds_cptr shm3=(lds_cptr)shm; const lds_cptr kp0=shm3+LDS_K+hi*1024+r32*16; const lds_cptr vp0=shm3+LDS_V+((lane>>4)&1)*32+(lane&3)*8+(4*hi+((lane&15)>>2))*64;
  const int NT=(q0+QB)/KVBLK-t0;
  DMA_K(0,0);DMA_V(0,0);DMA_K(1,SLOTB);
  bf16x8 qr[4];
  #pragma unroll
  for(int d0=0;d0<4;++d0)qr[d0]=*reinterpret_cast<const bf16x8*>(&Qw[(long)r32*DM+d0*16+hi*8]);
  float mhat=0.f,l_reg=0.f;f32x16 o[2];o[0]=f32x16{};o[1]=f32x16{};const f32x16 negm=f32x16{};
  const int qrel=wid*QBLK+r32;
  const unsigned slb_=0x3eb8aa3bu-((unsigned)__builtin_amdgcn_readfirstlane(h>>2)<<24); const float sl2=__uint_as_float(slb_);
  const float qposf=(float)(q0+qrel-4*hi-64*t0);
  const float s1_=sl2, s8_=__uint_as_float(slb_+(3u<<23)), s32_=__uint_as_float(slb_+(5u<<23));
  #define AADD(d,a,sv) asm volatile("v_add_f32_e32 %0, %1, %2":"=v"(d):"s"(sv),"v"(a))
  #define ALIBI(P0,P1,t) do{ float bq_=__builtin_fmaf(sl2,((float)(64*(t))-qposf),-mhat); \
    _Pragma("unroll") for(int q_=0;q_<4;++q_){ float b0_=bq_,b1_,b2_,b3_,c_; AADD(b1_,b0_,s1_); AADD(b2_,b1_,s1_); AADD(b3_,b2_,s1_); \
      P0[4*q_]+=b0_; P0[4*q_+1]+=b1_; P0[4*q_+2]+=b2_; P0[4*q_+3]+=b3_; \
      AADD(c_,b0_,s32_); P1[4*q_]+=c_; AADD(c_,b1_,s32_); P1[4*q_+1]+=c_; AADD(c_,b2_,s32_); P1[4*q_+2]+=c_; AADD(c_,b3_,s32_); P1[4*q_+3]+=c_; \
      if(q_<3){ AADD(bq_,b0_,s8_); } } }while(0)
  #define CMASK(P0,P1,t) do{int jb_=(t)-(NT-4); if(jb_>=0)cmask(P0,P1,jb_,qrel,hi);}while(0)
  bool resc=false;
  #define START(P0,P1) do{ const float rm=rowmax(P0,P1); resc=false; \
    { const float dl=rm; mhat=fadd_s(mhat,dl); \
      _Pragma("unroll") for(int r=0;r<16;++r){P0[r]=fsub_s(P0[r],dl);P1[r]=fsub_s(P1[r],dl);} \
      } \
    _Pragma("unroll") for(int r=0;r<16;++r)P0[r]=__builtin_amdgcn_exp2f(P0[r]); }while(0)
  #define RESC() do{ if(resc){ asm volatile("s_waitcnt lgkmcnt(0)":::"memory"); \
      _Pragma("unroll") for(int d_=0;d_<2;++d_) _Pragma("unroll") for(int r=0;r<16;++r)o[d_][r]*=wsf[crow(r,hi)]; } }while(0)
  f32x16 pA0,pA1,pB0,pB1;
  int sl_prev=0,sl_cur=0,sl_next=SLOTB;
  #define ROT() do{sl_prev=sl_cur;sl_cur=sl_next;sl_next=(sl_next==(NSLOT-1)*SLOTB)?0:sl_next+SLOTB;}while(0)
  DMA_K(2,2*SLOTB);
  WAIT_BAR(3);
  qkt(pA0,pA1,Kbase,qr,negm,r32,hi);asm volatile("s_nop 15\n\ts_nop 7":"+v"(pA0),"+v"(pA1));ALIBI(pA0,pA1,0);CMASK(pA0,pA1,0);
  START(pA0,pA1);
  _Pragma("unroll") for(int r=0;r<16;++r)pA1[r]=__builtin_amdgcn_exp2f(pA1[r]);
  WAIT_BAR(0);
  DMA_K(3,0);DMA_V(1,SLOTB);
  ROT();
  kload8(kf,kp0+sl_cur);
  WAIT_BAR(2);
  s16x4 vlo[8],vhi[8]; u32x4 pw0,pw1,pw2,pw3;
  #define PKW(P,B) cvtpk_s(P[B],P[B+1])
  #define PAF(k) __builtin_bit_cast(bf16x8,pw##k)
  #define VFR(i) (bf16x8){vlo[i][0],vlo[i][1],vlo[i][2],vlo[i][3],vhi[i][0],vhi[i][1],vhi[i][2],vhi[i][3]}
  #define PIN(x) asm volatile("":"+v"(x))
  #define MX3(a,b,c) __builtin_fmaxf(__builtin_fmaxf((a),(b)),(c))
  #define GAPA(MF,A0,A1,A2,A3,W0,W1,PW) do{ MF; sacc+=A0; sacc+=A1; sacc+=A2; sacc+=A3; PIN(sacc); W0; W1; PIN(PW); SBAR(); }while(0)
  #define EX(v) __builtin_amdgcn_exp2f(v)
  #define GAPB(MF,X,B) do{ MF; X[B]=EX(X[B]); X[B+1]=EX(X[B+1]); X[B+2]=EX(X[B+2]); X[B+3]=EX(X[B+3]); PIN(X); SBAR(); }while(0)
  #define VRD(i) do{ vlo[i]=vtr(vp_+(((i)>>2)*4096+((i)&3)*1024)); vhi[i]=vtr(vp_+(((i)>>2)*4096+((i)&3)*1024+512)); }while(0)
  #define KRD(G,j) do{ if(G){ kload2(kf,kp0+sl_next,j); SBAR(); } }while(0)
  #define STEP(C0,C1,P0,P1,t,GK,GV,GL) do{ SBAR(); \
    const lds_cptr vp_=vp0+sl_prev; \
    VRD(0); SBAR(); float sacc=(P0[0]+P0[1]); \
    GAPA(C0=__builtin_amdgcn_mfma_f32_32x32x16_bf16(kf[0],qr[0],negm,0,0,0), P0[2],P0[3],P0[4],P0[5],     pw0[0]=PKW(P0,0), pw0[1]=PKW(P0,2), pw0); \
    VRD(4); SBAR(); GAPA(C1=__builtin_amdgcn_mfma_f32_32x32x16_bf16(kf[1],qr[0],negm,0,0,0), P0[6],P0[7],P0[8],P0[9],     pw0[2]=PKW(P0,4), pw0[3]=PKW(P0,6), pw0); \
    VRD(1); SBAR(); GAPA(C0=__builtin_amdgcn_mfma_f32_32x32x16_bf16(kf[2],qr[1],C0,0,0,0),   P0[10],P0[11],P0[12],P0[13], pw1[0]=PKW(P0,8), pw1[1]=PKW(P0,10), pw1); \
    VRD(5); SBAR(); GAPA(C1=__builtin_amdgcn_mfma_f32_32x32x16_bf16(kf[3],qr[1],C1,0,0,0),   P0[14],P0[15],P1[0],P1[1],   pw1[2]=PKW(P0,12),pw1[3]=PKW(P0,14), pw1); \
    VRD(2); SBAR(); GAPA(C0=__builtin_amdgcn_mfma_f32_32x32x16_bf16(kf[4],qr[2],C0,0,0,0),   P1[2],P1[3],P1[4],P1[5],     pw2[0]=PKW(P1,0), pw2[1]=PKW(P1,2), pw2); \
    VRD(6); SBAR(); GAPA(C1=__builtin_amdgcn_mfma_f32_32x32x16_bf16(kf[5],qr[2],C1,0,0,0),   P1[6],P1[7],P1[8],P1[9],     pw2[2]=PKW(P1,4), pw2[3]=PKW(P1,6), pw2); \
    VRD(3); SBAR(); GAPA(C0=__builtin_amdgcn_mfma_f32_32x32x16_bf16(kf[6],qr[3],C0,0,0,0),   P1[10],P1[11],P1[12],P1[13], pw3[0]=PKW(P1,8), pw3[1]=PKW(P1,10), pw3); \
    VRD(7); SBAR(); GAPA(C1=__builtin_amdgcn_mfma_f32_32x32x16_bf16(kf[7],qr[3],C1,0,0,0),   P1[14],P1[15],0.f,0.f,       pw3[2]=PKW(P1,12),pw3[3]=PKW(P1,14), pw3); \
    l_reg+=sacc; \
    if(GK){DMA_K((t)+3,sl_cur);} if(GV){DMA_V((t)+1,sl_next);} \
    ALIBI(C0,C1,t); CMASK(C0,C1,t); \
    { float a=MX3(C0[0],C0[1],C1[0]),b=MX3(C0[2],C0[3],C1[1]); a=MX3(a,C1[2],C1[3]); \
      _Pragma("unroll") for(int r=4;r<16;r+=4){a=MX3(a,C0[r],C0[r+1]);b=MX3(b,C0[r+2],C0[r+3]);a=MX3(a,C1[r],C1[r+1]);b=MX3(b,C1[r+2],C1[r+3]);} \
      float rm=__builtin_fmaxf(a,b); { auto rr=__builtin_amdgcn_permlane32_swap(__float_as_uint(rm),__float_as_uint(rm),false,false); rm=__builtin_fmaxf(__uint_as_float(rr[0]),__uint_as_float(rr[1])); } \
      resc=false; \
      if(__builtin_expect(__any(rm>(float)THRL),0)){ const float dl=__builtin_fmaxf(rm,0.f); mhat+=dl; \
        _Pragma("unroll") for(int r=0;r<16;++r){C0[r]-=dl;C1[r]-=dl;} \
        const float f=__builtin_amdgcn_exp2f(-dl); l_reg*=f; if(hi==0)wsf[r32]=f; resc=true; } } \
    SBAR(); \
    GAPB(o[0]=__builtin_amdgcn_mfma_f32_32x32x16_bf16(PAF(0),VFR(0),o[0],0,0,0), C0,0); \
    GAPB(o[1]=__builtin_amdgcn_mfma_f32_32x32x16_bf16(PAF(0),VFR(4),o[1],0,0,0), C0,4); \
    KRD(GL,0); GAPB(o[0]=__builtin_amdgcn_mfma_f32_32x32x16_bf16(PAF(1),VFR(1),o[0],0,0,0), C0,8); \
    KRD(GL,1); GAPB(o[1]=__builtin_amdgcn_mfma_f32_32x32x16_bf16(PAF(1),VFR(5),o[1],0,0,0), C0,12); \
    KRD(GL,2); GAPB(o[0]=__builtin_amdgcn_mfma_f32_32x32x16_bf16(PAF(2),VFR(2),o[0],0,0,0), C1,0); \
    KRD(GL,3); GAPB(o[1]=__builtin_amdgcn_mfma_f32_32x32x16_bf16(PAF(2),VFR(6),o[1],0,0,0), C1,4); \
    GAPB(o[0]=__builtin_amdgcn_mfma_f32_32x32x16_bf16(PAF(3),VFR(3),o[0],0,0,0), C1,8); \
    GAPB(o[1]=__builtin_amdgcn_mfma_f32_32x32x16_bf16(PAF(3),VFR(7),o[1],0,0,0), C1,12); \
    }while(0)
  int t=1;
  #undef CMASK
  #define CMASK(P0,P1,t) do{}while(0)
  for(;t+5<NT;t+=2){
    STEP(pB0,pB1,pA0,pA1,t,true,true,true);     WAIT_BAR(2); RESC(); ROT();
    STEP(pA0,pA1,pB0,pB1,t+1,true,true,true);   WAIT_BAR(2); RESC(); ROT();
  }
  #undef CMASK
  #define CMASK(P0,P1,t) do{int jb_=(t)-(NT-4); if(jb_>=0)cmask(P0,P1,jb_,qrel,hi);}while(0)
  #define ENDW(tt) do{ if((tt)+3<NT){WAIT_BAR(2);} else if((tt)+2<NT){WAIT_BAR(1);} else {WAIT_BAR(0);} }while(0)
  for(;t+1<NT;t+=2){
    STEP(pB0,pB1,pA0,pA1,t,(t+3<NT),(t+1<NT),(t+1<NT));       ENDW(t);   RESC(); ROT();
    STEP(pA0,pA1,pB0,pB1,t+1,(t+4<NT),(t+2<NT),(t+2<NT));     ENDW(t+1); RESC(); ROT();
  }
  STEP(pB0,pB1,pA0,pA1,NT-1,false,false,false); RESC();
  { float sacc=pB0[0]+pB0[1]; _Pragma("unroll") for(int r=2;r<16;++r)sacc+=pB0[r]; _Pragma("unroll") for(int r=0;r<16;++r)sacc+=pB1[r]; l_reg+=sacc;
    pw0=(u32x4){PKW(pB0,0),PKW(pB0,2),PKW(pB0,4),PKW(pB0,6)};pw1=(u32x4){PKW(pB0,8),PKW(pB0,10),PKW(pB0,12),PKW(pB0,14)};pw2=(u32x4){PKW(pB1,0),PKW(pB1,2),PKW(pB1,4),PKW(pB1,6)};pw3=(u32x4){PKW(pB1,8),PKW(pB1,10),PKW(pB1,12),PKW(pB1,14)};
    SBAR(); pv(o,vb0+sl_cur,PAF(0),PAF(1),PAF(2),PAF(3)); }
  #undef PKW
  #undef PAF
  #undef VFR
  #undef PIN
  #undef MX3
  #undef GAPA
  #undef GAPB
  #undef EX
  #undef VRD
  #undef KRD
  #undef STEP
  #undef ENDW
  {auto rr=__builtin_amdgcn_permlane32_swap(__float_as_uint(l_reg),__float_as_uint(l_reg),false,false);l_reg=__uint_as_float(rr[0])+__uint_as_float(rr[1]);}
  if(hi==0)wsf[32+r32]=l_reg;asm volatile("s_waitcnt lgkmcnt(0)":::"memory");
  float rli[16];
  #pragma unroll
  for(int r=0;r<16;++r)rli[r]=__builtin_amdgcn_rcpf(wsf[32+crow(r,hi)]);
  bf16*Ow=O+(rowbase+q0+wid*QBLK)*DM+h*D;
  { bf16*stg=(bf16*)(shm+LDS_OST)+wid*2048;
    #pragma unroll
    for(int r=0;r<16;++r){const int orow=crow(r,hi);
      #pragma unroll
      for(int d0=0;d0<2;++d0)stg[orow*64+d0*32+r32]=__float2bfloat16(o[d0][r]*rli[r]);}
    asm volatile("s_waitcnt lgkmcnt(0)":::"memory");
    #pragma unroll
    for(int i=0;i<4;++i){const int row=i*8+(lane>>3),ch=lane&7; const u32x4 v=*(const u32x4*)(stg+row*64+ch*8); ATTN_STORE16(Ow+(long)row*DM+ch*8,v);} }
  asm volatile("s_waitcnt lgkmcnt(0)\n\ts_barrier":::"memory");
  #undef ALIBI
  #undef AADD
  #undef DMA_K
  #undef DMA_V
  #undef CMASK
  #undef START
  #undef RESC
  #undef ROT
}
constexpr int ATTN_LDS_BYTES=LDS_BYTES;
struct AttnTensors { const bf16* Q; const bf16* K; const bf16* V; bf16* O; const unsigned* nmax; };
struct AttnUnit { int bh; int qb; };
struct StaticOrder {
  int vcu;
  __device__ __forceinline__ explicit StaticOrder(int grid,int block):vcu((block%8)*(grid/8)+block/8){}
  __device__ __forceinline__ bool next(int i,AttnUnit&u)const{ if(i>=4)return false; const int s=vcu&7; u.bh=vcu>>3; u.qb=(i==0)?s:(i==1)?15-s:(i==2)?16+s:31-s; return true; }
  __device__ __forceinline__ void a_ready(const AttnUnit&)const{}
  __device__ __forceinline__ void done(const AttnUnit&)const{}
};
struct DynOrder {
  unsigned* qctr; volatile __attribute__((address_space(3))) unsigned* slot; int xq, wave;
  __device__ __forceinline__ bool next(int,AttnUnit&u)const{
    if(wave==0&&lane_id()==0){ slot[0]=__hip_atomic_fetch_add(qctr+64*xq,1u,__ATOMIC_RELAXED,__HIP_MEMORY_SCOPE_AGENT); }
    __syncthreads(); const unsigned v=slot[0]; __syncthreads();
    if(v>=128u)return false; u.qb=31-(int)(v>>2); u.bh=(xq>>2)*16+(3-(int)(v&3u))*4+(xq&3); return true; }
  __device__ __forceinline__ void a_ready(const AttnUnit&)const{}
  __device__ __forceinline__ void done(const AttnUnit&)const{}
};
template<class Sched,int THRL=8> __device__ __forceinline__ void attn_phase(char*lds,const AttnTensors&T,const Sched&S,const int wave_id){
  AttnUnit u;
  for(int i=0;S.next(i,u);++i){ S.a_ready(u); attn_unit<THRL>(u.bh/NHEAD,u.bh%NHEAD,u.qb,T.Q,T.K,T.V,T.O,lds,wave_id,T.nmax); S.done(u); }
}
#undef SBAR
#undef WAIT_BAR
}
constexpr int NWAVES = 8;
constexpr int BATCH = 2, T = 8192, D = 1024, FF = 2816, M = BATCH * T;
constexpr int WIN_SRC = 5648, WIN_N = 3840;
constexpr float RMS_EPS = 1e-6f, SUBLN_EPS = 1e-5f;
constexpr size_t MiB = 1u << 20;
constexpr size_t WS_SSQA = 1 * MiB, WS_SSQB = 2 * MiB, WS_DNCD = 3 * MiB;
constexpr size_t WS_WG = 4 * MiB, WS_WA = 8 * MiB, WS_WB = 9 * MiB, WS_WOUT = 10 * MiB;
constexpr size_t WS_XB = 12 * MiB;
constexpr size_t WS_H = 44 * MiB;
constexpr size_t WS_WGU1 = 232 * MiB, WS_WD1 = 243 * MiB, WS_WIN = 248 * MiB + 512 * 1024;
constexpr size_t WS_PRE = 44 * MiB, WS_Z = 92 * MiB, WS_QO = 108 * MiB, WS_KD = 140 * MiB, WS_VD = 156 * MiB, WS_AB = 172 * MiB;
constexpr size_t WS_DN = 173 * MiB;
constexpr size_t WS_ODN = 44 * MiB, WS_AA = 60 * MiB, WS_ABB = 76 * MiB;
constexpr size_t WS_WGU2 = 173 * MiB, WS_WD2 = 184 * MiB;
constexpr size_t WS_YA = 190 * MiB, WS_YB = 222 * MiB, WS_MG = 108 * MiB;
constexpr size_t WS_END = 256 * MiB;
constexpr int DN_REC = 40960;
static_assert(WS_DN + (size_t)2048 * DN_REC <= WS_END && WS_WIN + (size_t)WIN_N * D * 2 <= WS_END && WS_YB + (size_t)M * D * 2 <= WS_END, "d_ws map");

constexpr int RING_OFF = 0, RING_BYTES = 147456;
constexpr int MISC_OFF = 147456, LDS_BYTES = 147456 + 256;

#define LAS __attribute__((address_space(3)))
typedef unsigned short bf16;
typedef unsigned v4u __attribute__((ext_vector_type(4)));
typedef float f32x4 __attribute__((ext_vector_type(4)));
typedef float f32x16 __attribute__((ext_vector_type(16)));
typedef short bf16x8 __attribute__((ext_vector_type(8)));
#define LDSFENCE() asm volatile("s_waitcnt lgkmcnt(0)" ::: "memory")
__device__ __forceinline__ unsigned f2bf(float f) { unsigned u = __builtin_bit_cast(unsigned, f); return (u + 0x7fffu + ((u >> 16) & 1u)) >> 16; }
__device__ __forceinline__ unsigned pk2(float lo, float hi) { return f2bf(lo) | (f2bf(hi) << 16); }
__device__ __forceinline__ float bflo(unsigned w) { return __uint_as_float(w << 16); }
__device__ __forceinline__ float bfhi(unsigned w) { return __uint_as_float(w & 0xffff0000u); }
__device__ __forceinline__ float wave_sum(float v) {
#pragma unroll
    for (int o = 1; o < 64; o <<= 1) v += __shfl_xor(v, o);
    return v;
}

#define GAS __attribute__((address_space(1)))
typedef GAS unsigned gu32;
#define RLX_AGENT __ATOMIC_RELAXED, __HIP_MEMORY_SCOPE_AGENT
constexpr size_t WS_CTL = 0, CTL_ZERO_BYTES = 65536;
constexpr int CW_BAR = 1024, CW_ATTQ = 8192, CW_NMAX = 12288;
#define XB_TMO      128
#define XB_XCNT(j)  (256  + 64 * (j))
#define XB_XSUB(j)  (1280 + 64 * (j))
#define XB_XGEN(j)  (2304 + 64 * (j))
#define XB_TOP      3328
#define XB_TOPGEN   3392
#define XCD_BAR_WORDS 3456
#define XB_SPIN_CAP (1u << 18)

__device__ __forceinline__ unsigned xb_ld(unsigned* p)              { return __hip_atomic_load(p, __ATOMIC_RELAXED, __HIP_MEMORY_SCOPE_AGENT); }
__device__ __forceinline__ unsigned xb_add(unsigned* p, unsigned v) { return __hip_atomic_fetch_add(p, v, __ATOMIC_RELAXED, __HIP_MEMORY_SCOPE_AGENT); }
__device__ __forceinline__ unsigned xb_xcc_id() { return (unsigned)__builtin_amdgcn_s_getreg((3 << 11) | 20) & 0xFu; }
#define XB_SPIN(cond, bar) do { unsigned _sp = 0; while (cond) { __builtin_amdgcn_s_sleep(1); \
    if ((++_sp & 255u) == 0u) { if (xb_ld(&(bar)[XB_TMO])) break; if (_sp > XB_SPIN_CAP) { atomicAdd(&(bar)[XB_TMO], 1u); break; } } } } while (0)

struct XcdBarrier {
    unsigned* bar; unsigned x; int wave;
    volatile LAS unsigned* st;
};

__device__ __forceinline__ XcdBarrier xcd_barrier_post(unsigned* bar, volatile LAS unsigned* st, int wave) {
    XcdBarrier b; b.bar = bar; b.x = xb_xcc_id(); b.st = st; b.wave = wave;
    if (wave == 0 && lane_id() == 0) (void)xb_add(&bar[XB_XCNT(b.x)], 1u);
    return b;
}
__device__ __forceinline__ void xcd_barrier_complete(unsigned* bar, unsigned x, unsigned& nloc, unsigned& nx) {
    const unsigned G = gridDim.x * gridDim.y * gridDim.z;
    unsigned sum, cnt, mine, sp = 0u;
    for (;;) {
        sum = 0u; cnt = 0u; mine = 0u;
#pragma unroll
        for (unsigned j = 0; j < 16; ++j) { const unsigned c = xb_ld(&bar[XB_XCNT(j)]); sum += c; cnt += (c > 0u) ? 1u : 0u; mine = (j == x) ? c : mine; }
        if (sum == G) break;
        __builtin_amdgcn_s_sleep(1);
        if ((++sp & 255u) == 0u) { if (xb_ld(&bar[XB_TMO])) break; if (sp > XB_SPIN_CAP) { atomicAdd(&bar[XB_TMO], 1u); break; } }
    }
    nloc = mine > 0u ? mine : 1u; nx = cnt > 0u ? cnt : 1u;
}

__device__ __forceinline__ void xcd_barrier(const XcdBarrier& b) {
    asm volatile("s_waitcnt vmcnt(0)" ::: "memory");
    __syncthreads();
    if (b.wave == 0 && lane_id() == 0) {
        unsigned* bar = b.bar;
        __builtin_amdgcn_s_waitcnt(0);
        unsigned nloc = b.st[0], nx = b.st[1];
        if (nloc == 0u) { xcd_barrier_complete(bar, b.x, nloc, nx); b.st[0] = nloc; b.st[1] = nx; }
        const unsigned old = xb_add(&bar[XB_XSUB(b.x)], 1u);
        const unsigned gen = old / nloc;
        if (old + 1u == (gen + 1u) * nloc) {
            __builtin_amdgcn_fence(__ATOMIC_RELEASE, "agent");
            asm volatile("s_waitcnt vmcnt(0)" ::: "memory");
            const unsigned og = xb_add(&bar[XB_TOP], 1u);
            const unsigned tg = og / nx;
            if (og + 1u == (tg + 1u) * nx) xb_add(&bar[XB_TOPGEN], 1u);
            else XB_SPIN(xb_ld(&bar[XB_TOPGEN]) == tg, bar);
            __builtin_amdgcn_fence(__ATOMIC_ACQUIRE, "agent");
            xb_add(&bar[XB_XGEN(b.x)], 1u);
            asm volatile("s_waitcnt vmcnt(0)" ::: "memory");
        } else {
            XB_SPIN(xb_ld(&bar[XB_XGEN(b.x)]) == gen, bar);
            __builtin_amdgcn_fence(__ATOMIC_ACQUIRE, "agent");
            asm volatile("s_waitcnt vmcnt(0)" ::: "memory");
        }
    }
    __syncthreads();
}

struct Ctx {
    const float* const* in; float* out; unsigned char* ws;
    LAS unsigned char* lds; int wave, G, vcu;
};

__device__ __forceinline__ void conv_item(const float* W, int ldw, int scol0, int nvalid, const float* gain, bf16* WT, int K, int drow0, int k0, LAS float* scr, int lane) {
#pragma unroll 8
    for (int i = 0; i < 32; ++i) { const int kk = 2 * i + (lane >> 5), n = lane & 31; float v = (n < nvalid) ? W[(size_t)(k0 + kk) * ldw + scol0 + n] : 0.f; if (gain) v *= gain[k0 + kk]; scr[kk * 33 + n] = v; }
    LDSFENCE();
    const int c = lane & 7;
#pragma unroll
    for (int j = 0; j < 4; ++j) { const int n = (lane >> 3) + 8 * j; const LAS float* s = scr + (8 * c) * 33 + n;
        v4u o; o.x = pk2(s[0 * 33], s[1 * 33]); o.y = pk2(s[2 * 33], s[3 * 33]); o.z = pk2(s[4 * 33], s[5 * 33]); o.w = pk2(s[6 * 33], s[7 * 33]);
        *(v4u*)(WT + (size_t)(drow0 + n) * K + k0 + 8 * c) = o; }
    LDSFENCE();
}
__device__ __forceinline__ void conv_gu(const float* wg, const float* wu, const float* gain, bf16* WT, int it, LAS float* scr, int lane) {
    const int db = it >> 4, kb = it & 15, tile = db >> 3, w = db & 7;
    conv_item(w < 4 ? wg : wu, FF, 128 * tile + 32 * (w & 3), 32, gain, WT, D, 32 * db, 64 * kb, scr, lane);
}
__device__ __forceinline__ void conv_plain(const float* W, int K, int N, bf16* WT, int it, LAS float* scr, int lane) {
    const int nkb = K / 64, db = it / nkb, kb = it % nkb;
    conv_item(W, N, 32 * db, 32, nullptr, WT, K, 32 * db, 64 * kb, scr, lane);
}
__device__ __forceinline__ void conv_win(const float* W, const float* gain, bf16* WT, int it, LAS float* scr, int lane) {
    const int db = it >> 4, kb = it & 15, d0 = 32 * db; int sc, nv = 32;
    if (d0 < 2048) sc = d0; else if (d0 < 3584) sc = d0 + 16; else if (d0 == 3584) { sc = 2048; nv = 16; } else { sc = 0; nv = 0; }
    conv_item(W, WIN_SRC, sc, nv, gain, WT, D, d0, 64 * kb, scr, lane);
}
__device__ __forceinline__ void conv_wg(const float* W, const float* gain, bf16* WT, int it, LAS float* scr, int lane) {
    const int db = it >> 4, kb = it & 15, tile = db >> 3, w = db & 7;
    conv_item(W, WIN_SRC, 3600 + (w < 4 ? 0 : 1024) + 128 * tile + 32 * (w & 3), 32, gain, WT, D, 32 * db, 64 * kb, scr, lane);
}

__device__ __forceinline__ void p0_prologue(Ctx& F) {
    const int lane = lane_id();
    LAS float* scr = (LAS float*)(F.lds + RING_OFF + F.wave * 17408);
    const int gw = F.vcu * NWAVES + F.wave, NGW = F.G * NWAVES;
    bf16* ws16 = (bf16*)F.ws;
    constexpr int I_GU = 176 * 16, I_DN = 32 * 44, I_WIN = 120 * 16, I_WG = 64 * 16, I_AB = 32 * 8, I_WO = 32 * 16;
    constexpr int NIT = I_GU + I_DN + I_WIN + I_WG + 2 * I_AB + I_WO;
    for (int it = gw; it < NIT; it += NGW) {
        int r = it;
        if (r < I_GU) { conv_gu(F.in[2], F.in[3], F.in[1], (bf16*)(F.ws + WS_WGU1), r, scr, lane); continue; } r -= I_GU;
        if (r < I_DN) { conv_plain(F.in[4], FF, D, (bf16*)(F.ws + WS_WD1), r, scr, lane); continue; } r -= I_DN;
        if (r < I_WIN) { conv_win(F.in[6], F.in[5], (bf16*)(F.ws + WS_WIN), r, scr, lane); continue; } r -= I_WIN;
        if (r < I_WG) { conv_wg(F.in[6], F.in[5], (bf16*)(F.ws + WS_WG), r, scr, lane); continue; } r -= I_WG;
        if (r < I_AB) { conv_plain(F.in[16], 512, D, (bf16*)(F.ws + WS_WA), r, scr, lane); continue; } r -= I_AB;
        if (r < I_AB) { conv_plain(F.in[17], 512, D, (bf16*)(F.ws + WS_WB), r, scr, lane); continue; } r -= I_AB;
        conv_plain(F.in[18], D, D, (bf16*)(F.ws + WS_WOUT), r, scr, lane);
    }
    (void)ws16;
    const float* x = F.in[0]; bf16* xb = (bf16*)(F.ws + WS_XB); float* ssq = (float*)(F.ws + WS_SSQA);
    for (int m = gw; m < M; m += NGW) {
        const f32x4* xr = (const f32x4*)(x + (size_t)m * D) + lane; unsigned long long* o8 = (unsigned long long*)(xb + (size_t)m * D) + lane;
        float s = 0.f;
#pragma unroll
        for (int j = 0; j < 4; ++j) { const f32x4 v = xr[64 * j]; s += (v.x * v.x + v.y * v.y) + (v.z * v.z + v.w * v.w);
            o8[64 * j] = (unsigned long long)pk2(v.x, v.y) | ((unsigned long long)pk2(v.z, v.w) << 32); }
        s = wave_sum(s);
        if (lane < 16) ssq[(size_t)m * 16 + lane] = (lane == 0) ? s : 0.f;
    }
}
__device__ __forceinline__ void conv_ffn2(Ctx& F) {
    const int lane = lane_id();
    LAS float* scr = (LAS float*)(F.lds + RING_OFF + F.wave * 17408);
    const int gw = F.vcu * NWAVES + F.wave, NGW = F.G * NWAVES;
    constexpr int I_GU = 176 * 16, I_DN = 32 * 44;
    for (int it = gw; it < I_GU + I_DN; it += NGW) {
        if (it < I_GU) conv_gu(F.in[20], F.in[21], F.in[19], (bf16*)(F.ws + WS_WGU2), it, scr, lane);
        else conv_plain(F.in[22], FF, D, (bf16*)(F.ws + WS_WD2), it - I_GU, scr, lane);
    }
}

__device__ __forceinline__ float silu_acc(float v) { return v / (1.0f + __expf(-v)); }
typedef unsigned u32x2 __attribute__((ext_vector_type(2)));
__device__ __forceinline__ void dn_conv_l1(const bf16* PRE, const float* cw, long row0, int tin0, int colbase, int r, int hh, float (&y)[2][4][8]) {
#pragma unroll
    for (int s = 0; s < 4; ++s) {
        const int ch0 = colbase + 16 * s + 4 * hh;
        f32x4 wl[4], wh[4];
#pragma unroll
        for (int j = 0; j < 4; ++j) { wl[j] = *(const f32x4*)(cw + j * 1536 + ch0); wh[j] = *(const f32x4*)(cw + j * 1536 + ch0 + 8); }
#pragma unroll
        for (int i = 0; i < 2; ++i) { const int tok = r + 32 * i, tin = tin0 + tok; const long row = row0 + tok;
            float a[8];
#pragma unroll
            for (int e = 0; e < 8; ++e) a[e] = 0.f;
#pragma unroll
            for (int j = 0; j < 4; ++j) { u32x2 lo = (u32x2){0u, 0u}, hi = (u32x2){0u, 0u};
                if (tin - 3 + j >= 0) { const bf16* p = PRE + (size_t)(row - 3 + j) * 1536 + ch0; lo = *(const u32x2*)p; hi = *(const u32x2*)(p + 8); }
                a[0] += wl[j][0] * bflo(lo.x); a[1] += wl[j][1] * bfhi(lo.x); a[2] += wl[j][2] * bflo(lo.y); a[3] += wl[j][3] * bfhi(lo.y);
                a[4] += wh[j][0] * bflo(hi.x); a[5] += wh[j][1] * bfhi(hi.x); a[6] += wh[j][2] * bflo(hi.y); a[7] += wh[j][3] * bfhi(hi.y); }
#pragma unroll
            for (int e = 0; e < 8; ++e) { y[i][s][e] = silu_acc(a[e]); asm volatile("" : "+v"(y[i][s][e])); } }
        __builtin_amdgcn_sched_barrier(0);
    }
}
__device__ __forceinline__ bf16x8 pack8f(const float (&v)[8], float sc) {
    v4u o; o.x = pk2(v[0] * sc, v[1] * sc); o.y = pk2(v[2] * sc, v[3] * sc); o.z = pk2(v[4] * sc, v[5] * sc); o.w = pk2(v[6] * sc, v[7] * sc);
    return __builtin_bit_cast(bf16x8, o);
}
__device__ __forceinline__ v4u pack8acc(const f32x16& X, int kq) {
    v4u o; o.x = pk2(X[8 * kq], X[8 * kq + 1]); o.y = pk2(X[8 * kq + 2], X[8 * kq + 3]); o.z = pk2(X[8 * kq + 4], X[8 * kq + 5]); o.w = pk2(X[8 * kq + 6], X[8 * kq + 7]);
    return o;
}
__device__ __forceinline__ void write_xt(LAS unsigned short* XT, const bf16x8 (&fr)[2][4], const float (&sc)[2], int r, int hh) {
#pragma unroll
    for (int i = 0; i < 2; ++i)
#pragma unroll
        for (int s = 0; s < 4; ++s) { const v4u w = __builtin_bit_cast(v4u, fr[i][s]);
#pragma unroll
            for (int e = 0; e < 8; ++e) { const unsigned ww = w[e >> 1]; const float v = ((e & 1) ? bfhi(ww) : bflo(ww)) * sc[i];
                XT[(16 * s + 8 * (e >> 2) + 4 * hh + (e & 3)) * 72 + r + 32 * i] = (unsigned short)f2bf(v); } }
}
__device__ __forceinline__ float lane_bcast(float v, int l) { return __uint_as_float((unsigned)__builtin_amdgcn_readlane((int)__float_as_uint(v), l)); }

__device__ __forceinline__ void dn_prep_chunk(Ctx& F, int ch, LAS unsigned char* scrb, int opq  ) {
    int lane_ = lane_id();
    const int lane = lane_, r = lane & 31, hh = lane >> 5;
    const int n = ch & 127, h = (ch >> 7) & 7, b = ch >> 10;
    const long row0 = (long)b * T + 64 * n; const int tin0 = 64 * n;
    const bf16* PRE = (const bf16*)(F.ws + WS_PRE); const float* AB = (const float*)(F.ws + WS_AB); const float* cw = F.in[7];
    unsigned char* rec = F.ws + WS_DN + (size_t)ch * DN_REC;
    LAS float* At = (LAS float*)scrb; LAS unsigned short* TT = (LAS unsigned short*)scrb; LAS unsigned short* XT = (LAS unsigned short*)(scrb + 9216);
    float gc, betac;
    { const float al = AB[(size_t)(row0 + lane) * 16 + h], bl = AB[(size_t)(row0 + lane) * 16 + 8 + h];
      const float xs = al + F.in[9][h];
      const float sp = fmaxf(xs, 0.f) + log1pf(expf(-fabsf(xs)));
      gc = -expf(F.in[8][h]) * sp; betac = 1.0f / (1.0f + expf(-bl));
#pragma unroll
      for (int o = 1; o < 64; o <<= 1) { const float t = __shfl_up(gc, o); if (lane >= o) gc += t; } }
    const float gl = lane_bcast(gc, 63);
    float gct[2], bet[2];
#pragma unroll
    for (int i = 0; i < 2; ++i) { gct[i] = __shfl(gc, r + 32 * i); bet[i] = __shfl(betac, r + 32 * i); }
    bf16x8 kf[2][4];
#pragma unroll
    for (int i = 0; i < 2; ++i)
#pragma unroll
        for (int s = 0; s < 4; ++s) kf[i][s] = (bf16x8){0, 0, 0, 0, 0, 0, 0, 0};
    if (opq > 0) { int lane = lane_; asm volatile("" : "+v"(lane)); const int r = lane & 31, hh = lane >> 5;
      float y[2][4][8]; dn_conv_l1(PRE, cw, row0, tin0, 512 + h * 64, r, hh, y);
#pragma unroll
      for (int i = 0; i < 2; ++i) { float ss = 0.f;
#pragma unroll
          for (int s = 0; s < 4; ++s)
#pragma unroll
              for (int e = 0; e < 8; ++e) ss += y[i][s][e] * y[i][s][e];
          ss += __shfl_xor(ss, 32); const float rn = 1.0f / sqrtf(ss + 1e-6f);
#pragma unroll
          for (int s = 0; s < 4; ++s) { kf[i][s] = pack8f(y[i][s], rn); asm volatile("" : "+v"(kf[i][s])); } } }
    __builtin_amdgcn_sched_barrier(0);
    if (opq > 1) { int lane = lane_; asm volatile("" : "+v"(lane)); const int r = lane & 31, hh = lane >> 5;
      float sc[2] = {expf(gl - gct[0]), expf(gl - gct[1])};
      write_xt(XT, kf, sc, r, hh);
      LDSFENCE();
#pragma unroll
      for (int id = 0; id < 2; ++id)
#pragma unroll
          for (int ks = 0; ks < 4; ++ks) { const int d = r + 32 * id; const LAS unsigned short* p = XT + d * 72 + 16 * ks + 4 * hh;
              const u32x2 lo = *(const LAS u32x2*)p, hi = *(const LAS u32x2*)(p + 8);
              *(v4u*)(rec + 24576 + d * 128 + (ks * 2 + hh) * 16) = (v4u){lo.x, lo.y, hi.x, hi.y}; }
      LDSFENCE(); }
    __builtin_amdgcn_sched_barrier(0);
#ifndef SKQ
    if (opq > 2) {
        int lane = lane_; asm volatile("" : "+v"(lane)); const int r = lane & 31, hh = lane >> 5;
        bf16x8 qf[2][4];
        { float y[2][4][8]; dn_conv_l1(PRE, cw, row0, tin0, h * 64, r, hh, y);
#pragma unroll
          for (int i = 0; i < 2; ++i) { float ss = 0.f;
#pragma unroll
              for (int s = 0; s < 4; ++s)
#pragma unroll
                  for (int e = 0; e < 8; ++e) ss += y[i][s][e] * y[i][s][e];
              ss += __shfl_xor(ss, 32); const float rn = 0.125f / sqrtf(ss + 1e-6f); const float eg = expf(gct[i]);
#pragma unroll
              for (int s = 0; s < 4; ++s) { qf[i][s] = pack8f(y[i][s], rn);
                  *(bf16x8*)(rec + 8192 + (r + 32 * i) * 128 + (s * 2 + hh) * 16) = pack8f(y[i][s], rn * eg); asm volatile("" : "+v"(qf[i][s])); } } }
        __builtin_amdgcn_sched_barrier(0);
#pragma unroll
        for (int is = 0; is < 2; ++is) {
            float gcr[16];
#pragma unroll
            for (int g = 0; g < 16; ++g) gcr[g] = __shfl(gc, 32 * is + (g & 3) + 8 * (g >> 2) + 4 * hh);
#pragma unroll
            for (int ic = 0; ic < 2; ++ic) {
                if (is == 1 && ic == 0) {
#pragma unroll
                    for (int kq = 0; kq < 2; ++kq) *(v4u*)(rec + 16384 + r * 128 + ((2 + kq) * 2 + hh) * 16) = (v4u){0u, 0u, 0u, 0u};
#pragma unroll
                    for (int g = 0; g < 16; ++g) At[(32 + (g & 3) + 8 * (g >> 2) + 4 * hh) * 68 + r] = 0.f;
                    continue;
                }
                f32x16 pt, pk;
#pragma unroll
                for (int g = 0; g < 16; ++g) { pt[g] = 0.f; pk[g] = 0.f; }
#pragma unroll
                for (int ks = 0; ks < 4; ++ks) { pt = __builtin_amdgcn_mfma_f32_32x32x16_bf16(kf[is][ks], qf[ic][ks], pt, 0, 0, 0); pk = __builtin_amdgcn_mfma_f32_32x32x16_bf16(kf[is][ks], kf[ic][ks], pk, 0, 0, 0); }
                const int ccol = 32 * ic + r;
#pragma unroll
                for (int g = 0; g < 16; ++g) { const int srow = 32 * is + (g & 3) + 8 * (g >> 2) + 4 * hh; const float dec = expf(fminf(gct[ic] - gcr[g], 0.f));
                    pt[g] = (srow <= ccol) ? pt[g] * dec : 0.f;
                    At[srow * 68 + ccol] = (srow < ccol) ? bet[ic] * pk[g] * dec : 0.f; }
#pragma unroll
                for (int kq = 0; kq < 2; ++kq) *(v4u*)(rec + 16384 + ccol * 128 + ((2 * is + kq) * 2 + hh) * 16) = pack8acc(pt, kq);
                __builtin_amdgcn_sched_barrier(0);
            }
        }
    }
    LDSFENCE();
#endif
    __builtin_amdgcn_sched_barrier(0);
#ifndef SKS
    if (opq > 3) {
        int lane = lane_; asm volatile("" : "+v"(lane)); const int r = lane & 31, hh = lane >> 5;
        float t[64];
#pragma unroll
        for (int k = 0; k < 64; ++k) t[k] = (k == lane) ? 1.0f : 0.0f;
#pragma unroll
        for (int j = 62; j >= 0; --j) { float acc = 0.f;
#pragma unroll
            for (int k4 = (j + 1) & ~3; k4 < 64; k4 += 4) { const f32x4 x = *(const volatile LAS f32x4*)(At + j * 68 + k4);
#pragma unroll
                for (int i = 0; i < 4; ++i) if (k4 + i > j) acc += t[k4 + i] * x[i]; }
            t[j] -= acc; asm volatile("" : "+v"(t[j])); }
        LDSFENCE();
#pragma unroll
        for (int i = 0; i < 8; ++i) { v4u o; o.x = pk2(t[8 * i], t[8 * i + 1]); o.y = pk2(t[8 * i + 2], t[8 * i + 3]); o.z = pk2(t[8 * i + 4], t[8 * i + 5]); o.w = pk2(t[8 * i + 6], t[8 * i + 7]);
            *(LAS v4u*)(TT + lane * 72 + 8 * i) = o; }
    }
#endif
    __builtin_amdgcn_sched_barrier(0);
#ifndef SKW
    if (opq > 4) { int lane = lane_; asm volatile("" : "+v"(lane)); const int r = lane & 31, hh = lane >> 5;
      float sc[2] = {bet[0] * expf(gct[0]), bet[1] * expf(gct[1])};
      write_xt(XT, kf, sc, r, hh);
      LDSFENCE();
#pragma unroll
      for (int id = 0; id < 2; ++id)
#pragma unroll
          for (int ic = 0; ic < 2; ++ic) { f32x16 acc;
#pragma unroll
              for (int g = 0; g < 16; ++g) acc[g] = 0.f;
#pragma unroll
              for (int ks = 0; ks < 4; ++ks) { const bf16x8 af = *(const LAS bf16x8*)(XT + (r + 32 * id) * 72 + 16 * ks + 8 * hh), bfr = *(const LAS bf16x8*)(TT + (r + 32 * ic) * 72 + 16 * ks + 8 * hh);
                  acc = __builtin_amdgcn_mfma_f32_32x32x16_bf16(af, bfr, acc, 0, 0, 0); }
#pragma unroll
              for (int kq = 0; kq < 2; ++kq) *(v4u*)(rec + (32 * ic + r) * 128 + ((2 * id + kq) * 2 + hh) * 16) = pack8acc(acc, kq); __builtin_amdgcn_sched_barrier(0); }
      LDSFENCE(); }
    __builtin_amdgcn_sched_barrier(0);
#endif
#ifndef SKU
    if (opq > 1) { int lane = lane_; asm volatile("" : "+v"(lane)); const int r = lane & 31, hh = lane >> 5;
      bf16x8 vf[2][4];
      { float y[2][4][8]; dn_conv_l1(PRE, cw, row0, tin0, 1024 + h * 64, r, hh, y);
#pragma unroll
        for (int i = 0; i < 2; ++i)
#pragma unroll
            for (int s = 0; s < 4; ++s) { vf[i][s] = pack8f(y[i][s], bet[i]); asm volatile("" : "+v"(vf[i][s])); } }
      __builtin_amdgcn_sched_barrier(0);
      float one[2] = {1.0f, 1.0f};
      write_xt(XT, vf, one, r, hh);
      LDSFENCE();
      unsigned* U = (unsigned*)(rec + 32768);
#pragma unroll
      for (int ic = 0; ic < 2; ++ic)
#pragma unroll
          for (int ie = 0; ie < 2; ++ie) { f32x16 acc;
#pragma unroll
              for (int g = 0; g < 16; ++g) acc[g] = 0.f;
#pragma unroll
              for (int ks = 0; ks < 4; ++ks) { const bf16x8 af = *(const LAS bf16x8*)(TT + (r + 32 * ic) * 72 + 16 * ks + 8 * hh), bfr = *(const LAS bf16x8*)(XT + (r + 32 * ie) * 72 + 16 * ks + 8 * hh);
                  acc = __builtin_amdgcn_mfma_f32_32x32x16_bf16(af, bfr, acc, 0, 0, 0); }
#pragma unroll
              for (int gp = 0; gp < 8; ++gp) U[((ie * 2 + ic) * 8 + gp) * 64 + lane] = pk2(acc[2 * gp], acc[2 * gp + 1]); __builtin_amdgcn_sched_barrier(0); }
      LDSFENCE(); }
#endif
    if (lane == 0) ((float*)(F.ws + WS_DNCD))[ch] = expf(gl);
}

__device__ __forceinline__ bf16x8 pack8(const f32x16& X, int s) {
    v4u o; o.x = pg8::cvt_pk_bf16(X[8 * s], X[8 * s + 1]); o.y = pg8::cvt_pk_bf16(X[8 * s + 2], X[8 * s + 3]); o.z = pg8::cvt_pk_bf16(X[8 * s + 4], X[8 * s + 5]); o.w = pg8::cvt_pk_bf16(X[8 * s + 6], X[8 * s + 7]);
    return __builtin_bit_cast(bf16x8, o);
}
__device__ __forceinline__ void dn_scan(Ctx& F, int sw) {
    const int lane = lane_id(), r = lane & 31, hh = lane >> 5;
    const int bh = sw >> 1, sl = sw & 1, b = bh >> 3, h = bh & 7;
    const float* CD = (const float*)(F.ws + WS_DNCD) + bh * 128;
    bf16* ODN = (bf16*)(F.ws + WS_ODN);
    f32x16 S0, S1;
#pragma unroll
    for (int i = 0; i < 16; ++i) { S0[i] = 0.f; S1[i] = 0.f; }
    for (int n = 0; n < 128; ++n) {
        const unsigned char* rec = F.ws + WS_DN + ((size_t)bh * 128 + n) * DN_REC;
        const unsigned char* fb = rec + r * 128 + hh * 16;
        bf16x8 w[2][4], qd[2][4], at[2][4], kt[2][4];
#pragma unroll
        for (int i = 0; i < 2; ++i)
#pragma unroll
            for (int ks = 0; ks < 4; ++ks) { const int o = i * 4096 + ks * 32;
                w[i][ks] = *(const bf16x8*)(fb + o); qd[i][ks] = *(const bf16x8*)(fb + 8192 + o); at[i][ks] = *(const bf16x8*)(fb + 16384 + o); kt[i][ks] = *(const bf16x8*)(fb + 24576 + o); }
        const unsigned* up = (const unsigned*)(rec + 32768) + (sl * 2) * 8 * 64 + lane;
        unsigned uw[2][8];
#pragma unroll
        for (int i = 0; i < 2; ++i)
#pragma unroll
            for (int gp = 0; gp < 8; ++gp) uw[i][gp] = up[(i * 8 + gp) * 64];
        const float cd = CD[n];
        bf16x8 sb[4]; sb[0] = pack8(S0, 0); sb[1] = pack8(S0, 1); sb[2] = pack8(S1, 0); sb[3] = pack8(S1, 1);
        f32x16 ws[2], qs[2];
#pragma unroll
        for (int i = 0; i < 2; ++i) {
#pragma unroll
            for (int g = 0; g < 16; ++g) { ws[i][g] = 0.f; qs[i][g] = 0.f; }
#pragma unroll
            for (int ks = 0; ks < 4; ++ks) { ws[i] = __builtin_amdgcn_mfma_f32_32x32x16_bf16(w[i][ks], sb[ks], ws[i], 0, 0, 0); qs[i] = __builtin_amdgcn_mfma_f32_32x32x16_bf16(qd[i][ks], sb[ks], qs[i], 0, 0, 0); }
        }
#pragma unroll
        for (int i = 0; i < 2; ++i)
#pragma unroll
            for (int gp = 0; gp < 8; ++gp) { ws[i][2 * gp] = bflo(uw[i][gp]) - ws[i][2 * gp]; ws[i][2 * gp + 1] = bfhi(uw[i][gp]) - ws[i][2 * gp + 1]; }
        bf16x8 vb[4]; vb[0] = pack8(ws[0], 0); vb[1] = pack8(ws[0], 1); vb[2] = pack8(ws[1], 0); vb[3] = pack8(ws[1], 1);
#pragma unroll
        for (int g = 0; g < 16; ++g) { S0[g] *= cd; S1[g] *= cd; }
#pragma unroll
        for (int ks = 0; ks < 4; ++ks) {
            qs[0] = __builtin_amdgcn_mfma_f32_32x32x16_bf16(at[0][ks], vb[ks], qs[0], 0, 0, 0);
            qs[1] = __builtin_amdgcn_mfma_f32_32x32x16_bf16(at[1][ks], vb[ks], qs[1], 0, 0, 0);
            S0 = __builtin_amdgcn_mfma_f32_32x32x16_bf16(kt[0][ks], vb[ks], S0, 0, 0, 0);
            S1 = __builtin_amdgcn_mfma_f32_32x32x16_bf16(kt[1][ks], vb[ks], S1, 0, 0, 0);
        }
        bf16* orow = ODN + ((size_t)b * T + 64 * n) * 512 + h * 64 + 32 * sl + r;
#pragma unroll
        for (int i = 0; i < 2; ++i)
#pragma unroll
            for (int g = 0; g < 16; ++g) { const int c = 32 * i + (g & 3) + 8 * (g >> 2) + 4 * hh; orow[(size_t)c * 512] = (bf16)f2bf(qs[i][g]); }
    }
}

constexpr int SC_SLOT = 4 * 9216 + 8192, SC_NPIECE = DN_REC / 16, SC_LANES = 6 * 64, SC_PPL = (SC_NPIECE + SC_LANES - 1) / SC_LANES;
static_assert(3 * SC_SLOT <= RING_BYTES, "scan ring fits the phase scratch");
__device__ __forceinline__ int sc_piece_off(int p) { return p < 2048 ? (p >> 9) * 9216 + ((p & 511) >> 3) * 144 + (p & 7) * 16 : 36864 + (p - 2048) * 16; }
__device__ __forceinline__ void dn_scan_block(Ctx& F, int bh) {
    const int lane = lane_id(), wave = F.wave;
    LAS unsigned char* ring = F.lds + RING_OFF;
    const unsigned char* recs = F.ws + WS_DN + (size_t)bh * 128 * DN_REC;
#define SC_BAR() asm volatile("s_waitcnt vmcnt(0) lgkmcnt(0)\n\ts_barrier" ::: "memory")
    if (wave >= 2) {
        const int ll = (wave - 2) * 64 + lane; v4u d0[SC_PPL], d1[SC_PPL], d2[SC_PPL], d3[SC_PPL];
#define SC_LOAD(D, rec_) do { _Pragma("unroll") for (int j = 0; j < SC_PPL; ++j) { const int p = ll + j * SC_LANES; if (p < SC_NPIECE) D[j] = *(const v4u*)(recs + (size_t)(rec_) * DN_REC + p * 16); } } while (0)
#define SC_STORE(D, slot_) do { _Pragma("unroll") for (int j = 0; j < SC_PPL; ++j) { const int p = ll + j * SC_LANES; if (p < SC_NPIECE) *(LAS v4u*)(ring + (slot_) * SC_SLOT + sc_piece_off(p)) = D[j]; } } while (0)
#define SC_LBAR() asm volatile("s_waitcnt lgkmcnt(0)\n\ts_barrier" ::: "memory")
        SC_LOAD(d0, 0); SC_LOAD(d1, 1); SC_STORE(d0, 0); SC_STORE(d1, 1);
        SC_LOAD(d0, 2); SC_LOAD(d1, 3); SC_LOAD(d2, 4); SC_LOAD(d3, 5);
        SC_LBAR();
#define SC_STEP(D, n_, slot_) do { if ((n_) + 2 < 128) SC_STORE(D, slot_); if ((n_) + 6 < 128) SC_LOAD(D, (n_) + 6); SC_LBAR(); } while (0)
#pragma unroll 1
        for (int n = 0; n < 128; n += 12) {
            SC_STEP(d0, n, 2); SC_STEP(d1, n + 1, 0); SC_STEP(d2, n + 2, 1); SC_STEP(d3, n + 3, 2);
            SC_STEP(d0, n + 4, 0); SC_STEP(d1, n + 5, 1); SC_STEP(d2, n + 6, 2); SC_STEP(d3, n + 7, 0);
            if (n + 8 < 128) { SC_STEP(d0, n + 8, 1); SC_STEP(d1, n + 9, 2); SC_STEP(d2, n + 10, 0); SC_STEP(d3, n + 11, 1); }
        }
#undef SC_LOAD
#undef SC_STORE
#undef SC_STEP
#undef SC_LBAR
    } else {
        const int r = lane & 31, hh = lane >> 5, sl = wave, b = bh >> 3, h = bh & 7;
        const float* CD = (const float*)(F.ws + WS_DNCD) + bh * 128;
        bf16* ODN = (bf16*)(F.ws + WS_ODN);
        f32x16 S0, S1;
#pragma unroll
        for (int i = 0; i < 16; ++i) { S0[i] = 0.f; S1[i] = 0.f; }
        float cd = CD[0];
        asm volatile("s_waitcnt lgkmcnt(0)\n\ts_barrier" ::: "memory");
        int slot = 0;
#pragma unroll 1
        for (int n = 0; n < 128; ++n) {
            const LAS unsigned char* sb_ = ring + slot * SC_SLOT; const LAS unsigned char* fb = sb_ + r * 144 + hh * 16;
            const float cdn = CD[n + 1 < 128 ? n + 1 : n];
            bf16x8 w[2][4], qd[2][4];
#pragma unroll
            for (int i = 0; i < 2; ++i)
#pragma unroll
                for (int ks = 0; ks < 4; ++ks) { const int o = i * 32 * 144 + ks * 32; w[i][ks] = *(const LAS bf16x8*)(fb + o); qd[i][ks] = *(const LAS bf16x8*)(fb + 9216 + o); }
            bf16x8 sb[4]; sb[0] = pack8(S0, 0); sb[1] = pack8(S0, 1); sb[2] = pack8(S1, 0); sb[3] = pack8(S1, 1);
            f32x16 ws[2], qs[2];
#pragma unroll
            for (int i = 0; i < 2; ++i) {
#pragma unroll
                for (int g = 0; g < 16; ++g) { ws[i][g] = 0.f; qs[i][g] = 0.f; }
#pragma unroll
                for (int ks = 0; ks < 4; ++ks) { ws[i] = __builtin_amdgcn_mfma_f32_32x32x16_bf16(w[i][ks], sb[ks], ws[i], 0, 0, 0); qs[i] = __builtin_amdgcn_mfma_f32_32x32x16_bf16(qd[i][ks], sb[ks], qs[i], 0, 0, 0); }
            }
            bf16x8 at[2][4], kt[2][4];
#pragma unroll
            for (int i = 0; i < 2; ++i)
#pragma unroll
                for (int ks = 0; ks < 4; ++ks) { const int o = i * 32 * 144 + ks * 32; at[i][ks] = *(const LAS bf16x8*)(fb + 2 * 9216 + o); kt[i][ks] = *(const LAS bf16x8*)(fb + 3 * 9216 + o); }
            const LAS unsigned* up = (const LAS unsigned*)(sb_ + 36864) + (sl * 2) * 8 * 64 + lane;
#pragma unroll
            for (int i = 0; i < 2; ++i)
#pragma unroll
                for (int gp = 0; gp < 8; ++gp) { const unsigned uw = up[(i * 8 + gp) * 64]; ws[i][2 * gp] = bflo(uw) - ws[i][2 * gp]; ws[i][2 * gp + 1] = bfhi(uw) - ws[i][2 * gp + 1]; }
            bf16x8 vb[4]; vb[0] = pack8(ws[0], 0); vb[1] = pack8(ws[0], 1); vb[2] = pack8(ws[1], 0); vb[3] = pack8(ws[1], 1);
#pragma unroll
            for (int g = 0; g < 16; ++g) { S0[g] *= cd; S1[g] *= cd; }
#pragma unroll
            for (int ks = 0; ks < 4; ++ks) {
                S0 = __builtin_amdgcn_mfma_f32_32x32x16_bf16(kt[0][ks], vb[ks], S0, 0, 0, 0);
                S1 = __builtin_amdgcn_mfma_f32_32x32x16_bf16(kt[1][ks], vb[ks], S1, 0, 0, 0);
                qs[0] = __builtin_amdgcn_mfma_f32_32x32x16_bf16(at[0][ks], vb[ks], qs[0], 0, 0, 0);
                qs[1] = __builtin_amdgcn_mfma_f32_32x32x16_bf16(at[1][ks], vb[ks], qs[1], 0, 0, 0);
            }
            bf16* orow = ODN + ((size_t)b * T + 64 * n) * 512 + h * 64 + 32 * sl + r;
#pragma unroll
            for (int i = 0; i < 2; ++i)
#pragma unroll
                for (int g = 0; g < 16; ++g) { const int c = 32 * i + (g & 3) + 8 * (g >> 2) + 4 * hh; orow[(size_t)c * 512] = (bf16)f2bf(qs[i][g]); }
            cd = cdn; slot = (slot == 2) ? 0 : slot + 1;
            asm volatile("s_waitcnt lgkmcnt(0)\n\ts_barrier" ::: "memory");
        }
    }
    SC_BAR();
#undef SC_BAR
}

__device__ __forceinline__ void qk_norm_max(Ctx& F) {
    const int gw = F.vcu * NWAVES + F.wave, NGW = F.G * NWAVES, lane = lane_id(), j = lane >> 3;
    const bf16* QO = (const bf16*)(F.ws + WS_QO); const bf16* KD = (const bf16*)(F.ws + WS_KD);
    float mq[2] = {0.f, 0.f}, mk[2] = {0.f, 0.f};
    for (int m = gw; m < M; m += NGW) {
        const v4u qv = *(const v4u*)(QO + (size_t)m * 1024 + (2 * j) * 64 + (lane & 7) * 8), kv = *(const v4u*)(KD + (size_t)m * 512 + lane * 8);
        float sq = 0.f, sk = 0.f;
#pragma unroll
        for (int e = 0; e < 4; ++e) { const float a = bflo(qv[e]), b2 = bfhi(qv[e]), c = bflo(kv[e]), d = bfhi(kv[e]); sq += a * a + b2 * b2; sk += c * c + d * d; }
        sq += __shfl_xor(sq, 1); sq += __shfl_xor(sq, 2); sq += __shfl_xor(sq, 4);
        sk += __shfl_xor(sk, 1); sk += __shfl_xor(sk, 2); sk += __shfl_xor(sk, 4);
        const int bb = m >> 13;
        if (bb == 0) { mq[0] = fmaxf(mq[0], sq); mk[0] = fmaxf(mk[0], sk); } else { mq[1] = fmaxf(mq[1], sq); mk[1] = fmaxf(mk[1], sk); }
    }
    if ((lane & 7) == 0) { unsigned* nm = (unsigned*)(F.ws + WS_CTL) + CW_NMAX;
#pragma unroll
        for (int bb = 0; bb < 2; ++bb) { atomicMax(nm + bb * 8 + j, __float_as_uint(mq[bb])); atomicMax(nm + 16 + bb * 8 + j, __float_as_uint(mk[bb])); } }
}

__device__ __forceinline__ void finalize_rows(Ctx& F) {
    const int gw = F.vcu * NWAVES + F.wave, NGW = F.G * NWAVES, lane = lane_id();
    const bf16* ODN = (const bf16*)(F.ws + WS_ODN); const bf16* Z = (const bf16*)(F.ws + WS_Z); const bf16* QO = (const bf16*)(F.ws + WS_QO);
    bf16* AA = (bf16*)(F.ws + WS_AA); bf16* ABB = (bf16*)(F.ws + WS_ABB);
    float s1 = 0.f, s2 = 0.f;
    { const float a = F.in[11][lane] * F.in[12][lane], bq = F.in[13][lane] * F.in[14][lane]; s1 = wave_sum(a); s2 = wave_sum(bq); }
    const float lam_init = 0.2f;
    const float lam = expf(s1) - expf(s2) + lam_init;
    float gdn[8], gsub[8];
#pragma unroll
    for (int e = 0; e < 8; ++e) { gdn[e] = F.in[10][(lane & 7) * 8 + e]; gsub[e] = F.in[15][(lane & 15) * 8 + e] * (1.0f - lam_init); }
    for (int m = gw; m < M; m += NGW) {
        { const v4u ov = *(const v4u*)(ODN + (size_t)m * 512 + lane * 8), zv = *(const v4u*)(Z + (size_t)m * 512 + lane * 8);
          float o[8], z[8]; float ss = 0.f;
#pragma unroll
          for (int e = 0; e < 4; ++e) { o[2 * e] = bflo(ov[e]); o[2 * e + 1] = bfhi(ov[e]); z[2 * e] = bflo(zv[e]); z[2 * e + 1] = bfhi(zv[e]); }
#pragma unroll
          for (int e = 0; e < 8; ++e) ss += o[e] * o[e];
          ss += __shfl_xor(ss, 1); ss += __shfl_xor(ss, 2); ss += __shfl_xor(ss, 4);
          const float rn = 1.0f / sqrtf(ss * (1.0f / 64.0f) + RMS_EPS);
          float y[8];
#pragma unroll
          for (int e = 0; e < 8; ++e) y[e] = o[e] * rn * gdn[e] * silu_acc(z[e]);
          v4u w; w.x = pk2(y[0], y[1]); w.y = pk2(y[2], y[3]); w.z = pk2(y[4], y[5]); w.w = pk2(y[6], y[7]);
          *(v4u*)(AA + (size_t)m * 512 + lane * 8) = w; }
        { const int hd = lane >> 4, e0 = (lane & 15) * 8;
          const v4u a1 = *(const v4u*)(QO + (size_t)m * 1024 + hd * 256 + e0), a2 = *(const v4u*)(QO + (size_t)m * 1024 + hd * 256 + 128 + e0);
          float o[8]; float ss = 0.f;
#pragma unroll
          for (int e = 0; e < 4; ++e) { o[2 * e] = bflo(a1[e]) - lam * bflo(a2[e]); o[2 * e + 1] = bfhi(a1[e]) - lam * bfhi(a2[e]); }
#pragma unroll
          for (int e = 0; e < 8; ++e) ss += o[e] * o[e];
          ss += __shfl_xor(ss, 1); ss += __shfl_xor(ss, 2); ss += __shfl_xor(ss, 4); ss += __shfl_xor(ss, 8);
          const float rn = 1.0f / sqrtf(ss * (1.0f / 128.0f) + SUBLN_EPS);
          float y[8];
#pragma unroll
          for (int e = 0; e < 8; ++e) y[e] = o[e] * rn * gsub[e];
          v4u w; w.x = pk2(y[0], y[1]); w.y = pk2(y[2], y[3]); w.z = pk2(y[4], y[5]); w.w = pk2(y[6], y[7]);
          *(v4u*)(ABB + (size_t)m * 512 + hd * 128 + e0) = w; }
    }
}
__device__ __forceinline__ void final_norm_rows(Ctx& F) {
    const int lane = lane_id();
    const int gw = F.vcu * NWAVES + F.wave, NGW = F.G * NWAVES;
    const f32x4* gp = (const f32x4*)F.in[23] + lane; f32x4 gg[4];
#pragma unroll
    for (int j = 0; j < 4; ++j) gg[j] = gp[64 * j];
    for (int m = gw; m < M; m += NGW) {
        f32x4* xr = (f32x4*)(F.out + (size_t)m * D) + lane; f32x4 v[4]; float s = 0.f;
#pragma unroll
        for (int j = 0; j < 4; ++j) { v[j] = xr[64 * j]; s += (v[j].x * v[j].x + v[j].y * v[j].y) + (v[j].z * v[j].z + v[j].w * v[j].w); }
        const float rn = 1.0f / sqrtf(wave_sum(s) * (1.0f / D) + RMS_EPS);
#pragma unroll
        for (int j = 0; j < 4; ++j) xr[64 * j] = v[j] * rn * gg[j];
    }
}

constexpr int N_PHASES = 14;
struct Args { const float* in[24]; float* out; unsigned char* ws; int ph_lo, ph_hi; };
__global__ void __launch_bounds__(NWAVES * 64, 2) mk_fwd(Args args) {
    extern __shared__ __attribute__((aligned(16))) unsigned char lds[];
    Ctx F;
    F.in = args.in;
    F.out = args.out; F.ws = args.ws;
    F.lds = (LAS unsigned char*)lds;
    F.wave = __builtin_amdgcn_readfirstlane((int)threadIdx.x >> 6);
    F.G = gridDim.x; { const int bx = blockIdx.x; F.vcu = (F.G % 8 == 0) ? (bx % 8) * (F.G / 8) + bx / 8 : bx; }
    const int lo = args.ph_lo, hi = args.ph_hi;
    { volatile LAS unsigned* misc = (volatile LAS unsigned*)(F.lds + MISC_OFF); if (F.wave == 0) misc[lane_id()] = 0u; }
    __syncthreads();
    XcdBarrier bar = xcd_barrier_post((unsigned*)(args.ws + WS_CTL) + CW_BAR, (volatile LAS unsigned*)(F.lds + MISC_OFF) + 8, F.wave);
    if (lo < -7) cg::this_grid().sync();
    unsigned char* ws = F.ws;
    typedef pg8::bf16_t pb;
#ifndef PH_MASK
#define PH_MASK 0x3fff
#endif
#define IN(k) (((PH_MASK >> (k)) & 1) && lo <= (k) && (k) < hi)
#ifndef PROBE_A
#define PROBE_A -1
#endif
#ifndef PROBE_B
#define PROBE_B -1
#endif
#define STAMP(k) do { if (PROBE_A >= 0 && blockIdx.x == 0 && F.wave == 0 && lane_id() == 0) ((volatile unsigned long long*)(args.ws + WS_CTL + 32768))[k] = __builtin_amdgcn_s_memrealtime(); } while (0)
#define SEAM(k) do { if (IN(k) && IN((k) + 1)) xcd_barrier(bar); STAMP((k) + 1); } while (0)

    STAMP(0);
    if (IN(0)) { p0_prologue(F); } SEAM(0);
    if (IN(1)) { pg8::Gemm g{(const pb*)(ws + WS_XB), (const pb*)(ws + WS_WGU1), M, 2 * FF, D}; pg8::StaticOrder S; S.init(M, 2 * FF, F.G, (int)blockIdx.x);
        pg8::EpiSwiGLU E{(pb*)(ws + WS_H), FF, (const float*)(ws + WS_SSQA), RMS_EPS};
        pg8::gemm_phase<pg8::EpiSwiGLU, pg8::StaticOrder, true, true>(F.lds + RING_OFF, g, S, E, F.wave); } SEAM(1);
    if (IN(2)) { pg8::Gemm g{(const pb*)(ws + WS_H), (const pb*)(ws + WS_WD1), M, D, FF}; pg8::StaticOrder S; S.init(M, D, F.G, (int)blockIdx.x);
        pg8::EpiResid E{F.in[0], F.out, (pb*)(ws + WS_XB), (float*)(ws + WS_SSQB), 0.5f};
        pg8::gemm_phase<pg8::EpiResid, pg8::StaticOrder, true, true>(F.lds + RING_OFF, g, S, E, F.wave); } SEAM(2);
    if (IN(3)) { pg8::Gemm g{(const pb*)(ws + WS_XB), (const pb*)(ws + WS_WIN), M, WIN_N, D}; pg8::StaticOrder S; S.init(M, WIN_N, F.G, (int)blockIdx.x);
        pg8::EpiWin E{(pb*)(ws + WS_PRE), (pb*)(ws + WS_Z), (pb*)(ws + WS_QO), (pb*)(ws + WS_KD), (pb*)(ws + WS_VD), (float*)(ws + WS_AB), (const float*)(ws + WS_SSQB), RMS_EPS, attn_body::C2};
        pg8::gemm_phase<pg8::EpiWin, pg8::StaticOrder, true, true>(F.lds + RING_OFF, g, S, E, F.wave); } SEAM(3);
    if (IN(4)) { LAS unsigned char* scr = F.lds + RING_OFF + F.wave * 18432; const int gw = F.vcu * NWAVES + F.wave, NGW = F.G * NWAVES;
        for (int ch = gw; ch < 2048; ch += NGW) dn_prep_chunk(F, ch, scr, hi);
        qk_norm_max(F); } SEAM(4);
    if (IN(5)) {
        if (blockIdx.x < 16) dn_scan_block(F, (int)blockIdx.x);
        const attn_body::AttnTensors AT{(const attn_body::bf16*)(ws + WS_QO), (const attn_body::bf16*)(ws + WS_KD), (const attn_body::bf16*)(ws + WS_VD), (attn_body::bf16*)(ws + WS_QO), (const unsigned*)(ws + WS_CTL) + CW_NMAX};
        const attn_body::DynOrder S{(unsigned*)(ws + WS_CTL) + CW_ATTQ, (volatile LAS unsigned*)(F.lds + MISC_OFF) + 16, (int)(blockIdx.x & 7), F.wave};
        attn_body::attn_phase<attn_body::DynOrder>((char*)lds + RING_OFF, AT, S, F.wave); } SEAM(5);
    if (IN(7)) { finalize_rows(F); conv_ffn2(F); } SEAM(7);
    if (IN(8)) { pg8::StaticOrder S; S.init(M, D, F.G, (int)blockIdx.x);
        { pg8::Gemm g{(const pb*)(ws + WS_AA), (const pb*)(ws + WS_WA), M, D, 512}; pg8::EpiStoreBf16 E{(pb*)(ws + WS_YA), D};
          pg8::gemm_phase<pg8::EpiStoreBf16, pg8::StaticOrder, true, true>(F.lds + RING_OFF, g, S, E, F.wave); }
        { pg8::Gemm g{(const pb*)(ws + WS_ABB), (const pb*)(ws + WS_WB), M, D, 512}; pg8::EpiStoreBf16 E{(pb*)(ws + WS_YB), D};
          pg8::gemm_phase<pg8::EpiStoreBf16, pg8::StaticOrder, true, true>(F.lds + RING_OFF, g, S, E, F.wave); } } SEAM(8);
    if (IN(9)) { pg8::Gemm g{(const pb*)(ws + WS_XB), (const pb*)(ws + WS_WG), M, 2 * D, D}; pg8::StaticOrder S; S.init(M, 2 * D, F.G, (int)blockIdx.x);
        pg8::EpiGateMerge E{(const pb*)(ws + WS_YA), (const pb*)(ws + WS_YB), (pb*)(ws + WS_MG), (const float*)(ws + WS_SSQB), RMS_EPS};
        pg8::gemm_phase<pg8::EpiGateMerge, pg8::StaticOrder, true, true>(F.lds + RING_OFF, g, S, E, F.wave); } SEAM(9);
    if (IN(10)) { pg8::Gemm g{(const pb*)(ws + WS_MG), (const pb*)(ws + WS_WOUT), M, D, D}; pg8::StaticOrder S; S.init(M, D, F.G, (int)blockIdx.x);
        pg8::EpiResid E{F.out, F.out, (pb*)(ws + WS_XB), (float*)(ws + WS_SSQA), 1.0f};
        pg8::gemm_phase<pg8::EpiResid, pg8::StaticOrder, true, true>(F.lds + RING_OFF, g, S, E, F.wave); } SEAM(10);
    if (IN(11)) { pg8::Gemm g{(const pb*)(ws + WS_XB), (const pb*)(ws + WS_WGU2), M, 2 * FF, D}; pg8::StaticOrder S; S.init(M, 2 * FF, F.G, (int)blockIdx.x);
        pg8::EpiSwiGLU E{(pb*)(ws + WS_H), FF, (const float*)(ws + WS_SSQA), RMS_EPS};
        pg8::gemm_phase<pg8::EpiSwiGLU, pg8::StaticOrder, true, true>(F.lds + RING_OFF, g, S, E, F.wave); } SEAM(11);
    if (IN(12)) { pg8::Gemm g{(const pb*)(ws + WS_H), (const pb*)(ws + WS_WD2), M, D, FF}; pg8::StaticOrder S; S.init(M, D, F.G, (int)blockIdx.x);
        pg8::EpiResid E{F.out, F.out, (pb*)(ws + WS_XB), (float*)(ws + WS_SSQB), 0.5f};
        pg8::gemm_phase<pg8::EpiResid, pg8::StaticOrder, true, true>(F.lds + RING_OFF, g, S, E, F.wave); } SEAM(12);
    if (IN(13)) { final_norm_rows(F); } STAMP(14);
    if (PROBE_A >= 0) {
        xcd_barrier(bar);
        if (blockIdx.x == 0 && F.wave == 0) { volatile unsigned long long* ts = (volatile unsigned long long*)(args.ws + WS_CTL + 32768); const int l = lane_id();
            const float da = (float)(ts[PROBE_A + 1] - ts[PROBE_A]) * 0.01f, db = (float)(ts[PROBE_B + 1] - ts[PROBE_B]) * 0.01f;
            for (int i = l; i < 16384; i += 64) F.out[(size_t)i * 1024 + 512] = db;
            if (l == 0) F.out[0] = da; }
    }
#undef IN
#undef SEAM
}

#ifndef MK_N_LAUNCHES
#define MK_N_LAUNCHES 1
#endif
extern "C" void kernel_launch(void* const* d_in, const int* in_sizes, int n_in, void* d_out, int out_size, void* d_ws, size_t ws_size, hipStream_t stream) {
    static int grid = 0;
    if (grid == 0) {
        if (n_in != 24 || in_sizes[0] != M * D || out_size != M * D || ws_size < WS_END) { fprintf(stderr, "kernel_launch: unexpected shapes (n_in %d, in0 %d, out %d, ws %zu)\n", n_in, n_in > 0 ? in_sizes[0] : -1, out_size, ws_size); grid = -1; return; }
        int dev = 0, cus = 0, per_cu = 0;
        if (hipGetDevice(&dev) != hipSuccess || hipDeviceGetAttribute(&cus, hipDeviceAttributeMultiprocessorCount, dev) != hipSuccess) { grid = -1; return; }
        if (hipFuncSetAttribute((const void*)mk_fwd, hipFuncAttributeMaxDynamicSharedMemorySize, LDS_BYTES) != hipSuccess) { fprintf(stderr, "kernel_launch: hipFuncSetAttribute failed\n"); grid = -1; return; }
        if (hipOccupancyMaxActiveBlocksPerMultiprocessor(&per_cu, (const void*)mk_fwd, NWAVES * 64, LDS_BYTES) != hipSuccess || per_cu < 1) { fprintf(stderr, "kernel_launch: occupancy query says %d\n", per_cu); per_cu = 1; }
        (void)hipGetLastError();
        grid = cus;
    }
    if (grid < 0) return;
    if (hipMemsetAsync((char*)d_ws + WS_CTL, 0, CTL_ZERO_BYTES, stream) != hipSuccess) { fprintf(stderr, "kernel_launch: hipMemsetAsync failed\n"); return; }
    Args a{};
    for (int i = 0; i < 24; ++i) a.in[i] = (const float*)d_in[i];
    a.out = (float*)d_out; a.ws = (unsigned char*)d_ws;
#if MK_N_LAUNCHES == 1
    a.ph_lo = 0; a.ph_hi = N_PHASES;
    void* kargs[] = {&a};
    hipError_t e = hipLaunchCooperativeKernel((const void*)mk_fwd, dim3(grid), dim3(NWAVES * 64), kargs, LDS_BYTES, stream);
    if (e != hipSuccess) fprintf(stderr, "kernel_launch: cooperative launch failed: %s (grid %d)\n", hipGetErrorString(e), grid);
#else
    for (int p = 0; p < N_PHASES; ++p) { a.ph_lo = p; a.ph_hi = p + 1; hipLaunchKernelGGL(mk_fwd, dim3(grid), dim3(NWAVES * 64), LDS_BYTES, stream, a); }
#endif
}
```

```cpp
#include <hip/hip_runtime.h>
#include <hip/hip_cooperative_groups.h>
#include <cstdio>
#include <cstdint>
namespace cg = cooperative_groups;
__device__ __forceinline__ int lane_id() { int l = (int)__builtin_amdgcn_mbcnt_hi(~0u, __builtin_amdgcn_mbcnt_lo(~0u, 0u)); asm volatile("" : "+v"(l)); return l; }
namespace pg8 {
#define PG8_LAS __attribute__((address_space(3)))
typedef unsigned short bf16_t;
typedef short bf16x8 __attribute__((ext_vector_type(8)));
typedef float f32x4 __attribute__((ext_vector_type(4)));
typedef unsigned u32x4 __attribute__((ext_vector_type(4)));
constexpr int BM = 256, BK = 64, HALF = 128, HTB = HALF * BK * 2  , STAGE_BYTES = 8 * HTB, NXCD = 8, WGM = 8;

__host__ __device__ __forceinline__ int lds_byte(int r, int c) { const int st = (r >> 4) * 2 + (c >> 5), rr = r & 15, cc = c & 31, ob = rr * 64 + cc * 2; return st * 1024 + (ob ^ (((ob >> 9) & 1) << 5)); }
__host__ __device__ __forceinline__ void stage_rc(int b, int& R, int& C) { const int st = b / 1024, sb = b % 1024, swz = sb ^ (((sb >> 9) & 1) << 5); R = (st >> 1) * 16 + swz / 64; C = (st & 1) * 32 + (swz % 64) / 2; }
__host__ __device__ __forceinline__ int perm32(int rho) { const int n = rho >> 4, i = rho & 15; return 8 * (i >> 2) + 4 * n + (i & 3); }

struct Unit { int pm, pn; };
struct Gemm { const bf16_t* A; const bf16_t* Bt; int M, N, K; };

struct StaticOrder {
    int nM, nN, nwg, G, c;
    __host__ __device__ void init(int M, int N, int G_, int c_) { nM = M / BM; nN = N / BM; nwg = nM * nN; G = G_; c = c_; }
    __host__ __device__ bool next(int i, Unit& u) const {
        const long L = (long)i * G + c; if (L >= nwg) return false;
        int wgid = (int)L; { const int q = nwg / NXCD, r = nwg % NXCD, xcd = wgid % NXCD, off = wgid / NXCD; wgid = (xcd < r ? xcd * (q + 1) : r * (q + 1) + (xcd - r) * q) + off; }
        const int nig = WGM * nN, gid = wgid / nig, fm = gid * WGM, gsz = (nM - fm) < WGM ? (nM - fm) : WGM;
        u.pm = fm + ((wgid % nig) % gsz); u.pn = (wgid % nig) / gsz; return true;
    }
    __device__ __forceinline__ void a_ready(const Unit&) const {}
    __device__ __forceinline__ void done(const Unit&) const {}
};

__device__ __forceinline__ unsigned cvt_pk_bf16(float lo, float hi) { unsigned r; asm volatile("v_cvt_pk_bf16_f32 %0, %1, %2" : "=v"(r) : "v"(lo), "v"(hi)); return r; }
__device__ __forceinline__ float fast_sigmoid(float v) { return __builtin_amdgcn_rcpf(1.0f + __builtin_amdgcn_exp2f(-1.4426950408889634f * v)); }
__device__ __forceinline__ float fast_silu(float v) { return v * fast_sigmoid(v); }
__device__ __forceinline__ void load_rs(float (&rs)[2][4], const float* ssq, int row0, float eps) {
#pragma unroll
    for (int ai = 0; ai < 2; ++ai)
#pragma unroll
        for (int m = 0; m < 4; ++m) { const f32x4* p = (const f32x4*)(ssq + (size_t)(row0 + ai * HALF + m * 16) * 16); const f32x4 a = p[0], b = p[1], c = p[2], d = p[3];
            const float s = ((a[0] + a[1]) + (a[2] + a[3])) + ((b[0] + b[1]) + (b[2] + b[3])) + ((c[0] + c[1]) + (c[2] + c[3])) + ((d[0] + d[1]) + (d[2] + d[3]));
            rs[ai][m] = 1.0f / sqrtf(s * (1.0f / 1024.0f) + eps); }
}
struct EpiSwiGLU {
    static constexpr bool PERM = true, AFTER_DRAIN = false;
    bf16_t* H; int ldh; const float* ssq; float eps;
    __device__ __forceinline__ void operator()(const f32x4 (&acc)[2][2][4][2], const Unit& u, int wr, int wc, int fr, int fq) const {
        const int row0 = u.pm * BM + wr * 64 + fr, col0 = u.pn * HALF + wc * 32 + 8 * fq;
        float rs[2][4]; load_rs(rs, ssq, row0, eps);
#pragma unroll
        for (int ai = 0; ai < 2; ++ai)
#pragma unroll
            for (int m = 0; m < 4; ++m) { bf16_t* rowp = H + (size_t)(row0 + ai * HALF + m * 16) * ldh + col0; const float s = rs[ai][m];
                float h[8];
#pragma unroll
                for (int n = 0; n < 2; ++n)
#pragma unroll
                    for (int j = 0; j < 4; ++j) h[n * 4 + j] = fast_silu(acc[ai][0][m][n][j] * s) * (acc[ai][1][m][n][j] * s);
                u32x4 w; w.x = cvt_pk_bf16(h[0], h[1]); w.y = cvt_pk_bf16(h[2], h[3]); w.z = cvt_pk_bf16(h[4], h[5]); w.w = cvt_pk_bf16(h[6], h[7]);
                *(u32x4*)rowp = w; }
    }
};
struct EpiResid {
    static constexpr bool PERM = false, AFTER_DRAIN = false;
    const float* base; float* out; bf16_t* xb; float* ssq_out; float scale;
    __device__ __forceinline__ void operator()(const f32x4 (&acc)[2][2][4][2], const Unit& u, int wr, int wc, int fr, int fq) const {
        typedef unsigned u32x2v __attribute__((ext_vector_type(2)));
        const int row0 = u.pm * BM + wr * 64 + fr, col0 = u.pn * BM + wc * 32 + 4 * fq;
#pragma unroll
        for (int ai = 0; ai < 2; ++ai)
#pragma unroll
            for (int m = 0; m < 4; ++m) { const int row = row0 + ai * HALF + m * 16; const size_t off = (size_t)row * 1024 + col0; float ss = 0.f;
#pragma unroll
                for (int bj = 0; bj < 2; ++bj)
#pragma unroll
                    for (int n = 0; n < 2; ++n) { const f32x4 bs = *(const f32x4*)(base + off + bj * HALF + n * 16); const f32x4 o = bs + acc[ai][bj][m][n] * scale;
                        *(f32x4*)(out + off + bj * HALF + n * 16) = o; ss += (o[0] * o[0] + o[1] * o[1]) + (o[2] * o[2] + o[3] * o[3]);
                        u32x2v w; w.x = cvt_pk_bf16(o[0], o[1]); w.y = cvt_pk_bf16(o[2], o[3]); *(u32x2v*)(xb + off + bj * HALF + n * 16) = w; }
                ss += __shfl_xor(ss, 16); ss += __shfl_xor(ss, 32);
                if (fq == 0) ssq_out[(size_t)row * 16 + u.pn * 4 + wc] = ss; }
    }
};
struct EpiStoreBf16 {
    static constexpr bool PERM = true, AFTER_DRAIN = false;
    bf16_t* O; int ldc;
    __device__ __forceinline__ void operator()(const f32x4 (&acc)[2][2][4][2], const Unit& u, int wr, int wc, int fr, int fq) const {
        const int row0 = u.pm * BM + wr * 64 + fr, col0 = u.pn * BM + wc * 32 + 8 * fq;
#pragma unroll
        for (int ai = 0; ai < 2; ++ai)
#pragma unroll
            for (int m = 0; m < 4; ++m) { bf16_t* rowp = O + (size_t)(row0 + ai * HALF + m * 16) * ldc + col0;
#pragma unroll
                for (int bj = 0; bj < 2; ++bj) { const f32x4 v0 = acc[ai][bj][m][0], v1 = acc[ai][bj][m][1];
                    u32x4 w; w.x = cvt_pk_bf16(v0[0], v0[1]); w.y = cvt_pk_bf16(v0[2], v0[3]); w.z = cvt_pk_bf16(v1[0], v1[1]); w.w = cvt_pk_bf16(v1[2], v1[3]);
                    *(u32x4*)(rowp + bj * HALF) = w; } }
    }
};
struct EpiWin {
    static constexpr bool PERM = true, AFTER_DRAIN = false;
    bf16_t *PRE, *Z, *QO, *KD, *VD; float* AB; const float* ssq; float eps, qscale;
    __device__ __forceinline__ void operator()(const f32x4 (&acc)[2][2][4][2], const Unit& u, int wr, int wc, int fr, int fq) const {
        const int row0 = u.pm * BM + wr * 64 + fr, cl0 = wc * 32 + 8 * fq, pn = u.pn;
        float rs[2][4]; load_rs(rs, ssq, row0, eps);
        if (pn == 14) {
            if (wc == 0 && fq < 2) {
#pragma unroll
                for (int ai = 0; ai < 2; ++ai)
#pragma unroll
                    for (int m = 0; m < 4; ++m) { float* rowp = AB + (size_t)(row0 + ai * HALF + m * 16) * 16 + 8 * fq; const float s = rs[ai][m];
                        *(f32x4*)rowp = acc[ai][0][m][0] * s; *(f32x4*)(rowp + 4) = acc[ai][0][m][1] * s; }
            }
            return;
        }
        bf16_t* base; int ld, cb; float sc = 1.f; bool dup = false;
        if (pn < 6) { base = PRE; ld = 1536; cb = pn * 256; }
        else if (pn < 8) { base = Z; ld = 512; cb = (pn - 6) * 256; }
        else if (pn < 10) { base = QO; ld = 1024; cb = (pn - 8) * 256; sc = qscale; dup = true; }
        else if (pn < 12) { base = KD; ld = 512; cb = (pn - 10) * 256; }
        else { base = VD; ld = 512; cb = (pn - 12) * 256; }
#pragma unroll
        for (int ai = 0; ai < 2; ++ai)
#pragma unroll
            for (int m = 0; m < 4; ++m) { const float s = rs[ai][m] * sc; bf16_t* rowp = base + (size_t)(row0 + ai * HALF + m * 16) * ld;
#pragma unroll
                for (int bj = 0; bj < 2; ++bj) { const f32x4 v0 = acc[ai][bj][m][0] * s, v1 = acc[ai][bj][m][1] * s;
                    u32x4 w; w.x = cvt_pk_bf16(v0[0], v0[1]); w.y = cvt_pk_bf16(v0[2], v0[3]); w.z = cvt_pk_bf16(v1[0], v1[1]); w.w = cvt_pk_bf16(v1[2], v1[3]);
                    const int c = cb + bj * HALF + cl0;
                    if (dup) { const int qc = ((c >> 6) * 2) * 64 + (c & 63); *(u32x4*)(rowp + qc) = w; *(u32x4*)(rowp + qc + 64) = w; }
                    else *(u32x4*)(rowp + c) = w; } }
    }
};
struct EpiGateMerge {
    static constexpr bool PERM = true, AFTER_DRAIN = false;
    const bf16_t *YA, *YB; bf16_t* MG; const float* ssq; float eps;
    __device__ __forceinline__ void operator()(const f32x4 (&acc)[2][2][4][2], const Unit& u, int wr, int wc, int fr, int fq) const {
        const int row0 = u.pm * BM + wr * 64 + fr, col0 = u.pn * HALF + wc * 32 + 8 * fq;
        float rs[2][4]; load_rs(rs, ssq, row0, eps);
#pragma unroll
        for (int ai = 0; ai < 2; ++ai)
#pragma unroll
            for (int m = 0; m < 4; ++m) { const size_t off = (size_t)(row0 + ai * HALF + m * 16) * 1024 + col0; const float s = rs[ai][m];
                const u32x4 ya = *(const u32x4*)(YA + off), yb = *(const u32x4*)(YB + off);
                float o[8];
#pragma unroll
                for (int n = 0; n < 2; ++n)
#pragma unroll
                    for (int j = 0; j < 4; ++j) { const int e = n * 4 + j; const unsigned wa = ya[e >> 1], wb = yb[e >> 1];
                        const float fa = __uint_as_float((e & 1) ? (wa & 0xffff0000u) : (wa << 16)), fb = __uint_as_float((e & 1) ? (wb & 0xffff0000u) : (wb << 16));
                        o[e] = fast_sigmoid(acc[ai][0][m][n][j] * s) * fa + fast_sigmoid(acc[ai][1][m][n][j] * s) * fb; }
                u32x4 w; w.x = cvt_pk_bf16(o[0], o[1]); w.y = cvt_pk_bf16(o[2], o[3]); w.z = cvt_pk_bf16(o[4], o[5]); w.w = cvt_pk_bf16(o[6], o[7]);
                *(u32x4*)(MG + off) = w; }
    }
};

template <class Epi, class Sched, bool ALIGN_EPI = false, bool SP2 = false>
__device__ __forceinline__ void gemm_phase(PG8_LAS unsigned char* lds, const Gemm g, const Sched& S, const Epi& E, const int wave_id) {
    const int wid = wave_id, lane = lane_id(), tid = wid * 64 + lane, wr = wid >> 2, wc = wid & 3, fr = lane & 15, fq = lane >> 4;
    const int K = g.K, nt = K / BK;
    unsigned voffA[2], voffB[2];
#pragma unroll
    for (int i = 0; i < 2; ++i) { int R, C; stage_rc(tid * 16 + i * 8192, R, C); const int Rb = Epi::PERM ? ((R & ~31) + perm32(R & 31)) : R;
        voffA[i] = (unsigned)(R * K + C) * 2u; voffB[i] = (unsigned)(Rb * K + C) * 2u; }
    const size_t kstep = (size_t)(BK * 2);
    const size_t hstep = (size_t)HALF * K * 2;
    const size_t tstep = 2 * hstep;
    const unsigned ldsw = (unsigned)wid * 1024u;
    const int aoff = lds_byte(wr * 64 + fr, fq * 8), boff = lds_byte(wc * 32 + fr, fq * 8);
#define PG8_SA(b, h) (((b) * 2 + (h)) * HTB)
#define PG8_SB(b, h) ((4 + (b) * 2 + (h)) * HTB)
#define PG8_STAGE(bufoff, gbase, voff) do { _Pragma("unroll") for (int _i = 0; _i < 2; ++_i) \
        __builtin_amdgcn_global_load_lds((const unsigned*)((const char*)(gbase) + (voff)[_i]), (PG8_LAS unsigned*)(lds + (bufoff) + ldsw + _i * 8192), 16, 0, 0); } while (0)
#define PG8_LDA(dst, b, h) do { _Pragma("unroll") for (int m = 0; m < 4; ++m) _Pragma("unroll") for (int k = 0; k < 2; ++k) dst[m][k] = *(const PG8_LAS bf16x8*)(lds + PG8_SA(b, h) + aoff + m * 2048 + k * 1024); } while (0)
#define PG8_LDB(dst, b, h) do { _Pragma("unroll") for (int n = 0; n < 2; ++n) _Pragma("unroll") for (int k = 0; k < 2; ++k) dst[n][k] = *(const PG8_LAS bf16x8*)(lds + PG8_SB(b, h) + boff + n * 2048 + k * 1024); } while (0)
#define PG8_MMA(ai, bj, At, Bt) do { __builtin_amdgcn_s_setprio(1); _Pragma("unroll") for (int m = 0; m < 4; ++m) _Pragma("unroll") for (int n = 0; n < 2; ++n) _Pragma("unroll") for (int k = 0; k < 2; ++k) \
        acc[ai][bj][m][n] = __builtin_amdgcn_mfma_f32_16x16x32_bf16(Bt[n][k], At[m][k], acc[ai][bj][m][n], 0, 0, 0); __builtin_amdgcn_s_setprio(0); } while (0)
#define PG8_WAIT_V(n) asm volatile("s_waitcnt vmcnt(" #n ")" ::: "memory")
#define PG8_WAIT_L(n) asm volatile("s_waitcnt lgkmcnt(" #n ")" ::: "memory")
#define PG8_BAR __builtin_amdgcn_s_barrier()
#define PG8_SCHED __builtin_amdgcn_sched_barrier(0)
    Unit cur, nxt; int ui = 0;
    if (!S.next(0, cur)) return;
    f32x4 acc[2][2][4][2];
#pragma unroll
    for (int a = 0; a < 2; ++a)
#pragma unroll
        for (int b = 0; b < 2; ++b)
#pragma unroll
            for (int m = 0; m < 4; ++m)
#pragma unroll
                for (int n = 0; n < 2; ++n) acc[a][b][m][n] = (f32x4){0.f, 0.f, 0.f, 0.f};
    bf16x8 At[4][2], B0[2][2], B1[2][2];
    const char* cA = (const char*)g.A + (size_t)cur.pm * tstep; const char* cB = (const char*)g.Bt + (size_t)cur.pn * tstep;
    S.a_ready(cur);
    if constexpr (SP2) {
        PG8_STAGE(PG8_SB(0, 0), cB, voffB); PG8_STAGE(PG8_SB(0, 1), cB + hstep, voffB); PG8_STAGE(PG8_SA(0, 0), cA, voffA); PG8_STAGE(PG8_SA(0, 1), cA + hstep, voffA);
        if (wr == 1) PG8_BAR;
        PG8_WAIT_V(2); PG8_BAR;
        PG8_STAGE(PG8_SB(1, 0), cB + kstep, voffB); PG8_STAGE(PG8_SA(1, 0), cA + kstep, voffA); PG8_STAGE(PG8_SB(1, 1), cB + hstep + kstep, voffB);
        PG8_WAIT_V(6); PG8_BAR;
    } else {
        PG8_STAGE(PG8_SB(0, 0), cB, voffB); PG8_STAGE(PG8_SA(0, 0), cA, voffA); PG8_STAGE(PG8_SB(0, 1), cB + hstep, voffB); PG8_STAGE(PG8_SA(0, 1), cA + hstep, voffA);
        if (wr == 1) PG8_BAR;
        PG8_WAIT_V(4); PG8_BAR;
        PG8_STAGE(PG8_SB(1, 0), cB + kstep, voffB); PG8_STAGE(PG8_SA(1, 0), cA + kstep, voffA); PG8_STAGE(PG8_SB(1, 1), cB + hstep + kstep, voffB);
        PG8_WAIT_V(6); PG8_BAR;
    }
    for (;;) {
        const bool has_next = S.next(ui + 1, nxt);
        const char* nA = has_next ? (const char*)g.A + (size_t)nxt.pm * tstep : cA; const char* nB = has_next ? (const char*)g.Bt + (size_t)nxt.pn * tstep : cB;
        for (int t = 0; t < nt; t += 2) {
            const bool last = (t == nt - 2);
            const char* a1 = cA + (size_t)(t + 1) * kstep;
            const char* a2 = last ? nA : cA + (size_t)(t + 2) * kstep; const char* b2 = last ? nB : cB + (size_t)(t + 2) * kstep;
            const char* a3 = a2 + kstep; const char* b3 = b2 + kstep;
            if (last && has_next) S.a_ready(nxt);
            if constexpr (SP2) {
            PG8_LDB(B0, 0, 0); PG8_LDB(B1, 0, 1); PG8_SCHED; PG8_LDA(At, 0, 0); PG8_STAGE(PG8_SA(1, 1), a1 + hstep, voffA);
            PG8_WAIT_V(8); PG8_WAIT_L(0); PG8_BAR; PG8_MMA(0, 0, At, B0); PG8_MMA(0, 1, At, B1); PG8_BAR; PG8_SCHED;
            PG8_LDA(At, 0, 1); PG8_STAGE(PG8_SB(0, 0), b2, voffB); PG8_STAGE(PG8_SB(0, 1), b2 + hstep, voffB); PG8_STAGE(PG8_SA(0, 0), a2, voffA);
            PG8_WAIT_V(8); PG8_WAIT_L(0); PG8_BAR; PG8_MMA(1, 0, At, B0); PG8_MMA(1, 1, At, B1); PG8_BAR; PG8_SCHED;
            PG8_LDB(B0, 1, 0); PG8_LDB(B1, 1, 1); PG8_SCHED; PG8_LDA(At, 1, 0); PG8_STAGE(PG8_SA(0, 1), a2 + hstep, voffA);
            PG8_WAIT_V(8); PG8_WAIT_L(0); PG8_BAR; PG8_MMA(0, 0, At, B0); PG8_MMA(0, 1, At, B1); PG8_BAR; PG8_SCHED;
            PG8_LDA(At, 1, 1); PG8_STAGE(PG8_SB(1, 0), b3, voffB); PG8_STAGE(PG8_SB(1, 1), b3 + hstep, voffB); PG8_STAGE(PG8_SA(1, 0), a3, voffA);
            PG8_WAIT_V(8); PG8_WAIT_L(0); PG8_BAR; PG8_MMA(1, 0, At, B0); PG8_MMA(1, 1, At, B1); PG8_BAR; PG8_SCHED;
            } else {
            PG8_LDB(B0, 0, 0); PG8_SCHED; PG8_LDA(At, 0, 0); PG8_STAGE(PG8_SA(1, 1), a1 + hstep, voffA);
            PG8_WAIT_L(8); PG8_BAR; PG8_WAIT_L(0); PG8_MMA(0, 0, At, B0); PG8_BAR; PG8_SCHED;
            PG8_LDB(B1, 0, 1); PG8_STAGE(PG8_SB(0, 0), b2, voffB);
            PG8_BAR; PG8_WAIT_L(0); PG8_MMA(0, 1, At, B1); PG8_BAR;
            PG8_LDA(At, 0, 1); PG8_STAGE(PG8_SA(0, 0), a2, voffA);
            PG8_BAR; PG8_WAIT_L(0); PG8_MMA(1, 0, At, B0); PG8_BAR; PG8_SCHED;
            PG8_STAGE(PG8_SB(0, 1), b2 + hstep, voffB);
            PG8_WAIT_V(6); PG8_BAR; PG8_MMA(1, 1, At, B1); PG8_BAR;
            PG8_LDB(B0, 1, 0); PG8_SCHED; PG8_LDA(At, 1, 0); PG8_STAGE(PG8_SA(0, 1), a2 + hstep, voffA);
            PG8_WAIT_L(8); PG8_BAR; PG8_WAIT_L(0); PG8_MMA(0, 0, At, B0); PG8_BAR; PG8_SCHED;
            PG8_LDB(B1, 1, 1); PG8_STAGE(PG8_SB(1, 0), b3, voffB);
            PG8_BAR; PG8_WAIT_L(0); PG8_MMA(0, 1, At, B1); PG8_BAR;
            PG8_LDA(At, 1, 1); PG8_STAGE(PG8_SA(1, 0), a3, voffA);
            PG8_BAR; PG8_WAIT_L(0); PG8_MMA(1, 0, At, B0); PG8_BAR; PG8_SCHED;
            PG8_STAGE(PG8_SB(1, 1), b3 + hstep, voffB);
            PG8_WAIT_V(6); PG8_BAR; PG8_MMA(1, 1, At, B1); PG8_BAR;
            }
        }
        if constexpr (ALIGN_EPI) { if (wr == 0) PG8_BAR; }
        if constexpr (!Epi::AFTER_DRAIN) { E(acc, cur, wr, wc, fr, fq); S.done(cur); }
        if (!has_next) break;
#pragma unroll
        for (int a = 0; a < 2; ++a)
#pragma unroll
            for (int b = 0; b < 2; ++b)
#pragma unroll
                for (int m = 0; m < 4; ++m)
#pragma unroll
                    for (int n = 0; n < 2; ++n) acc[a][b][m][n] = (f32x4){0.f, 0.f, 0.f, 0.f};
        cur = nxt; cA = nA; cB = nB; ++ui;
        if constexpr (ALIGN_EPI) { if (wr == 1) PG8_BAR; }
    }
    PG8_WAIT_V(0);
    if constexpr (!ALIGN_EPI) { if (wr == 0) PG8_BAR; }
    PG8_BAR;
    if constexpr (Epi::AFTER_DRAIN) { E.fused(acc, cur, wr, wc, fr, fq, lds, wid, lane); S.done(cur); }
#undef PG8_SA
#undef PG8_SB
#undef PG8_STAGE
#undef PG8_LDA
#undef PG8_LDB
#undef PG8_MMA
#undef PG8_WAIT_V
#undef PG8_WAIT_L
#undef PG8_BAR
#undef PG8_SCHED
}
}
#include <hip/hip_bf16.h>
#include <cmath>
namespace attn_body {
using bf16=__hip_bfloat16;
using bf16x8=__attribute__((ext_vector_type(8)))short;
using s16x4=__attribute__((ext_vector_type(4)))short;
using f32x16=__attribute__((ext_vector_type(16)))float;
using u32x4=__attribute__((ext_vector_type(4)))unsigned;
constexpr int BATCH=2,NHEAD=16,SEQ=8192,D=64,DM=NHEAD*D,KP=512;
constexpr int NW=8,QBLK=32,QB=QBLK*NW,KVBLK=64,NQB=SEQ/QB;
constexpr int ATTN_PITCH=DM, ATTN_UNIT_ROWS=QB;
__device__ __forceinline__ int crow(int r,int hi){return (r&3)+8*(r>>2)+4*hi;}
#define SBAR() __builtin_amdgcn_sched_barrier(0)
__device__ __forceinline__ void cmask(f32x16&p0,f32x16&p1,int jb,int qrel,int hi){
  const float NEG=-INFINITY; int lim=qrel-64*jb-4*hi; asm volatile("":"+v"(lim));
  #pragma unroll
  for(int r=0;r<16;++r){const int cr=(r&3)+8*(r>>2); if(cr>lim)p0[r]=NEG; if(cr+32>lim)p1[r]=NEG;}
}

constexpr int NSLOT=3, SLOTB=8192;
constexpr int LDS_K=0, LDS_V=NSLOT*SLOTB, LDS_WS=2*NSLOT*SLOTB, LDS_OST=LDS_WS+NW*64*4, LDS_BYTES=LDS_OST+NW*4096;
constexpr float C2=0.125f*1.4426950408889634f;
__device__ __forceinline__ void glds16(const void*gsrc,unsigned lds_dst){unsigned keep;
  asm volatile("s_mov_b32 %0, m0\n\ts_mov_b32 m0, %2\n\ts_nop 0\n\tglobal_load_lds_dwordx4 %1, off\n\ts_mov_b32 m0, %0":"=&s"(keep):"v"(gsrc),"s"(lds_dst):"memory");}
__device__ __forceinline__ float max3f(float a,float b,float c){float r;asm("v_max3_f32 %0, %1, %2, %3":"=v"(r):"v"(a),"v"(b),"v"(c));return r;}
__device__ __forceinline__ float max2f(float a,float b){float r;asm("v_max_f32_e32 %0, %1, %2":"=v"(r):"v"(a),"v"(b));return r;}
__device__ __forceinline__ float fadd_s(float a,float b){float r;asm("v_add_f32_e32 %0, %1, %2":"=v"(r):"v"(a),"v"(b));return r;}
__device__ __forceinline__ float fsub_s(float a,float b){float r;asm("v_sub_f32_e32 %0, %1, %2":"=v"(r):"v"(a),"v"(b));return r;}
typedef float f32x2_t __attribute__((ext_vector_type(2))); typedef __bf16 bf16x2_t __attribute__((ext_vector_type(2)));
__device__ __forceinline__ unsigned cvtpk_s(float lo,float hi){f32x2_t v={lo,hi};bf16x2_t b=__builtin_convertvector(v,bf16x2_t);return __builtin_bit_cast(unsigned,b);}
#define WAIT_BAR(N) asm volatile("s_waitcnt vmcnt(" #N ") lgkmcnt(0)\n\ts_barrier":::"memory")

__device__ __forceinline__ void qkt(f32x16&p0,f32x16&p1,const char*Kslot,const bf16x8*qr,const f32x16&negm,int r32,int hi){
  const char*kb=Kslot+hi*1024+r32*16;
  #pragma unroll
  for(int d0=0;d0<4;++d0){
    const bf16x8 b0=*reinterpret_cast<const bf16x8*>(kb+d0*2048);
    const bf16x8 b1=*reinterpret_cast<const bf16x8*>(kb+d0*2048+512);
    if(d0==0){p0=__builtin_amdgcn_mfma_f32_32x32x16_bf16(b0,qr[0],negm,0,0,0);p1=__builtin_amdgcn_mfma_f32_32x32x16_bf16(b1,qr[0],negm,0,0,0);}
    else{p0=__builtin_amdgcn_mfma_f32_32x32x16_bf16(b0,qr[d0],p0,0,0,0);p1=__builtin_amdgcn_mfma_f32_32x32x16_bf16(b1,qr[d0],p1,0,0,0);}}
}
typedef __attribute__((address_space(3))) const char* lds_cptr;
typedef short v4i16_t __attribute__((ext_vector_type(4)));
__device__ __forceinline__ void kload8(bf16x8*kf,lds_cptr kp){
  kf[0]=*(const __attribute__((address_space(3))) bf16x8*)(kp);      kf[1]=*(const __attribute__((address_space(3))) bf16x8*)(kp+512);
  kf[2]=*(const __attribute__((address_space(3))) bf16x8*)(kp+2048); kf[3]=*(const __attribute__((address_space(3))) bf16x8*)(kp+2560);
  kf[4]=*(const __attribute__((address_space(3))) bf16x8*)(kp+4096); kf[5]=*(const __attribute__((address_space(3))) bf16x8*)(kp+4608);
  kf[6]=*(const __attribute__((address_space(3))) bf16x8*)(kp+6144); kf[7]=*(const __attribute__((address_space(3))) bf16x8*)(kp+6656);
}
__device__ __forceinline__ void kload2(bf16x8*kf,lds_cptr kp,int j){ kf[2*j]=*(const __attribute__((address_space(3))) bf16x8*)(kp+j*2048); kf[2*j+1]=*(const __attribute__((address_space(3))) bf16x8*)(kp+j*2048+512); }
__device__ __forceinline__ s16x4 vtr(lds_cptr p){ return __builtin_bit_cast(s16x4,__builtin_amdgcn_ds_read_tr16_b64_v4i16((__attribute__((address_space(3))) v4i16_t*)p)); }
__device__ __forceinline__ float rowmax(const f32x16&p0,const f32x16&p1){
  float a=max3f(p0[0],p0[1],p1[0]),b=max3f(p0[2],p0[3],p1[1]);a=max3f(a,p1[2],p1[3]);
  #pragma unroll
  for(int r=4;r<16;r+=4){a=max3f(a,p0[r],p0[r+1]);b=max3f(b,p0[r+2],p0[r+3]);a=max3f(a,p1[r],p1[r+1]);b=max3f(b,p1[r+2],p1[r+3]);}
  const float m=max2f(a,b);
  auto rr=__builtin_amdgcn_permlane32_swap(__float_as_uint(m),__float_as_uint(m),false,false);
  return max2f(__uint_as_float(rr[0]),__uint_as_float(rr[1]));
}
__device__ __forceinline__ void pv(f32x16*o,int vb,bf16x8 pa0,bf16x8 pa1,bf16x8 pa2,bf16x8 pa3){
  #pragma unroll
  for(int d0=0;d0<2;++d0){s16x4 lo[4],hi[4];
    #pragma unroll
    for(int ks=0;ks<4;++ks){
      asm volatile("ds_read_b64_tr_b16 %0,%1 offset:%c2":"=&v"(lo[ks]):"v"(vb),"i"(d0*4096+ks*1024):"memory");
      asm volatile("ds_read_b64_tr_b16 %0,%1 offset:%c2":"=&v"(hi[ks]):"v"(vb),"i"(d0*4096+ks*1024+512):"memory");}
    asm volatile("s_waitcnt lgkmcnt(0)":::"memory");SBAR();
    #define PK(k) (bf16x8){lo[k][0],lo[k][1],lo[k][2],lo[k][3],hi[k][0],hi[k][1],hi[k][2],hi[k][3]}
    o[d0]=__builtin_amdgcn_mfma_f32_32x32x16_bf16(pa0,PK(0),o[d0],0,0,0);
    o[d0]=__builtin_amdgcn_mfma_f32_32x32x16_bf16(pa1,PK(1),o[d0],0,0,0);
    o[d0]=__builtin_amdgcn_mfma_f32_32x32x16_bf16(pa2,PK(2),o[d0],0,0,0);
    o[d0]=__builtin_amdgcn_mfma_f32_32x32x16_bf16(pa3,PK(3),o[d0],0,0,0);
    #undef PK
  }
}

#ifndef ATTN_STORE16
#define ATTN_STORE16(p,v) (*(u32x4*)(p)=(v))
#endif
template<int THRL> __device__ __forceinline__ void attn_unit(int b,int h,int qb,const bf16*Q,const bf16*__restrict__ K,const bf16*__restrict__ V,bf16*O,char*shm,const int wave_id,const unsigned*nmax){
  const int wid=wave_id,lane=lane_id(),tid=wid*64+lane,r32=lane&31,hi=lane>>5;
  const long rowbase=(long)b*SEQ; const int q0=qb*QB;
  const bf16*Qw=Q+(rowbase+q0+wid*QBLK)*DM+h*D;
  int t0=0;
  { const int j=b*8+(h>>1); const float q2=__uint_as_float(__builtin_amdgcn_readfirstlane((int)nmax[j])), k2=__uint_as_float(__builtin_amdgcn_readfirstlane((int)nmax[16+j]));
    const unsigned slb0_=0x3eb8aa3bu-((unsigned)__builtin_amdgcn_readfirstlane(h>>2)<<24);
    const float B2=2.0f*sqrtf(q2*k2)*1.0001f+34.7f, dmin=B2/__uint_as_float(slb0_);
    const float tf=floorf(((float)(q0+1)-dmin)*(1.0f/64.0f)); int tt=(tf>0.f)?(int)tf:0; tt&=~1; const int tmax=(q0+QB)/KVBLK-4; t0=tt<tmax?tt:tmax; t0=__builtin_amdgcn_readfirstlane(t0); }
  const bf16*Kh=K+(rowbase+(long)t0*KVBLK)*KP+(h>>1)*D,*Vh=V+(rowbase+(long)t0*KVBLK)*KP+(h>>2)*128+(h&1)*D;
  const unsigned lds0=(unsigned)(uintptr_t)shm;
  float*wsf=(float*)(shm+LDS_WS)+wid*64;
  const bf16*ksrc=Kh+(long)lane*KP+wid*8;
  const bf16*vsrc=Vh+(long)(16*(wid&3)+(lane>>2))*KP+(wid>>2)*32+(lane&3)*8;
  const unsigned kdst=lds0+LDS_K+wid*1024, vdst=lds0+LDS_V+wid*1024;
  #define DMA_K(t,slot) glds16(ksrc+(long)(t)*KVBLK*KP,(unsigned)__builtin_amdgcn_readfirstlane(kdst+(slot)))
  #define DMA_V(t,slot) glds16(vsrc+(long)(t)*KVBLK*KP,(unsigned)__builtin_amdgcn_readfirstlane(vdst+(slot)))
  const int vb0=(int)(lds0+LDS_V)+((lane>>4)&1)*32+(lane&3)*8+(4*hi+((lane&15)>>2))*64;
  const char*Kbase=shm+LDS_K; bf16x8 kf[8];
  const lds_cptr shm3=(lds_cptr)shm; const lds_cptr kp0=shm3+LDS_K+hi*1024+r32*16; const lds_cptr vp0=shm3+LDS_V+((lane>>4)&1)*32+(lane&3)*8+(4*hi+((lane&15)>>2))*64;
  const int NT=(q0+QB)/KVBLK-t0;
  DMA_K(0,0);DMA_V(0,0);DMA_K(1,SLOTB);
  bf16x8 qr[4];
  #pragma unroll
  for(int d0=0;d0<4;++d0)qr[d0]=*reinterpret_cast<const bf16x8*>(&Qw[(long)r32*DM+d0*16+hi*8]);
  float mhat=0.f,l_reg=0.f;f32x16 o[2];o[0]=f32x16{};o[1]=f32x16{};const f32x16 negm=f32x16{};
  const int qrel=wid*QBLK+r32;
  const unsigned slb_=0x3eb8aa3bu-((unsigned)__builtin_amdgcn_readfirstlane(h>>2)<<24); const float sl2=__uint_as_float(slb_);
  const float qposf=(float)(q0+qrel-4*hi-64*t0);
  const float s1_=sl2, s8_=__uint_as_float(slb_+(3u<<23)), s32_=__uint_as_float(slb_+(5u<<23));
  #define AADD(d,a,sv) asm volatile("v_add_f32_e32 %0, %1, %2":"=v"(d):"s"(sv),"v"(a))
  #define ALIBI(P0,P1,t) do{ float bq_=__builtin_fmaf(sl2,((float)(64*(t))-qposf),-mhat); \
    _Pragma("unroll") for(int q_=0;q_<4;++q_){ float b0_=bq_,b1_,b2_,b3_,c_; AADD(b1_,b0_,s1_); AADD(b2_,b1_,s1_); AADD(b3_,b2_,s1_); \
      P0[4*q_]+=b0_; P0[4*q_+1]+=b1_; P0[4*q_+2]+=b2_; P0[4*q_+3]+=b3_; \
      AADD(c_,b0_,s32_); P1[4*q_]+=c_; AADD(c_,b1_,s32_); P1[4*q_+1]+=c_; AADD(c_,b2_,s32_); P1[4*q_+2]+=c_; AADD(c_,b3_,s32_); P1[4*q_+3]+=c_; \
      if(q_<3){ AADD(bq_,b0_,s8_); } } }while(0)
  #define CMASK(P0,P1,t) do{int jb_=(t)-(NT-4); if(jb_>=0)cmask(P0,P1,jb_,qrel,hi);}while(0)
  bool resc=false;
  #define START(P0,P1) do{ const float rm=rowmax(P0,P1); resc=false; \
    { const float dl=rm; mhat=fadd_s(mhat,dl); \
      _Pragma("unroll") for(int r=0;r<16;++r){P0[r]=fsub_s(P0[r],dl);P1[r]=fsub_s(P1[r],dl);} \
      } \
    _Pragma("unroll") for(int r=0;r<16;++r)P0[r]=__builtin_amdgcn_exp2f(P0[r]); }while(0)
  #define RESC() do{ if(resc){ asm volatile("s_waitcnt lgkmcnt(0)":::"memory"); \
      _Pragma("unroll") for(int d_=0;d_<2;++d_) _Pragma("unroll") for(int r=0;r<16;++r)o[d_][r]*=wsf[crow(r,hi)]; } }while(0)
  f32x16 pA0,pA1,pB0,pB1;
  int sl_prev=0,sl_cur=0,sl_next=SLOTB;
  #define ROT() do{sl_prev=sl_cur;sl_cur=sl_next;sl_next=(sl_next==(NSLOT-1)*SLOTB)?0:sl_next+SLOTB;}while(0)
  DMA_K(2,2*SLOTB);
  WAIT_BAR(3);
  qkt(pA0,pA1,Kbase,qr,negm,r32,hi);asm volatile("s_nop 15\n\ts_nop 7":"+v"(pA0),"+v"(pA1));ALIBI(pA0,pA1,0);CMASK(pA0,pA1,0);
  START(pA0,pA1);
  _Pragma("unroll") for(int r=0;r<16;++r)pA1[r]=__builtin_amdgcn_exp2f(pA1[r]);
  WAIT_BAR(0);
  DMA_K(3,0);DMA_V(1,SLOTB);
  ROT();
  kload8(kf,kp0+sl_cur);
  WAIT_BAR(2);
  s16x4 vlo[8],vhi[8]; u32x4 pw0,pw1,pw2,pw3;
  #define PKW(P,B) cvtpk_s(P[B],P[B+1])
  #define PAF(k) __builtin_bit_cast(bf16x8,pw##k)
  #define VFR(i) (bf16x8){vlo[i][0],vlo[i][1],vlo[i][2],vlo[i][3],vhi[i][0],vhi[i][1],vhi[i][2],vhi[i][3]}
  #define PIN(x) asm volatile("":"+v"(x))
  #define MX3(a,b,c) __builtin_fmaxf(__builtin_fmaxf((a),(b)),(c))
  #define GAPA(MF,A0,A1,A2,A3,W0,W1,PW) do{ MF; sacc+=A0; sacc+=A1; sacc+=A2; sacc+=A3; PIN(sacc); W0; W1; PIN(PW); SBAR(); }while(0)
  #define EX(v) __builtin_amdgcn_exp2f(v)
  #define GAPB(MF,X,B) do{ MF; X[B]=EX(X[B]); X[B+1]=EX(X[B+1]); X[B+2]=EX(X[B+2]); X[B+3]=EX(X[B+3]); PIN(X); SBAR(); }while(0)
  #define VRD(i) do{ vlo[i]=vtr(vp_+(((i)>>2)*4096+((i)&3)*1024)); vhi[i]=vtr(vp_+(((i)>>2)*4096+((i)&3)*1024+512)); }while(0)
  #define KRD(G,j) do{ if(G){ kload2(kf,kp0+sl_next,j); SBAR(); } }while(0)
  #define STEP(C0,C1,P0,P1,t,GK,GV,GL) do{ SBAR(); \
    const lds_cptr vp_=vp0+sl_prev; \
    VRD(0); SBAR(); float sacc=(P0[0]+P0[1]); \
    GAPA(C0=__builtin_amdgcn_mfma_f32_32x32x16_bf16(kf[0],qr[0],negm,0,0,0), P0[2],P0[3],P0[4],P0[5],     pw0[0]=PKW(P0,0), pw0[1]=PKW(P0,2), pw0); \
    VRD(4); SBAR(); GAPA(C1=__builtin_amdgcn_mfma_f32_32x32x16_bf16(kf[1],qr[0],negm,0,0,0), P0[6],P0[7],P0[8],P0[9],     pw0[2]=PKW(P0,4), pw0[3]=PKW(P0,6), pw0); \
    VRD(1); SBAR(); GAPA(C0=__builtin_amdgcn_mfma_f32_32x32x16_bf16(kf[2],qr[1],C0,0,0,0),   P0[10],P0[11],P0[12],P0[13], pw1[0]=PKW(P0,8), pw1[1]=PKW(P0,10), pw1); \
    VRD(5); SBAR(); GAPA(C1=__builtin_amdgcn_mfma_f32_32x32x16_bf16(kf[3],qr[1],C1,0,0,0),   P0[14],P0[15],P1[0],P1[1],   pw1[2]=PKW(P0,12),pw1[3]=PKW(P0,14), pw1); \
    VRD(2); SBAR(); GAPA(C0=__builtin_amdgcn_mfma_f32_32x32x16_bf16(kf[4],qr[2],C0,0,0,0),   P1[2],P1[3],P1[4],P1[5],     pw2[0]=PKW(P1,0), pw2[1]=PKW(P1,2), pw2); \
    VRD(6); SBAR(); GAPA(C1=__builtin_amdgcn_mfma_f32_32x32x16_bf16(kf[5],qr[2],C1,0,0,0),   P1[6],P1[7],P1[8],P1[9],     pw2[2]=PKW(P1,4), pw2[3]=PKW(P1,6), pw2); \
    VRD(3); SBAR(); GAPA(C0=__builtin_amdgcn_mfma_f32_32x32x16_bf16(kf[6],qr[3],C0,0,0,0),   P1[10],P1[11],P1[12],P1[13], pw3[0]=PKW(P1,8), pw3[1]=PKW(P1,10), pw3); \
    VRD(7); SBAR(); GAPA(C1=__builtin_amdgcn_mfma_f32_32x32x16_bf16(kf[7],qr[3],C1,0,0,0),   P1[14],P1[15],0.f,0.f,       pw3[2]=PKW(P1,12),pw3[3]=PKW(P1,14), pw3); \
    l_reg+=sacc; \
    if(GK){DMA_K((t)+3,sl_cur);} if(GV){DMA_V((t)+1,sl_next);} \
    ALIBI(C0,C1,t); CMASK(C0,C1,t); \
    { float a=MX3(C0[0],C0[1],C1[0]),b=MX3(C0[2],C0[3],C1[1]); a=MX3(a,C1[2],C1[3]); \
      _Pragma("unroll") for(int r=4;r<16;r+=4){a=MX3(a,C0[r],C0[r+1]);b=MX3(b,C0[r+2],C0[r+3]);a=MX3(a,C1[r],C1[r+1]);b=MX3(b,C1[r+2],C1[r+3]);} \
      float rm=__builtin_fmaxf(a,b); { auto rr=__builtin_amdgcn_permlane32_swap(__float_as_uint(rm),__float_as_uint(rm),false,false); rm=__builtin_fmaxf(__uint_as_float(rr[0]),__uint_as_float(rr[1])); } \
      resc=false; \
      if(__builtin_expect(__any(rm>(float)THRL),0)){ const float dl=__builtin_fmaxf(rm,0.f); mhat+=dl; \
        _Pragma("unroll") for(int r=0;r<16;++r){C0[r]-=dl;C1[r]-=dl;} \
        const float f=__builtin_amdgcn_exp2f(-dl); l_reg*=f; if(hi==0)wsf[r32]=f; resc=true; } } \
    SBAR(); \
    GAPB(o[0]=__builtin_amdgcn_mfma_f32_32x32x16_bf16(PAF(0),VFR(0),o[0],0,0,0), C0,0); \
    GAPB(o[1]=__builtin_amdgcn_mfma_f32_32x32x16_bf16(PAF(0),VFR(4),o[1],0,0,0), C0,4); \
    KRD(GL,0); GAPB(o[0]=__builtin_amdgcn_mfma_f32_32x32x16_bf16(PAF(1),VFR(1),o[0],0,0,0), C0,8); \
    KRD(GL,1); GAPB(o[1]=__builtin_amdgcn_mfma_f32_32x32x16_bf16(PAF(1),VFR(5),o[1],0,0,0), C0,12); \
    KRD(GL,2); GAPB(o[0]=__builtin_amdgcn_mfma_f32_32x32x16_bf16(PAF(2),VFR(2),o[0],0,0,0), C1,0); \
    KRD(GL,3); GAPB(o[1]=__builtin_amdgcn_mfma_f32_32x32x16_bf16(PAF(2),VFR(6),o[1],0,0,0), C1,4); \
    GAPB(o[0]=__builtin_amdgcn_mfma_f32_32x32x16_bf16(PAF(3),VFR(3),o[0],0,0,0), C1,8); \
    GAPB(o[1]=__builtin_amdgcn_mfma_f32_32x32x16_bf16(PAF(3),VFR(7),o[1],0,0,0), C1,12); \
    }while(0)
  int t=1;
  #undef CMASK
  #define CMASK(P0,P1,t) do{}while(0)
  for(;t+5<NT;t+=2){
    STEP(pB0,pB1,pA0,pA1,t,true,true,true);     WAIT_BAR(2); RESC(); ROT();
    STEP(pA0,pA1,pB0,pB1,t+1,true,true,true);   WAIT_BAR(2); RESC(); ROT();
  }
  #undef CMASK
  #define CMASK(P0,P1,t) do{int jb_=(t)-(NT-4); if(jb_>=0)cmask(P0,P1,jb_,qrel,hi);}while(0)
  #define ENDW(tt) do{ if((tt)+3<NT){WAIT_BAR(2);} else if((tt)+2<NT){WAIT_BAR(1);} else {WAIT_BAR(0);} }while(0)
  for(;t+1<NT;t+=2){
    STEP(pB0,pB1,pA0,pA1,t,(t+3<NT),(t+1<NT),(t+1<NT));       ENDW(t);   RESC(); ROT();
    STEP(pA0,pA1,pB0,pB1,t+1,(t+4<NT),(t+2<NT),(t+2<NT));     ENDW(t+1); RESC(); ROT();
  }
  STEP(pB0,pB1,pA0,pA1,NT-1,false,false,false); RESC();
  { float sacc=pB0[0]+pB0[1]; _Pragma("unroll") for(int r=2;r<16;++r)sacc+=pB0[r]; _Pragma("unroll") for(int r=0;r<16;++r)sacc+=pB1[r]; l_reg+=sacc;
    pw0=(u32x4){PKW(pB0,0),PKW(pB0,2),PKW(pB0,4),PKW(pB0,6)};pw1=(u32x4){PKW(pB0,8),PKW(pB0,10),PKW(pB0,12),PKW(pB0,14)};pw2=(u32x4){PKW(pB1,0),PKW(pB1,2),PKW(pB1,4),PKW(pB1,6)};pw3=(u32x4){PKW(pB1,8),PKW(pB1,10),PKW(pB1,12),PKW(pB1,14)};
    SBAR(); pv(o,vb0+sl_cur,PAF(0),PAF(1),PAF(2),PAF(3)); }
  #undef PKW
  #undef PAF
  #undef VFR
  #undef PIN
  #undef MX3
  #undef GAPA
  #undef GAPB
  #undef EX
  #undef VRD
  #undef KRD
  #undef STEP
  #undef ENDW
  {auto rr=__builtin_amdgcn_permlane32_swap(__float_as_uint(l_reg),__float_as_uint(l_reg),false,false);l_reg=__uint_as_float(rr[0])+__uint_as_float(rr[1]);}
  if(hi==0)wsf[32+r32]=l_reg;asm volatile("s_waitcnt lgkmcnt(0)":::"memory");
  float rli[16];
  #pragma unroll
  for(int r=0;r<16;++r)rli[r]=__builtin_amdgcn_rcpf(wsf[32+crow(r,hi)]);
  bf16*Ow=O+(rowbase+q0+wid*QBLK)*DM+h*D;
  { bf16*stg=(bf16*)(shm+LDS_OST)+wid*2048;
    #pragma unroll
    for(int r=0;r<16;++r){const int orow=crow(r,hi);
      #pragma unroll
      for(int d0=0;d0<2;++d0)stg[orow*64+d0*32+r32]=__float2bfloat16(o[d0][r]*rli[r]);}
    asm volatile("s_waitcnt lgkmcnt(0)":::"memory");
    #pragma unroll
    for(int i=0;i<4;++i){const int row=i*8+(lane>>3),ch=lane&7; const u32x4 v=*(const u32x4*)(stg+row*64+ch*8); ATTN_STORE16(Ow+(long)row*DM+ch*8,v);} }
  asm volatile("s_waitcnt lgkmcnt(0)\n\ts_barrier":::"memory");
  #undef ALIBI
  #undef AADD
  #undef DMA_K
  #undef DMA_V
  #undef CMASK
  #undef START
  #undef RESC
  #undef ROT
}
constexpr int ATTN_LDS_BYTES=LDS_BYTES;
struct AttnTensors { const bf16* Q; const bf16* K; const bf16* V; bf16* O; const unsigned* nmax; };
struct AttnUnit { int bh; int qb; };
struct StaticOrder {
  int vcu;
  __device__ __forceinline__ explicit StaticOrder(int grid,int block):vcu((block%8)*(grid/8)+block/8){}
  __device__ __forceinline__ bool next(int i,AttnUnit&u)const{ if(i>=4)return false; const int s=vcu&7; u.bh=vcu>>3; u.qb=(i==0)?s:(i==1)?15-s:(i==2)?16+s:31-s; return true; }
  __device__ __forceinline__ void a_ready(const AttnUnit&)const{}
  __device__ __forceinline__ void done(const AttnUnit&)const{}
};
struct DynOrder {
  unsigned* qctr; volatile __attribute__((address_space(3))) unsigned* slot; int xq, wave;
  __device__ __forceinline__ bool next(int,AttnUnit&u)const{
    if(wave==0&&lane_id()==0){ slot[0]=__hip_atomic_fetch_add(qctr+64*xq,1u,__ATOMIC_RELAXED,__HIP_MEMORY_SCOPE_AGENT); }
    __syncthreads(); const unsigned v=slot[0]; __syncthreads();
    if(v>=128u)return false; u.qb=31-(int)(v>>2); u.bh=(xq>>2)*16+(3-(int)(v&3u))*4+(xq&3); return true; }
  __device__ __forceinline__ void a_ready(const AttnUnit&)const{}
  __device__ __forceinline__ void done(const AttnUnit&)const{}
};
template<class Sched,int THRL=8> __device__ __forceinline__ void attn_phase(char*lds,const AttnTensors&T,const Sched&S,const int wave_id){
  AttnUnit u;
  for(int i=0;S.next(i,u);++i){ S.a_ready(u); attn_unit<THRL>(u.bh/NHEAD,u.bh%NHEAD,u.qb,T.Q,T.K,T.V,T.O,lds,wave_id,T.nmax); S.done(u); }
}
#undef SBAR
#undef WAIT_BAR
}
constexpr int NWAVES = 8;
constexpr int BATCH = 2, T = 8192, D = 1024, FF = 2816, M = BATCH * T;
constexpr int WIN_SRC = 5648, WIN_N = 3840;
constexpr float RMS_EPS = 1e-6f, SUBLN_EPS = 1e-5f;
constexpr size_t MiB = 1u << 20;
constexpr size_t WS_SSQA = 1 * MiB, WS_SSQB = 2 * MiB, WS_DNCD = 3 * MiB;
constexpr size_t WS_WG = 4 * MiB, WS_WA = 8 * MiB, WS_WB = 9 * MiB, WS_WOUT = 10 * MiB;
constexpr size_t WS_XB = 12 * MiB;
constexpr size_t WS_H = 44 * MiB;
constexpr size_t WS_WGU1 = 232 * MiB, WS_WD1 = 243 * MiB, WS_WIN = 248 * MiB + 512 * 1024;
constexpr size_t WS_PRE = 44 * MiB, WS_Z = 92 * MiB, WS_QO = 108 * MiB, WS_KD = 140 * MiB, WS_VD = 156 * MiB, WS_AB = 172 * MiB;
constexpr size_t WS_DN = 173 * MiB;
constexpr size_t WS_ODN = 44 * MiB, WS_AA = 60 * MiB, WS_ABB = 76 * MiB;
constexpr size_t WS_WGU2 = 173 * MiB, WS_WD2 = 184 * MiB;
constexpr size_t WS_YA = 190 * MiB, WS_YB = 222 * MiB, WS_MG = 108 * MiB;
constexpr size_t WS_END = 256 * MiB;
constexpr int DN_REC = 40960;
static_assert(WS_DN + (size_t)2048 * DN_REC <= WS_END && WS_WIN + (size_t)WIN_N * D * 2 <= WS_END && WS_YB + (size_t)M * D * 2 <= WS_END, "d_ws map");

constexpr int RING_OFF = 0, RING_BYTES = 147456;
constexpr int MISC_OFF = 147456, LDS_BYTES = 147456 + 256;

#define LAS __attribute__((address_space(3)))
typedef unsigned short bf16;
typedef unsigned v4u __attribute__((ext_vector_type(4)));
typedef float f32x4 __attribute__((ext_vector_type(4)));
typedef float f32x16 __attribute__((ext_vector_type(16)));
typedef short bf16x8 __attribute__((ext_vector_type(8)));
#define LDSFENCE() asm volatile("s_waitcnt lgkmcnt(0)" ::: "memory")
__device__ __forceinline__ unsigned f2bf(float f) { unsigned u = __builtin_bit_cast(unsigned, f); return (u + 0x7fffu + ((u >> 16) & 1u)) >> 16; }
__device__ __forceinline__ unsigned pk2(float lo, float hi) { return f2bf(lo) | (f2bf(hi) << 16); }
__device__ __forceinline__ float bflo(unsigned w) { return __uint_as_float(w << 16); }
__device__ __forceinline__ float bfhi(unsigned w) { return __uint_as_float(w & 0xffff0000u); }
__device__ __forceinline__ float wave_sum(float v) {
#pragma unroll
    for (int o = 1; o < 64; o <<= 1) v += __shfl_xor(v, o);
    return v;
}

#define GAS __attribute__((address_space(1)))
typedef GAS unsigned gu32;
#define RLX_AGENT __ATOMIC_RELAXED, __HIP_MEMORY_SCOPE_AGENT
constexpr size_t WS_CTL = 0, CTL_ZERO_BYTES = 65536;
constexpr int CW_BAR = 1024, CW_ATTQ = 8192, CW_NMAX = 12288;
#define XB_TMO      128
#define XB_XCNT(j)  (256  + 64 * (j))
#define XB_XSUB(j)  (1280 + 64 * (j))
#define XB_XGEN(j)  (2304 + 64 * (j))
#define XB_TOP      3328
#define XB_TOPGEN   3392
#define XCD_BAR_WORDS 3456
#define XB_SPIN_CAP (1u << 18)

__device__ __forceinline__ unsigned xb_ld(unsigned* p)              { return __hip_atomic_load(p, __ATOMIC_RELAXED, __HIP_MEMORY_SCOPE_AGENT); }
__device__ __forceinline__ unsigned xb_add(unsigned* p, unsigned v) { return __hip_atomic_fetch_add(p, v, __ATOMIC_RELAXED, __HIP_MEMORY_SCOPE_AGENT); }
__device__ __forceinline__ unsigned xb_xcc_id() { return (unsigned)__builtin_amdgcn_s_getreg((3 << 11) | 20) & 0xFu; }
#define XB_SPIN(cond, bar) do { unsigned _sp = 0; while (cond) { __builtin_amdgcn_s_sleep(1); \
    if ((++_sp & 255u) == 0u) { if (xb_ld(&(bar)[XB_TMO])) break; if (_sp > XB_SPIN_CAP) { atomicAdd(&(bar)[XB_TMO], 1u); break; } } } } while (0)

struct XcdBarrier {
    unsigned* bar; unsigned x; int wave;
    volatile LAS unsigned* st;
};

__device__ __forceinline__ XcdBarrier xcd_barrier_post(unsigned* bar, volatile LAS unsigned* st, int wave) {
    XcdBarrier b; b.bar = bar; b.x = xb_xcc_id(); b.st = st; b.wave = wave;
    if (wave == 0 && lane_id() == 0) (void)xb_add(&bar[XB_XCNT(b.x)], 1u);
    return b;
}
__device__ __forceinline__ void xcd_barrier_complete(unsigned* bar, unsigned x, unsigned& nloc, unsigned& nx) {
    const unsigned G = gridDim.x * gridDim.y * gridDim.z;
    unsigned sum, cnt, mine, sp = 0u;
    for (;;) {
        sum = 0u; cnt = 0u; mine = 0u;
#pragma unroll
        for (unsigned j = 0; j < 16; ++j) { const unsigned c = xb_ld(&bar[XB_XCNT(j)]); sum += c; cnt += (c > 0u) ? 1u : 0u; mine = (j == x) ? c : mine; }
        if (sum == G) break;
        __builtin_amdgcn_s_sleep(1);
        if ((++sp & 255u) == 0u) { if (xb_ld(&bar[XB_TMO])) break; if (sp > XB_SPIN_CAP) { atomicAdd(&bar[XB_TMO], 1u); break; } }
    }
    nloc = mine > 0u ? mine : 1u; nx = cnt > 0u ? cnt : 1u;
}

__device__ __forceinline__ void xcd_barrier(const XcdBarrier& b) {
    asm volatile("s_waitcnt vmcnt(0)" ::: "memory");
    __syncthreads();
    if (b.wave == 0 && lane_id() == 0) {
        unsigned* bar = b.bar;
        __builtin_amdgcn_s_waitcnt(0);
        unsigned nloc = b.st[0], nx = b.st[1];
        if (nloc == 0u) { xcd_barrier_complete(bar, b.x, nloc, nx); b.st[0] = nloc; b.st[1] = nx; }
        const unsigned old = xb_add(&bar[XB_XSUB(b.x)], 1u);
        const unsigned gen = old / nloc;
        if (old + 1u == (gen + 1u) * nloc) {
            __builtin_amdgcn_fence(__ATOMIC_RELEASE, "agent");
            asm volatile("s_waitcnt vmcnt(0)" ::: "memory");
            const unsigned og = xb_add(&bar[XB_TOP], 1u);
            const unsigned tg = og / nx;
            if (og + 1u == (tg + 1u) * nx) xb_add(&bar[XB_TOPGEN], 1u);
            else XB_SPIN(xb_ld(&bar[XB_TOPGEN]) == tg, bar);
            __builtin_amdgcn_fence(__ATOMIC_ACQUIRE, "agent");
            xb_add(&bar[XB_XGEN(b.x)], 1u);
            asm volatile("s_waitcnt vmcnt(0)" ::: "memory");
        } else {
            XB_SPIN(xb_ld(&bar[XB_XGEN(b.x)]) == gen, bar);
            __builtin_amdgcn_fence(__ATOMIC_ACQUIRE, "agent");
            asm volatile("s_waitcnt vmcnt(0)" ::: "memory");
        }
    }
    __syncthreads();
}

struct Ctx {
    const float* const* in; float* out; unsigned char* ws;
    LAS unsigned char* lds; int wave, G, vcu;
};

__device__ __forceinline__ void conv_item(const float* W, int ldw, int scol0, int nvalid, const float* gain, bf16* WT, int K, int drow0, int k0, LAS float* scr, int lane) {
#pragma unroll 8
    for (int i = 0; i < 32; ++i) { const int kk = 2 * i + (lane >> 5), n = lane & 31; float v = (n < nvalid) ? W[(size_t)(k0 + kk) * ldw + scol0 + n] : 0.f; if (gain) v *= gain[k0 + kk]; scr[kk * 33 + n] = v; }
    LDSFENCE();
    const int c = lane & 7;
#pragma unroll
    for (int j = 0; j < 4; ++j) { const int n = (lane >> 3) + 8 * j; const LAS float* s = scr + (8 * c) * 33 + n;
        v4u o; o.x = pk2(s[0 * 33], s[1 * 33]); o.y = pk2(s[2 * 33], s[3 * 33]); o.z = pk2(s[4 * 33], s[5 * 33]); o.w = pk2(s[6 * 33], s[7 * 33]);
        *(v4u*)(WT + (size_t)(drow0 + n) * K + k0 + 8 * c) = o; }
    LDSFENCE();
}
__device__ __forceinline__ void conv_gu(const float* wg, const float* wu, const float* gain, bf16* WT, int it, LAS float* scr, int lane) {
    const int db = it >> 4, kb = it & 15, tile = db >> 3, w = db & 7;
    conv_item(w < 4 ? wg : wu, FF, 128 * tile + 32 * (w & 3), 32, gain, WT, D, 32 * db, 64 * kb, scr, lane);
}
__device__ __forceinline__ void conv_plain(const float* W, int K, int N, bf16* WT, int it, LAS float* scr, int lane) {
    const int nkb = K / 64, db = it / nkb, kb = it % nkb;
    conv_item(W, N, 32 * db, 32, nullptr, WT, K, 32 * db, 64 * kb, scr, lane);
}
__device__ __forceinline__ void conv_win(const float* W, const float* gain, bf16* WT, int it, LAS float* scr, int lane) {
    const int db = it >> 4, kb = it & 15, d0 = 32 * db; int sc, nv = 32;
    if (d0 < 2048) sc = d0; else if (d0 < 3584) sc = d0 + 16; else if (d0 == 3584) { sc = 2048; nv = 16; } else { sc = 0; nv = 0; }
    conv_item(W, WIN_SRC, sc, nv, gain, WT, D, d0, 64 * kb, scr, lane);
}
__device__ __forceinline__ void conv_wg(const float* W, const float* gain, bf16* WT, int it, LAS float* scr, int lane) {
    const int db = it >> 4, kb = it & 15, tile = db >> 3, w = db & 7;
    conv_item(W, WIN_SRC, 3600 + (w < 4 ? 0 : 1024) + 128 * tile + 32 * (w & 3), 32, gain, WT, D, 32 * db, 64 * kb, scr, lane);
}

__device__ __forceinline__ void p0_prologue(Ctx& F) {
    const int lane = lane_id();
    LAS float* scr = (LAS float*)(F.lds + RING_OFF + F.wave * 17408);
    const int gw = F.vcu * NWAVES + F.wave, NGW = F.G * NWAVES;
    bf16* ws16 = (bf16*)F.ws;
    constexpr int I_GU = 176 * 16, I_DN = 32 * 44, I_WIN = 120 * 16, I_WG = 64 * 16, I_AB = 32 * 8, I_WO = 32 * 16;
    constexpr int NIT = I_GU + I_DN + I_WIN + I_WG + 2 * I_AB + I_WO;
    for (int it = gw; it < NIT; it += NGW) {
        int r = it;
        if (r < I_GU) { conv_gu(F.in[2], F.in[3], F.in[1], (bf16*)(F.ws + WS_WGU1), r, scr, lane); continue; } r -= I_GU;
        if (r < I_DN) { conv_plain(F.in[4], FF, D, (bf16*)(F.ws + WS_WD1), r, scr, lane); continue; } r -= I_DN;
        if (r < I_WIN) { conv_win(F.in[6], F.in[5], (bf16*)(F.ws + WS_WIN), r, scr, lane); continue; } r -= I_WIN;
        if (r < I_WG) { conv_wg(F.in[6], F.in[5], (bf16*)(F.ws + WS_WG), r, scr, lane); continue; } r -= I_WG;
        if (r < I_AB) { conv_plain(F.in[16], 512, D, (bf16*)(F.ws + WS_WA), r, scr, lane); continue; } r -= I_AB;
        if (r < I_AB) { conv_plain(F.in[17], 512, D, (bf16*)(F.ws + WS_WB), r, scr, lane); continue; } r -= I_AB;
        conv_plain(F.in[18], D, D, (bf16*)(F.ws + WS_WOUT), r, scr, lane);
    }
    (void)ws16;
    const float* x = F.in[0]; bf16* xb = (bf16*)(F.ws + WS_XB); float* ssq = (float*)(F.ws + WS_SSQA);
    for (int m = gw; m < M; m += NGW) {
        const f32x4* xr = (const f32x4*)(x + (size_t)m * D) + lane; unsigned long long* o8 = (unsigned long long*)(xb + (size_t)m * D) + lane;
        float s = 0.f;
#pragma unroll
        for (int j = 0; j < 4; ++j) { const f32x4 v = xr[64 * j]; s += (v.x * v.x + v.y * v.y) + (v.z * v.z + v.w * v.w);
            o8[64 * j] = (unsigned long long)pk2(v.x, v.y) | ((unsigned long long)pk2(v.z, v.w) << 32); }
        s = wave_sum(s);
        if (lane < 16) ssq[(size_t)m * 16 + lane] = (lane == 0) ? s : 0.f;
    }
}
__device__ __forceinline__ void conv_ffn2(Ctx& F) {
    const int lane = lane_id();
    LAS float* scr = (LAS float*)(F.lds + RING_OFF + F.wave * 17408);
    const int gw = F.vcu * NWAVES + F.wave, NGW = F.G * NWAVES;
    constexpr int I_GU = 176 * 16, I_DN = 32 * 44;
    for (int it = gw; it < I_GU + I_DN; it += NGW) {
        if (it < I_GU) conv_gu(F.in[20], F.in[21], F.in[19], (bf16*)(F.ws + WS_WGU2), it, scr, lane);
        else conv_plain(F.in[22], FF, D, (bf16*)(F.ws + WS_WD2), it - I_GU, scr, lane);
    }
}

__device__ __forceinline__ float silu_acc(float v) { return v / (1.0f + __expf(-v)); }
typedef unsigned u32x2 __attribute__((ext_vector_type(2)));
__device__ __forceinline__ void dn_conv_l1(const bf16* PRE, const float* cw, long row0, int tin0, int colbase, int r, int hh, float (&y)[2][4][8]) {
#pragma unroll
    for (int s = 0; s < 4; ++s) {
        const int ch0 = colbase + 16 * s + 4 * hh;
        f32x4 wl[4], wh[4];
#pragma unroll
        for (int j = 0; j < 4; ++j) { wl[j] = *(const f32x4*)(cw + j * 1536 + ch0); wh[j] = *(const f32x4*)(cw + j * 1536 + ch0 + 8); }
#pragma unroll
        for (int i = 0; i < 2; ++i) { const int tok = r + 32 * i, tin = tin0 + tok; const long row = row0 + tok;
            float a[8];
#pragma unroll
            for (int e = 0; e < 8; ++e) a[e] = 0.f;
#pragma unroll
            for (int j = 0; j < 4; ++j) { u32x2 lo = (u32x2){0u, 0u}, hi = (u32x2){0u, 0u};
                if (tin - 3 + j >= 0) { const bf16* p = PRE + (size_t)(row - 3 + j) * 1536 + ch0; lo = *(const u32x2*)p; hi = *(const u32x2*)(p + 8); }
                a[0] += wl[j][0] * bflo(lo.x); a[1] += wl[j][1] * bfhi(lo.x); a[2] += wl[j][2] * bflo(lo.y); a[3] += wl[j][3] * bfhi(lo.y);
                a[4] += wh[j][0] * bflo(hi.x); a[5] += wh[j][1] * bfhi(hi.x); a[6] += wh[j][2] * bflo(hi.y); a[7] += wh[j][3] * bfhi(hi.y); }
#pragma unroll
            for (int e = 0; e < 8; ++e) { y[i][s][e] = silu_acc(a[e]); asm volatile("" : "+v"(y[i][s][e])); } }
        __builtin_amdgcn_sched_barrier(0);
    }
}
__device__ __forceinline__ bf16x8 pack8f(const float (&v)[8], float sc) {
    v4u o; o.x = pk2(v[0] * sc, v[1] * sc); o.y = pk2(v[2] * sc, v[3] * sc); o.z = pk2(v[4] * sc, v[5] * sc); o.w = pk2(v[6] * sc, v[7] * sc);
    return __builtin_bit_cast(bf16x8, o);
}
__device__ __forceinline__ v4u pack8acc(const f32x16& X, int kq) {
    v4u o; o.x = pk2(X[8 * kq], X[8 * kq + 1]); o.y = pk2(X[8 * kq + 2], X[8 * kq + 3]); o.z = pk2(X[8 * kq + 4], X[8 * kq + 5]); o.w = pk2(X[8 * kq + 6], X[8 * kq + 7]);
    return o;
}
__device__ __forceinline__ void write_xt(LAS unsigned short* XT, const bf16x8 (&fr)[2][4], const float (&sc)[2], int r, int hh) {
#pragma unroll
    for (int i = 0; i < 2; ++i)
#pragma unroll
        for (int s = 0; s < 4; ++s) { const v4u w = __builtin_bit_cast(v4u, fr[i][s]);
#pragma unroll
            for (int e = 0; e < 8; ++e) { const unsigned ww = w[e >> 1]; const float v = ((e & 1) ? bfhi(ww) : bflo(ww)) * sc[i];
                XT[(16 * s + 8 * (e >> 2) + 4 * hh + (e & 3)) * 72 + r + 32 * i] = (unsigned short)f2bf(v); } }
}
__device__ __forceinline__ float lane_bcast(float v, int l) { return __uint_as_float((unsigned)__builtin_amdgcn_readlane((int)__float_as_uint(v), l)); }

__device__ __forceinline__ void dn_prep_chunk(Ctx& F, int ch, LAS unsigned char* scrb, int opq  ) {
    int lane_ = lane_id();
    const int lane = lane_, r = lane & 31, hh = lane >> 5;
    const int n = ch & 127, h = (ch >> 7) & 7, b = ch >> 10;
    const long row0 = (long)b * T + 64 * n; const int tin0 = 64 * n;
    const bf16* PRE = (const bf16*)(F.ws + WS_PRE); const float* AB = (const float*)(F.ws + WS_AB); const float* cw = F.in[7];
    unsigned char* rec = F.ws + WS_DN + (size_t)ch * DN_REC;
    LAS float* At = (LAS float*)scrb; LAS unsigned short* TT = (LAS unsigned short*)scrb; LAS unsigned short* XT = (LAS unsigned short*)(scrb + 9216);
    float gc, betac;
    { const float al = AB[(size_t)(row0 + lane) * 16 + h], bl = AB[(size_t)(row0 + lane) * 16 + 8 + h];
      const float xs = al + F.in[9][h];
      const float sp = fmaxf(xs, 0.f) + log1pf(expf(-fabsf(xs)));
      gc = -expf(F.in[8][h]) * sp; betac = 1.0f / (1.0f + expf(-bl));
#pragma unroll
      for (int o = 1; o < 64; o <<= 1) { const float t = __shfl_up(gc, o); if (lane >= o) gc += t; } }
    const float gl = lane_bcast(gc, 63);
    float gct[2], bet[2];
#pragma unroll
    for (int i = 0; i < 2; ++i) { gct[i] = __shfl(gc, r + 32 * i); bet[i] = __shfl(betac, r + 32 * i); }
    bf16x8 kf[2][4];
#pragma unroll
    for (int i = 0; i < 2; ++i)
#pragma unroll
        for (int s = 0; s < 4; ++s) kf[i][s] = (bf16x8){0, 0, 0, 0, 0, 0, 0, 0};
    if (opq > 0) { int lane = lane_; asm volatile("" : "+v"(lane)); const int r = lane & 31, hh = lane >> 5;
      float y[2][4][8]; dn_conv_l1(PRE, cw, row0, tin0, 512 + h * 64, r, hh, y);
#pragma unroll
      for (int i = 0; i < 2; ++i) { float ss = 0.f;
#pragma unroll
          for (int s = 0; s < 4; ++s)
#pragma unroll
              for (int e = 0; e < 8; ++e) ss += y[i][s][e] * y[i][s][e];
          ss += __shfl_xor(ss, 32); const float rn = 1.0f / sqrtf(ss + 1e-6f);
#pragma unroll
          for (int s = 0; s < 4; ++s) { kf[i][s] = pack8f(y[i][s], rn); asm volatile("" : "+v"(kf[i][s])); } } }
    __builtin_amdgcn_sched_barrier(0);
    if (opq > 1) { int lane = lane_; asm volatile("" : "+v"(lane)); const int r = lane & 31, hh = lane >> 5;
      float sc[2] = {expf(gl - gct[0]), expf(gl - gct[1])};
      write_xt(XT, kf, sc, r, hh);
      LDSFENCE();
#pragma unroll
      for (int id = 0; id < 2; ++id)
#pragma unroll
          for (int ks = 0; ks < 4; ++ks) { const int d = r + 32 * id; const LAS unsigned short* p = XT + d * 72 + 16 * ks + 4 * hh;
              const u32x2 lo = *(const LAS u32x2*)p, hi = *(const LAS u32x2*)(p + 8);
              *(v4u*)(rec + 24576 + d * 128 + (ks * 2 + hh) * 16) = (v4u){lo.x, lo.y, hi.x, hi.y}; }
      LDSFENCE(); }
    __builtin_amdgcn_sched_barrier(0);
#ifndef SKQ
    if (opq > 2) {
        int lane = lane_; asm volatile("" : "+v"(lane)); const int r = lane & 31, hh = lane >> 5;
        bf16x8 qf[2][4];
        { float y[2][4][8]; dn_conv_l1(PRE, cw, row0, tin0, h * 64, r, hh, y);
#pragma unroll
          for (int i = 0; i < 2; ++i) { float ss = 0.f;
#pragma unroll
              for (int s = 0; s < 4; ++s)
#pragma unroll
                  for (int e = 0; e < 8; ++e) ss += y[i][s][e] * y[i][s][e];
              ss += __shfl_xor(ss, 32); const float rn = 0.125f / sqrtf(ss + 1e-6f); const float eg = expf(gct[i]);
#pragma unroll
              for (int s = 0; s < 4; ++s) { qf[i][s] = pack8f(y[i][s], rn);
                  *(bf16x8*)(rec + 8192 + (r + 32 * i) * 128 + (s * 2 + hh) * 16) = pack8f(y[i][s], rn * eg); asm volatile("" : "+v"(qf[i][s])); } } }
        __builtin_amdgcn_sched_barrier(0);
#pragma unroll
        for (int is = 0; is < 2; ++is) {
            float gcr[16];
#pragma unroll
            for (int g = 0; g < 16; ++g) gcr[g] = __shfl(gc, 32 * is + (g & 3) + 8 * (g >> 2) + 4 * hh);
#pragma unroll
            for (int ic = 0; ic < 2; ++ic) {
                if (is == 1 && ic == 0) {
#pragma unroll
                    for (int kq = 0; kq < 2; ++kq) *(v4u*)(rec + 16384 + r * 128 + ((2 + kq) * 2 + hh) * 16) = (v4u){0u, 0u, 0u, 0u};
#pragma unroll
                    for (int g = 0; g < 16; ++g) At[(32 + (g & 3) + 8 * (g >> 2) + 4 * hh) * 68 + r] = 0.f;
                    continue;
                }
                f32x16 pt, pk;
#pragma unroll
                for (int g = 0; g < 16; ++g) { pt[g] = 0.f; pk[g] = 0.f; }
#pragma unroll
                for (int ks = 0; ks < 4; ++ks) { pt = __builtin_amdgcn_mfma_f32_32x32x16_bf16(kf[is][ks], qf[ic][ks], pt, 0, 0, 0); pk = __builtin_amdgcn_mfma_f32_32x32x16_bf16(kf[is][ks], kf[ic][ks], pk, 0, 0, 0); }
                const int ccol = 32 * ic + r;
#pragma unroll
                for (int g = 0; g < 16; ++g) { const int srow = 32 * is + (g & 3) + 8 * (g >> 2) + 4 * hh; const float dec = expf(fminf(gct[ic] - gcr[g], 0.f));
                    pt[g] = (srow <= ccol) ? pt[g] * dec : 0.f;
                    At[srow * 68 + ccol] = (srow < ccol) ? bet[ic] * pk[g] * dec : 0.f; }
#pragma unroll
                for (int kq = 0; kq < 2; ++kq) *(v4u*)(rec + 16384 + ccol * 128 + ((2 * is + kq) * 2 + hh) * 16) = pack8acc(pt, kq);
                __builtin_amdgcn_sched_barrier(0);
            }
        }
    }
    LDSFENCE();
#endif
    __builtin_amdgcn_sched_barrier(0);
#ifndef SKS
    if (opq > 3) {
        int lane = lane_; asm volatile("" : "+v"(lane)); const int r = lane & 31, hh = lane >> 5;
        float t[64];
#pragma unroll
        for (int k = 0; k < 64; ++k) t[k] = (k == lane) ? 1.0f : 0.0f;
#pragma unroll
        for (int j = 62; j >= 0; --j) { float acc = 0.f;
#pragma unroll
            for (int k4 = (j + 1) & ~3; k4 < 64; k4 += 4) { const f32x4 x = *(const volatile LAS f32x4*)(At + j * 68 + k4);
#pragma unroll
                for (int i = 0; i < 4; ++i) if (k4 + i > j) acc += t[k4 + i] * x[i]; }
            t[j] -= acc; asm volatile("" : "+v"(t[j])); }
        LDSFENCE();
#pragma unroll
        for (int i = 0; i < 8; ++i) { v4u o; o.x = pk2(t[8 * i], t[8 * i + 1]); o.y = pk2(t[8 * i + 2], t[8 * i + 3]); o.z = pk2(t[8 * i + 4], t[8 * i + 5]); o.w = pk2(t[8 * i + 6], t[8 * i + 7]);
            *(LAS v4u*)(TT + lane * 72 + 8 * i) = o; }
    }
#endif
    __builtin_amdgcn_sched_barrier(0);
#ifndef SKW
    if (opq > 4) { int lane = lane_; asm volatile("" : "+v"(lane)); const int r = lane & 31, hh = lane >> 5;
      float sc[2] = {bet[0] * expf(gct[0]), bet[1] * expf(gct[1])};
      write_xt(XT, kf, sc, r, hh);
      LDSFENCE();
#pragma unroll
      for (int id = 0; id < 2; ++id)
#pragma unroll
          for (int ic = 0; ic < 2; ++ic) { f32x16 acc;
#pragma unroll
              for (int g = 0; g < 16; ++g) acc[g] = 0.f;
#pragma unroll
              for (int ks = 0; ks < 4; ++ks) { const bf16x8 af = *(const LAS bf16x8*)(XT + (r + 32 * id) * 72 + 16 * ks + 8 * hh), bfr = *(const LAS bf16x8*)(TT + (r + 32 * ic) * 72 + 16 * ks + 8 * hh);
                  acc = __builtin_amdgcn_mfma_f32_32x32x16_bf16(af, bfr, acc, 0, 0, 0); }
#pragma unroll
              for (int kq = 0; kq < 2; ++kq) *(v4u*)(rec + (32 * ic + r) * 128 + ((2 * id + kq) * 2 + hh) * 16) = pack8acc(acc, kq); __builtin_amdgcn_sched_barrier(0); }
      LDSFENCE(); }
    __builtin_amdgcn_sched_barrier(0);
#endif
#ifndef SKU
    if (opq > 1) { int lane = lane_; asm volatile("" : "+v"(lane)); const int r = lane & 31, hh = lane >> 5;
      bf16x8 vf[2][4];
      { float y[2][4][8]; dn_conv_l1(PRE, cw, row0, tin0, 1024 + h * 64, r, hh, y);
#pragma unroll
        for (int i = 0; i < 2; ++i)
#pragma unroll
            for (int s = 0; s < 4; ++s) { vf[i][s] = pack8f(y[i][s], bet[i]); asm volatile("" : "+v"(vf[i][s])); } }
      __builtin_amdgcn_sched_barrier(0);
      float one[2] = {1.0f, 1.0f};
      write_xt(XT, vf, one, r, hh);
      LDSFENCE();
      unsigned* U = (unsigned*)(rec + 32768);
#pragma unroll
      for (int ic = 0; ic < 2; ++ic)
#pragma unroll
          for (int ie = 0; ie < 2; ++ie) { f32x16 acc;
#pragma unroll
              for (int g = 0; g < 16; ++g) acc[g] = 0.f;
#pragma unroll
              for (int ks = 0; ks < 4; ++ks) { const bf16x8 af = *(const LAS bf16x8*)(TT + (r + 32 * ic) * 72 + 16 * ks + 8 * hh), bfr = *(const LAS bf16x8*)(XT + (r + 32 * ie) * 72 + 16 * ks + 8 * hh);
                  acc = __builtin_amdgcn_mfma_f32_32x32x16_bf16(af, bfr, acc, 0, 0, 0); }
#pragma unroll
              for (int gp = 0; gp < 8; ++gp) U[((ie * 2 + ic) * 8 + gp) * 64 + lane] = pk2(acc[2 * gp], acc[2 * gp + 1]); __builtin_amdgcn_sched_barrier(0); }
      LDSFENCE(); }
#endif
    if (lane == 0) ((float*)(F.ws + WS_DNCD))[ch] = expf(gl);
}

__device__ __forceinline__ bf16x8 pack8(const f32x16& X, int s) {
    v4u o; o.x = pg8::cvt_pk_bf16(X[8 * s], X[8 * s + 1]); o.y = pg8::cvt_pk_bf16(X[8 * s + 2], X[8 * s + 3]); o.z = pg8::cvt_pk_bf16(X[8 * s + 4], X[8 * s + 5]); o.w = pg8::cvt_pk_bf16(X[8 * s + 6], X[8 * s + 7]);
    return __builtin_bit_cast(bf16x8, o);
}
__device__ __forceinline__ void dn_scan(Ctx& F, int sw) {
    const int lane = lane_id(), r = lane & 31, hh = lane >> 5;
    const int bh = sw >> 1, sl = sw & 1, b = bh >> 3, h = bh & 7;
    const float* CD = (const float*)(F.ws + WS_DNCD) + bh * 128;
    bf16* ODN = (bf16*)(F.ws + WS_ODN);
    f32x16 S0, S1;
#pragma unroll
    for (int i = 0; i < 16; ++i) { S0[i] = 0.f; S1[i] = 0.f; }
    for (int n = 0; n < 128; ++n) {
        const unsigned char* rec = F.ws + WS_DN + ((size_t)bh * 128 + n) * DN_REC;
        const unsigned char* fb = rec + r * 128 + hh * 16;
        bf16x8 w[2][4], qd[2][4], at[2][4], kt[2][4];
#pragma unroll
        for (int i = 0; i < 2; ++i)
#pragma unroll
            for (int ks = 0; ks < 4; ++ks) { const int o = i * 4096 + ks * 32;
                w[i][ks] = *(const bf16x8*)(fb + o); qd[i][ks] = *(const bf16x8*)(fb + 8192 + o); at[i][ks] = *(const bf16x8*)(fb + 16384 + o); kt[i][ks] = *(const bf16x8*)(fb + 24576 + o); }
        const unsigned* up = (const unsigned*)(rec + 32768) + (sl * 2) * 8 * 64 + lane;
        unsigned uw[2][8];
#pragma unroll
        for (int i = 0; i < 2; ++i)
#pragma unroll
            for (int gp = 0; gp < 8; ++gp) uw[i][gp] = up[(i * 8 + gp) * 64];
        const float cd = CD[n];
        bf16x8 sb[4]; sb[0] = pack8(S0, 0); sb[1] = pack8(S0, 1); sb[2] = pack8(S1, 0); sb[3] = pack8(S1, 1);
        f32x16 ws[2], qs[2];
#pragma unroll
        for (int i = 0; i < 2; ++i) {
#pragma unroll
            for (int g = 0; g < 16; ++g) { ws[i][g] = 0.f; qs[i][g] = 0.f; }
#pragma unroll
            for (int ks = 0; ks < 4; ++ks) { ws[i] = __builtin_amdgcn_mfma_f32_32x32x16_bf16(w[i][ks], sb[ks], ws[i], 0, 0, 0); qs[i] = __builtin_amdgcn_mfma_f32_32x32x16_bf16(qd[i][ks], sb[ks], qs[i], 0, 0, 0); }
        }
#pragma unroll
        for (int i = 0; i < 2; ++i)
#pragma unroll
            for (int gp = 0; gp < 8; ++gp) { ws[i][2 * gp] = bflo(uw[i][gp]) - ws[i][2 * gp]; ws[i][2 * gp + 1] = bfhi(uw[i][gp]) - ws[i][2 * gp + 1]; }
        bf16x8 vb[4]; vb[0] = pack8(ws[0], 0); vb[1] = pack8(ws[0], 1); vb[2] = pack8(ws[1], 0); vb[3] = pack8(ws[1], 1);
#pragma unroll
        for (int g = 0; g < 16; ++g) { S0[g] *= cd; S1[g] *= cd; }
#pragma unroll
        for (int ks = 0; ks < 4; ++ks) {
            qs[0] = __builtin_amdgcn_mfma_f32_32x32x16_bf16(at[0][ks], vb[ks], qs[0], 0, 0, 0);
            qs[1] = __builtin_amdgcn_mfma_f32_32x32x16_bf16(at[1][ks], vb[ks], qs[1], 0, 0, 0);
            S0 = __builtin_amdgcn_mfma_f32_32x32x16_bf16(kt[0][ks], vb[ks], S0, 0, 0, 0);
            S1 = __builtin_amdgcn_mfma_f32_32x32x16_bf16(kt[1][ks], vb[ks], S1, 0, 0, 0);
        }
        bf16* orow = ODN + ((size_t)b * T + 64 * n) * 512 + h * 64 + 32 * sl + r;
#pragma unroll
        for (int i = 0; i < 2; ++i)
#pragma unroll
            for (int g = 0; g < 16; ++g) { const int c = 32 * i + (g & 3) + 8 * (g >> 2) + 4 * hh; orow[(size_t)c * 512] = (bf16)f2bf(qs[i][g]); }
    }
}

constexpr int SC_SLOT = 4 * 9216 + 8192, SC_NPIECE = DN_REC / 16, SC_LANES = 5 * 64, SC_PPL = SC_NPIECE / SC_LANES;
static_assert(SC_PPL * SC_LANES == SC_NPIECE, "whole pieces per loader lane");
static_assert(3 * SC_SLOT <= RING_BYTES, "scan ring fits the phase scratch");
__device__ __forceinline__ int sc_piece_off(int p) { return p < 2048 ? (p >> 9) * 9216 + ((p & 511) >> 3) * 144 + (p & 7) * 16 : 36864 + (p - 2048) * 16; }
__device__ __forceinline__ void dn_scan_block(Ctx& F, int bh) {
    const int lane = lane_id(), wave = F.wave;
    LAS unsigned char* ring = F.lds + RING_OFF;
    const unsigned char* recs = F.ws + WS_DN + (size_t)bh * 128 * DN_REC;
#define SC_BAR() asm volatile("s_waitcnt vmcnt(0) lgkmcnt(0)\n\ts_barrier" ::: "memory")
    if (wave == 7) {
        asm volatile("s_barrier" ::: "memory");
#pragma unroll 1
        for (int n = 0; n < 128; ++n) asm volatile("s_barrier" ::: "memory");
    } else if (wave >= 2) {
        const int ll = (wave - 2) * 64 + lane; v4u d0[SC_PPL], d1[SC_PPL], d2[SC_PPL], d3[SC_PPL];
#define SC_LOAD(D, rec_) do { _Pragma("unroll") for (int j = 0; j < SC_PPL; ++j) { const int p = ll + j * SC_LANES; D[j] = *(const v4u*)(recs + (size_t)(rec_) * DN_REC + p * 16); } } while (0)
#define SC_STORE(D, slot_) do { _Pragma("unroll") for (int j = 0; j < SC_PPL; ++j) { const int p = ll + j * SC_LANES; *(LAS v4u*)(ring + (slot_) * SC_SLOT + sc_piece_off(p)) = D[j]; } } while (0)
#define SC_LBAR() asm volatile("s_waitcnt lgkmcnt(0)\n\ts_barrier" ::: "memory")
        SC_LOAD(d0, 0); SC_LOAD(d1, 1); SC_STORE(d0, 0); SC_STORE(d1, 1);
        SC_LOAD(d0, 2); SC_LOAD(d1, 3); SC_LOAD(d2, 4); SC_LOAD(d3, 5);
        SC_LBAR();
#define SC_STEP(D, n_, slot_) do { SC_STORE(D, slot_); SC_LOAD(D, (n_) + 6); SC_LBAR(); } while (0)
#pragma unroll 1
        for (int n = 0; n < 128; n += 12) {
            SC_STEP(d0, n, 2); SC_STEP(d1, n + 1, 0); SC_STEP(d2, n + 2, 1); SC_STEP(d3, n + 3, 2);
            SC_STEP(d0, n + 4, 0); SC_STEP(d1, n + 5, 1); SC_STEP(d2, n + 6, 2); SC_STEP(d3, n + 7, 0);
            if (n + 8 < 128) { SC_STEP(d0, n + 8, 1); SC_STEP(d1, n + 9, 2); SC_STEP(d2, n + 10, 0); SC_STEP(d3, n + 11, 1); }
        }
#undef SC_LOAD
#undef SC_STORE
#undef SC_STEP
#undef SC_LBAR
    } else {
        const int r = lane & 31, hh = lane >> 5, sl = wave, b = bh >> 3, h = bh & 7;
        const float* CD = (const float*)(F.ws + WS_DNCD) + bh * 128;
        bf16* ODN = (bf16*)(F.ws + WS_ODN);
        f32x16 S0, S1;
#pragma unroll
        for (int i = 0; i < 16; ++i) { S0[i] = 0.f; S1[i] = 0.f; }
        float cd = CD[0];
        asm volatile("s_waitcnt lgkmcnt(0)\n\ts_barrier" ::: "memory");
        int slot = 0;
#pragma unroll 1
        for (int n = 0; n < 128; ++n) {
            const LAS unsigned char* sb_ = ring + slot * SC_SLOT; const LAS unsigned char* fb = sb_ + r * 144 + hh * 16;
            const float cdn = CD[n + 1 < 128 ? n + 1 : n];
            bf16x8 w[2][4], qd[2][4];
#pragma unroll
            for (int i = 0; i < 2; ++i)
#pragma unroll
                for (int ks = 0; ks < 4; ++ks) { const int o = i * 32 * 144 + ks * 32; w[i][ks] = *(const LAS bf16x8*)(fb + o); qd[i][ks] = *(const LAS bf16x8*)(fb + 9216 + o); }
            bf16x8 sb[4]; sb[0] = pack8(S0, 0); sb[1] = pack8(S0, 1); sb[2] = pack8(S1, 0); sb[3] = pack8(S1, 1);
            f32x16 ws[2], qs[2];
#pragma unroll
            for (int i = 0; i < 2; ++i) {
#pragma unroll
                for (int g = 0; g < 16; ++g) { ws[i][g] = 0.f; qs[i][g] = 0.f; }
#pragma unroll
                for (int ks = 0; ks < 4; ++ks) { ws[i] = __builtin_amdgcn_mfma_f32_32x32x16_bf16(w[i][ks], sb[ks], ws[i], 0, 0, 0); qs[i] = __builtin_amdgcn_mfma_f32_32x32x16_bf16(qd[i][ks], sb[ks], qs[i], 0, 0, 0); }
            }
            bf16x8 at[2][4], kt[2][4];
#pragma unroll
            for (int i = 0; i < 2; ++i)
#pragma unroll
                for (int ks = 0; ks < 4; ++ks) { const int o = i * 32 * 144 + ks * 32; at[i][ks] = *(const LAS bf16x8*)(fb + 2 * 9216 + o); kt[i][ks] = *(const LAS bf16x8*)(fb + 3 * 9216 + o); }
            const LAS unsigned* up = (const LAS unsigned*)(sb_ + 36864) + (sl * 2) * 8 * 64 + lane;
#pragma unroll
            for (int i = 0; i < 2; ++i)
#pragma unroll
                for (int gp = 0; gp < 8; ++gp) { const unsigned uw = up[(i * 8 + gp) * 64]; ws[i][2 * gp] = bflo(uw) - ws[i][2 * gp]; ws[i][2 * gp + 1] = bfhi(uw) - ws[i][2 * gp + 1]; }
            bf16x8 vb[4]; vb[0] = pack8(ws[0], 0); vb[1] = pack8(ws[0], 1); vb[2] = pack8(ws[1], 0); vb[3] = pack8(ws[1], 1);
#pragma unroll
            for (int g = 0; g < 16; ++g) { S0[g] *= cd; S1[g] *= cd; }
#pragma unroll
            for (int ks = 0; ks < 4; ++ks) {
                S0 = __builtin_amdgcn_mfma_f32_32x32x16_bf16(kt[0][ks], vb[ks], S0, 0, 0, 0);
                S1 = __builtin_amdgcn_mfma_f32_32x32x16_bf16(kt[1][ks], vb[ks], S1, 0, 0, 0);
                qs[0] = __builtin_amdgcn_mfma_f32_32x32x16_bf16(at[0][ks], vb[ks], qs[0], 0, 0, 0);
                qs[1] = __builtin_amdgcn_mfma_f32_32x32x16_bf16(at[1][ks], vb[ks], qs[1], 0, 0, 0);
            }
            bf16* orow = ODN + ((size_t)b * T + 64 * n) * 512 + h * 64 + 32 * sl + r;
#pragma unroll
            for (int i = 0; i < 2; ++i)
#pragma unroll
                for (int g = 0; g < 16; ++g) { const int c = 32 * i + (g & 3) + 8 * (g >> 2) + 4 * hh; orow[(size_t)c * 512] = (bf16)f2bf(qs[i][g]); }
            cd = cdn; slot = (slot == 2) ? 0 : slot + 1;
            asm volatile("s_waitcnt lgkmcnt(0)\n\ts_barrier" ::: "memory");
        }
    }
    SC_BAR();
#undef SC_BAR
}

__device__ __forceinline__ void qk_norm_max(Ctx& F) {
    const int gw = F.vcu * NWAVES + F.wave, NGW = F.G * NWAVES, lane = lane_id(), j = lane >> 3;
    const bf16* QO = (const bf16*)(F.ws + WS_QO); const bf16* KD = (const bf16*)(F.ws + WS_KD);
    float mq[2] = {0.f, 0.f}, mk[2] = {0.f, 0.f};
    for (int m = gw; m < M; m += NGW) {
        const v4u qv = *(const v4u*)(QO + (size_t)m * 1024 + (2 * j) * 64 + (lane & 7) * 8), kv = *(const v4u*)(KD + (size_t)m * 512 + lane * 8);
        float sq = 0.f, sk = 0.f;
#pragma unroll
        for (int e = 0; e < 4; ++e) { const float a = bflo(qv[e]), b2 = bfhi(qv[e]), c = bflo(kv[e]), d = bfhi(kv[e]); sq += a * a + b2 * b2; sk += c * c + d * d; }
        sq += __shfl_xor(sq, 1); sq += __shfl_xor(sq, 2); sq += __shfl_xor(sq, 4);
        sk += __shfl_xor(sk, 1); sk += __shfl_xor(sk, 2); sk += __shfl_xor(sk, 4);
        const int bb = m >> 13;
        if (bb == 0) { mq[0] = fmaxf(mq[0], sq); mk[0] = fmaxf(mk[0], sk); } else { mq[1] = fmaxf(mq[1], sq); mk[1] = fmaxf(mk[1], sk); }
    }
    if ((lane & 7) == 0) { unsigned* nm = (unsigned*)(F.ws + WS_CTL) + CW_NMAX;
#pragma unroll
        for (int bb = 0; bb < 2; ++bb) { atomicMax(nm + bb * 8 + j, __float_as_uint(mq[bb])); atomicMax(nm + 16 + bb * 8 + j, __float_as_uint(mk[bb])); } }
}

__device__ __forceinline__ void finalize_rows(Ctx& F) {
    const int gw = F.vcu * NWAVES + F.wave, NGW = F.G * NWAVES, lane = lane_id();
    const bf16* ODN = (const bf16*)(F.ws + WS_ODN); const bf16* Z = (const bf16*)(F.ws + WS_Z); const bf16* QO = (const bf16*)(F.ws + WS_QO);
    bf16* AA = (bf16*)(F.ws + WS_AA); bf16* ABB = (bf16*)(F.ws + WS_ABB);
    float s1 = 0.f, s2 = 0.f;
    { const float a = F.in[11][lane] * F.in[12][lane], bq = F.in[13][lane] * F.in[14][lane]; s1 = wave_sum(a); s2 = wave_sum(bq); }
    const float lam_init = 0.2f;
    const float lam = expf(s1) - expf(s2) + lam_init;
    float gdn[8], gsub[8];
#pragma unroll
    for (int e = 0; e < 8; ++e) { gdn[e] = F.in[10][(lane & 7) * 8 + e]; gsub[e] = F.in[15][(lane & 15) * 8 + e] * (1.0f - lam_init); }
    for (int m = gw; m < M; m += NGW) {
        { const v4u ov = *(const v4u*)(ODN + (size_t)m * 512 + lane * 8), zv = *(const v4u*)(Z + (size_t)m * 512 + lane * 8);
          float o[8], z[8]; float ss = 0.f;
#pragma unroll
          for (int e = 0; e < 4; ++e) { o[2 * e] = bflo(ov[e]); o[2 * e + 1] = bfhi(ov[e]); z[2 * e] = bflo(zv[e]); z[2 * e + 1] = bfhi(zv[e]); }
#pragma unroll
          for (int e = 0; e < 8; ++e) ss += o[e] * o[e];
          ss += __shfl_xor(ss, 1); ss += __shfl_xor(ss, 2); ss += __shfl_xor(ss, 4);
          const float rn = 1.0f / sqrtf(ss * (1.0f / 64.0f) + RMS_EPS);
          float y[8];
#pragma unroll
          for (int e = 0; e < 8; ++e) y[e] = o[e] * rn * gdn[e] * silu_acc(z[e]);
          v4u w; w.x = pk2(y[0], y[1]); w.y = pk2(y[2], y[3]); w.z = pk2(y[4], y[5]); w.w = pk2(y[6], y[7]);
          *(v4u*)(AA + (size_t)m * 512 + lane * 8) = w; }
        { const int hd = lane >> 4, e0 = (lane & 15) * 8;
          const v4u a1 = *(const v4u*)(QO + (size_t)m * 1024 + hd * 256 + e0), a2 = *(const v4u*)(QO + (size_t)m * 1024 + hd * 256 + 128 + e0);
          float o[8]; float ss = 0.f;
#pragma unroll
          for (int e = 0; e < 4; ++e) { o[2 * e] = bflo(a1[e]) - lam * bflo(a2[e]); o[2 * e + 1] = bfhi(a1[e]) - lam * bfhi(a2[e]); }
#pragma unroll
          for (int e = 0; e < 8; ++e) ss += o[e] * o[e];
          ss += __shfl_xor(ss, 1); ss += __shfl_xor(ss, 2); ss += __shfl_xor(ss, 4); ss += __shfl_xor(ss, 8);
          const float rn = 1.0f / sqrtf(ss * (1.0f / 128.0f) + SUBLN_EPS);
          float y[8];
#pragma unroll
          for (int e = 0; e < 8; ++e) y[e] = o[e] * rn * gsub[e];
          v4u w; w.x = pk2(y[0], y[1]); w.y = pk2(y[2], y[3]); w.z = pk2(y[4], y[5]); w.w = pk2(y[6], y[7]);
          *(v4u*)(ABB + (size_t)m * 512 + hd * 128 + e0) = w; }
    }
}
__device__ __forceinline__ void final_norm_rows(Ctx& F) {
    const int lane = lane_id();
    const int gw = F.vcu * NWAVES + F.wave, NGW = F.G * NWAVES;
    const f32x4* gp = (const f32x4*)F.in[23] + lane; f32x4 gg[4];
#pragma unroll
    for (int j = 0; j < 4; ++j) gg[j] = gp[64 * j];
    for (int m = gw; m < M; m += NGW) {
        f32x4* xr = (f32x4*)(F.out + (size_t)m * D) + lane; f32x4 v[4]; float s = 0.f;
#pragma unroll
        for (int j = 0; j < 4; ++j) { v[j] = xr[64 * j]; s += (v[j].x * v[j].x + v[j].y * v[j].y) + (v[j].z * v[j].z + v[j].w * v[j].w); }
        const float rn = 1.0f / sqrtf(wave_sum(s) * (1.0f / D) + RMS_EPS);
#pragma unroll
        for (int j = 0; j < 4; ++j) xr[64 * j] = v[j] * rn * gg[j];
    }
}

constexpr int N_PHASES = 14;
struct Args { const float* in[24]; float* out; unsigned char* ws; int ph_lo, ph_hi; };
__global__ void __launch_bounds__(NWAVES * 64, 2) mk_fwd(Args args) {
    extern __shared__ __attribute__((aligned(16))) unsigned char lds[];
    Ctx F;
    F.in = args.in;
    F.out = args.out; F.ws = args.ws;
    F.lds = (LAS unsigned char*)lds;
    F.wave = __builtin_amdgcn_readfirstlane((int)threadIdx.x >> 6);
    F.G = gridDim.x; { const int bx = blockIdx.x; F.vcu = (F.G % 8 == 0) ? (bx % 8) * (F.G / 8) + bx / 8 : bx; }
    const int lo = args.ph_lo, hi = args.ph_hi;
    { volatile LAS unsigned* misc = (volatile LAS unsigned*)(F.lds + MISC_OFF); if (F.wave == 0) misc[lane_id()] = 0u; }
    __syncthreads();
    XcdBarrier bar = xcd_barrier_post((unsigned*)(args.ws + WS_CTL) + CW_BAR, (volatile LAS unsigned*)(F.lds + MISC_OFF) + 8, F.wave);
    if (lo < -7) cg::this_grid().sync();
    unsigned char* ws = F.ws;
    typedef pg8::bf16_t pb;
#ifndef PH_MASK
#define PH_MASK 0x3fff
#endif
#define IN(k) (((PH_MASK >> (k)) & 1) && lo <= (k) && (k) < hi)
#ifndef PROBE_A
#define PROBE_A -1
#endif
#ifndef PROBE_B
#define PROBE_B -1
#endif
#define STAMP(k) do { if (PROBE_A >= 0 && blockIdx.x == 0 && F.wave == 0 && lane_id() == 0) ((volatile unsigned long long*)(args.ws + WS_CTL + 32768))[k] = __builtin_amdgcn_s_memrealtime(); } while (0)
#define SEAM(k) do { if (IN(k) && IN((k) + 1)) xcd_barrier(bar); STAMP((k) + 1); } while (0)

    STAMP(0);
    if (IN(0)) { p0_prologue(F); } SEAM(0);
    if (IN(1)) { pg8::Gemm g{(const pb*)(ws + WS_XB), (const pb*)(ws + WS_WGU1), M, 2 * FF, D}; pg8::StaticOrder S; S.init(M, 2 * FF, F.G, (int)blockIdx.x);
        pg8::EpiSwiGLU E{(pb*)(ws + WS_H), FF, (const float*)(ws + WS_SSQA), RMS_EPS};
        pg8::gemm_phase<pg8::EpiSwiGLU, pg8::StaticOrder, true, true>(F.lds + RING_OFF, g, S, E, F.wave); } SEAM(1);
    if (IN(2)) { pg8::Gemm g{(const pb*)(ws + WS_H), (const pb*)(ws + WS_WD1), M, D, FF}; pg8::StaticOrder S; S.init(M, D, F.G, (int)blockIdx.x);
        pg8::EpiResid E{F.in[0], F.out, (pb*)(ws + WS_XB), (float*)(ws + WS_SSQB), 0.5f};
        pg8::gemm_phase<pg8::EpiResid, pg8::StaticOrder, true, true>(F.lds + RING_OFF, g, S, E, F.wave); } SEAM(2);
    if (IN(3)) { pg8::Gemm g{(const pb*)(ws + WS_XB), (const pb*)(ws + WS_WIN), M, WIN_N, D}; pg8::StaticOrder S; S.init(M, WIN_N, F.G, (int)blockIdx.x);
        pg8::EpiWin E{(pb*)(ws + WS_PRE), (pb*)(ws + WS_Z), (pb*)(ws + WS_QO), (pb*)(ws + WS_KD), (pb*)(ws + WS_VD), (float*)(ws + WS_AB), (const float*)(ws + WS_SSQB), RMS_EPS, attn_body::C2};
        pg8::gemm_phase<pg8::EpiWin, pg8::StaticOrder, true, true>(F.lds + RING_OFF, g, S, E, F.wave); } SEAM(3);
    if (IN(4)) { LAS unsigned char* scr = F.lds + RING_OFF + F.wave * 18432; const int gw = F.vcu * NWAVES + F.wave, NGW = F.G * NWAVES;
        for (int ch = gw; ch < 2048; ch += NGW) dn_prep_chunk(F, ch, scr, hi);
        qk_norm_max(F); } SEAM(4);
    if (IN(5)) {
        if (blockIdx.x < 16) dn_scan_block(F, (int)blockIdx.x);
        const attn_body::AttnTensors AT{(const attn_body::bf16*)(ws + WS_QO), (const attn_body::bf16*)(ws + WS_KD), (const attn_body::bf16*)(ws + WS_VD), (attn_body::bf16*)(ws + WS_QO), (const unsigned*)(ws + WS_CTL) + CW_NMAX};
        const attn_body::DynOrder S{(unsigned*)(ws + WS_CTL) + CW_ATTQ, (volatile LAS unsigned*)(F.lds + MISC_OFF) + 16, (int)(blockIdx.x & 7), F.wave};
        attn_body::attn_phase<attn_body::DynOrder>((char*)lds + RING_OFF, AT, S, F.wave); } SEAM(5);
    if (IN(7)) { finalize_rows(F); conv_ffn2(F); } SEAM(7);
    if (IN(8)) { pg8::StaticOrder S; S.init(M, D, F.G, (int)blockIdx.x);
        { pg8::Gemm g{(const pb*)(ws + WS_AA), (const pb*)(ws + WS_WA), M, D, 512}; pg8::EpiStoreBf16 E{(pb*)(ws + WS_YA), D};
          pg8::gemm_phase<pg8::EpiStoreBf16, pg8::StaticOrder, true, true>(F.lds + RING_OFF, g, S, E, F.wave); }
        { pg8::Gemm g{(const pb*)(ws + WS_ABB), (const pb*)(ws + WS_WB), M, D, 512}; pg8::EpiStoreBf16 E{(pb*)(ws + WS_YB), D};
          pg8::gemm_phase<pg8::EpiStoreBf16, pg8::StaticOrder, true, true>(F.lds + RING_OFF, g, S, E, F.wave); } } SEAM(8);
    if (IN(9)) { pg8::Gemm g{(const pb*)(ws + WS_XB), (const pb*)(ws + WS_WG), M, 2 * D, D}; pg8::StaticOrder S; S.init(M, 2 * D, F.G, (int)blockIdx.x);
        pg8::EpiGateMerge E{(const pb*)(ws + WS_YA), (const pb*)(ws + WS_YB), (pb*)(ws + WS_MG), (const float*)(ws + WS_SSQB), RMS_EPS};
        pg8::gemm_phase<pg8::EpiGateMerge, pg8::StaticOrder, true, true>(F.lds + RING_OFF, g, S, E, F.wave); } SEAM(9);
    if (IN(10)) { pg8::Gemm g{(const pb*)(ws + WS_MG), (const pb*)(ws + WS_WOUT), M, D, D}; pg8::StaticOrder S; S.init(M, D, F.G, (int)blockIdx.x);
        pg8::EpiResid E{F.out, F.out, (pb*)(ws + WS_XB), (float*)(ws + WS_SSQA), 1.0f};
        pg8::gemm_phase<pg8::EpiResid, pg8::StaticOrder, true, true>(F.lds + RING_OFF, g, S, E, F.wave); } SEAM(10);
    if (IN(11)) { pg8::Gemm g{(const pb*)(ws + WS_XB), (const pb*)(ws + WS_WGU2), M, 2 * FF, D}; pg8::StaticOrder S; S.init(M, 2 * FF, F.G, (int)blockIdx.x);
        pg8::EpiSwiGLU E{(pb*)(ws + WS_H), FF, (const float*)(ws + WS_SSQA), RMS_EPS};
        pg8::gemm_phase<pg8::EpiSwiGLU, pg8::StaticOrder, true, true>(F.lds + RING_OFF, g, S, E, F.wave); } SEAM(11);
    if (IN(12)) { pg8::Gemm g{(const pb*)(ws + WS_H), (const pb*)(ws + WS_WD2), M, D, FF}; pg8::StaticOrder S; S.init(M, D, F.G, (int)blockIdx.x);
        pg8::EpiResid E{F.out, F.out, (pb*)(ws + WS_XB), (float*)(ws + WS_SSQB), 0.5f};
        pg8::gemm_phase<pg8::EpiResid, pg8::StaticOrder, true, true>(F.lds + RING_OFF, g, S, E, F.wave); } SEAM(12);
    if (IN(13)) { final_norm_rows(F); } STAMP(14);
    if (PROBE_A >= 0) {
        xcd_barrier(bar);
        if (blockIdx.x == 0 && F.wave == 0) { volatile unsigned long long* ts = (volatile unsigned long long*)(args.ws + WS_CTL + 32768); const int l = lane_id();
            const float da = (float)(ts[PROBE_A + 1] - ts[PROBE_A]) * 0.01f, db = (float)(ts[PROBE_B + 1] - ts[PROBE_B]) * 0.01f;
            for (int i = l; i < 16384; i += 64) F.out[(size_t)i * 1024 + 512] = db;
            if (l == 0) F.out[0] = da; }
    }
#undef IN
#undef SEAM
}

#ifndef MK_N_LAUNCHES
#define MK_N_LAUNCHES 1
#endif
extern "C" void kernel_launch(void* const* d_in, const int* in_sizes, int n_in, void* d_out, int out_size, void* d_ws, size_t ws_size, hipStream_t stream) {
    static int grid = 0;
    if (grid == 0) {
        if (n_in != 24 || in_sizes[0] != M * D || out_size != M * D || ws_size < WS_END) { fprintf(stderr, "kernel_launch: unexpected shapes (n_in %d, in0 %d, out %d, ws %zu)\n", n_in, n_in > 0 ? in_sizes[0] : -1, out_size, ws_size); grid = -1; return; }
        int dev = 0, cus = 0, per_cu = 0;
        if (hipGetDevice(&dev) != hipSuccess || hipDeviceGetAttribute(&cus, hipDeviceAttributeMultiprocessorCount, dev) != hipSuccess) { grid = -1; return; }
        if (hipFuncSetAttribute((const void*)mk_fwd, hipFuncAttributeMaxDynamicSharedMemorySize, LDS_BYTES) != hipSuccess) { fprintf(stderr, "kernel_launch: hipFuncSetAttribute failed\n"); grid = -1; return; }
        if (hipOccupancyMaxActiveBlocksPerMultiprocessor(&per_cu, (const void*)mk_fwd, NWAVES * 64, LDS_BYTES) != hipSuccess || per_cu < 1) { fprintf(stderr, "kernel_launch: occupancy query says %d\n", per_cu); per_cu = 1; }
        (void)hipGetLastError();
        grid = cus;
    }
    if (grid < 0) return;
    if (hipMemsetAsync((char*)d_ws + WS_CTL, 0, CTL_ZERO_BYTES, stream) != hipSuccess) { fprintf(stderr, "kernel_launch: hipMemsetAsync failed\n"); return; }
    Args a{};
    for (int i = 0; i < 24; ++i) a.in[i] = (const float*)d_in[i];
    a.out = (float*)d_out; a.ws = (unsigned char*)d_ws;
#if MK_N_LAUNCHES == 1
    a.ph_lo = 0; a.ph_hi = N_PHASES;
    void* kargs[] = {&a};
    hipError_t e = hipLaunchCooperativeKernel((const void*)mk_fwd, dim3(grid), dim3(NWAVES * 64), kargs, LDS_BYTES, stream);
    if (e != hipSuccess) fprintf(stderr, "kernel_launch: cooperative launch failed: %s (grid %d)\n", hipGetErrorString(e), grid);
#else
    for (int p = 0; p < N_PHASES; ++p) { a.ph_lo = p; a.ph_hi = p + 1; hipLaunchKernelGGL(mk_fwd, dim3(grid), dim3(NWAVES * 64), LDS_BYTES, stream, a); }
#endif
}
```

```cpp
#include <hip/hip_runtime.h>
#include <hip/hip_cooperative_groups.h>
#include <cstdio>
#include <cstdint>
namespace cg = cooperative_groups;
__device__ __forceinline__ int lane_id() { int l = (int)__builtin_amdgcn_mbcnt_hi(~0u, __builtin_amdgcn_mbcnt_lo(~0u, 0u)); asm volatile("" : "+v"(l)); return l; }
namespace pg8 {
#define PG8_LAS __attribute__((address_space(3)))
typedef unsigned short bf16_t;
typedef short bf16x8 __attribute__((ext_vector_type(8)));
typedef float f32x4 __attribute__((ext_vector_type(4)));
typedef unsigned u32x4 __attribute__((ext_vector_type(4)));
constexpr int BM = 256, BK = 64, HALF = 128, HTB = HALF * BK * 2  , STAGE_BYTES = 8 * HTB, NXCD = 8, WGM = 8;

__host__ __device__ __forceinline__ int lds_byte(int r, int c) { const int st = (r >> 4) * 2 + (c >> 5), rr = r & 15, cc = c & 31, ob = rr * 64 + cc * 2; return st * 1024 + (ob ^ (((ob >> 9) & 1) << 5)); }
__host__ __device__ __forceinline__ void stage_rc(int b, int& R, int& C) { const int st = b / 1024, sb = b % 1024, swz = sb ^ (((sb >> 9) & 1) << 5); R = (st >> 1) * 16 + swz / 64; C = (st & 1) * 32 + (swz % 64) / 2; }
__host__ __device__ __forceinline__ int perm32(int rho) { const int n = rho >> 4, i = rho & 15; return 8 * (i >> 2) + 4 * n + (i & 3); }

struct Unit { int pm, pn; };
struct Gemm { const bf16_t* A; const bf16_t* Bt; int M, N, K; };

struct StaticOrder {
    int nM, nN, nwg, G, c;
    __host__ __device__ void init(int M, int N, int G_, int c_) { nM = M / BM; nN = N / BM; nwg = nM * nN; G = G_; c = c_; }
    __host__ __device__ bool next(int i, Unit& u) const {
        const long L = (long)i * G + c; if (L >= nwg) return false;
        int wgid = (int)L; { const int q = nwg / NXCD, r = nwg % NXCD, xcd = wgid % NXCD, off = wgid / NXCD; wgid = (xcd < r ? xcd * (q + 1) : r * (q + 1) + (xcd - r) * q) + off; }
        const int nig = WGM * nN, gid = wgid / nig, fm = gid * WGM, gsz = (nM - fm) < WGM ? (nM - fm) : WGM;
        u.pm = fm + ((wgid % nig) % gsz); u.pn = (wgid % nig) / gsz; return true;
    }
    __device__ __forceinline__ void a_ready(const Unit&) const {}
    __device__ __forceinline__ void done(const Unit&) const {}
};

__device__ __forceinline__ unsigned cvt_pk_bf16(float lo, float hi) { unsigned r; asm volatile("v_cvt_pk_bf16_f32 %0, %1, %2" : "=v"(r) : "v"(lo), "v"(hi)); return r; }
__device__ __forceinline__ float fast_sigmoid(float v) { return __builtin_amdgcn_rcpf(1.0f + __builtin_amdgcn_exp2f(-1.4426950408889634f * v)); }
__device__ __forceinline__ float fast_silu(float v) { return v * fast_sigmoid(v); }
__device__ __forceinline__ void load_rs(float (&rs)[2][4], const float* ssq, int row0, float eps) {
#pragma unroll
    for (int ai = 0; ai < 2; ++ai)
#pragma unroll
        for (int m = 0; m < 4; ++m) { const f32x4* p = (const f32x4*)(ssq + (size_t)(row0 + ai * HALF + m * 16) * 16); const f32x4 a = p[0], b = p[1], c = p[2], d = p[3];
            const float s = ((a[0] + a[1]) + (a[2] + a[3])) + ((b[0] + b[1]) + (b[2] + b[3])) + ((c[0] + c[1]) + (c[2] + c[3])) + ((d[0] + d[1]) + (d[2] + d[3]));
            rs[ai][m] = 1.0f / sqrtf(s * (1.0f / 1024.0f) + eps); }
}
struct EpiSwiGLU {
    static constexpr bool PERM = true, AFTER_DRAIN = false;
    bf16_t* H; int ldh; const float* ssq; float eps;
    __device__ __forceinline__ void operator()(const f32x4 (&acc)[2][2][4][2], const Unit& u, int wr, int wc, int fr, int fq) const {
        const int row0 = u.pm * BM + wr * 64 + fr, col0 = u.pn * HALF + wc * 32 + 8 * fq;
        float rs[2][4]; load_rs(rs, ssq, row0, eps);
#pragma unroll
        for (int ai = 0; ai < 2; ++ai)
#pragma unroll
            for (int m = 0; m < 4; ++m) { bf16_t* rowp = H + (size_t)(row0 + ai * HALF + m * 16) * ldh + col0; const float s = rs[ai][m];
                float h[8];
#pragma unroll
                for (int n = 0; n < 2; ++n)
#pragma unroll
                    for (int j = 0; j < 4; ++j) h[n * 4 + j] = fast_silu(acc[ai][0][m][n][j] * s) * (acc[ai][1][m][n][j] * s);
                u32x4 w; w.x = cvt_pk_bf16(h[0], h[1]); w.y = cvt_pk_bf16(h[2], h[3]); w.z = cvt_pk_bf16(h[4], h[5]); w.w = cvt_pk_bf16(h[6], h[7]);
                *(u32x4*)rowp = w; }
    }
};
struct EpiResid {
    static constexpr bool PERM = false, AFTER_DRAIN = false;
    const float* base; float* out; bf16_t* xb; float* ssq_out; float scale;
    __device__ __forceinline__ void operator()(const f32x4 (&acc)[2][2][4][2], const Unit& u, int wr, int wc, int fr, int fq) const {
        typedef unsigned u32x2v __attribute__((ext_vector_type(2)));
        const int row0 = u.pm * BM + wr * 64 + fr, col0 = u.pn * BM + wc * 32 + 4 * fq;
#pragma unroll
        for (int ai = 0; ai < 2; ++ai)
#pragma unroll
            for (int m = 0; m < 4; ++m) { const int row = row0 + ai * HALF + m * 16; const size_t off = (size_t)row * 1024 + col0; float ss = 0.f;
#pragma unroll
                for (int bj = 0; bj < 2; ++bj)
#pragma unroll
                    for (int n = 0; n < 2; ++n) { const f32x4 bs = *(const f32x4*)(base + off + bj * HALF + n * 16); const f32x4 o = bs + acc[ai][bj][m][n] * scale;
                        *(f32x4*)(out + off + bj * HALF + n * 16) = o; ss += (o[0] * o[0] + o[1] * o[1]) + (o[2] * o[2] + o[3] * o[3]);
                        u32x2v w; w.x = cvt_pk_bf16(o[0], o[1]); w.y = cvt_pk_bf16(o[2], o[3]); *(u32x2v*)(xb + off + bj * HALF + n * 16) = w; }
                ss += __shfl_xor(ss, 16); ss += __shfl_xor(ss, 32);
                if (fq == 0) ssq_out[(size_t)row * 16 + u.pn * 4 + wc] = ss; }
    }
};
struct EpiStoreBf16 {
    static constexpr bool PERM = true, AFTER_DRAIN = false;
    bf16_t* O; int ldc;
    __device__ __forceinline__ void operator()(const f32x4 (&acc)[2][2][4][2], const Unit& u, int wr, int wc, int fr, int fq) const {
        const int row0 = u.pm * BM + wr * 64 + fr, col0 = u.pn * BM + wc * 32 + 8 * fq;
#pragma unroll
        for (int ai = 0; ai < 2; ++ai)
#pragma unroll
            for (int m = 0; m < 4; ++m) { bf16_t* rowp = O + (size_t)(row0 + ai * HALF + m * 16) * ldc + col0;
#pragma unroll
                for (int bj = 0; bj < 2; ++bj) { const f32x4 v0 = acc[ai][bj][m][0], v1 = acc[ai][bj][m][1];
                    u32x4 w; w.x = cvt_pk_bf16(v0[0], v0[1]); w.y = cvt_pk_bf16(v0[2], v0[3]); w.z = cvt_pk_bf16(v1[0], v1[1]); w.w = cvt_pk_bf16(v1[2], v1[3]);
                    *(u32x4*)(rowp + bj * HALF) = w; } }
    }
};
struct EpiWin {
    static constexpr bool PERM = true, AFTER_DRAIN = false;
    bf16_t *PRE, *Z, *QO, *KD, *VD; float* AB; const float* ssq; float eps, qscale;
    __device__ __forceinline__ void operator()(const f32x4 (&acc)[2][2][4][2], const Unit& u, int wr, int wc, int fr, int fq) const {
        const int row0 = u.pm * BM + wr * 64 + fr, cl0 = wc * 32 + 8 * fq, pn = u.pn;
        float rs[2][4]; load_rs(rs, ssq, row0, eps);
        if (pn == 14) {
            if (wc == 0 && fq < 2) {
#pragma unroll
                for (int ai = 0; ai < 2; ++ai)
#pragma unroll
                    for (int m = 0; m < 4; ++m) { float* rowp = AB + (size_t)(row0 + ai * HALF + m * 16) * 16 + 8 * fq; const float s = rs[ai][m];
                        *(f32x4*)rowp = acc[ai][0][m][0] * s; *(f32x4*)(rowp + 4) = acc[ai][0][m][1] * s; }
            }
            return;
        }
        bf16_t* base; int ld, cb; float sc = 1.f; bool dup = false;
        if (pn < 6) { base = PRE; ld = 1536; cb = pn * 256; }
        else if (pn < 8) { base = Z; ld = 512; cb = (pn - 6) * 256; }
        else if (pn < 10) { base = QO; ld = 1024; cb = (pn - 8) * 256; sc = qscale; dup = true; }
        else if (pn < 12) { base = KD; ld = 512; cb = (pn - 10) * 256; }
        else { base = VD; ld = 512; cb = (pn - 12) * 256; }
#pragma unroll
        for (int ai = 0; ai < 2; ++ai)
#pragma unroll
            for (int m = 0; m < 4; ++m) { const float s = rs[ai][m] * sc; bf16_t* rowp = base + (size_t)(row0 + ai * HALF + m * 16) * ld;
#pragma unroll
                for (int bj = 0; bj < 2; ++bj) { const f32x4 v0 = acc[ai][bj][m][0] * s, v1 = acc[ai][bj][m][1] * s;
                    u32x4 w; w.x = cvt_pk_bf16(v0[0], v0[1]); w.y = cvt_pk_bf16(v0[2], v0[3]); w.z = cvt_pk_bf16(v1[0], v1[1]); w.w = cvt_pk_bf16(v1[2], v1[3]);
                    const int c = cb + bj * HALF + cl0;
                    if (dup) { const int qc = ((c >> 6) * 2) * 64 + (c & 63); *(u32x4*)(rowp + qc) = w; *(u32x4*)(rowp + qc + 64) = w; }
                    else *(u32x4*)(rowp + c) = w; } }
    }
};
struct EpiGateMerge {
    static constexpr bool PERM = true, AFTER_DRAIN = false;
    const bf16_t *YA, *YB; bf16_t* MG; const float* ssq; float eps;
    __device__ __forceinline__ void operator()(const f32x4 (&acc)[2][2][4][2], const Unit& u, int wr, int wc, int fr, int fq) const {
        const int row0 = u.pm * BM + wr * 64 + fr, col0 = u.pn * HALF + wc * 32 + 8 * fq;
        float rs[2][4]; load_rs(rs, ssq, row0, eps);
#pragma unroll
        for (int ai = 0; ai < 2; ++ai)
#pragma unroll
            for (int m = 0; m < 4; ++m) { const size_t off = (size_t)(row0 + ai * HALF + m * 16) * 1024 + col0; const float s = rs[ai][m];
                const u32x4 ya = *(const u32x4*)(YA + off), yb = *(const u32x4*)(YB + off);
                float o[8];
#pragma unroll
                for (int n = 0; n < 2; ++n)
#pragma unroll
                    for (int j = 0; j < 4; ++j) { const int e = n * 4 + j; const unsigned wa = ya[e >> 1], wb = yb[e >> 1];
                        const float fa = __uint_as_float((e & 1) ? (wa & 0xffff0000u) : (wa << 16)), fb = __uint_as_float((e & 1) ? (wb & 0xffff0000u) : (wb << 16));
                        o[e] = fast_sigmoid(acc[ai][0][m][n][j] * s) * fa + fast_sigmoid(acc[ai][1][m][n][j] * s) * fb; }
                u32x4 w; w.x = cvt_pk_bf16(o[0], o[1]); w.y = cvt_pk_bf16(o[2], o[3]); w.z = cvt_pk_bf16(o[4], o[5]); w.w = cvt_pk_bf16(o[6], o[7]);
                *(u32x4*)(MG + off) = w; }
    }
};

template <class Epi, class Sched, bool ALIGN_EPI = false, bool SP2 = false>
__device__ __forceinline__ void gemm_phase(PG8_LAS unsigned char* lds, const Gemm g, const Sched& S, const Epi& E, const int wave_id) {
    const int wid = wave_id, lane = lane_id(), tid = wid * 64 + lane, wr = wid >> 2, wc = wid & 3, fr = lane & 15, fq = lane >> 4;
    const int K = g.K, nt = K / BK;
    unsigned voffA[2], voffB[2];
#pragma unroll
    for (int i = 0; i < 2; ++i) { int R, C; stage_rc(tid * 16 + i * 8192, R, C); const int Rb = Epi::PERM ? ((R & ~31) + perm32(R & 31)) : R;
        voffA[i] = (unsigned)(R * K + C) * 2u; voffB[i] = (unsigned)(Rb * K + C) * 2u; }
    const size_t kstep = (size_t)(BK * 2);
    const size_t hstep = (size_t)HALF * K * 2;
    const size_t tstep = 2 * hstep;
    const unsigned ldsw = (unsigned)wid * 1024u;
    const int aoff = lds_byte(wr * 64 + fr, fq * 8), boff = lds_byte(wc * 32 + fr, fq * 8);
#define PG8_SA(b, h) (((b) * 2 + (h)) * HTB)
#define PG8_SB(b, h) ((4 + (b) * 2 + (h)) * HTB)
#define PG8_STAGE(bufoff, gbase, voff) do { _Pragma("unroll") for (int _i = 0; _i < 2; ++_i) \
        __builtin_amdgcn_global_load_lds((const unsigned*)((const char*)(gbase) + (voff)[_i]), (PG8_LAS unsigned*)(lds + (bufoff) + ldsw + _i * 8192), 16, 0, 0); } while (0)
#define PG8_LDA(dst, b, h) do { _Pragma("unroll") for (int m = 0; m < 4; ++m) _Pragma("unroll") for (int k = 0; k < 2; ++k) dst[m][k] = *(const PG8_LAS bf16x8*)(lds + PG8_SA(b, h) + aoff + m * 2048 + k * 1024); } while (0)
#define PG8_LDB(dst, b, h) do { _Pragma("unroll") for (int n = 0; n < 2; ++n) _Pragma("unroll") for (int k = 0; k < 2; ++k) dst[n][k] = *(const PG8_LAS bf16x8*)(lds + PG8_SB(b, h) + boff + n * 2048 + k * 1024); } while (0)
#define PG8_MMA(ai, bj, At, Bt) do { __builtin_amdgcn_s_setprio(1); _Pragma("unroll") for (int m = 0; m < 4; ++m) _Pragma("unroll") for (int n = 0; n < 2; ++n) _Pragma("unroll") for (int k = 0; k < 2; ++k) \
        acc[ai][bj][m][n] = __builtin_amdgcn_mfma_f32_16x16x32_bf16(Bt[n][k], At[m][k], acc[ai][bj][m][n], 0, 0, 0); __builtin_amdgcn_s_setprio(0); } while (0)
#define PG8_WAIT_V(n) asm volatile("s_waitcnt vmcnt(" #n ")" ::: "memory")
#define PG8_WAIT_L(n) asm volatile("s_waitcnt lgkmcnt(" #n ")" ::: "memory")
#define PG8_BAR __builtin_amdgcn_s_barrier()
#define PG8_SCHED __builtin_amdgcn_sched_barrier(0)
    Unit cur, nxt; int ui = 0;
    if (!S.next(0, cur)) return;
    f32x4 acc[2][2][4][2];
#pragma unroll
    for (int a = 0; a < 2; ++a)
#pragma unroll
        for (int b = 0; b < 2; ++b)
#pragma unroll
            for (int m = 0; m < 4; ++m)
#pragma unroll
                for (int n = 0; n < 2; ++n) acc[a][b][m][n] = (f32x4){0.f, 0.f, 0.f, 0.f};
    bf16x8 At[4][2], B0[2][2], B1[2][2];
    const char* cA = (const char*)g.A + (size_t)cur.pm * tstep; const char* cB = (const char*)g.Bt + (size_t)cur.pn * tstep;
    S.a_ready(cur);
    if constexpr (SP2) {
        PG8_STAGE(PG8_SB(0, 0), cB, voffB); PG8_STAGE(PG8_SB(0, 1), cB + hstep, voffB); PG8_STAGE(PG8_SA(0, 0), cA, voffA); PG8_STAGE(PG8_SA(0, 1), cA + hstep, voffA);
        if (wr == 1) PG8_BAR;
        PG8_WAIT_V(2); PG8_BAR;
        PG8_STAGE(PG8_SB(1, 0), cB + kstep, voffB); PG8_STAGE(PG8_SA(1, 0), cA + kstep, voffA); PG8_STAGE(PG8_SB(1, 1), cB + hstep + kstep, voffB);
        PG8_WAIT_V(6); PG8_BAR;
    } else {
        PG8_STAGE(PG8_SB(0, 0), cB, voffB); PG8_STAGE(PG8_SA(0, 0), cA, voffA); PG8_STAGE(PG8_SB(0, 1), cB + hstep, voffB); PG8_STAGE(PG8_SA(0, 1), cA + hstep, voffA);
        if (wr == 1) PG8_BAR;
        PG8_WAIT_V(4); PG8_BAR;
        PG8_STAGE(PG8_SB(1, 0), cB + kstep, voffB); PG8_STAGE(PG8_SA(1, 0), cA + kstep, voffA); PG8_STAGE(PG8_SB(1, 1), cB + hstep + kstep, voffB);
        PG8_WAIT_V(6); PG8_BAR;
    }
    for (;;) {
        const bool has_next = S.next(ui + 1, nxt);
        const char* nA = has_next ? (const char*)g.A + (size_t)nxt.pm * tstep : cA; const char* nB = has_next ? (const char*)g.Bt + (size_t)nxt.pn * tstep : cB;
        for (int t = 0; t < nt; t += 2) {
            const bool last = (t == nt - 2);
            const char* a1 = cA + (size_t)(t + 1) * kstep;
            const char* a2 = last ? nA : cA + (size_t)(t + 2) * kstep; const char* b2 = last ? nB : cB + (size_t)(t + 2) * kstep;
            const char* a3 = a2 + kstep; const char* b3 = b2 + kstep;
            if (last && has_next) S.a_ready(nxt);
            if constexpr (SP2) {
            PG8_LDB(B0, 0, 0); PG8_LDB(B1, 0, 1); PG8_SCHED; PG8_LDA(At, 0, 0); PG8_STAGE(PG8_SA(1, 1), a1 + hstep, voffA);
            PG8_WAIT_V(8); PG8_WAIT_L(0); PG8_BAR; PG8_MMA(0, 0, At, B0); PG8_MMA(0, 1, At, B1); PG8_BAR; PG8_SCHED;
            PG8_LDA(At, 0, 1); PG8_STAGE(PG8_SB(0, 0), b2, voffB); PG8_STAGE(PG8_SB(0, 1), b2 + hstep, voffB); PG8_STAGE(PG8_SA(0, 0), a2, voffA);
            PG8_WAIT_V(8); PG8_WAIT_L(0); PG8_BAR; PG8_MMA(1, 0, At, B0); PG8_MMA(1, 1, At, B1); PG8_BAR; PG8_SCHED;
            PG8_LDB(B0, 1, 0); PG8_LDB(B1, 1, 1); PG8_SCHED; PG8_LDA(At, 1, 0); PG8_STAGE(PG8_SA(0, 1), a2 + hstep, voffA);
            PG8_WAIT_V(8); PG8_WAIT_L(0); PG8_BAR; PG8_MMA(0, 0, At, B0); PG8_MMA(0, 1, At, B1); PG8_BAR; PG8_SCHED;
            PG8_LDA(At, 1, 1); PG8_STAGE(PG8_SB(1, 0), b3, voffB); PG8_STAGE(PG8_SB(1, 1), b3 + hstep, voffB); PG8_STAGE(PG8_SA(1, 0), a3, voffA);
            PG8_WAIT_V(8); PG8_WAIT_L(0); PG8_BAR; PG8_MMA(1, 0, At, B0); PG8_MMA(1, 1, At, B1); PG8_BAR; PG8_SCHED;
            } else {
            PG8_LDB(B0, 0, 0); PG8_SCHED; PG8_LDA(At, 0, 0); PG8_STAGE(PG8_SA(1, 1), a1 + hstep, voffA);
            PG8_WAIT_L(8); PG8_BAR; PG8_WAIT_L(0); PG8_MMA(0, 0, At, B0); PG8_BAR; PG8_SCHED;
            PG8_LDB(B1, 0, 1); PG8_STAGE(PG8_SB(0, 0), b2, voffB);
            PG8_BAR; PG8_WAIT_L(0); PG8_MMA(0, 1, At, B1); PG8_BAR;
            PG8_LDA(At, 0, 1); PG8_STAGE(PG8_SA(0, 0), a2, voffA);
            PG8_BAR; PG8_WAIT_L(0); PG8_MMA(1, 0, At, B0); PG8_BAR; PG8_SCHED;
            PG8_STAGE(PG8_SB(0, 1), b2 + hstep, voffB);
            PG8_WAIT_V(6); PG8_BAR; PG8_MMA(1, 1, At, B1); PG8_BAR;
            PG8_LDB(B0, 1, 0); PG8_SCHED; PG8_LDA(At, 1, 0); PG8_STAGE(PG8_SA(0, 1), a2 + hstep, voffA);
            PG8_WAIT_L(8); PG8_BAR; PG8_WAIT_L(0); PG8_MMA(0, 0, At, B0); PG8_BAR; PG8_SCHED;
            PG8_LDB(B1, 1, 1); PG8_STAGE(PG8_SB(1, 0), b3, voffB);
            PG8_BAR; PG8_WAIT_L(0); PG8_MMA(0, 1, At, B1); PG8_BAR;
            PG8_LDA(At, 1, 1); PG8_STAGE(PG8_SA(1, 0), a3, voffA);
            PG8_BAR; PG8_WAIT_L(0); PG8_MMA(1, 0, At, B0); PG8_BAR; PG8_SCHED;
            PG8_STAGE(PG8_SB(1, 1), b3 + hstep, voffB);
            PG8_WAIT_V(6); PG8_BAR; PG8_MMA(1, 1, At, B1); PG8_BAR;
            }
        }
        if constexpr (ALIGN_EPI) { if (wr == 0) PG8_BAR; }
        if constexpr (!Epi::AFTER_DRAIN) { E(acc, cur, wr, wc, fr, fq); S.done(cur); }
        if (!has_next) break;
#pragma unroll
        for (int a = 0; a < 2; ++a)
#pragma unroll
            for (int b = 0; b < 2; ++b)
#pragma unroll
                for (int m = 0; m < 4; ++m)
#pragma unroll
                    for (int n = 0; n < 2; ++n) acc[a][b][m][n] = (f32x4){0.f, 0.f, 0.f, 0.f};
        cur = nxt; cA = nA; cB = nB; ++ui;
        if constexpr (ALIGN_EPI) { if (wr == 1) PG8_BAR; }
    }
    PG8_WAIT_V(0);
    if constexpr (!ALIGN_EPI) { if (wr == 0) PG8_BAR; }
    PG8_BAR;
    if constexpr (Epi::AFTER_DRAIN) { E.fused(acc, cur, wr, wc, fr, fq, lds, wid, lane); S.done(cur); }
#undef PG8_SA
#undef PG8_SB
#undef PG8_STAGE
#undef PG8_LDA
#undef PG8_LDB
#undef PG8_MMA
#undef PG8_WAIT_V
#undef PG8_WAIT_L
#undef PG8_BAR
#undef PG8_SCHED
}
}
#include <hip/hip_bf16.h>
#include <cmath>
namespace attn_body {
using bf16=__hip_bfloat16;
using bf16x8=__attribute__((ext_vector_type(8)))short;
using s16x4=__attribute__((ext_vector_type(4)))short;
using f32x16=__attribute__((ext_vector_type(16)))float;
using u32x4=__attribute__((ext_vector_type(4)))unsigned;
constexpr int BATCH=2,NHEAD=16,SEQ=8192,D=64,DM=NHEAD*D,KP=512;
constexpr int NW=8,QBLK=32,QB=QBLK*NW,KVBLK=64,NQB=SEQ/QB;
constexpr int ATTN_PITCH=DM, ATTN_UNIT_ROWS=QB;
__device__ __forceinline__ int crow(int r,int hi){return (r&3)+8*(r>>2)+4*hi;}
#define SBAR() __builtin_amdgcn_sched_barrier(0)
__device__ __forceinline__ void cmask(f32x16&p0,f32x16&p1,int jb,int qrel,int hi){
  const float NEG=-INFINITY; int lim=qrel-64*jb-4*hi; asm volatile("":"+v"(lim));
  #pragma unroll
  for(int r=0;r<16;++r){const int cr=(r&3)+8*(r>>2); if(cr>lim)p0[r]=NEG; if(cr+32>lim)p1[r]=NEG;}
}

constexpr int NSLOT=3, SLOTB=8192;
constexpr int LDS_K=0, LDS_V=NSLOT*SLOTB, LDS_WS=2*NSLOT*SLOTB, LDS_OST=LDS_WS+NW*64*4, LDS_BYTES=LDS_OST+NW*4096;
constexpr float C2=0.125f*1.4426950408889634f;
__device__ __forceinline__ void glds16(const void*gsrc,unsigned lds_dst){unsigned keep;
  asm volatile("s_mov_b32 %0, m0\n\ts_mov_b32 m0, %2\n\ts_nop 0\n\tglobal_load_lds_dwordx4 %1, off\n\ts_mov_b32 m0, %0":"=&s"(keep):"v"(gsrc),"s"(lds_dst):"memory");}
__device__ __forceinline__ float max3f(float a,float b,float c){float r;asm("v_max3_f32 %0, %1, %2, %3":"=v"(r):"v"(a),"v"(b),"v"(c));return r;}
__device__ __forceinline__ float max2f(float a,float b){float r;asm("v_max_f32_e32 %0, %1, %2":"=v"(r):"v"(a),"v"(b));return r;}
__device__ __forceinline__ float fadd_s(float a,float b){float r;asm("v_add_f32_e32 %0, %1, %2":"=v"(r):"v"(a),"v"(b));return r;}
__device__ __forceinline__ float fsub_s(float a,float b){float r;asm("v_sub_f32_e32 %0, %1, %2":"=v"(r):"v"(a),"v"(b));return r;}
typedef float f32x2_t __attribute__((ext_vector_type(2))); typedef __bf16 bf16x2_t __attribute__((ext_vector_type(2)));
__device__ __forceinline__ unsigned cvtpk_s(float lo,float hi){f32x2_t v={lo,hi};bf16x2_t b=__builtin_convertvector(v,bf16x2_t);return __builtin_bit_cast(unsigned,b);}
#define WAIT_BAR(N) asm volatile("s_waitcnt vmcnt(" #N ") lgkmcnt(0)\n\ts_barrier":::"memory")

__device__ __forceinline__ void qkt(f32x16&p0,f32x16&p1,const char*Kslot,const bf16x8*qr,const f32x16&negm,int r32,int hi){
  const char*kb=Kslot+hi*1024+r32*16;
  #pragma unroll
  for(int d0=0;d0<4;++d0){
    const bf16x8 b0=*reinterpret_cast<const bf16x8*>(kb+d0*2048);
    const bf16x8 b1=*reinterpret_cast<const bf16x8*>(kb+d0*2048+512);
    if(d0==0){p0=__builtin_amdgcn_mfma_f32_32x32x16_bf16(b0,qr[0],negm,0,0,0);p1=__builtin_amdgcn_mfma_f32_32x32x16_bf16(b1,qr[0],negm,0,0,0);}
    else{p0=__builtin_amdgcn_mfma_f32_32x32x16_bf16(b0,qr[d0],p0,0,0,0);p1=__builtin_amdgcn_mfma_f32_32x32x16_bf16(b1,qr[d0],p1,0,0,0);}}
}
typedef __attribute__((address_space(3))) const char* lds_cptr;
typedef short v4i16_t __attribute__((ext_vector_type(4)));
__device__ __forceinline__ void kload8(bf16x8*kf,lds_cptr kp){
  kf[0]=*(const __attribute__((address_space(3))) bf16x8*)(kp);      kf[1]=*(const __attribute__((address_space(3))) bf16x8*)(kp+512);
  kf[2]=*(const __attribute__((address_space(3))) bf16x8*)(kp+2048); kf[3]=*(const __attribute__((address_space(3))) bf16x8*)(kp+2560);
  kf[4]=*(const __attribute__((address_space(3))) bf16x8*)(kp+4096); kf[5]=*(const __attribute__((address_space(3))) bf16x8*)(kp+4608);
  kf[6]=*(const __attribute__((address_space(3))) bf16x8*)(kp+6144); kf[7]=*(const __attribute__((address_space(3))) bf16x8*)(kp+6656);
}
__device__ __forceinline__ void kload2(bf16x8*kf,lds_cptr kp,int j){ kf[2*j]=*(const __attribute__((address_space(3))) bf16x8*)(kp+j*2048); kf[2*j+1]=*(const __attribute__((address_space(3))) bf16x8*)(kp+j*2048+512); }
__device__ __forceinline__ s16x4 vtr(lds_cptr p){ return __builtin_bit_cast(s16x4,__builtin_amdgcn_ds_read_tr16_b64_v4i16((__attribute__((address_space(3))) v4i16_t*)p)); }
__device__ __forceinline__ float rowmax(const f32x16&p0,const f32x16&p1){
  float a=max3f(p0[0],p0[1],p1[0]),b=max3f(p0[2],p0[3],p1[1]);a=max3f(a,p1[2],p1[3]);
  #pragma unroll
  for(int r=4;r<16;r+=4){a=max3f(a,p0[r],p0[r+1]);b=max3f(b,p0[r+2],p0[r+3]);a=max3f(a,p1[r],p1[r+1]);b=max3f(b,p1[r+2],p1[r+3]);}
  const float m=max2f(a,b);
  auto rr=__builtin_amdgcn_permlane32_swap(__float_as_uint(m),__float_as_uint(m),false,false);
  return max2f(__uint_as_float(rr[0]),__uint_as_float(rr[1]));
}
__device__ __forceinline__ void pv(f32x16*o,int vb,bf16x8 pa0,bf16x8 pa1,bf16x8 pa2,bf16x8 pa3){
  #pragma unroll
  for(int d0=0;d0<2;++d0){s16x4 lo[4],hi[4];
    #pragma unroll
    for(int ks=0;ks<4;++ks){
      asm volatile("ds_read_b64_tr_b16 %0,%1 offset:%c2":"=&v"(lo[ks]):"v"(vb),"i"(d0*4096+ks*1024):"memory");
      asm volatile("ds_read_b64_tr_b16 %0,%1 offset:%c2":"=&v"(hi[ks]):"v"(vb),"i"(d0*4096+ks*1024+512):"memory");}
    asm volatile("s_waitcnt lgkmcnt(0)":::"memory");SBAR();
    #define PK(k) (bf16x8){lo[k][0],lo[k][1],lo[k][2],lo[k][3],hi[k][0],hi[k][1],hi[k][2],hi[k][3]}
    o[d0]=__builtin_amdgcn_mfma_f32_32x32x16_bf16(pa0,PK(0),o[d0],0,0,0);
    o[d0]=__builtin_amdgcn_mfma_f32_32x32x16_bf16(pa1,PK(1),o[d0],0,0,0);
    o[d0]=__builtin_amdgcn_mfma_f32_32x32x16_bf16(pa2,PK(2),o[d0],0,0,0);
    o[d0]=__builtin_amdgcn_mfma_f32_32x32x16_bf16(pa3,PK(3),o[d0],0,0,0);
    #undef PK
  }
}

#ifndef ATTN_STORE16
#define ATTN_STORE16(p,v) (*(u32x4*)(p)=(v))
#endif
template<int THRL> __device__ __forceinline__ void attn_unit(int b,int h,int qb,const bf16*Q,const bf16*__restrict__ K,const bf16*__restrict__ V,bf16*O,char*shm,const int wave_id,const unsigned*nmax){
  const int wid=wave_id,lane=lane_id(),tid=wid*64+lane,r32=lane&31,hi=lane>>5;
  const long rowbase=(long)b*SEQ; const int q0=qb*QB;
  const bf16*Qw=Q+(rowbase+q0+wid*QBLK)*DM+h*D;
  int t0=0;
  { const int j=b*8+(h>>1); const float q2=__uint_as_float(__builtin_amdgcn_readfirstlane((int)nmax[j])), k2=__uint_as_float(__builtin_amdgcn_readfirstlane((int)nmax[16+j]));
    const unsigned slb0_=0x3eb8aa3bu-((unsigned)__builtin_amdgcn_readfirstlane(h>>2)<<24);
    const float B2=2.0f*sqrtf(q2*k2)*1.0001f+34.7f, dmin=B2/__uint_as_float(slb0_);
    const float tf=floorf(((float)(q0+1)-dmin)*(1.0f/64.0f)); int tt=(tf>0.f)?(int)tf:0; tt&=~1; const int tmax=(q0+QB)/KVBLK-4; t0=tt<tmax?tt:tmax; t0=__builtin_amdgcn_readfirstlane(t0); }
  const bf16*Kh=K+(rowbase+(long)t0*KVBLK)*KP+(h>>1)*D,*Vh=V+(rowbase+(long)t0*KVBLK)*KP+(h>>2)*128+(h&1)*D;
  const unsigned lds0=(unsigned)(uintptr_t)shm;
  float*wsf=(float*)(shm+LDS_WS)+wid*64;
  const bf16*ksrc=Kh+(long)lane*KP+wid*8;
  const bf16*vsrc=Vh+(long)(16*(wid&3)+(lane>>2))*KP+(wid>>2)*32+(lane&3)*8;
  const unsigned kdst=lds0+LDS_K+wid*1024, vdst=lds0+LDS_V+wid*1024;
  #define DMA_K(t,slot) glds16(ksrc+(long)(t)*KVBLK*KP,(unsigned)__builtin_amdgcn_readfirstlane(kdst+(slot)))
  #define DMA_V(t,slot) glds16(vsrc+(long)(t)*KVBLK*KP,(unsigned)__builtin_amdgcn_readfirstlane(vdst+(slot)))
  const int vb0=(int)(lds0+LDS_V)+((lane>>4)&1)*32+(lane&3)*8+(4*hi+((lane&15)>>2))*64;
  const char*Kbase=shm+LDS_K; bf16x8 kf[8];
  const lds_cptr shm3=(lds_cptr)shm; const lds_cptr kp0=shm3+LDS_K+hi*1024+r32*16; const lds_cptr vp0=shm3+LDS_V+((lane>>4)&1)*32+(lane&3)*8+(4*hi+((lane&15)>>2))*64;
  const int NT=(q0+QB)/KVBLK-t0;
  DMA_K(0,0);DMA_V(0,0);DMA_K(1,SLOTB);
  bf16x8 qr[4];
  #pragma unroll
  for(int d0=0;d0<4;++d0)qr[d0]=*reinterpret_cast<const bf16x8*>(&Qw[(long)r32*DM+d0*16+hi*8]);
  float mhat=0.f,l_reg=0.f;f32x16 o[2];o[0]=f32x16{};o[1]=f32x16{};const f32x16 negm=f32x16{};
  const int qrel=wid*QBLK+r32;
  const unsigned slb_=0x3eb8aa3bu-((unsigned)__builtin_amdgcn_readfirstlane(h>>2)<<24); const float sl2=__uint_as_float(slb_);
  const float qposf=(float)(q0+qrel-4*hi-64*t0);
  const float s1_=sl2, s8_=__uint_as_float(slb_+(3u<<23)), s32_=__uint_as_float(slb_+(5u<<23));
  #define AADD(d,a,sv) asm volatile("v_add_f32_e32 %0, %1, %2":"=v"(d):"s"(sv),"v"(a))
  #define ALIBI(P0,P1,t) do{ float bq_=__builtin_fmaf(sl2,((float)(64*(t))-qposf),-mhat); \
    _Pragma("unroll") for(int q_=0;q_<4;++q_){ float b0_=bq_,b1_,b2_,b3_,c_; AADD(b1_,b0_,s1_); AADD(b2_,b1_,s1_); AADD(b3_,b2_,s1_); \
      P0[4*q_]+=b0_; P0[4*q_+1]+=b1_; P0[4*q_+2]+=b2_; P0[4*q_+3]+=b3_; \
      AADD(c_,b0_,s32_); P1[4*q_]+=c_; AADD(c_,b1_,s32_); P1[4*q_+1]+=c_; AADD(c_,b2_,s32_); P1[4*q_+2]+=c_; AADD(c_,b3_,s32_); P1[4*q_+3]+=c_; \
      if(q_<3){ AADD(bq_,b0_,s8_); } } }while(0)
  #define CMASK(P0,P1,t) do{int jb_=(t)-(NT-4); if(jb_>=0)cmask(P0,P1,jb_,qrel,hi);}while(0)
  bool resc=false;
  #define START(P0,P1) do{ const float rm=rowmax(P0,P1); resc=false; \
    { const float dl=rm; mhat=fadd_s(mhat,dl); \
      _Pragma("unroll") for(int r=0;r<16;++r){P0[r]=fsub_s(P0[r],dl);P1[r]=fsub_s(P1[r],dl);} \
      } \
    _Pragma("unroll") for(int r=0;r<16;++r)P0[r]=__builtin_amdgcn_exp2f(P0[r]); }while(0)
  #define RESC() do{ if(resc){ asm volatile("s_waitcnt lgkmcnt(0)":::"memory"); \
      _Pragma("unroll") for(int d_=0;d_<2;++d_) _Pragma("unroll") for(int r=0;r<16;++r)o[d_][r]*=wsf[crow(r,hi)]; } }while(0)
  f32x16 pA0,pA1,pB0,pB1;
  int sl_prev=0,sl_cur=0,sl_next=SLOTB;
  #define ROT() do{sl_prev=sl_cur;sl_cur=sl_next;sl_next=(sl_next==(NSLOT-1)*SLOTB)?0:sl_next+SLOTB;}while(0)
  DMA_K(2,2*SLOTB);
  WAIT_BAR(3);
  qkt(pA0,pA1,Kbase,qr,negm,r32,hi);asm volatile("s_nop 15\n\ts_nop 7":"+v"(pA0),"+v"(pA1));ALIBI(pA0,pA1,0);CMASK(pA0,pA1,0);
  START(pA0,pA1);
  _Pragma("unroll") for(int r=0;r<16;++r)pA1[r]=__builtin_amdgcn_exp2f(pA1[r]);
  WAIT_BAR(0);
  DMA_K(3,0);DMA_V(1,SLOTB);
  ROT();
  kload8(kf,kp0+sl_cur);
  WAIT_BAR(2);
  s16x4 vlo[8],vhi[8]; u32x4 pw0,pw1,pw2,pw3;
  #define PKW(P,B) cvtpk_s(P[B],P[B+1])
  #define PAF(k) __builtin_bit_cast(bf16x8,pw##k)
  #define VFR(i) (bf16x8){vlo[i][0],vlo[i][1],vlo[i][2],vlo[i][3],vhi[i][0],vhi[i][1],vhi[i][2],vhi[i][3]}
  #define PIN(x) asm volatile("":"+v"(x))
  #define MX3(a,b,c) __builtin_fmaxf(__builtin_fmaxf((a),(b)),(c))
  #define GAPA(MF,A0,A1,A2,A3,W0,W1,PW) do{ MF; sacc+=A0; sacc+=A1; sacc+=A2; sacc+=A3; PIN(sacc); W0; W1; PIN(PW); SBAR(); }while(0)
  #define EX(v) __builtin_amdgcn_exp2f(v)
  #define GAPB(MF,X,B) do{ MF; X[B]=EX(X[B]); X[B+1]=EX(X[B+1]); X[B+2]=EX(X[B+2]); X[B+3]=EX(X[B+3]); PIN(X); SBAR(); }while(0)
  #define VRD(i) do{ vlo[i]=vtr(vp_+(((i)>>2)*4096+((i)&3)*1024)); vhi[i]=vtr(vp_+(((i)>>2)*4096+((i)&3)*1024+512)); }while(0)
  #define KRD(G,j) do{ if(G){ kload2(kf,kp0+sl_next,j); SBAR(); } }while(0)
  #define STEP(C0,C1,P0,P1,t,GK,GV,GL) do{ SBAR(); \
    const lds_cptr vp_=vp0+sl_prev; \
    VRD(0); SBAR(); float sacc=(P0[0]+P0[1]); \
    GAPA(C0=__builtin_amdgcn_mfma_f32_32x32x16_bf16(kf[0],qr[0],negm,0,0,0), P0[2],P0[3],P0[4],P0[5],     pw0[0]=PKW(P0,0), pw0[1]=PKW(P0,2), pw0); \
    VRD(4); SBAR(); GAPA(C1=__builtin_amdgcn_mfma_f32_32x32x16_bf16(kf[1],qr[0],negm,0,0,0), P0[6],P0[7],P0[8],P0[9],     pw0[2]=PKW(P0,4), pw0[3]=PKW(P0,6), pw0); \
    VRD(1); SBAR(); GAPA(C0=__builtin_amdgcn_mfma_f32_32x32x16_bf16(kf[2],qr[1],C0,0,0,0),   P0[10],P0[11],P0[12],P0[13], pw1[0]=PKW(P0,8), pw1[1]=PKW(P0,10), pw1); \
    VRD(5); SBAR(); GAPA(C1=__builtin_amdgcn_mfma_f32_32x32x16_bf16(kf[3],qr[1],C1,0,0,0),   P0[14],P0[15],P1[0],P1[1],   pw1[2]=PKW(P0,12),pw1[3]=PKW(P0,14), pw1); \
    VRD(2); SBAR(); GAPA(C0=__builtin_amdgcn_mfma_f32_32x32x16_bf16(kf[4],qr[2],C0,0,0,0),   P1[2],P1[3],P1[4],P1[5],     pw2[0]=PKW(P1,0), pw2[1]=PKW(P1,2), pw2); \
    VRD(6); SBAR(); GAPA(C1=__builtin_amdgcn_mfma_f32_32x32x16_bf16(kf[5],qr[2],C1,0,0,0),   P1[6],P1[7],P1[8],P1[9],     pw2[2]=PKW(P1,4), pw2[3]=PKW(P1,6), pw2); \
    VRD(3); SBAR(); GAPA(C0=__builtin_amdgcn_mfma_f32_32x32x16_bf16(kf[6],qr[3],C0,0,0,0),   P1[10],P1[11],P1[12],P1[13], pw3[0]=PKW(P1,8), pw3[1]=PKW(P1,10), pw3); \
    VRD(7); SBAR(); GAPA(C1=__builtin_amdgcn_mfma_f32_32x32x16_bf16(kf[7],qr[3],C1,0,0,0),   P1[14],P1[15],0.f,0.f,       pw3[2]=PKW(P1,12),pw3[3]=PKW(P1,14), pw3); \
    l_reg+=sacc; \
    if(GK){DMA_K((t)+3,sl_cur);} if(GV){DMA_V((t)+1,sl_next);} \
    ALIBI(C0,C1,t); CMASK(C0,C1,t); \
    { float a=MX3(C0[0],C0[1],C1[0]),b=MX3(C0[2],C0[3],C1[1]); a=MX3(a,C1[2],C1[3]); \
      _Pragma("unroll") for(int r=4;r<16;r+=4){a=MX3(a,C0[r],C0[r+1]);b=MX3(b,C0[r+2],C0[r+3]);a=MX3(a,C1[r],C1[r+1]);b=MX3(b,C1[r+2],C1[r+3]);} \
      float rm=__builtin_fmaxf(a,b); { auto rr=__builtin_amdgcn_permlane32_swap(__float_as_uint(rm),__float_as_uint(rm),false,false); rm=__builtin_fmaxf(__uint_as_float(rr[0]),__uint_as_float(rr[1])); } \
      resc=false; \
      if(__builtin_expect(__any(rm>(float)THRL),0)){ const float dl=__builtin_fmaxf(rm,0.f); mhat+=dl; \
        _Pragma("unroll") for(int r=0;r<16;++r){C0[r]-=dl;C1[r]-=dl;} \
        const float f=__builtin_amdgcn_exp2f(-dl); l_reg*=f; if(hi==0)wsf[r32]=f; resc=true; } } \
    SBAR(); \
    GAPB(o[0]=__builtin_amdgcn_mfma_f32_32x32x16_bf16(PAF(0),VFR(0),o[0],0,0,0), C0,0); \
    GAPB(o[1]=__builtin_amdgcn_mfma_f32_32x32x16_bf16(PAF(0),VFR(4),o[1],0,0,0), C0,4); \
    KRD(GL,0); GAPB(o[0]=__builtin_amdgcn_mfma_f32_32x32x16_bf16(PAF(1),VFR(1),o[0],0,0,0), C0,8); \
    KRD(GL,1); GAPB(o[1]=__builtin_amdgcn_mfma_f32_32x32x16_bf16(PAF(1),VFR(5),o[1],0,0,0), C0,12); \
    KRD(GL,2); GAPB(o[0]=__builtin_amdgcn_mfma_f32_32x32x16_bf16(PAF(2),VFR(2),o[0],0,0,0), C1,0); \
    KRD(GL,3); GAPB(o[1]=__builtin_amdgcn_mfma_f32_32x32x16_bf16(PAF(2),VFR(6),o[1],0,0,0), C1,4); \
    GAPB(o[0]=__builtin_amdgcn_mfma_f32_32x32x16_bf16(PAF(3),VFR(3),o[0],0,0,0), C1,8); \
    GAPB(o[1]=__builtin_amdgcn_mfma_f32_32x32x16_bf16(PAF(3),VFR(7),o[1],0,0,0), C1,12); \
    }while(0)
  int t=1;
  #undef CMASK
  #define CMASK(P0,P1,t) do{}while(0)
  for(;t+5<NT;t+=2){
    STEP(pB0,pB1,pA0,pA1,t,true,true,true);     WAIT_BAR(2); RESC(); ROT();
    STEP(pA0,pA1,pB0,pB1,t+1,true,true,true);   WAIT_BAR(2); RESC(); ROT();
  }
  #undef CMASK
  #define CMASK(P0,P1,t) do{int jb_=(t)-(NT-4); if(jb_>=0)cmask(P0,P1,jb_,qrel,hi);}while(0)
  #define ENDW(tt) do{ if((tt)+3<NT){WAIT_BAR(2);} else if((tt)+2<NT){WAIT_BAR(1);} else {WAIT_BAR(0);} }while(0)
  for(;t+1<NT;t+=2){
    STEP(pB0,pB1,pA0,pA1,t,(t+3<NT),(t+1<NT),(t+1<NT));       ENDW(t);   RESC(); ROT();
    STEP(pA0,pA1,pB0,pB1,t+1,(t+4<NT),(t+2<NT),(t+2<NT));     ENDW(t+1); RESC(); ROT();
  }
  STEP(pB0,pB1,pA0,pA1,NT-1,false,false,false); RESC();
  { float sacc=pB0[0]+pB0[1]; _Pragma("unroll") for(int r=2;r<16;++r)sacc+=pB0[r]; _Pragma("unroll") for(int r=0;r<16;++r)sacc+=pB1[r]; l_reg+=sacc;
    pw0=(u32x4){PKW(pB0,0),PKW(pB0,2),PKW(pB0,4),PKW(pB0,6)};pw1=(u32x4){PKW(pB0,8),PKW(pB0,10),PKW(pB0,12),PKW(pB0,14)};pw2=(u32x4){PKW(pB1,0),PKW(pB1,2),PKW(pB1,4),PKW(pB1,6)};pw3=(u32x4){PKW(pB1,8),PKW(pB1,10),PKW(pB1,12),PKW(pB1,14)};
    SBAR(); pv(o,vb0+sl_cur,PAF(0),PAF(1),PAF(2),PAF(3)); }
  #undef PKW
  #undef PAF
  #undef VFR
  #undef PIN
  #undef MX3
  #undef GAPA
  #undef GAPB
  #undef EX
  #undef VRD
  #undef KRD
  #undef STEP
  #undef ENDW
  {auto rr=__builtin_amdgcn_permlane32_swap(__float_as_uint(l_reg),__float_as_uint(l_reg),false,false);l_reg=__uint_as_float(rr[0])+__uint_as_float(rr[1]);}
  if(hi==0)wsf[32+r32]=l_reg;asm volatile("s_waitcnt lgkmcnt(0)":::"memory");
  float rli[16];
  #pragma unroll
  for(int r=0;r<16;++r)rli[r]=__builtin_amdgcn_rcpf(wsf[32+crow(r,hi)]);
  bf16*Ow=O+(rowbase+q0+wid*QBLK)*DM+h*D;
  { bf16*stg=(bf16*)(shm+LDS_OST)+wid*2048;
    #pragma unroll
    for(int r=0;r<16;++r){const int orow=crow(r,hi);
      #pragma unroll
      for(int d0=0;d0<2;++d0)stg[orow*64+d0*32+r32]=__float2bfloat16(o[d0][r]*rli[r]);}
    asm volatile("s_waitcnt lgkmcnt(0)":::"memory");
    #pragma unroll
    for(int i=0;i<4;++i){const int row=i*8+(lane>>3),ch=lane&7; const u32x4 v=*(const u32x4*)(stg+row*64+ch*8); ATTN_STORE16(Ow+(long)row*DM+ch*8,v);} }
  asm volatile("s_waitcnt lgkmcnt(0)\n\ts_barrier":::"memory");
  #undef ALIBI
  #undef AADD
  #undef DMA_K
  #undef DMA_V
  #undef CMASK
  #undef START
  #undef RESC
  #undef ROT
}
constexpr int ATTN_LDS_BYTES=LDS_BYTES;
struct AttnTensors { const bf16* Q; const bf16* K; const bf16* V; bf16* O; const unsigned* nmax; };
struct AttnUnit { int bh; int qb; };
struct StaticOrder {
  int vcu;
  __device__ __forceinline__ explicit StaticOrder(int grid,int block):vcu((block%8)*(grid/8)+block/8){}
  __device__ __forceinline__ bool next(int i,AttnUnit&u)const{ if(i>=4)return false; const int s=vcu&7; u.bh=vcu>>3; u.qb=(i==0)?s:(i==1)?15-s:(i==2)?16+s:31-s; return true; }
  __device__ __forceinline__ void a_ready(const AttnUnit&)const{}
  __device__ __forceinline__ void done(const AttnUnit&)const{}
};
struct DynOrder {
  unsigned* qctr; volatile __attribute__((address_space(3))) unsigned* slot; int xq, wave;
  __device__ __forceinline__ bool next(int,AttnUnit&u)const{
    if(wave==0&&lane_id()==0){ slot[0]=__hip_atomic_fetch_add(qctr+64*xq,1u,__ATOMIC_RELAXED,__HIP_MEMORY_SCOPE_AGENT); }
    __syncthreads(); const unsigned v=slot[0]; __syncthreads();
    if(v>=128u)return false; u.qb=31-(int)(v>>2); u.bh=(xq>>2)*16+(3-(int)(v&3u))*4+(xq&3); return true; }
  __device__ __forceinline__ void a_ready(const AttnUnit&)const{}
  __device__ __forceinline__ void done(const AttnUnit&)const{}
};
template<class Sched,int THRL=8> __device__ __forceinline__ void attn_phase(char*lds,const AttnTensors&T,const Sched&S,const int wave_id){
  AttnUnit u;
  for(int i=0;S.next(i,u);++i){ S.a_ready(u); attn_unit<THRL>(u.bh/NHEAD,u.bh%NHEAD,u.qb,T.Q,T.K,T.V,T.O,lds,wave_id,T.nmax); S.done(u); }
}
#undef SBAR
#undef WAIT_BAR
}
constexpr int NWAVES = 8;
constexpr int BATCH = 2, T = 8192, D = 1024, FF = 2816, M = BATCH * T;
constexpr int WIN_SRC = 5648, WIN_N = 3840;
constexpr float RMS_EPS = 1e-6f, SUBLN_EPS = 1e-5f;
constexpr size_t MiB = 1u << 20;
constexpr size_t WS_SSQA = 1 * MiB, WS_SSQB = 2 * MiB, WS_DNCD = 3 * MiB;
constexpr size_t WS_WG = 4 * MiB, WS_WA = 8 * MiB, WS_WB = 9 * MiB, WS_WOUT = 10 * MiB;
constexpr size_t WS_XB = 12 * MiB;
constexpr size_t WS_H = 44 * MiB;
constexpr size_t WS_WGU1 = 232 * MiB, WS_WD1 = 243 * MiB, WS_WIN = 248 * MiB + 512 * 1024;
constexpr size_t WS_PRE = 44 * MiB, WS_Z = 92 * MiB, WS_QO = 108 * MiB, WS_KD = 140 * MiB, WS_VD = 156 * MiB, WS_AB = 172 * MiB;
constexpr size_t WS_DN = 173 * MiB;
constexpr size_t WS_ODN = 44 * MiB, WS_AA = 60 * MiB, WS_ABB = 76 * MiB;
constexpr size_t WS_WGU2 = 173 * MiB, WS_WD2 = 184 * MiB;
constexpr size_t WS_YA = 190 * MiB, WS_YB = 222 * MiB, WS_MG = 108 * MiB;
constexpr size_t WS_END = 256 * MiB;
constexpr int DN_REC = 40960;
static_assert(WS_DN + (size_t)2048 * DN_REC <= WS_END && WS_WIN + (size_t)WIN_N * D * 2 <= WS_END && WS_YB + (size_t)M * D * 2 <= WS_END, "d_ws map");

constexpr int RING_OFF = 0, RING_BYTES = 147456;
constexpr int MISC_OFF = 147456, LDS_BYTES = 147456 + 256;

#define LAS __attribute__((address_space(3)))
typedef unsigned short bf16;
typedef unsigned v4u __attribute__((ext_vector_type(4)));
typedef float f32x4 __attribute__((ext_vector_type(4)));
typedef float f32x16 __attribute__((ext_vector_type(16)));
typedef short bf16x8 __attribute__((ext_vector_type(8)));
#define LDSFENCE() asm volatile("s_waitcnt lgkmcnt(0)" ::: "memory")
__device__ __forceinline__ unsigned f2bf(float f) { unsigned u = __builtin_bit_cast(unsigned, f); return (u + 0x7fffu + ((u >> 16) & 1u)) >> 16; }
typedef float f32x2_t_ __attribute__((ext_vector_type(2))); typedef __bf16 bf16x2_t_ __attribute__((ext_vector_type(2)));
__device__ __forceinline__ unsigned pk2(float lo, float hi) { f32x2_t_ v = {lo, hi}; bf16x2_t_ b = __builtin_convertvector(v, bf16x2_t_); return __builtin_bit_cast(unsigned, b); }
__device__ __forceinline__ float bflo(unsigned w) { return __uint_as_float(w << 16); }
__device__ __forceinline__ float bfhi(unsigned w) { return __uint_as_float(w & 0xffff0000u); }
__device__ __forceinline__ float wave_sum(float v) {
#pragma unroll
    for (int o = 1; o < 64; o <<= 1) v += __shfl_xor(v, o);
    return v;
}

#define GAS __attribute__((address_space(1)))
typedef GAS unsigned gu32;
#define RLX_AGENT __ATOMIC_RELAXED, __HIP_MEMORY_SCOPE_AGENT
constexpr size_t WS_CTL = 0, CTL_ZERO_BYTES = 65536;
constexpr int CW_BAR = 1024, CW_ATTQ = 8192, CW_NMAX = 12288;
#define XB_TMO      128
#define XB_XCNT(j)  (256  + 64 * (j))
#define XB_XSUB(j)  (1280 + 64 * (j))
#define XB_XGEN(j)  (2304 + 64 * (j))
#define XB_TOP      3328
#define XB_TOPGEN   3392
#define XCD_BAR_WORDS 3456
#define XB_SPIN_CAP (1u << 18)

__device__ __forceinline__ unsigned xb_ld(unsigned* p)              { return __hip_atomic_load(p, __ATOMIC_RELAXED, __HIP_MEMORY_SCOPE_AGENT); }
__device__ __forceinline__ unsigned xb_add(unsigned* p, unsigned v) { return __hip_atomic_fetch_add(p, v, __ATOMIC_RELAXED, __HIP_MEMORY_SCOPE_AGENT); }
__device__ __forceinline__ unsigned xb_xcc_id() { return (unsigned)__builtin_amdgcn_s_getreg((3 << 11) | 20) & 0xFu; }
#define XB_SPIN(cond, bar) do { unsigned _sp = 0; while (cond) { __builtin_amdgcn_s_sleep(1); \
    if ((++_sp & 255u) == 0u) { if (xb_ld(&(bar)[XB_TMO])) break; if (_sp > XB_SPIN_CAP) { atomicAdd(&(bar)[XB_TMO], 1u); break; } } } } while (0)

struct XcdBarrier {
    unsigned* bar; unsigned x; int wave;
    volatile LAS unsigned* st;
};

__device__ __forceinline__ XcdBarrier xcd_barrier_post(unsigned* bar, volatile LAS unsigned* st, int wave) {
    XcdBarrier b; b.bar = bar; b.x = xb_xcc_id(); b.st = st; b.wave = wave;
    if (wave == 0 && lane_id() == 0) (void)xb_add(&bar[XB_XCNT(b.x)], 1u);
    return b;
}
__device__ __forceinline__ void xcd_barrier_complete(unsigned* bar, unsigned x, unsigned& nloc, unsigned& nx) {
    const unsigned G = gridDim.x * gridDim.y * gridDim.z;
    unsigned sum, cnt, mine, sp = 0u;
    for (;;) {
        sum = 0u; cnt = 0u; mine = 0u;
#pragma unroll
        for (unsigned j = 0; j < 16; ++j) { const unsigned c = xb_ld(&bar[XB_XCNT(j)]); sum += c; cnt += (c > 0u) ? 1u : 0u; mine = (j == x) ? c : mine; }
        if (sum == G) break;
        __builtin_amdgcn_s_sleep(1);
        if ((++sp & 255u) == 0u) { if (xb_ld(&bar[XB_TMO])) break; if (sp > XB_SPIN_CAP) { atomicAdd(&bar[XB_TMO], 1u); break; } }
    }
    nloc = mine > 0u ? mine : 1u; nx = cnt > 0u ? cnt : 1u;
}

__device__ __forceinline__ void xcd_barrier(const XcdBarrier& b) {
    asm volatile("s_waitcnt vmcnt(0)" ::: "memory");
    __syncthreads();
    if (b.wave == 0 && lane_id() == 0) {
        unsigned* bar = b.bar;
        __builtin_amdgcn_s_waitcnt(0);
        unsigned nloc = b.st[0], nx = b.st[1];
        if (nloc == 0u) { xcd_barrier_complete(bar, b.x, nloc, nx); b.st[0] = nloc; b.st[1] = nx; }
        const unsigned old = xb_add(&bar[XB_XSUB(b.x)], 1u);
        const unsigned gen = old / nloc;
        if (old + 1u == (gen + 1u) * nloc) {
            __builtin_amdgcn_fence(__ATOMIC_RELEASE, "agent");
            asm volatile("s_waitcnt vmcnt(0)" ::: "memory");
            const unsigned og = xb_add(&bar[XB_TOP], 1u);
            const unsigned tg = og / nx;
            if (og + 1u == (tg + 1u) * nx) xb_add(&bar[XB_TOPGEN], 1u);
            else XB_SPIN(xb_ld(&bar[XB_TOPGEN]) == tg, bar);
            __builtin_amdgcn_fence(__ATOMIC_ACQUIRE, "agent");
            xb_add(&bar[XB_XGEN(b.x)], 1u);
            asm volatile("s_waitcnt vmcnt(0)" ::: "memory");
        } else {
            XB_SPIN(xb_ld(&bar[XB_XGEN(b.x)]) == gen, bar);
            __builtin_amdgcn_fence(__ATOMIC_ACQUIRE, "agent");
            asm volatile("s_waitcnt vmcnt(0)" ::: "memory");
        }
    }
    __syncthreads();
}

struct Ctx {
    const float* const* in; float* out; unsigned char* ws;
    LAS unsigned char* lds; int wave, G, vcu;
};

__device__ __forceinline__ void conv_item(const float* W, int ldw, int scol0, int nvalid, const float* gain, bf16* WT, int K, int drow0, int k0, LAS float* scr, int lane) {
#pragma unroll 8
    for (int i = 0; i < 32; ++i) { const int kk = 2 * i + (lane >> 5), n = lane & 31; float v = (n < nvalid) ? W[(size_t)(k0 + kk) * ldw + scol0 + n] : 0.f; if (gain) v *= gain[k0 + kk]; scr[kk * 33 + n] = v; }
    LDSFENCE();
    const int c = lane & 7;
#pragma unroll
    for (int j = 0; j < 4; ++j) { const int n = (lane >> 3) + 8 * j; const LAS float* s = scr + (8 * c) * 33 + n;
        v4u o; o.x = pk2(s[0 * 33], s[1 * 33]); o.y = pk2(s[2 * 33], s[3 * 33]); o.z = pk2(s[4 * 33], s[5 * 33]); o.w = pk2(s[6 * 33], s[7 * 33]);
        *(v4u*)(WT + (size_t)(drow0 + n) * K + k0 + 8 * c) = o; }
    LDSFENCE();
}
__device__ __forceinline__ void conv_gu(const float* wg, const float* wu, const float* gain, bf16* WT, int it, LAS float* scr, int lane) {
    const int db = it >> 4, kb = it & 15, tile = db >> 3, w = db & 7;
    conv_item(w < 4 ? wg : wu, FF, 128 * tile + 32 * (w & 3), 32, gain, WT, D, 32 * db, 64 * kb, scr, lane);
}
__device__ __forceinline__ void conv_plain(const float* W, int K, int N, bf16* WT, int it, LAS float* scr, int lane) {
    const int nkb = K / 64, db = it / nkb, kb = it % nkb;
    conv_item(W, N, 32 * db, 32, nullptr, WT, K, 32 * db, 64 * kb, scr, lane);
}
__device__ __forceinline__ void conv_win(const float* W, const float* gain, bf16* WT, int it, LAS float* scr, int lane) {
    const int db = it >> 4, kb = it & 15, d0 = 32 * db; int sc, nv = 32;
    if (d0 < 2048) sc = d0; else if (d0 < 3584) sc = d0 + 16; else if (d0 == 3584) { sc = 2048; nv = 16; } else { sc = 0; nv = 0; }
    conv_item(W, WIN_SRC, sc, nv, gain, WT, D, d0, 64 * kb, scr, lane);
}
__device__ __forceinline__ void conv_wg(const float* W, const float* gain, bf16* WT, int it, LAS float* scr, int lane) {
    const int db = it >> 4, kb = it & 15, tile = db >> 3, w = db & 7;
    conv_item(W, WIN_SRC, 3600 + (w < 4 ? 0 : 1024) + 128 * tile + 32 * (w & 3), 32, gain, WT, D, 32 * db, 64 * kb, scr, lane);
}

__device__ __forceinline__ void p0_prologue(Ctx& F) {
    const int lane = lane_id();
    LAS float* scr = (LAS float*)(F.lds + RING_OFF + F.wave * 17408);
    const int gw = F.vcu * NWAVES + F.wave, NGW = F.G * NWAVES;
    bf16* ws16 = (bf16*)F.ws;
    constexpr int I_GU = 176 * 16, I_DN = 32 * 44, I_WIN = 120 * 16, I_WG = 64 * 16, I_AB = 32 * 8, I_WO = 32 * 16;
    constexpr int NIT = I_GU + I_DN + I_WIN + I_WG + 2 * I_AB + I_WO;
    for (int it = gw; it < NIT; it += NGW) {
        int r = it;
        if (r < I_GU) { conv_gu(F.in[2], F.in[3], F.in[1], (bf16*)(F.ws + WS_WGU1), r, scr, lane); continue; } r -= I_GU;
        if (r < I_DN) { conv_plain(F.in[4], FF, D, (bf16*)(F.ws + WS_WD1), r, scr, lane); continue; } r -= I_DN;
        if (r < I_WIN) { conv_win(F.in[6], F.in[5], (bf16*)(F.ws + WS_WIN), r, scr, lane); continue; } r -= I_WIN;
        if (r < I_WG) { conv_wg(F.in[6], F.in[5], (bf16*)(F.ws + WS_WG), r, scr, lane); continue; } r -= I_WG;
        if (r < I_AB) { conv_plain(F.in[16], 512, D, (bf16*)(F.ws + WS_WA), r, scr, lane); continue; } r -= I_AB;
        if (r < I_AB) { conv_plain(F.in[17], 512, D, (bf16*)(F.ws + WS_WB), r, scr, lane); continue; } r -= I_AB;
        conv_plain(F.in[18], D, D, (bf16*)(F.ws + WS_WOUT), r, scr, lane);
    }
    (void)ws16;
    const float* x = F.in[0]; bf16* xb = (bf16*)(F.ws + WS_XB); float* ssq = (float*)(F.ws + WS_SSQA);
    for (int m = gw; m < M; m += NGW) {
        const f32x4* xr = (const f32x4*)(x + (size_t)m * D) + lane; unsigned long long* o8 = (unsigned long long*)(xb + (size_t)m * D) + lane;
        float s = 0.f;
#pragma unroll
        for (int j = 0; j < 4; ++j) { const f32x4 v = xr[64 * j]; s += (v.x * v.x + v.y * v.y) + (v.z * v.z + v.w * v.w);
            o8[64 * j] = (unsigned long long)pk2(v.x, v.y) | ((unsigned long long)pk2(v.z, v.w) << 32); }
        s = wave_sum(s);
        if (lane < 16) ssq[(size_t)m * 16 + lane] = (lane == 0) ? s : 0.f;
    }
}
__device__ __forceinline__ void conv_ffn2(Ctx& F) {
    const int lane = lane_id();
    LAS float* scr = (LAS float*)(F.lds + RING_OFF + F.wave * 17408);
    const int gw = F.vcu * NWAVES + F.wave, NGW = F.G * NWAVES;
    constexpr int I_GU = 176 * 16, I_DN = 32 * 44;
    for (int it = gw; it < I_GU + I_DN; it += NGW) {
        if (it < I_GU) conv_gu(F.in[20], F.in[21], F.in[19], (bf16*)(F.ws + WS_WGU2), it, scr, lane);
        else conv_plain(F.in[22], FF, D, (bf16*)(F.ws + WS_WD2), it - I_GU, scr, lane);
    }
}

__device__ __forceinline__ float silu_acc(float v) { return v * __builtin_amdgcn_rcpf(1.0f + __builtin_amdgcn_exp2f(-1.4426950408889634f * v)); }
typedef unsigned u32x2 __attribute__((ext_vector_type(2)));
__device__ __forceinline__ void dn_conv_l1(const bf16* PRE, const float* cw, long row0, int tin0, int colbase, int r, int hh, float (&y)[2][4][8]) {
#pragma unroll
    for (int s = 0; s < 4; ++s) {
        const int ch0 = colbase + 16 * s + 4 * hh;
        f32x4 wl[4], wh[4];
#pragma unroll
        for (int j = 0; j < 4; ++j) { wl[j] = *(const f32x4*)(cw + j * 1536 + ch0); wh[j] = *(const f32x4*)(cw + j * 1536 + ch0 + 8); }
#pragma unroll
        for (int i = 0; i < 2; ++i) { const int tok = r + 32 * i, tin = tin0 + tok; const long row = row0 + tok;
            float a[8];
#pragma unroll
            for (int e = 0; e < 8; ++e) a[e] = 0.f;
#pragma unroll
            for (int j = 0; j < 4; ++j) { u32x2 lo = (u32x2){0u, 0u}, hi = (u32x2){0u, 0u};
                if (tin - 3 + j >= 0) { const bf16* p = PRE + (size_t)(row - 3 + j) * 1536 + ch0; lo = *(const u32x2*)p; hi = *(const u32x2*)(p + 8); }
                a[0] += wl[j][0] * bflo(lo.x); a[1] += wl[j][1] * bfhi(lo.x); a[2] += wl[j][2] * bflo(lo.y); a[3] += wl[j][3] * bfhi(lo.y);
                a[4] += wh[j][0] * bflo(hi.x); a[5] += wh[j][1] * bfhi(hi.x); a[6] += wh[j][2] * bflo(hi.y); a[7] += wh[j][3] * bfhi(hi.y); }
#pragma unroll
            for (int e = 0; e < 8; ++e) { y[i][s][e] = silu_acc(a[e]); asm volatile("" : "+v"(y[i][s][e])); } }
        __builtin_amdgcn_sched_barrier(0);
    }
}
__device__ __forceinline__ bf16x8 pack8f(const float (&v)[8], float sc) {
    v4u o; o.x = pk2(v[0] * sc, v[1] * sc); o.y = pk2(v[2] * sc, v[3] * sc); o.z = pk2(v[4] * sc, v[5] * sc); o.w = pk2(v[6] * sc, v[7] * sc);
    return __builtin_bit_cast(bf16x8, o);
}
__device__ __forceinline__ v4u pack8acc(const f32x16& X, int kq) {
    v4u o; o.x = pk2(X[8 * kq], X[8 * kq + 1]); o.y = pk2(X[8 * kq + 2], X[8 * kq + 3]); o.z = pk2(X[8 * kq + 4], X[8 * kq + 5]); o.w = pk2(X[8 * kq + 6], X[8 * kq + 7]);
    return o;
}
__device__ __forceinline__ void write_xt(LAS unsigned short* XT, const bf16x8 (&fr)[2][4], const float (&sc)[2], int r, int hh) {
#pragma unroll
    for (int i = 0; i < 2; ++i)
#pragma unroll
        for (int s = 0; s < 4; ++s) { const v4u w = __builtin_bit_cast(v4u, fr[i][s]);
#pragma unroll
            for (int e2 = 0; e2 < 4; ++e2) { const unsigned ww = w[e2]; const unsigned o = pk2(bflo(ww) * sc[i], bfhi(ww) * sc[i]); const int e = 2 * e2;
                LAS unsigned short* p = XT + (16 * s + 8 * (e >> 2) + 4 * hh + (e & 3)) * 72 + r + 32 * i;
                p[0] = (unsigned short)o; p[72] = (unsigned short)(o >> 16); } }
}
__device__ __forceinline__ float lane_bcast(float v, int l) { return __uint_as_float((unsigned)__builtin_amdgcn_readlane((int)__float_as_uint(v), l)); }

__device__ __forceinline__ float fexp(float v) { return __builtin_amdgcn_exp2f(1.4426950408889634f * v); }
__device__ __forceinline__ void dn_prep_chunk(Ctx& F, int ch, LAS unsigned char* scrb, int opq  ) {
    int lane_ = lane_id();
    const int lane = lane_, r = lane & 31, hh = lane >> 5;
    const int n = ch & 127, h = (ch >> 7) & 7, b = ch >> 10;
    const long row0 = (long)b * T + 64 * n; const int tin0 = 64 * n;
    const bf16* PRE = (const bf16*)(F.ws + WS_PRE); const float* AB = (const float*)(F.ws + WS_AB); const float* cw = F.in[7];
    unsigned char* rec = F.ws + WS_DN + (size_t)ch * DN_REC;
    LAS float* At = (LAS float*)scrb; LAS unsigned short* TT = (LAS unsigned short*)scrb; LAS unsigned short* XT = (LAS unsigned short*)(scrb + 9216);
    float gc, betac;
    { const float al = AB[(size_t)(row0 + lane) * 16 + h], bl = AB[(size_t)(row0 + lane) * 16 + 8 + h];
      const float xs = al + F.in[9][h];
      const float sp = fmaxf(xs, 0.f) + log1pf(fexp(-fabsf(xs)));
      gc = -fexp(F.in[8][h]) * sp; betac = 1.0f / (1.0f + fexp(-bl));
#pragma unroll
      for (int o = 1; o < 64; o <<= 1) { const float t = __shfl_up(gc, o); if (lane >= o) gc += t; } }
    const float gl = lane_bcast(gc, 63);
    float gct[2], bet[2];
#pragma unroll
    for (int i = 0; i < 2; ++i) { gct[i] = __shfl(gc, r + 32 * i); bet[i] = __shfl(betac, r + 32 * i); }
    bf16x8 kf[2][4];
#pragma unroll
    for (int i = 0; i < 2; ++i)
#pragma unroll
        for (int s = 0; s < 4; ++s) kf[i][s] = (bf16x8){0, 0, 0, 0, 0, 0, 0, 0};
    if (opq > 0) { int lane = lane_; asm volatile("" : "+v"(lane)); const int r = lane & 31, hh = lane >> 5;
      float y[2][4][8]; dn_conv_l1(PRE, cw, row0, tin0, 512 + h * 64, r, hh, y);
#pragma unroll
      for (int i = 0; i < 2; ++i) { float ss = 0.f;
#pragma unroll
          for (int s = 0; s < 4; ++s)
#pragma unroll
              for (int e = 0; e < 8; ++e) ss += y[i][s][e] * y[i][s][e];
          ss += __shfl_xor(ss, 32); const float rn = 1.0f / sqrtf(ss + 1e-6f);
#pragma unroll
          for (int s = 0; s < 4; ++s) { kf[i][s] = pack8f(y[i][s], rn); asm volatile("" : "+v"(kf[i][s])); } } }
    __builtin_amdgcn_sched_barrier(0);
    if (opq > 1) { int lane = lane_; asm volatile("" : "+v"(lane)); const int r = lane & 31, hh = lane >> 5;
      float sc[2] = {fexp(gl - gct[0]), fexp(gl - gct[1])};
      write_xt(XT, kf, sc, r, hh);
      LDSFENCE();
#pragma unroll
      for (int id = 0; id < 2; ++id)
#pragma unroll
          for (int ks = 0; ks < 4; ++ks) { const int d = r + 32 * id; const LAS unsigned short* p = XT + d * 72 + 16 * ks + 4 * hh;
              const u32x2 lo = *(const LAS u32x2*)p, hi = *(const LAS u32x2*)(p + 8);
              *(v4u*)(rec + 24576 + d * 128 + (ks * 2 + hh) * 16) = (v4u){lo.x, lo.y, hi.x, hi.y}; }
      LDSFENCE(); }
    __builtin_amdgcn_sched_barrier(0);
#ifndef SKQ
    if (opq > 2) {
        int lane = lane_; asm volatile("" : "+v"(lane)); const int r = lane & 31, hh = lane >> 5;
        bf16x8 qf[2][4];
        { float y[2][4][8]; dn_conv_l1(PRE, cw, row0, tin0, h * 64, r, hh, y);
#pragma unroll
          for (int i = 0; i < 2; ++i) { float ss = 0.f;
#pragma unroll
              for (int s = 0; s < 4; ++s)
#pragma unroll
                  for (int e = 0; e < 8; ++e) ss += y[i][s][e] * y[i][s][e];
              ss += __shfl_xor(ss, 32); const float rn = 0.125f / sqrtf(ss + 1e-6f); const float eg = fexp(gct[i]);
#pragma unroll
              for (int s = 0; s < 4; ++s) { qf[i][s] = pack8f(y[i][s], rn);
                  *(bf16x8*)(rec + 8192 + (r + 32 * i) * 128 + (s * 2 + hh) * 16) = pack8f(y[i][s], rn * eg); asm volatile("" : "+v"(qf[i][s])); } } }
        __builtin_amdgcn_sched_barrier(0);
#pragma unroll
        for (int is = 0; is < 2; ++is) {
            float gcr[16];
#pragma unroll
            for (int g = 0; g < 16; ++g) gcr[g] = __shfl(gc, 32 * is + (g & 3) + 8 * (g >> 2) + 4 * hh);
#pragma unroll
            for (int ic = 0; ic < 2; ++ic) {
                if (is == 1 && ic == 0) {
#pragma unroll
                    for (int kq = 0; kq < 2; ++kq) *(v4u*)(rec + 16384 + r * 128 + ((2 + kq) * 2 + hh) * 16) = (v4u){0u, 0u, 0u, 0u};
#pragma unroll
                    for (int g = 0; g < 16; ++g) At[(32 + (g & 3) + 8 * (g >> 2) + 4 * hh) * 68 + r] = 0.f;
                    continue;
                }
                f32x16 pt, pk;
#pragma unroll
                for (int g = 0; g < 16; ++g) { pt[g] = 0.f; pk[g] = 0.f; }
#pragma unroll
                for (int ks = 0; ks < 4; ++ks) { pt = __builtin_amdgcn_mfma_f32_32x32x16_bf16(kf[is][ks], qf[ic][ks], pt, 0, 0, 0); pk = __builtin_amdgcn_mfma_f32_32x32x16_bf16(kf[is][ks], kf[ic][ks], pk, 0, 0, 0); }
                const int ccol = 32 * ic + r;
#pragma unroll
                for (int g = 0; g < 16; ++g) { const int srow = 32 * is + (g & 3) + 8 * (g >> 2) + 4 * hh; const float dec = fexp(fminf(gct[ic] - gcr[g], 0.f));
                    pt[g] = (srow <= ccol) ? pt[g] * dec : 0.f;
                    At[srow * 68 + ccol] = (srow < ccol) ? bet[ic] * pk[g] * dec : 0.f; }
#pragma unroll
                for (int kq = 0; kq < 2; ++kq) *(v4u*)(rec + 16384 + ccol * 128 + ((2 * is + kq) * 2 + hh) * 16) = pack8acc(pt, kq);
                __builtin_amdgcn_sched_barrier(0);
            }
        }
    }
    LDSFENCE();
#endif
    __builtin_amdgcn_sched_barrier(0);
#ifndef SKS
    if (opq > 3) {
        int lane = lane_; asm volatile("" : "+v"(lane)); const int r = lane & 31, hh = lane >> 5;
        float t[64];
#pragma unroll
        for (int k = 0; k < 64; ++k) t[k] = (k == lane) ? 1.0f : 0.0f;
#pragma unroll
        for (int j = 62; j >= 0; --j) { float acc = 0.f;
#pragma unroll
            for (int k4 = (j + 1) & ~3; k4 < 64; k4 += 4) { const f32x4 x = *(const volatile LAS f32x4*)(At + j * 68 + k4);
#pragma unroll
                for (int i = 0; i < 4; ++i) if (k4 + i > j) acc += t[k4 + i] * x[i]; }
            t[j] -= acc; asm volatile("" : "+v"(t[j])); }
        LDSFENCE();
#pragma unroll
        for (int i = 0; i < 8; ++i) { v4u o; o.x = pk2(t[8 * i], t[8 * i + 1]); o.y = pk2(t[8 * i + 2], t[8 * i + 3]); o.z = pk2(t[8 * i + 4], t[8 * i + 5]); o.w = pk2(t[8 * i + 6], t[8 * i + 7]);
            *(LAS v4u*)(TT + lane * 72 + 8 * i) = o; }
    }
#endif
    __builtin_amdgcn_sched_barrier(0);
#ifndef SKW
    if (opq > 4) { int lane = lane_; asm volatile("" : "+v"(lane)); const int r = lane & 31, hh = lane >> 5;
      float sc[2] = {bet[0] * fexp(gct[0]), bet[1] * fexp(gct[1])};
      write_xt(XT, kf, sc, r, hh);
      LDSFENCE();
#pragma unroll
      for (int id = 0; id < 2; ++id)
#pragma unroll
          for (int ic = 0; ic < 2; ++ic) { f32x16 acc;
#pragma unroll
              for (int g = 0; g < 16; ++g) acc[g] = 0.f;
#pragma unroll
              for (int ks = 0; ks < 4; ++ks) { const bf16x8 af = *(const LAS bf16x8*)(XT + (r + 32 * id) * 72 + 16 * ks + 8 * hh), bfr = *(const LAS bf16x8*)(TT + (r + 32 * ic) * 72 + 16 * ks + 8 * hh);
                  acc = __builtin_amdgcn_mfma_f32_32x32x16_bf16(af, bfr, acc, 0, 0, 0); }
#pragma unroll
              for (int kq = 0; kq < 2; ++kq) *(v4u*)(rec + (32 * ic + r) * 128 + ((2 * id + kq) * 2 + hh) * 16) = pack8acc(acc, kq); __builtin_amdgcn_sched_barrier(0); }
      LDSFENCE(); }
    __builtin_amdgcn_sched_barrier(0);
#endif
#ifndef SKU
    if (opq > 1) { int lane = lane_; asm volatile("" : "+v"(lane)); const int r = lane & 31, hh = lane >> 5;
      bf16x8 vf[2][4];
      { float y[2][4][8]; dn_conv_l1(PRE, cw, row0, tin0, 1024 + h * 64, r, hh, y);
#pragma unroll
        for (int i = 0; i < 2; ++i)
#pragma unroll
            for (int s = 0; s < 4; ++s) { vf[i][s] = pack8f(y[i][s], bet[i]); asm volatile("" : "+v"(vf[i][s])); } }
      __builtin_amdgcn_sched_barrier(0);
      float one[2] = {1.0f, 1.0f};
      write_xt(XT, vf, one, r, hh);
      LDSFENCE();
      unsigned* U = (unsigned*)(rec + 32768);
#pragma unroll
      for (int ic = 0; ic < 2; ++ic)
#pragma unroll
          for (int ie = 0; ie < 2; ++ie) { f32x16 acc;
#pragma unroll
              for (int g = 0; g < 16; ++g) acc[g] = 0.f;
#pragma unroll
              for (int ks = 0; ks < 4; ++ks) { const bf16x8 af = *(const LAS bf16x8*)(TT + (r + 32 * ic) * 72 + 16 * ks + 8 * hh), bfr = *(const LAS bf16x8*)(XT + (r + 32 * ie) * 72 + 16 * ks + 8 * hh);
                  acc = __builtin_amdgcn_mfma_f32_32x32x16_bf16(af, bfr, acc, 0, 0, 0); }
#pragma unroll
              for (int gp = 0; gp < 8; ++gp) U[((ie * 2 + ic) * 8 + gp) * 64 + lane] = pk2(acc[2 * gp], acc[2 * gp + 1]); __builtin_amdgcn_sched_barrier(0); }
      LDSFENCE(); }
#endif
    if (lane == 0) ((float*)(F.ws + WS_DNCD))[ch] = fexp(gl);
}

__device__ __forceinline__ bf16x8 pack8(const f32x16& X, int s) {
    v4u o; o.x = pg8::cvt_pk_bf16(X[8 * s], X[8 * s + 1]); o.y = pg8::cvt_pk_bf16(X[8 * s + 2], X[8 * s + 3]); o.z = pg8::cvt_pk_bf16(X[8 * s + 4], X[8 * s + 5]); o.w = pg8::cvt_pk_bf16(X[8 * s + 6], X[8 * s + 7]);
    return __builtin_bit_cast(bf16x8, o);
}
__device__ __forceinline__ void dn_scan(Ctx& F, int sw) {
    const int lane = lane_id(), r = lane & 31, hh = lane >> 5;
    const int bh = sw >> 1, sl = sw & 1, b = bh >> 3, h = bh & 7;
    const float* CD = (const float*)(F.ws + WS_DNCD) + bh * 128;
    bf16* ODN = (bf16*)(F.ws + WS_ODN);
    f32x16 S0, S1;
#pragma unroll
    for (int i = 0; i < 16; ++i) { S0[i] = 0.f; S1[i] = 0.f; }
    for (int n = 0; n < 128; ++n) {
        const unsigned char* rec = F.ws + WS_DN + ((size_t)bh * 128 + n) * DN_REC;
        const unsigned char* fb = rec + r * 128 + hh * 16;
        bf16x8 w[2][4], qd[2][4], at[2][4], kt[2][4];
#pragma unroll
        for (int i = 0; i < 2; ++i)
#pragma unroll
            for (int ks = 0; ks < 4; ++ks) { const int o = i * 4096 + ks * 32;
                w[i][ks] = *(const bf16x8*)(fb + o); qd[i][ks] = *(const bf16x8*)(fb + 8192 + o); at[i][ks] = *(const bf16x8*)(fb + 16384 + o); kt[i][ks] = *(const bf16x8*)(fb + 24576 + o); }
        const unsigned* up = (const unsigned*)(rec + 32768) + (sl * 2) * 8 * 64 + lane;
        unsigned uw[2][8];
#pragma unroll
        for (int i = 0; i < 2; ++i)
#pragma unroll
            for (int gp = 0; gp < 8; ++gp) uw[i][gp] = up[(i * 8 + gp) * 64];
        const float cd = CD[n];
        bf16x8 sb[4]; sb[0] = pack8(S0, 0); sb[1] = pack8(S0, 1); sb[2] = pack8(S1, 0); sb[3] = pack8(S1, 1);
        f32x16 ws[2], qs[2];
#pragma unroll
        for (int i = 0; i < 2; ++i) {
#pragma unroll
            for (int g = 0; g < 16; ++g) { ws[i][g] = 0.f; qs[i][g] = 0.f; }
#pragma unroll
            for (int ks = 0; ks < 4; ++ks) { ws[i] = __builtin_amdgcn_mfma_f32_32x32x16_bf16(w[i][ks], sb[ks], ws[i], 0, 0, 0); qs[i] = __builtin_amdgcn_mfma_f32_32x32x16_bf16(qd[i][ks], sb[ks], qs[i], 0, 0, 0); }
        }
#pragma unroll
        for (int i = 0; i < 2; ++i)
#pragma unroll
            for (int gp = 0; gp < 8; ++gp) { ws[i][2 * gp] = bflo(uw[i][gp]) - ws[i][2 * gp]; ws[i][2 * gp + 1] = bfhi(uw[i][gp]) - ws[i][2 * gp + 1]; }
        bf16x8 vb[4]; vb[0] = pack8(ws[0], 0); vb[1] = pack8(ws[0], 1); vb[2] = pack8(ws[1], 0); vb[3] = pack8(ws[1], 1);
#pragma unroll
        for (int g = 0; g < 16; ++g) { S0[g] *= cd; S1[g] *= cd; }
#pragma unroll
        for (int ks = 0; ks < 4; ++ks) {
            qs[0] = __builtin_amdgcn_mfma_f32_32x32x16_bf16(at[0][ks], vb[ks], qs[0], 0, 0, 0);
            qs[1] = __builtin_amdgcn_mfma_f32_32x32x16_bf16(at[1][ks], vb[ks], qs[1], 0, 0, 0);
            S0 = __builtin_amdgcn_mfma_f32_32x32x16_bf16(kt[0][ks], vb[ks], S0, 0, 0, 0);
            S1 = __builtin_amdgcn_mfma_f32_32x32x16_bf16(kt[1][ks], vb[ks], S1, 0, 0, 0);
        }
        bf16* orow = ODN + ((size_t)b * T + 64 * n) * 512 + h * 64 + 32 * sl + r;
#pragma unroll
        for (int i = 0; i < 2; ++i)
#pragma unroll
            for (int g = 0; g < 16; ++g) { const int c = 32 * i + (g & 3) + 8 * (g >> 2) + 4 * hh; orow[(size_t)c * 512] = (bf16)f2bf(qs[i][g]); }
    }
}

constexpr int SC_SLOT = 4 * 9216 + 8192, SC_NPIECE = DN_REC / 16, SC_LANES = 5 * 64, SC_PPL = SC_NPIECE / SC_LANES;
static_assert(SC_PPL * SC_LANES == SC_NPIECE, "whole pieces per loader lane");
static_assert(3 * SC_SLOT <= RING_BYTES, "scan ring fits the phase scratch");
__device__ __forceinline__ int sc_piece_off(int p) { return p < 2048 ? (p >> 9) * 9216 + ((p & 511) >> 3) * 144 + (p & 7) * 16 : 36864 + (p - 2048) * 16; }
__device__ __forceinline__ void dn_scan_block(Ctx& F, int bh) {
    const int lane = lane_id(), wave = F.wave;
    LAS unsigned char* ring = F.lds + RING_OFF;
    const unsigned char* recs = F.ws + WS_DN + (size_t)bh * 128 * DN_REC;
#define SC_BAR() asm volatile("s_waitcnt vmcnt(0) lgkmcnt(0)\n\ts_barrier" ::: "memory")
    if (wave == 7) {
        asm volatile("s_barrier" ::: "memory");
#pragma unroll 1
        for (int n = 0; n < 128; ++n) asm volatile("s_barrier" ::: "memory");
    } else if (wave >= 2) {
        const int ll = (wave - 2) * 64 + lane; v4u d0[SC_PPL], d1[SC_PPL], d2[SC_PPL], d3[SC_PPL];
#define SC_LOAD(D, rec_) do { _Pragma("unroll") for (int j = 0; j < SC_PPL; ++j) { const int p = ll + j * SC_LANES; D[j] = *(const v4u*)(recs + (size_t)(rec_) * DN_REC + p * 16); } } while (0)
#define SC_STORE(D, slot_) do { _Pragma("unroll") for (int j = 0; j < SC_PPL; ++j) { const int p = ll + j * SC_LANES; *(LAS v4u*)(ring + (slot_) * SC_SLOT + sc_piece_off(p)) = D[j]; } } while (0)
#define SC_LBAR() asm volatile("s_waitcnt lgkmcnt(0)\n\ts_barrier" ::: "memory")
        SC_LOAD(d0, 0); SC_LOAD(d1, 1); SC_STORE(d0, 0); SC_STORE(d1, 1);
        SC_LOAD(d0, 2); SC_LOAD(d1, 3); SC_LOAD(d2, 4); SC_LOAD(d3, 5);
        SC_LBAR();
#define SC_STEP(D, n_, slot_) do { SC_STORE(D, slot_); SC_LOAD(D, (n_) + 6); SC_LBAR(); } while (0)
#pragma unroll 1
        for (int n = 0; n < 128; n += 12) {
            SC_STEP(d0, n, 2); SC_STEP(d1, n + 1, 0); SC_STEP(d2, n + 2, 1); SC_STEP(d3, n + 3, 2);
            SC_STEP(d0, n + 4, 0); SC_STEP(d1, n + 5, 1); SC_STEP(d2, n + 6, 2); SC_STEP(d3, n + 7, 0);
            if (n + 8 < 128) { SC_STEP(d0, n + 8, 1); SC_STEP(d1, n + 9, 2); SC_STEP(d2, n + 10, 0); SC_STEP(d3, n + 11, 1); }
        }
#undef SC_LOAD
#undef SC_STORE
#undef SC_STEP
#undef SC_LBAR
    } else {
        const int r = lane & 31, hh = lane >> 5, sl = wave, b = bh >> 3, h = bh & 7;
        const float* CD = (const float*)(F.ws + WS_DNCD) + bh * 128;
        bf16* ODN = (bf16*)(F.ws + WS_ODN);
        f32x16 S0, S1;
#pragma unroll
        for (int i = 0; i < 16; ++i) { S0[i] = 0.f; S1[i] = 0.f; }
        float cd = CD[0];
        asm volatile("s_waitcnt lgkmcnt(0)\n\ts_barrier" ::: "memory");
        int slot = 0;
#pragma unroll 1
        for (int n = 0; n < 128; ++n) {
            const LAS unsigned char* sb_ = ring + slot * SC_SLOT; const LAS unsigned char* fb = sb_ + r * 144 + hh * 16;
            const float cdn = CD[n + 1 < 128 ? n + 1 : n];
            bf16x8 w[2][4], qd[2][4];
#pragma unroll
            for (int i = 0; i < 2; ++i)
#pragma unroll
                for (int ks = 0; ks < 4; ++ks) { const int o = i * 32 * 144 + ks * 32; w[i][ks] = *(const LAS bf16x8*)(fb + o); qd[i][ks] = *(const LAS bf16x8*)(fb + 9216 + o); }
            bf16x8 sb[4]; sb[0] = pack8(S0, 0); sb[1] = pack8(S0, 1); sb[2] = pack8(S1, 0); sb[3] = pack8(S1, 1);
            f32x16 ws[2], qs[2];
#pragma unroll
            for (int i = 0; i < 2; ++i) {
#pragma unroll
                for (int g = 0; g < 16; ++g) { ws[i][g] = 0.f; qs[i][g] = 0.f; }
#pragma unroll
                for (int ks = 0; ks < 4; ++ks) { ws[i] = __builtin_amdgcn_mfma_f32_32x32x16_bf16(w[i][ks], sb[ks], ws[i], 0, 0, 0); qs[i] = __builtin_amdgcn_mfma_f32_32x32x16_bf16(qd[i][ks], sb[ks], qs[i], 0, 0, 0); }
            }
            bf16x8 at[2][4], kt[2][4];
#pragma unroll
            for (int i = 0; i < 2; ++i)
#pragma unroll
                for (int ks = 0; ks < 4; ++ks) { const int o = i * 32 * 144 + ks * 32; at[i][ks] = *(const LAS bf16x8*)(fb + 2 * 9216 + o); kt[i][ks] = *(const LAS bf16x8*)(fb + 3 * 9216 + o); }
            const LAS unsigned* up = (const LAS unsigned*)(sb_ + 36864) + (sl * 2) * 8 * 64 + lane;
#pragma unroll
            for (int i = 0; i < 2; ++i)
#pragma unroll
                for (int gp = 0; gp < 8; ++gp) { const unsigned uw = up[(i * 8 + gp) * 64]; ws[i][2 * gp] = bflo(uw) - ws[i][2 * gp]; ws[i][2 * gp + 1] = bfhi(uw) - ws[i][2 * gp + 1]; }
            bf16x8 vb[4]; vb[0] = pack8(ws[0], 0); vb[1] = pack8(ws[0], 1); vb[2] = pack8(ws[1], 0); vb[3] = pack8(ws[1], 1);
#pragma unroll
            for (int g = 0; g < 16; ++g) { S0[g] *= cd; S1[g] *= cd; }
#pragma unroll
            for (int ks = 0; ks < 4; ++ks) {
                S0 = __builtin_amdgcn_mfma_f32_32x32x16_bf16(kt[0][ks], vb[ks], S0, 0, 0, 0);
                S1 = __builtin_amdgcn_mfma_f32_32x32x16_bf16(kt[1][ks], vb[ks], S1, 0, 0, 0);
                qs[0] = __builtin_amdgcn_mfma_f32_32x32x16_bf16(at[0][ks], vb[ks], qs[0], 0, 0, 0);
                qs[1] = __builtin_amdgcn_mfma_f32_32x32x16_bf16(at[1][ks], vb[ks], qs[1], 0, 0, 0);
            }
            bf16* orow = ODN + ((size_t)b * T + 64 * n) * 512 + h * 64 + 32 * sl + r;
#pragma unroll
            for (int i = 0; i < 2; ++i)
#pragma unroll
                for (int g = 0; g < 16; ++g) { const int c = 32 * i + (g & 3) + 8 * (g >> 2) + 4 * hh; orow[(size_t)c * 512] = (bf16)f2bf(qs[i][g]); }
            cd = cdn; slot = (slot == 2) ? 0 : slot + 1;
            asm volatile("s_waitcnt lgkmcnt(0)\n\ts_barrier" ::: "memory");
        }
    }
    SC_BAR();
#undef SC_BAR
}

__device__ __forceinline__ void qk_norm_max(Ctx& F) {
    const int gw = F.vcu * NWAVES + F.wave, NGW = F.G * NWAVES, lane = lane_id(), j = lane >> 3;
    const bf16* QO = (const bf16*)(F.ws + WS_QO); const bf16* KD = (const bf16*)(F.ws + WS_KD);
    float mq[2] = {0.f, 0.f}, mk[2] = {0.f, 0.f};
    for (int m = gw; m < M; m += NGW) {
        const v4u qv = *(const v4u*)(QO + (size_t)m * 1024 + (2 * j) * 64 + (lane & 7) * 8), kv = *(const v4u*)(KD + (size_t)m * 512 + lane * 8);
        float sq = 0.f, sk = 0.f;
#pragma unroll
        for (int e = 0; e < 4; ++e) { const float a = bflo(qv[e]), b2 = bfhi(qv[e]), c = bflo(kv[e]), d = bfhi(kv[e]); sq += a * a + b2 * b2; sk += c * c + d * d; }
        sq += __shfl_xor(sq, 1); sq += __shfl_xor(sq, 2); sq += __shfl_xor(sq, 4);
        sk += __shfl_xor(sk, 1); sk += __shfl_xor(sk, 2); sk += __shfl_xor(sk, 4);
        const int bb = m >> 13;
        if (bb == 0) { mq[0] = fmaxf(mq[0], sq); mk[0] = fmaxf(mk[0], sk); } else { mq[1] = fmaxf(mq[1], sq); mk[1] = fmaxf(mk[1], sk); }
    }
    if ((lane & 7) == 0) { unsigned* nm = (unsigned*)(F.ws + WS_CTL) + CW_NMAX;
#pragma unroll
        for (int bb = 0; bb < 2; ++bb) { atomicMax(nm + bb * 8 + j, __float_as_uint(mq[bb])); atomicMax(nm + 16 + bb * 8 + j, __float_as_uint(mk[bb])); } }
}

__device__ __forceinline__ void finalize_rows(Ctx& F) {
    const int gw = F.vcu * NWAVES + F.wave, NGW = F.G * NWAVES, lane = lane_id();
    const bf16* ODN = (const bf16*)(F.ws + WS_ODN); const bf16* Z = (const bf16*)(F.ws + WS_Z); const bf16* QO = (const bf16*)(F.ws + WS_QO);
    bf16* AA = (bf16*)(F.ws + WS_AA); bf16* ABB = (bf16*)(F.ws + WS_ABB);
    float s1 = 0.f, s2 = 0.f;
    { const float a = F.in[11][lane] * F.in[12][lane], bq = F.in[13][lane] * F.in[14][lane]; s1 = wave_sum(a); s2 = wave_sum(bq); }
    const float lam_init = 0.2f;
    const float lam = expf(s1) - expf(s2) + lam_init;
    float gdn[8], gsub[8];
#pragma unroll
    for (int e = 0; e < 8; ++e) { gdn[e] = F.in[10][(lane & 7) * 8 + e]; gsub[e] = F.in[15][(lane & 15) * 8 + e] * (1.0f - lam_init); }
    for (int m = gw; m < M; m += NGW) {
        { const v4u ov = *(const v4u*)(ODN + (size_t)m * 512 + lane * 8), zv = *(const v4u*)(Z + (size_t)m * 512 + lane * 8);
          float o[8], z[8]; float ss = 0.f;
#pragma unroll
          for (int e = 0; e < 4; ++e) { o[2 * e] = bflo(ov[e]); o[2 * e + 1] = bfhi(ov[e]); z[2 * e] = bflo(zv[e]); z[2 * e + 1] = bfhi(zv[e]); }
#pragma unroll
          for (int e = 0; e < 8; ++e) ss += o[e] * o[e];
          ss += __shfl_xor(ss, 1); ss += __shfl_xor(ss, 2); ss += __shfl_xor(ss, 4);
          const float rn = 1.0f / sqrtf(ss * (1.0f / 64.0f) + RMS_EPS);
          float y[8];
#pragma unroll
          for (int e = 0; e < 8; ++e) y[e] = o[e] * rn * gdn[e] * silu_acc(z[e]);
          v4u w; w.x = pk2(y[0], y[1]); w.y = pk2(y[2], y[3]); w.z = pk2(y[4], y[5]); w.w = pk2(y[6], y[7]);
          *(v4u*)(AA + (size_t)m * 512 + lane * 8) = w; }
        { const int hd = lane >> 4, e0 = (lane & 15) * 8;
          const v4u a1 = *(const v4u*)(QO + (size_t)m * 1024 + hd * 256 + e0), a2 = *(const v4u*)(QO + (size_t)m * 1024 + hd * 256 + 128 + e0);
          float o[8]; float ss = 0.f;
#pragma unroll
          for (int e = 0; e < 4; ++e) { o[2 * e] = bflo(a1[e]) - lam * bflo(a2[e]); o[2 * e + 1] = bfhi(a1[e]) - lam * bfhi(a2[e]); }
#pragma unroll
          for (int e = 0; e < 8; ++e) ss += o[e] * o[e];
          ss += __shfl_xor(ss, 1); ss += __shfl_xor(ss, 2); ss += __shfl_xor(ss, 4); ss += __shfl_xor(ss, 8);
          const float rn = 1.0f / sqrtf(ss * (1.0f / 128.0f) + SUBLN_EPS);
          float y[8];
#pragma unroll
          for (int e = 0; e < 8; ++e) y[e] = o[e] * rn * gsub[e];
          v4u w; w.x = pk2(y[0], y[1]); w.y = pk2(y[2], y[3]); w.z = pk2(y[4], y[5]); w.w = pk2(y[6], y[7]);
          *(v4u*)(ABB + (size_t)m * 512 + hd * 128 + e0) = w; }
    }
}
__device__ __forceinline__ void final_norm_rows(Ctx& F) {
    const int lane = lane_id();
    const int gw = F.vcu * NWAVES + F.wave, NGW = F.G * NWAVES;
    const f32x4* gp = (const f32x4*)F.in[23] + lane; f32x4 gg[4];
#pragma unroll
    for (int j = 0; j < 4; ++j) gg[j] = gp[64 * j];
    for (int m = gw; m < M; m += NGW) {
        f32x4* xr = (f32x4*)(F.out + (size_t)m * D) + lane; f32x4 v[4]; float s = 0.f;
#pragma unroll
        for (int j = 0; j < 4; ++j) { v[j] = xr[64 * j]; s += (v[j].x * v[j].x + v[j].y * v[j].y) + (v[j].z * v[j].z + v[j].w * v[j].w); }
        const float rn = 1.0f / sqrtf(wave_sum(s) * (1.0f / D) + RMS_EPS);
#pragma unroll
        for (int j = 0; j < 4; ++j) xr[64 * j] = v[j] * rn * gg[j];
    }
}

constexpr int N_PHASES = 14;
struct Args { const float* in[24]; float* out; unsigned char* ws; int ph_lo, ph_hi; };
__global__ void __launch_bounds__(NWAVES * 64, 2) mk_fwd(Args args) {
    extern __shared__ __attribute__((aligned(16))) unsigned char lds[];
    Ctx F;
    F.in = args.in;
    F.out = args.out; F.ws = args.ws;
    F.lds = (LAS unsigned char*)lds;
    F.wave = __builtin_amdgcn_readfirstlane((int)threadIdx.x >> 6);
    F.G = gridDim.x; { const int bx = blockIdx.x; F.vcu = (F.G % 8 == 0) ? (bx % 8) * (F.G / 8) + bx / 8 : bx; }
    const int lo = args.ph_lo, hi = args.ph_hi;
    { volatile LAS unsigned* misc = (volatile LAS unsigned*)(F.lds + MISC_OFF); if (F.wave == 0) misc[lane_id()] = 0u; }
    __syncthreads();
    XcdBarrier bar = xcd_barrier_post((unsigned*)(args.ws + WS_CTL) + CW_BAR, (volatile LAS unsigned*)(F.lds + MISC_OFF) + 8, F.wave);
    if (lo < -7) cg::this_grid().sync();
    unsigned char* ws = F.ws;
    typedef pg8::bf16_t pb;
#ifndef PH_MASK
#define PH_MASK 0x3fff
#endif
#define IN(k) (((PH_MASK >> (k)) & 1) && lo <= (k) && (k) < hi)
#ifndef PROBE_A
#define PROBE_A -1
#endif
#ifndef PROBE_B
#define PROBE_B -1
#endif
#define STAMP(k) do { if (PROBE_A >= 0 && blockIdx.x == 0 && F.wave == 0 && lane_id() == 0) ((volatile unsigned long long*)(args.ws + WS_CTL + 32768))[k] = __builtin_amdgcn_s_memrealtime(); } while (0)
#define SEAM(k) do { if (IN(k) && IN((k) + 1)) xcd_barrier(bar); STAMP((k) + 1); } while (0)

    STAMP(0);
    if (IN(0)) { p0_prologue(F); } SEAM(0);
    if (IN(1)) { pg8::Gemm g{(const pb*)(ws + WS_XB), (const pb*)(ws + WS_WGU1), M, 2 * FF, D}; pg8::StaticOrder S; S.init(M, 2 * FF, F.G, (int)blockIdx.x);
        pg8::EpiSwiGLU E{(pb*)(ws + WS_H), FF, (const float*)(ws + WS_SSQA), RMS_EPS};
        pg8::gemm_phase<pg8::EpiSwiGLU, pg8::StaticOrder, true, true>(F.lds + RING_OFF, g, S, E, F.wave); } SEAM(1);
    if (IN(2)) { pg8::Gemm g{(const pb*)(ws + WS_H), (const pb*)(ws + WS_WD1), M, D, FF}; pg8::StaticOrder S; S.init(M, D, F.G, (int)blockIdx.x);
        pg8::EpiResid E{F.in[0], F.out, (pb*)(ws + WS_XB), (float*)(ws + WS_SSQB), 0.5f};
        pg8::gemm_phase<pg8::EpiResid, pg8::StaticOrder, true, true>(F.lds + RING_OFF, g, S, E, F.wave); } SEAM(2);
    if (IN(3)) { pg8::Gemm g{(const pb*)(ws + WS_XB), (const pb*)(ws + WS_WIN), M, WIN_N, D}; pg8::StaticOrder S; S.init(M, WIN_N, F.G, (int)blockIdx.x);
        pg8::EpiWin E{(pb*)(ws + WS_PRE), (pb*)(ws + WS_Z), (pb*)(ws + WS_QO), (pb*)(ws + WS_KD), (pb*)(ws + WS_VD), (float*)(ws + WS_AB), (const float*)(ws + WS_SSQB), RMS_EPS, attn_body::C2};
        pg8::gemm_phase<pg8::EpiWin, pg8::StaticOrder, true, true>(F.lds + RING_OFF, g, S, E, F.wave); } SEAM(3);
    if (IN(4)) { LAS unsigned char* scr = F.lds + RING_OFF + F.wave * 18432; const int gw = F.vcu * NWAVES + F.wave, NGW = F.G * NWAVES;
        for (int ch = gw; ch < 2048; ch += NGW) dn_prep_chunk(F, ch, scr, hi);
        qk_norm_max(F); } SEAM(4);
    if (IN(5)) {
        if (blockIdx.x < 16) dn_scan_block(F, (int)blockIdx.x);
        const attn_body::AttnTensors AT{(const attn_body::bf16*)(ws + WS_QO), (const attn_body::bf16*)(ws + WS_KD), (const attn_body::bf16*)(ws + WS_VD), (attn_body::bf16*)(ws + WS_QO), (const unsigned*)(ws + WS_CTL) + CW_NMAX};
        const attn_body::DynOrder S{(unsigned*)(ws + WS_CTL) + CW_ATTQ, (volatile LAS unsigned*)(F.lds + MISC_OFF) + 16, (int)(blockIdx.x & 7), F.wave};
        attn_body::attn_phase<attn_body::DynOrder>((char*)lds + RING_OFF, AT, S, F.wave); } SEAM(5);
    if (IN(7)) { finalize_rows(F); conv_ffn2(F); } SEAM(7);
    if (IN(8)) { pg8::StaticOrder S; S.init(M, D, F.G, (int)blockIdx.x);
        { pg8::Gemm g{(const pb*)(ws + WS_AA), (const pb*)(ws + WS_WA), M, D, 512}; pg8::EpiStoreBf16 E{(pb*)(ws + WS_YA), D};
          pg8::gemm_phase<pg8::EpiStoreBf16, pg8::StaticOrder, true, true>(F.lds + RING_OFF, g, S, E, F.wave); }
        { pg8::Gemm g{(const pb*)(ws + WS_ABB), (const pb*)(ws + WS_WB), M, D, 512}; pg8::EpiStoreBf16 E{(pb*)(ws + WS_YB), D};
          pg8::gemm_phase<pg8::EpiStoreBf16, pg8::StaticOrder, true, true>(F.lds + RING_OFF, g, S, E, F.wave); } } SEAM(8);
    if (IN(9)) { pg8::Gemm g{(const pb*)(ws + WS_XB), (const pb*)(ws + WS_WG), M, 2 * D, D}; pg8::StaticOrder S; S.init(M, 2 * D, F.G, (int)blockIdx.x);
        pg8::EpiGateMerge E{(const pb*)(ws + WS_YA), (const pb*)(ws + WS_YB), (pb*)(ws + WS_MG), (const float*)(ws + WS_SSQB), RMS_EPS};
        pg8::gemm_phase<pg8::EpiGateMerge, pg8::StaticOrder, true, true>(F.lds + RING_OFF, g, S, E, F.wave); } SEAM(9);
    if (IN(10)) { pg8::Gemm g{(const pb*)(ws + WS_MG), (const pb*)(ws + WS_WOUT), M, D, D}; pg8::StaticOrder S; S.init(M, D, F.G, (int)blockIdx.x);
        pg8::EpiResid E{F.out, F.out, (pb*)(ws + WS_XB), (float*)(ws + WS_SSQA), 1.0f};
        pg8::gemm_phase<pg8::EpiResid, pg8::StaticOrder, true, true>(F.lds + RING_OFF, g, S, E, F.wave); } SEAM(10);
    if (IN(11)) { pg8::Gemm g{(const pb*)(ws + WS_XB), (const pb*)(ws + WS_WGU2), M, 2 * FF, D}; pg8::StaticOrder S; S.init(M, 2 * FF, F.G, (int)blockIdx.x);
        pg8::EpiSwiGLU E{(pb*)(ws + WS_H), FF, (const float*)(ws + WS_SSQA), RMS_EPS};
        pg8::gemm_phase<pg8::EpiSwiGLU, pg8::StaticOrder, true, true>(F.lds + RING_OFF, g, S, E, F.wave); } SEAM(11);
    if (IN(12)) { pg8::Gemm g{(const pb*)(ws + WS_H), (const pb*)(ws + WS_WD2), M, D, FF}; pg8::StaticOrder S; S.init(M, D, F.G, (int)blockIdx.x);
        pg8::EpiResid E{F.out, F.out, (pb*)(ws + WS_XB), (float*)(ws + WS_SSQB), 0.5f};
        pg8::gemm_phase<pg8::EpiResid, pg8::StaticOrder, true, true>(F.lds + RING_OFF, g, S, E, F.wave); } SEAM(12);
    if (IN(13)) { final_norm_rows(F); } STAMP(14);
    if (PROBE_A >= 0) {
        xcd_barrier(bar);
        if (blockIdx.x == 0 && F.wave == 0) { volatile unsigned long long* ts = (volatile unsigned long long*)(args.ws + WS_CTL + 32768); const int l = lane_id();
            const float da = (float)(ts[PROBE_A + 1] - ts[PROBE_A]) * 0.01f, db = (float)(ts[PROBE_B + 1] - ts[PROBE_B]) * 0.01f;
            for (int i = l; i < 16384; i += 64) F.out[(size_t)i * 1024 + 512] = db;
            if (l == 0) F.out[0] = da; }
    }
#undef IN
#undef SEAM
}

#ifndef MK_N_LAUNCHES
#define MK_N_LAUNCHES 1
#endif
extern "C" void kernel_launch(void* const* d_in, const int* in_sizes, int n_in, void* d_out, int out_size, void* d_ws, size_t ws_size, hipStream_t stream) {
    static int grid = 0;
    if (grid == 0) {
        if (n_in != 24 || in_sizes[0] != M * D || out_size != M * D || ws_size < WS_END) { fprintf(stderr, "kernel_launch: unexpected shapes (n_in %d, in0 %d, out %d, ws %zu)\n", n_in, n_in > 0 ? in_sizes[0] : -1, out_size, ws_size); grid = -1; return; }
        int dev = 0, cus = 0, per_cu = 0;
        if (hipGetDevice(&dev) != hipSuccess || hipDeviceGetAttribute(&cus, hipDeviceAttributeMultiprocessorCount, dev) != hipSuccess) { grid = -1; return; }
        if (hipFuncSetAttribute((const void*)mk_fwd, hipFuncAttributeMaxDynamicSharedMemorySize, LDS_BYTES) != hipSuccess) { fprintf(stderr, "kernel_launch: hipFuncSetAttribute failed\n"); grid = -1; return; }
        if (hipOccupancyMaxActiveBlocksPerMultiprocessor(&per_cu, (const void*)mk_fwd, NWAVES * 64, LDS_BYTES) != hipSuccess || per_cu < 1) { fprintf(stderr, "kernel_launch: occupancy query says %d\n", per_cu); per_cu = 1; }
        (void)hipGetLastError();
        grid = cus;
    }
    if (grid < 0) return;
    if (hipMemsetAsync((char*)d_ws + WS_CTL, 0, CTL_ZERO_BYTES, stream) != hipSuccess) { fprintf(stderr, "kernel_launch: hipMemsetAsync failed\n"); return; }
    Args a{};
    for (int i = 0; i < 24; ++i) a.in[i] = (const float*)d_in[i];
    a.out = (float*)d_out; a.ws = (unsigned char*)d_ws;
#if MK_N_LAUNCHES == 1
    a.ph_lo = 0; a.ph_hi = N_PHASES;
    void* kargs[] = {&a};
    hipError_t e = hipLaunchCooperativeKernel((const void*)mk_fwd, dim3(grid), dim3(NWAVES * 64), kargs, LDS_BYTES, stream);
    if (e != hipSuccess) fprintf(stderr, "kernel_launch: cooperative launch failed: %s (grid %d)\n", hipGetErrorString(e), grid);
#else
    for (int p = 0; p < N_PHASES; ++p) { a.ph_lo = p; a.ph_hi = p + 1; hipLaunchKernelGGL(mk_fwd, dim3(grid), dim3(NWAVES * 64), LDS_BYTES, stream, a); }
#endif
}
```

```cpp
#include <hip/hip_runtime.h>
#include <hip/hip_cooperative_groups.h>
#include <cstdio>
#include <cstdint>
namespace cg = cooperative_groups;
__device__ __forceinline__ int lane_id() { int l = (int)__builtin_amdgcn_mbcnt_hi(~0u, __builtin_amdgcn_mbcnt_lo(~0u, 0u)); asm volatile("" : "+v"(l)); return l; }
namespace pg8 {
#define PG8_LAS __attribute__((address_space(3)))
typedef unsigned short bf16_t;
typedef short bf16x8 __attribute__((ext_vector_type(8)));
typedef float f32x4 __attribute__((ext_vector_type(4)));
typedef unsigned u32x4 __attribute__((ext_vector_type(4)));
constexpr int BM = 256, BK = 64, HALF = 128, HTB = HALF * BK * 2  , STAGE_BYTES = 8 * HTB, NXCD = 8, WGM = 8;

__host__ __device__ __forceinline__ int lds_byte(int r, int c) { const int st = (r >> 4) * 2 + (c >> 5), rr = r & 15, cc = c & 31, ob = rr * 64 + cc * 2; return st * 1024 + (ob ^ (((ob >> 9) & 1) << 5)); }
__host__ __device__ __forceinline__ void stage_rc(int b, int& R, int& C) { const int st = b / 1024, sb = b % 1024, swz = sb ^ (((sb >> 9) & 1) << 5); R = (st >> 1) * 16 + swz / 64; C = (st & 1) * 32 + (swz % 64) / 2; }
__host__ __device__ __forceinline__ int perm32(int rho) { const int n = rho >> 4, i = rho & 15; return 8 * (i >> 2) + 4 * n + (i & 3); }

struct Unit { int pm, pn; };
struct Gemm { const bf16_t* A; const bf16_t* Bt; int M, N, K; };

struct StaticOrder {
    int nM, nN, nwg, G, c;
    __host__ __device__ void init(int M, int N, int G_, int c_) { nM = M / BM; nN = N / BM; nwg = nM * nN; G = G_; c = c_; }
    __host__ __device__ bool next(int i, Unit& u) const {
        const long L = (long)i * G + c; if (L >= nwg) return false;
        int wgid = (int)L; { const int q = nwg / NXCD, r = nwg % NXCD, xcd = wgid % NXCD, off = wgid / NXCD; wgid = (xcd < r ? xcd * (q + 1) : r * (q + 1) + (xcd - r) * q) + off; }
        const int nig = WGM * nN, gid = wgid / nig, fm = gid * WGM, gsz = (nM - fm) < WGM ? (nM - fm) : WGM;
        u.pm = fm + ((wgid % nig) % gsz); u.pn = (wgid % nig) / gsz; return true;
    }
    __device__ __forceinline__ void a_ready(const Unit&) const {}
    __device__ __forceinline__ void done(const Unit&) const {}
};

__device__ __forceinline__ unsigned cvt_pk_bf16(float lo, float hi) { unsigned r; asm volatile("v_cvt_pk_bf16_f32 %0, %1, %2" : "=v"(r) : "v"(lo), "v"(hi)); return r; }
__device__ __forceinline__ float fast_sigmoid(float v) { return __builtin_amdgcn_rcpf(1.0f + __builtin_amdgcn_exp2f(-1.4426950408889634f * v)); }
__device__ __forceinline__ float fast_silu(float v) { return v * fast_sigmoid(v); }
__device__ __forceinline__ void load_rs(float (&rs)[2][4], const float* ssq, int row0, float eps) {
#pragma unroll
    for (int ai = 0; ai < 2; ++ai)
#pragma unroll
        for (int m = 0; m < 4; ++m) { const f32x4* p = (const f32x4*)(ssq + (size_t)(row0 + ai * HALF + m * 16) * 16); const f32x4 a = p[0], b = p[1], c = p[2], d = p[3];
            const float s = ((a[0] + a[1]) + (a[2] + a[3])) + ((b[0] + b[1]) + (b[2] + b[3])) + ((c[0] + c[1]) + (c[2] + c[3])) + ((d[0] + d[1]) + (d[2] + d[3]));
            rs[ai][m] = 1.0f / sqrtf(s * (1.0f / 1024.0f) + eps); }
}
struct EpiSwiGLU {
    static constexpr bool PERM = true, AFTER_DRAIN = false;
    bf16_t* H; int ldh; const float* ssq; float eps;
    __device__ __forceinline__ void operator()(const f32x4 (&acc)[2][2][4][2], const Unit& u, int wr, int wc, int fr, int fq) const {
        const int row0 = u.pm * BM + wr * 64 + fr, col0 = u.pn * HALF + wc * 32 + 8 * fq;
        float rs[2][4]; load_rs(rs, ssq, row0, eps);
#pragma unroll
        for (int ai = 0; ai < 2; ++ai)
#pragma unroll
            for (int m = 0; m < 4; ++m) { bf16_t* rowp = H + (size_t)(row0 + ai * HALF + m * 16) * ldh + col0; const float s = rs[ai][m];
                float h[8];
#pragma unroll
                for (int n = 0; n < 2; ++n)
#pragma unroll
                    for (int j = 0; j < 4; ++j) h[n * 4 + j] = fast_silu(acc[ai][0][m][n][j] * s) * (acc[ai][1][m][n][j] * s);
                u32x4 w; w.x = cvt_pk_bf16(h[0], h[1]); w.y = cvt_pk_bf16(h[2], h[3]); w.z = cvt_pk_bf16(h[4], h[5]); w.w = cvt_pk_bf16(h[6], h[7]);
                *(u32x4*)rowp = w; }
    }
};
struct EpiResid {
    static constexpr bool PERM = false, AFTER_DRAIN = false;
    const float* base; float* out; bf16_t* xb; float* ssq_out; float scale;
    __device__ __forceinline__ void operator()(const f32x4 (&acc)[2][2][4][2], const Unit& u, int wr, int wc, int fr, int fq) const {
        typedef unsigned u32x2v __attribute__((ext_vector_type(2)));
        const int row0 = u.pm * BM + wr * 64 + fr, col0 = u.pn * BM + wc * 32 + 4 * fq;
#pragma unroll
        for (int ai = 0; ai < 2; ++ai)
#pragma unroll
            for (int m = 0; m < 4; ++m) { const int row = row0 + ai * HALF + m * 16; const size_t off = (size_t)row * 1024 + col0; float ss = 0.f;
#pragma unroll
                for (int bj = 0; bj < 2; ++bj)
#pragma unroll
                    for (int n = 0; n < 2; ++n) { const f32x4 bs = *(const f32x4*)(base + off + bj * HALF + n * 16); const f32x4 o = bs + acc[ai][bj][m][n] * scale;
                        *(f32x4*)(out + off + bj * HALF + n * 16) = o; ss += (o[0] * o[0] + o[1] * o[1]) + (o[2] * o[2] + o[3] * o[3]);
                        u32x2v w; w.x = cvt_pk_bf16(o[0], o[1]); w.y = cvt_pk_bf16(o[2], o[3]); *(u32x2v*)(xb + off + bj * HALF + n * 16) = w; }
                ss += __shfl_xor(ss, 16); ss += __shfl_xor(ss, 32);
                if (fq == 0) ssq_out[(size_t)row * 16 + u.pn * 4 + wc] = ss; }
    }
};
struct EpiStoreBf16 {
    static constexpr bool PERM = true, AFTER_DRAIN = false;
    bf16_t* O; int ldc;
    __device__ __forceinline__ void operator()(const f32x4 (&acc)[2][2][4][2], const Unit& u, int wr, int wc, int fr, int fq) const {
        const int row0 = u.pm * BM + wr * 64 + fr, col0 = u.pn * BM + wc * 32 + 8 * fq;
#pragma unroll
        for (int ai = 0; ai < 2; ++ai)
#pragma unroll
            for (int m = 0; m < 4; ++m) { bf16_t* rowp = O + (size_t)(row0 + ai * HALF + m * 16) * ldc + col0;
#pragma unroll
                for (int bj = 0; bj < 2; ++bj) { const f32x4 v0 = acc[ai][bj][m][0], v1 = acc[ai][bj][m][1];
                    u32x4 w; w.x = cvt_pk_bf16(v0[0], v0[1]); w.y = cvt_pk_bf16(v0[2], v0[3]); w.z = cvt_pk_bf16(v1[0], v1[1]); w.w = cvt_pk_bf16(v1[2], v1[3]);
                    *(u32x4*)(rowp + bj * HALF) = w; } }
    }
};
struct EpiWin {
    static constexpr bool PERM = true, AFTER_DRAIN = false;
    bf16_t *PRE, *Z, *QO, *KD, *VD; float* AB; const float* ssq; float eps, qscale;
    __device__ __forceinline__ void operator()(const f32x4 (&acc)[2][2][4][2], const Unit& u, int wr, int wc, int fr, int fq) const {
        const int row0 = u.pm * BM + wr * 64 + fr, cl0 = wc * 32 + 8 * fq, pn = u.pn;
        float rs[2][4]; load_rs(rs, ssq, row0, eps);
        if (pn == 14) {
            if (wc == 0 && fq < 2) {
#pragma unroll
                for (int ai = 0; ai < 2; ++ai)
#pragma unroll
                    for (int m = 0; m < 4; ++m) { float* rowp = AB + (size_t)(row0 + ai * HALF + m * 16) * 16 + 8 * fq; const float s = rs[ai][m];
                        *(f32x4*)rowp = acc[ai][0][m][0] * s; *(f32x4*)(rowp + 4) = acc[ai][0][m][1] * s; }
            }
            return;
        }
        bf16_t* base; int ld, cb; float sc = 1.f; bool dup = false;
        if (pn < 6) { base = PRE; ld = 1536; cb = pn * 256; }
        else if (pn < 8) { base = Z; ld = 512; cb = (pn - 6) * 256; }
        else if (pn < 10) { base = QO; ld = 1024; cb = (pn - 8) * 256; sc = qscale; dup = true; }
        else if (pn < 12) { base = KD; ld = 512; cb = (pn - 10) * 256; }
        else { base = VD; ld = 512; cb = (pn - 12) * 256; }
#pragma unroll
        for (int ai = 0; ai < 2; ++ai)
#pragma unroll
            for (int m = 0; m < 4; ++m) { const float s = rs[ai][m] * sc; bf16_t* rowp = base + (size_t)(row0 + ai * HALF + m * 16) * ld;
#pragma unroll
                for (int bj = 0; bj < 2; ++bj) { const f32x4 v0 = acc[ai][bj][m][0] * s, v1 = acc[ai][bj][m][1] * s;
                    u32x4 w; w.x = cvt_pk_bf16(v0[0], v0[1]); w.y = cvt_pk_bf16(v0[2], v0[3]); w.z = cvt_pk_bf16(v1[0], v1[1]); w.w = cvt_pk_bf16(v1[2], v1[3]);
                    const int c = cb + bj * HALF + cl0;
                    if (dup) { const int qc = ((c >> 6) * 2) * 64 + (c & 63); *(u32x4*)(rowp + qc) = w; *(u32x4*)(rowp + qc + 64) = w; }
                    else *(u32x4*)(rowp + c) = w; } }
    }
};
struct EpiGateMerge {
    static constexpr bool PERM = true, AFTER_DRAIN = false;
    const bf16_t *YA, *YB; bf16_t* MG; const float* ssq; float eps;
    __device__ __forceinline__ void operator()(const f32x4 (&acc)[2][2][4][2], const Unit& u, int wr, int wc, int fr, int fq) const {
        const int row0 = u.pm * BM + wr * 64 + fr, col0 = u.pn * HALF + wc * 32 + 8 * fq;
        float rs[2][4]; load_rs(rs, ssq, row0, eps);
#pragma unroll
        for (int ai = 0; ai < 2; ++ai)
#pragma unroll
            for (int m = 0; m < 4; ++m) { const size_t off = (size_t)(row0 + ai * HALF + m * 16) * 1024 + col0; const float s = rs[ai][m];
                const u32x4 ya = *(const u32x4*)(YA + off), yb = *(const u32x4*)(YB + off);
                float o[8];
#pragma unroll
                for (int n = 0; n < 2; ++n)
#pragma unroll
                    for (int j = 0; j < 4; ++j) { const int e = n * 4 + j; const unsigned wa = ya[e >> 1], wb = yb[e >> 1];
                        const float fa = __uint_as_float((e & 1) ? (wa & 0xffff0000u) : (wa << 16)), fb = __uint_as_float((e & 1) ? (wb & 0xffff0000u) : (wb << 16));
                        o[e] = fast_sigmoid(acc[ai][0][m][n][j] * s) * fa + fast_sigmoid(acc[ai][1][m][n][j] * s) * fb; }
                u32x4 w; w.x = cvt_pk_bf16(o[0], o[1]); w.y = cvt_pk_bf16(o[2], o[3]); w.z = cvt_pk_bf16(o[4], o[5]); w.w = cvt_pk_bf16(o[6], o[7]);
                *(u32x4*)(MG + off) = w; }
    }
};

template <class Epi, class Sched, bool ALIGN_EPI = false, bool SP2 = false>
__device__ __forceinline__ void gemm_phase(PG8_LAS unsigned char* lds, const Gemm g, const Sched& S, const Epi& E, const int wave_id) {
    const int wid = wave_id, lane = lane_id(), tid = wid * 64 + lane, wr = wid >> 2, wc = wid & 3, fr = lane & 15, fq = lane >> 4;
    const int K = g.K, nt = K / BK;
    unsigned voffA[2], voffB[2];
#pragma unroll
    for (int i = 0; i < 2; ++i) { int R, C; stage_rc(tid * 16 + i * 8192, R, C); const int Rb = Epi::PERM ? ((R & ~31) + perm32(R & 31)) : R;
        voffA[i] = (unsigned)(R * K + C) * 2u; voffB[i] = (unsigned)(Rb * K + C) * 2u; }
    const size_t kstep = (size_t)(BK * 2);
    const size_t hstep = (size_t)HALF * K * 2;
    const size_t tstep = 2 * hstep;
    const unsigned ldsw = (unsigned)wid * 1024u;
    const int aoff = lds_byte(wr * 64 + fr, fq * 8), boff = lds_byte(wc * 32 + fr, fq * 8);
#define PG8_SA(b, h) (((b) * 2 + (h)) * HTB)
#define PG8_SB(b, h) ((4 + (b) * 2 + (h)) * HTB)
#define PG8_STAGE(bufoff, gbase, voff) do { _Pragma("unroll") for (int _i = 0; _i < 2; ++_i) \
        __builtin_amdgcn_global_load_lds((const unsigned*)((const char*)(gbase) + (voff)[_i]), (PG8_LAS unsigned*)(lds + (bufoff) + ldsw + _i * 8192), 16, 0, 0); } while (0)
#define PG8_LDA(dst, b, h) do { _Pragma("unroll") for (int m = 0; m < 4; ++m) _Pragma("unroll") for (int k = 0; k < 2; ++k) dst[m][k] = *(const PG8_LAS bf16x8*)(lds + PG8_SA(b, h) + aoff + m * 2048 + k * 1024); } while (0)
#define PG8_LDB(dst, b, h) do { _Pragma("unroll") for (int n = 0; n < 2; ++n) _Pragma("unroll") for (int k = 0; k < 2; ++k) dst[n][k] = *(const PG8_LAS bf16x8*)(lds + PG8_SB(b, h) + boff + n * 2048 + k * 1024); } while (0)
#define PG8_MMA(ai, bj, At, Bt) do { __builtin_amdgcn_s_setprio(1); _Pragma("unroll") for (int m = 0; m < 4; ++m) _Pragma("unroll") for (int n = 0; n < 2; ++n) _Pragma("unroll") for (int k = 0; k < 2; ++k) \
        acc[ai][bj][m][n] = __builtin_amdgcn_mfma_f32_16x16x32_bf16(Bt[n][k], At[m][k], acc[ai][bj][m][n], 0, 0, 0); __builtin_amdgcn_s_setprio(0); } while (0)
#define PG8_WAIT_V(n) asm volatile("s_waitcnt vmcnt(" #n ")" ::: "memory")
#define PG8_WAIT_L(n) asm volatile("s_waitcnt lgkmcnt(" #n ")" ::: "memory")
#define PG8_BAR __builtin_amdgcn_s_barrier()
#define PG8_SCHED __builtin_amdgcn_sched_barrier(0)
    Unit cur, nxt; int ui = 0;
    if (!S.next(0, cur)) return;
    f32x4 acc[2][2][4][2];
#pragma unroll
    for (int a = 0; a < 2; ++a)
#pragma unroll
        for (int b = 0; b < 2; ++b)
#pragma unroll
            for (int m = 0; m < 4; ++m)
#pragma unroll
                for (int n = 0; n < 2; ++n) acc[a][b][m][n] = (f32x4){0.f, 0.f, 0.f, 0.f};
    bf16x8 At[4][2], B0[2][2], B1[2][2];
    const char* cA = (const char*)g.A + (size_t)cur.pm * tstep; const char* cB = (const char*)g.Bt + (size_t)cur.pn * tstep;
    S.a_ready(cur);
    if constexpr (SP2) {
        PG8_STAGE(PG8_SB(0, 0), cB, voffB); PG8_STAGE(PG8_SB(0, 1), cB + hstep, voffB); PG8_STAGE(PG8_SA(0, 0), cA, voffA); PG8_STAGE(PG8_SA(0, 1), cA + hstep, voffA);
        if (wr == 1) PG8_BAR;
        PG8_WAIT_V(2); PG8_BAR;
        PG8_STAGE(PG8_SB(1, 0), cB + kstep, voffB); PG8_STAGE(PG8_SA(1, 0), cA + kstep, voffA); PG8_STAGE(PG8_SB(1, 1), cB + hstep + kstep, voffB);
        PG8_WAIT_V(6); PG8_BAR;
    } else {
        PG8_STAGE(PG8_SB(0, 0), cB, voffB); PG8_STAGE(PG8_SA(0, 0), cA, voffA); PG8_STAGE(PG8_SB(0, 1), cB + hstep, voffB); PG8_STAGE(PG8_SA(0, 1), cA + hstep, voffA);
        if (wr == 1) PG8_BAR;
        PG8_WAIT_V(4); PG8_BAR;
        PG8_STAGE(PG8_SB(1, 0), cB + kstep, voffB); PG8_STAGE(PG8_SA(1, 0), cA + kstep, voffA); PG8_STAGE(PG8_SB(1, 1), cB + hstep + kstep, voffB);
        PG8_WAIT_V(6); PG8_BAR;
    }
    for (;;) {
        const bool has_next = S.next(ui + 1, nxt);
        const char* nA = has_next ? (const char*)g.A + (size_t)nxt.pm * tstep : cA; const char* nB = has_next ? (const char*)g.Bt + (size_t)nxt.pn * tstep : cB;
        for (int t = 0; t < nt; t += 2) {
            const bool last = (t == nt - 2);
            const char* a1 = cA + (size_t)(t + 1) * kstep;
            const char* a2 = last ? nA : cA + (size_t)(t + 2) * kstep; const char* b2 = last ? nB : cB + (size_t)(t + 2) * kstep;
            const char* a3 = a2 + kstep; const char* b3 = b2 + kstep;
            if (last && has_next) S.a_ready(nxt);
            if constexpr (SP2) {
            PG8_LDB(B0, 0, 0); PG8_LDB(B1, 0, 1); PG8_SCHED; PG8_LDA(At, 0, 0); PG8_STAGE(PG8_SA(1, 1), a1 + hstep, voffA);
            PG8_WAIT_V(8); PG8_WAIT_L(0); PG8_BAR; PG8_MMA(0, 0, At, B0); PG8_MMA(0, 1, At, B1); PG8_BAR; PG8_SCHED;
            PG8_LDA(At, 0, 1); PG8_STAGE(PG8_SB(0, 0), b2, voffB); PG8_STAGE(PG8_SB(0, 1), b2 + hstep, voffB); PG8_STAGE(PG8_SA(0, 0), a2, voffA);
            PG8_WAIT_V(8); PG8_WAIT_L(0); PG8_BAR; PG8_MMA(1, 0, At, B0); PG8_MMA(1, 1, At, B1); PG8_BAR; PG8_SCHED;
            PG8_LDB(B0, 1, 0); PG8_LDB(B1, 1, 1); PG8_SCHED; PG8_LDA(At, 1, 0); PG8_STAGE(PG8_SA(0, 1), a2 + hstep, voffA);
            PG8_WAIT_V(8); PG8_WAIT_L(0); PG8_BAR; PG8_MMA(0, 0, At, B0); PG8_MMA(0, 1, At, B1); PG8_BAR; PG8_SCHED;
            PG8_LDA(At, 1, 1); PG8_STAGE(PG8_SB(1, 0), b3, voffB); PG8_STAGE(PG8_SB(1, 1), b3 + hstep, voffB); PG8_STAGE(PG8_SA(1, 0), a3, voffA);
            PG8_WAIT_V(8); PG8_WAIT_L(0); PG8_BAR; PG8_MMA(1, 0, At, B0); PG8_MMA(1, 1, At, B1); PG8_BAR; PG8_SCHED;
            } else {
            PG8_LDB(B0, 0, 0); PG8_SCHED; PG8_LDA(At, 0, 0); PG8_STAGE(PG8_SA(1, 1), a1 + hstep, voffA);
            PG8_WAIT_L(8); PG8_BAR; PG8_WAIT_L(0); PG8_MMA(0, 0, At, B0); PG8_BAR; PG8_SCHED;
            PG8_LDB(B1, 0, 1); PG8_STAGE(PG8_SB(0, 0), b2, voffB);
            PG8_BAR; PG8_WAIT_L(0); PG8_MMA(0, 1, At, B1); PG8_BAR;
            PG8_LDA(At, 0, 1); PG8_STAGE(PG8_SA(0, 0), a2, voffA);
            PG8_BAR; PG8_WAIT_L(0); PG8_MMA(1, 0, At, B0); PG8_BAR; PG8_SCHED;
            PG8_STAGE(PG8_SB(0, 1), b2 + hstep, voffB);
            PG8_WAIT_V(6); PG8_BAR; PG8_MMA(1, 1, At, B1); PG8_BAR;
            PG8_LDB(B0, 1, 0); PG8_SCHED; PG8_LDA(At, 1, 0); PG8_STAGE(PG8_SA(0, 1), a2 + hstep, voffA);
            PG8_WAIT_L(8); PG8_BAR; PG8_WAIT_L(0); PG8_MMA(0, 0, At, B0); PG8_BAR; PG8_SCHED;
            PG8_LDB(B1, 1, 1); PG8_STAGE(PG8_SB(1, 0), b3, voffB);
            PG8_BAR; PG8_WAIT_L(0); PG8_MMA(0, 1, At, B1); PG8_BAR;
            PG8_LDA(At, 1, 1); PG8_STAGE(PG8_SA(1, 0), a3, voffA);
            PG8_BAR; PG8_WAIT_L(0); PG8_MMA(1, 0, At, B0); PG8_BAR; PG8_SCHED;
            PG8_STAGE(PG8_SB(1, 1), b3 + hstep, voffB);
            PG8_WAIT_V(6); PG8_BAR; PG8_MMA(1, 1, At, B1); PG8_BAR;
            }
        }
        if constexpr (ALIGN_EPI) { if (wr == 0) PG8_BAR; }
        if constexpr (!Epi::AFTER_DRAIN) { E(acc, cur, wr, wc, fr, fq); S.done(cur); }
        if (!has_next) break;
#pragma unroll
        for (int a = 0; a < 2; ++a)
#pragma unroll
            for (int b = 0; b < 2; ++b)
#pragma unroll
                for (int m = 0; m < 4; ++m)
#pragma unroll
                    for (int n = 0; n < 2; ++n) acc[a][b][m][n] = (f32x4){0.f, 0.f, 0.f, 0.f};
        cur = nxt; cA = nA; cB = nB; ++ui;
        if constexpr (ALIGN_EPI) { if (wr == 1) PG8_BAR; }
    }
    PG8_WAIT_V(0);
    if constexpr (!ALIGN_EPI) { if (wr == 0) PG8_BAR; }
    PG8_BAR;
    if constexpr (Epi::AFTER_DRAIN) { E.fused(acc, cur, wr, wc, fr, fq, lds, wid, lane); S.done(cur); }
#undef PG8_SA
#undef PG8_SB
#undef PG8_STAGE
#undef PG8_LDA
#undef PG8_LDB
#undef PG8_MMA
#undef PG8_WAIT_V
#undef PG8_WAIT_L
#undef PG8_BAR
#undef PG8_SCHED
}
}
#include <hip/hip_bf16.h>
#include <cmath>
namespace attn_body {
using bf16=__hip_bfloat16;
using bf16x8=__attribute__((ext_vector_type(8)))short;
using s16x4=__attribute__((ext_vector_type(4)))short;
using f32x16=__attribute__((ext_vector_type(16)))float;
using u32x4=__attribute__((ext_vector_type(4)))unsigned;
constexpr int BATCH=2,NHEAD=16,SEQ=8192,D=64,DM=NHEAD*D,KP=512;
constexpr int NW=8,QBLK=32,QB=QBLK*NW,KVBLK=64,NQB=SEQ/QB;
constexpr int ATTN_PITCH=DM, ATTN_UNIT_ROWS=QB;
__device__ __forceinline__ int crow(int r,int hi){return (r&3)+8*(r>>2)+4*hi;}
#define SBAR() __builtin_amdgcn_sched_barrier(0)
__device__ __forceinline__ void cmask(f32x16&p0,f32x16&p1,int jb,int qrel,int hi){
  const float NEG=-INFINITY; int lim=qrel-64*jb-4*hi; asm volatile("":"+v"(lim));
  #pragma unroll
  for(int r=0;r<16;++r){const int cr=(r&3)+8*(r>>2); if(cr>lim)p0[r]=NEG; if(cr+32>lim)p1[r]=NEG;}
}

constexpr int NSLOT=3, SLOTB=8192;
constexpr int LDS_K=0, LDS_V=NSLOT*SLOTB, LDS_WS=2*NSLOT*SLOTB, LDS_OST=LDS_WS+NW*64*4, LDS_BYTES=LDS_OST+NW*4096;
constexpr float C2=0.125f*1.4426950408889634f;
__device__ __forceinline__ void glds16(const void*gsrc,unsigned lds_dst){unsigned keep;
  asm volatile("s_mov_b32 %0, m0\n\ts_mov_b32 m0, %2\n\ts_nop 0\n\tglobal_load_lds_dwordx4 %1, off\n\ts_mov_b32 m0, %0":"=&s"(keep):"v"(gsrc),"s"(lds_dst):"memory");}
__device__ __forceinline__ float max3f(float a,float b,float c){float r;asm("v_max3_f32 %0, %1, %2, %3":"=v"(r):"v"(a),"v"(b),"v"(c));return r;}
__device__ __forceinline__ float max2f(float a,float b){float r;asm("v_max_f32_e32 %0, %1, %2":"=v"(r):"v"(a),"v"(b));return r;}
__device__ __forceinline__ float fadd_s(float a,float b){float r;asm("v_add_f32_e32 %0, %1, %2":"=v"(r):"v"(a),"v"(b));return r;}
__device__ __forceinline__ float fsub_s(float a,float b){float r;asm("v_sub_f32_e32 %0, %1, %2":"=v"(r):"v"(a),"v"(b));return r;}
typedef float f32x2_t __attribute__((ext_vector_type(2))); typedef __bf16 bf16x2_t __attribute__((ext_vector_type(2)));
__device__ __forceinline__ unsigned cvtpk_s(float lo,float hi){f32x2_t v={lo,hi};bf16x2_t b=__builtin_convertvector(v,bf16x2_t);return __builtin_bit_cast(unsigned,b);}
#define WAIT_BAR(N) asm volatile("s_waitcnt vmcnt(" #N ") lgkmcnt(0)\n\ts_barrier":::"memory")

__device__ __forceinline__ void qkt(f32x16&p0,f32x16&p1,const char*Kslot,const bf16x8*qr,const f32x16&negm,int r32,int hi){
  const char*kb=Kslot+hi*1024+r32*16;
  #pragma unroll
  for(int d0=0;d0<4;++d0){
    const bf16x8 b0=*reinterpret_cast<const bf16x8*>(kb+d0*2048);
    const bf16x8 b1=*reinterpret_cast<const bf16x8*>(kb+d0*2048+512);
    if(d0==0){p0=__builtin_amdgcn_mfma_f32_32x32x16_bf16(b0,qr[0],negm,0,0,0);p1=__builtin_amdgcn_mfma_f32_32x32x16_bf16(b1,qr[0],negm,0,0,0);}
    else{p0=__builtin_amdgcn_mfma_f32_32x32x16_bf16(b0,qr[d0],p0,0,0,0);p1=__builtin_amdgcn_mfma_f32_32x32x16_bf16(b1,qr[d0],p1,0,0,0);}}
}
typedef __attribute__((address_space(3))) const char* lds_cptr;
typedef short v4i16_t __attribute__((ext_vector_type(4)));
__device__ __forceinline__ void kload8(bf16x8*kf,lds_cptr kp){
  kf[0]=*(const __attribute__((address_space(3))) bf16x8*)(kp);      kf[1]=*(const __attribute__((address_space(3))) bf16x8*)(kp+512);
  kf[2]=*(const __attribute__((address_space(3))) bf16x8*)(kp+2048); kf[3]=*(const __attribute__((address_space(3))) bf16x8*)(kp+2560);
  kf[4]=*(const __attribute__((address_space(3))) bf16x8*)(kp+4096); kf[5]=*(const __attribute__((address_space(3))) bf16x8*)(kp+4608);
  kf[6]=*(const __attribute__((address_space(3))) bf16x8*)(kp+6144); kf[7]=*(const __attribute__((address_space(3))) bf16x8*)(kp+6656);
}
__device__ __forceinline__ void kload2(bf16x8*kf,lds_cptr kp,int j){ kf[2*j]=*(const __attribute__((address_space(3))) bf16x8*)(kp+j*2048); kf[2*j+1]=*(const __attribute__((address_space(3))) bf16x8*)(kp+j*2048+512); }
__device__ __forceinline__ s16x4 vtr(lds_cptr p){ return __builtin_bit_cast(s16x4,__builtin_amdgcn_ds_read_tr16_b64_v4i16((__attribute__((address_space(3))) v4i16_t*)p)); }
__device__ __forceinline__ float rowmax(const f32x16&p0,const f32x16&p1){
  float a=max3f(p0[0],p0[1],p1[0]),b=max3f(p0[2],p0[3],p1[1]);a=max3f(a,p1[2],p1[3]);
  #pragma unroll
  for(int r=4;r<16;r+=4){a=max3f(a,p0[r],p0[r+1]);b=max3f(b,p0[r+2],p0[r+3]);a=max3f(a,p1[r],p1[r+1]);b=max3f(b,p1[r+2],p1[r+3]);}
  const float m=max2f(a,b);
  auto rr=__builtin_amdgcn_permlane32_swap(__float_as_uint(m),__float_as_uint(m),false,false);
  return max2f(__uint_as_float(rr[0]),__uint_as_float(rr[1]));
}
__device__ __forceinline__ void pv(f32x16*o,int vb,bf16x8 pa0,bf16x8 pa1,bf16x8 pa2,bf16x8 pa3){
  #pragma unroll
  for(int d0=0;d0<2;++d0){s16x4 lo[4],hi[4];
    #pragma unroll
    for(int ks=0;ks<4;++ks){
      asm volatile("ds_read_b64_tr_b16 %0,%1 offset:%c2":"=&v"(lo[ks]):"v"(vb),"i"(d0*4096+ks*1024):"memory");
      asm volatile("ds_read_b64_tr_b16 %0,%1 offset:%c2":"=&v"(hi[ks]):"v"(vb),"i"(d0*4096+ks*1024+512):"memory");}
    asm volatile("s_waitcnt lgkmcnt(0)":::"memory");SBAR();
    #define PK(k) (bf16x8){lo[k][0],lo[k][1],lo[k][2],lo[k][3],hi[k][0],hi[k][1],hi[k][2],hi[k][3]}
    o[d0]=__builtin_amdgcn_mfma_f32_32x32x16_bf16(pa0,PK(0),o[d0],0,0,0);
    o[d0]=__builtin_amdgcn_mfma_f32_32x32x16_bf16(pa1,PK(1),o[d0],0,0,0);
    o[d0]=__builtin_amdgcn_mfma_f32_32x32x16_bf16(pa2,PK(2),o[d0],0,0,0);
    o[d0]=__builtin_amdgcn_mfma_f32_32x32x16_bf16(pa3,PK(3),o[d0],0,0,0);
    #undef PK
  }
}

#ifndef ATTN_STORE16
#define ATTN_STORE16(p,v) (*(u32x4*)(p)=(v))
#endif
template<int THRL> __device__ __forceinline__ void attn_unit(int b,int h,int qb,const bf16*Q,const bf16*__restrict__ K,const bf16*__restrict__ V,bf16*O,char*shm,const int wave_id,const unsigned*nmax){
  const int wid=wave_id,lane=lane_id(),tid=wid*64+lane,r32=lane&31,hi=lane>>5;
  const long rowbase=(long)b*SEQ; const int q0=qb*QB;
  const bf16*Qw=Q+(rowbase+q0+wid*QBLK)*DM+h*D;
  int t0=0;
  { const int j=b*8+(h>>1); const float q2=__uint_as_float(__builtin_amdgcn_readfirstlane((int)nmax[j])), k2=__uint_as_float(__builtin_amdgcn_readfirstlane((int)nmax[16+j]));
    const unsigned slb0_=0x3eb8aa3bu-((unsigned)__builtin_amdgcn_readfirstlane(h>>2)<<24);
    const float B2=2.0f*sqrtf(q2*k2)*1.0001f+34.7f, dmin=B2/__uint_as_float(slb0_);
    const float tf=floorf(((float)(q0+1)-dmin)*(1.0f/64.0f)); int tt=(tf>0.f)?(int)tf:0; tt&=~1; const int tmax=(q0+QB)/KVBLK-4; t0=tt<tmax?tt:tmax; t0=__builtin_amdgcn_readfirstlane(t0); }
  const bf16*Kh=K+(rowbase+(long)t0*KVBLK)*KP+(h>>1)*D,*Vh=V+(rowbase+(long)t0*KVBLK)*KP+(h>>2)*128+(h&1)*D;
  const unsigned lds0=(unsigned)(uintptr_t)shm;
  float*wsf=(float*)(shm+LDS_WS)+wid*64;
  const bf16*ksrc=Kh+(long)lane*KP+wid*8;
  const bf16*vsrc=Vh+(long)(16*(wid&3)+(lane>>2))*KP+(wid>>2)*32+(lane&3)*8;
  const unsigned kdst=lds0+LDS_K+wid*1024, vdst=lds0+LDS_V+wid*1024;
  #define DMA_K(t,slot) glds16(ksrc+(long)(t)*KVBLK*KP,(unsigned)__builtin_amdgcn_readfirstlane(kdst+(slot)))
  #define DMA_V(t,slot) glds16(vsrc+(long)(t)*KVBLK*KP,(unsigned)__builtin_amdgcn_readfirstlane(vdst+(slot)))
  const int vb0=(int)(lds0+LDS_V)+((lane>>4)&1)*32+(lane&3)*8+(4*hi+((lane&15)>>2))*64;
  const char*Kbase=shm+LDS_K; bf16x8 kf[8];
  const lds_cptr shm3=(lds_cptr)shm; const lds_cptr kp0=shm3+LDS_K+hi*1024+r32*16; const lds_cptr vp0=shm3+LDS_V+((lane>>4)&1)*32+(lane&3)*8+(4*hi+((lane&15)>>2))*64;
  const int NT=(q0+QB)/KVBLK-t0;
  DMA_K(0,0);DMA_V(0,0);DMA_K(1,SLOTB);
  bf16x8 qr[4];
  #pragma unroll
  for(int d0=0;d0<4;++d0)qr[d0]=*reinterpret_cast<const bf16x8*>(&Qw[(long)r32*DM+d0*16+hi*8]);
  float mhat=0.f,l_reg=0.f;f32x16 o[2];o[0]=f32x16{};o[1]=f32x16{};const f32x16 negm=f32x16{};
  const int qrel=wid*QBLK+r32;
  const unsigned slb_=0x3eb8aa3bu-((unsigned)__builtin_amdgcn_readfirstlane(h>>2)<<24); const float sl2=__uint_as_float(slb_);
  const float qposf=(float)(q0+qrel-4*hi-64*t0);
  const float s1_=sl2, s8_=__uint_as_float(slb_+(3u<<23)), s32_=__uint_as_float(slb_+(5u<<23));
  #define AADD(d,a,sv) asm volatile("v_add_f32_e32 %0, %1, %2":"=v"(d):"s"(sv),"v"(a))
  #define ALIBI(P0,P1,t) do{ float bq_=__builtin_fmaf(sl2,((float)(64*(t))-qposf),-mhat); \
    _Pragma("unroll") for(int q_=0;q_<4;++q_){ float b0_=bq_,b1_,b2_,b3_,c_; AADD(b1_,b0_,s1_); AADD(b2_,b1_,s1_); AADD(b3_,b2_,s1_); \
      P0[4*q_]+=b0_; P0[4*q_+1]+=b1_; P0[4*q_+2]+=b2_; P0[4*q_+3]+=b3_; \
      AADD(c_,b0_,s32_); P1[4*q_]+=c_; AADD(c_,b1_,s32_); P1[4*q_+1]+=c_; AADD(c_,b2_,s32_); P1[4*q_+2]+=c_; AADD(c_,b3_,s32_); P1[4*q_+3]+=c_; \
      if(q_<3){ AADD(bq_,b0_,s8_); } } }while(0)
  #define CMASK(P0,P1,t) do{int jb_=(t)-(NT-4); if(jb_>=0)cmask(P0,P1,jb_,qrel,hi);}while(0)
  bool resc=false;
  #define START(P0,P1) do{ const float rm=rowmax(P0,P1); resc=false; \
    { const float dl=rm; mhat=fadd_s(mhat,dl); \
      _Pragma("unroll") for(int r=0;r<16;++r){P0[r]=fsub_s(P0[r],dl);P1[r]=fsub_s(P1[r],dl);} \
      } \
    _Pragma("unroll") for(int r=0;r<16;++r)P0[r]=__builtin_amdgcn_exp2f(P0[r]); }while(0)
  #define RESC() do{ if(resc){ asm volatile("s_waitcnt lgkmcnt(0)":::"memory"); \
      _Pragma("unroll") for(int d_=0;d_<2;++d_) _Pragma("unroll") for(int r=0;r<16;++r)o[d_][r]*=wsf[crow(r,hi)]; } }while(0)
  f32x16 pA0,pA1,pB0,pB1;
  int sl_prev=0,sl_cur=0,sl_next=SLOTB;
  #define ROT() do{sl_prev=sl_cur;sl_cur=sl_next;sl_next=(sl_next==(NSLOT-1)*SLOTB)?0:sl_next+SLOTB;}while(0)
  DMA_K(2,2*SLOTB);
  WAIT_BAR(3);
  qkt(pA0,pA1,Kbase,qr,negm,r32,hi);asm volatile("s_nop 15\n\ts_nop 7":"+v"(pA0),"+v"(pA1));ALIBI(pA0,pA1,0);CMASK(pA0,pA1,0);
  START(pA0,pA1);
  _Pragma("unroll") for(int r=0;r<16;++r)pA1[r]=__builtin_amdgcn_exp2f(pA1[r]);
  WAIT_BAR(0);
  DMA_K(3,0);DMA_V(1,SLOTB);
  ROT();
  kload8(kf,kp0+sl_cur);
  WAIT_BAR(2);
  s16x4 vlo[8],vhi[8]; u32x4 pw0,pw1,pw2,pw3;
  #define PKW(P,B) cvtpk_s(P[B],P[B+1])
  #define PAF(k) __builtin_bit_cast(bf16x8,pw##k)
  #define VFR(i) (bf16x8){vlo[i][0],vlo[i][1],vlo[i][2],vlo[i][3],vhi[i][0],vhi[i][1],vhi[i][2],vhi[i][3]}
  #define PIN(x) asm volatile("":"+v"(x))
  #define MX3(a,b,c) __builtin_fmaxf(__builtin_fmaxf((a),(b)),(c))
  #define GAPA(MF,A0,A1,A2,A3,W0,W1,PW) do{ MF; sacc+=A0; sacc+=A1; sacc+=A2; sacc+=A3; PIN(sacc); W0; W1; PIN(PW); SBAR(); }while(0)
  #define EX(v) __builtin_amdgcn_exp2f(v)
  #define GAPB(MF,X,B) do{ MF; X[B]=EX(X[B]); X[B+1]=EX(X[B+1]); X[B+2]=EX(X[B+2]); X[B+3]=EX(X[B+3]); PIN(X); SBAR(); }while(0)
  #define VRD(i) do{ vlo[i]=vtr(vp_+(((i)>>2)*4096+((i)&3)*1024)); vhi[i]=vtr(vp_+(((i)>>2)*4096+((i)&3)*1024+512)); }while(0)
  #define KRD(G,j) do{ if(G){ kload2(kf,kp0+sl_next,j); SBAR(); } }while(0)
  #define STEP(C0,C1,P0,P1,t,GK,GV,GL) do{ SBAR(); \
    const lds_cptr vp_=vp0+sl_prev; \
    VRD(0); SBAR(); float sacc=(P0[0]+P0[1]); \
    GAPA(C0=__builtin_amdgcn_mfma_f32_32x32x16_bf16(kf[0],qr[0],negm,0,0,0), P0[2],P0[3],P0[4],P0[5],     pw0[0]=PKW(P0,0), pw0[1]=PKW(P0,2), pw0); \
    VRD(4); SBAR(); GAPA(C1=__builtin_amdgcn_mfma_f32_32x32x16_bf16(kf[1],qr[0],negm,0,0,0), P0[6],P0[7],P0[8],P0[9],     pw0[2]=PKW(P0,4), pw0[3]=PKW(P0,6), pw0); \
    VRD(1); SBAR(); GAPA(C0=__builtin_amdgcn_mfma_f32_32x32x16_bf16(kf[2],qr[1],C0,0,0,0),   P0[10],P0[11],P0[12],P0[13], pw1[0]=PKW(P0,8), pw1[1]=PKW(P0,10), pw1); \
    VRD(5); SBAR(); GAPA(C1=__builtin_amdgcn_mfma_f32_32x32x16_bf16(kf[3],qr[1],C1,0,0,0),   P0[14],P0[15],P1[0],P1[1],   pw1[2]=PKW(P0,12),pw1[3]=PKW(P0,14), pw1); \
    VRD(2); SBAR(); GAPA(C0=__builtin_amdgcn_mfma_f32_32x32x16_bf16(kf[4],qr[2],C0,0,0,0),   P1[2],P1[3],P1[4],P1[5],     pw2[0]=PKW(P1,0), pw2[1]=PKW(P1,2), pw2); \
    VRD(6); SBAR(); GAPA(C1=__builtin_amdgcn_mfma_f32_32x32x16_bf16(kf[5],qr[2],C1,0,0,0),   P1[6],P1[7],P1[8],P1[9],     pw2[2]=PKW(P1,4), pw2[3]=PKW(P1,6), pw2); \
    VRD(3); SBAR(); GAPA(C0=__builtin_amdgcn_mfma_f32_32x32x16_bf16(kf[6],qr[3],C0,0,0,0),   P1[10],P1[11],P1[12],P1[13], pw3[0]=PKW(P1,8), pw3[1]=PKW(P1,10), pw3); \
    VRD(7); SBAR(); GAPA(C1=__builtin_amdgcn_mfma_f32_32x32x16_bf16(kf[7],qr[3],C1,0,0,0),   P1[14],P1[15],0.f,0.f,       pw3[2]=PKW(P1,12),pw3[3]=PKW(P1,14), pw3); \
    l_reg+=sacc; \
    if(GK){DMA_K((t)+3,sl_cur);} if(GV){DMA_V((t)+1,sl_next);} \
    ALIBI(C0,C1,t); CMASK(C0,C1,t); \
    { float a=MX3(C0[0],C0[1],C1[0]),b=MX3(C0[2],C0[3],C1[1]); a=MX3(a,C1[2],C1[3]); \
      _Pragma("unroll") for(int r=4;r<16;r+=4){a=MX3(a,C0[r],C0[r+1]);b=MX3(b,C0[r+2],C0[r+3]);a=MX3(a,C1[r],C1[r+1]);b=MX3(b,C1[r+2],C1[r+3]);} \
      float rm=__builtin_fmaxf(a,b); { auto rr=__builtin_amdgcn_permlane32_swap(__float_as_uint(rm),__float_as_uint(rm),false,false); rm=__builtin_fmaxf(__uint_as_float(rr[0]),__uint_as_float(rr[1])); } \
      resc=false; \
      if(__builtin_expect(__any(rm>(float)THRL),0)){ const float dl=__builtin_fmaxf(rm,0.f); mhat+=dl; \
        _Pragma("unroll") for(int r=0;r<16;++r){C0[r]-=dl;C1[r]-=dl;} \
        const float f=__builtin_amdgcn_exp2f(-dl); l_reg*=f; if(hi==0)wsf[r32]=f; resc=true; } } \
    SBAR(); \
    GAPB(o[0]=__builtin_amdgcn_mfma_f32_32x32x16_bf16(PAF(0),VFR(0),o[0],0,0,0), C0,0); \
    GAPB(o[1]=__builtin_amdgcn_mfma_f32_32x32x16_bf16(PAF(0),VFR(4),o[1],0,0,0), C0,4); \
    KRD(GL,0); GAPB(o[0]=__builtin_amdgcn_mfma_f32_32x32x16_bf16(PAF(1),VFR(1),o[0],0,0,0), C0,8); \
    KRD(GL,1); GAPB(o[1]=__builtin_amdgcn_mfma_f32_32x32x16_bf16(PAF(1),VFR(5),o[1],0,0,0), C0,12); \
    KRD(GL,2); GAPB(o[0]=__builtin_amdgcn_mfma_f32_32x32x16_bf16(PAF(2),VFR(2),o[0],0,0,0), C1,0); \
    KRD(GL,3); GAPB(o[1]=__builtin_amdgcn_mfma_f32_32x32x16_bf16(PAF(2),VFR(6),o[1],0,0,0), C1,4); \
    GAPB(o[0]=__builtin_amdgcn_mfma_f32_32x32x16_bf16(PAF(3),VFR(3),o[0],0,0,0), C1,8); \
    GAPB(o[1]=__builtin_amdgcn_mfma_f32_32x32x16_bf16(PAF(3),VFR(7),o[1],0,0,0), C1,12); \
    }while(0)
  int t=1;
  #undef CMASK
  #define CMASK(P0,P1,t) do{}while(0)
  for(;t+5<NT;t+=2){
    STEP(pB0,pB1,pA0,pA1,t,true,true,true);     WAIT_BAR(2); RESC(); ROT();
    STEP(pA0,pA1,pB0,pB1,t+1,true,true,true);   WAIT_BAR(2); RESC(); ROT();
  }
  #undef CMASK
  #define CMASK(P0,P1,t) do{int jb_=(t)-(NT-4); if(jb_>=0)cmask(P0,P1,jb_,qrel,hi);}while(0)
  #define ENDW(tt) do{ if((tt)+3<NT){WAIT_BAR(2);} else if((tt)+2<NT){WAIT_BAR(1);} else {WAIT_BAR(0);} }while(0)
  for(;t+1<NT;t+=2){
    STEP(pB0,pB1,pA0,pA1,t,(t+3<NT),(t+1<NT),(t+1<NT));       ENDW(t);   RESC(); ROT();
    STEP(pA0,pA1,pB0,pB1,t+1,(t+4<NT),(t+2<NT),(t+2<NT));     ENDW(t+1); RESC(); ROT();
  }
  STEP(pB0,pB1,pA0,pA1,NT-1,false,false,false); RESC();
  { float sacc=pB0[0]+pB0[1]; _Pragma("unroll") for(int r=2;r<16;++r)sacc+=pB0[r]; _Pragma("unroll") for(int r=0;r<16;++r)sacc+=pB1[r]; l_reg+=sacc;
    pw0=(u32x4){PKW(pB0,0),PKW(pB0,2),PKW(pB0,4),PKW(pB0,6)};pw1=(u32x4){PKW(pB0,8),PKW(pB0,10),PKW(pB0,12),PKW(pB0,14)};pw2=(u32x4){PKW(pB1,0),PKW(pB1,2),PKW(pB1,4),PKW(pB1,6)};pw3=(u32x4){PKW(pB1,8),PKW(pB1,10),PKW(pB1,12),PKW(pB1,14)};
    SBAR(); pv(o,vb0+sl_cur,PAF(0),PAF(1),PAF(2),PAF(3)); }
  #undef PKW
  #undef PAF
  #undef VFR
  #undef PIN
  #undef MX3
  #undef GAPA
  #undef GAPB
  #undef EX
  #undef VRD
  #undef KRD
  #undef STEP
  #undef ENDW
  {auto rr=__builtin_amdgcn_permlane32_swap(__float_as_uint(l_reg),__float_as_uint(l_reg),false,false);l_reg=__uint_as_float(rr[0])+__uint_as_float(rr[1]);}
  if(hi==0)wsf[32+r32]=l_reg;asm volatile("s_waitcnt lgkmcnt(0)":::"memory");
  float rli[16];
  #pragma unroll
  for(int r=0;r<16;++r)rli[r]=__builtin_amdgcn_rcpf(wsf[32+crow(r,hi)]);
  bf16*Ow=O+(rowbase+q0+wid*QBLK)*DM+h*D;
  { bf16*stg=(bf16*)(shm+LDS_OST)+wid*2048;
    #pragma unroll
    for(int r=0;r<16;++r){const int orow=crow(r,hi);
      #pragma unroll
      for(int d0=0;d0<2;++d0)stg[orow*64+d0*32+r32]=__float2bfloat16(o[d0][r]*rli[r]);}
    asm volatile("s_waitcnt lgkmcnt(0)":::"memory");
    #pragma unroll
    for(int i=0;i<4;++i){const int row=i*8+(lane>>3),ch=lane&7; const u32x4 v=*(const u32x4*)(stg+row*64+ch*8); ATTN_STORE16(Ow+(long)row*DM+ch*8,v);} }
  asm volatile("s_waitcnt lgkmcnt(0)\n\ts_barrier":::"memory");
  #undef ALIBI
  #undef AADD
  #undef DMA_K
  #undef DMA_V
  #undef CMASK
  #undef START
  #undef RESC
  #undef ROT
}
constexpr int ATTN_LDS_BYTES=LDS_BYTES;
struct AttnTensors { const bf16* Q; const bf16* K; const bf16* V; bf16* O; const unsigned* nmax; };
struct AttnUnit { int bh; int qb; };
struct StaticOrder {
  int vcu;
  __device__ __forceinline__ explicit StaticOrder(int grid,int block):vcu((block%8)*(grid/8)+block/8){}
  __device__ __forceinline__ bool next(int i,AttnUnit&u)const{ if(i>=4)return false; const int s=vcu&7; u.bh=vcu>>3; u.qb=(i==0)?s:(i==1)?15-s:(i==2)?16+s:31-s; return true; }
  __device__ __forceinline__ void a_ready(const AttnUnit&)const{}
  __device__ __forceinline__ void done(const AttnUnit&)const{}
};
struct DynOrder {
  unsigned* qctr; volatile __attribute__((address_space(3))) unsigned* slot; int xq, wave;
  __device__ __forceinline__ bool next(int,AttnUnit&u)const{
    if(wave==0&&lane_id()==0){ slot[0]=__hip_atomic_fetch_add(qctr+64*xq,1u,__ATOMIC_RELAXED,__HIP_MEMORY_SCOPE_AGENT); }
    __syncthreads(); const unsigned v=slot[0]; __syncthreads();
    if(v>=128u)return false; u.qb=31-(int)(v>>2); u.bh=(xq>>2)*16+(3-(int)(v&3u))*4+(xq&3); return true; }
  __device__ __forceinline__ void a_ready(const AttnUnit&)const{}
  __device__ __forceinline__ void done(const AttnUnit&)const{}
};
template<class Sched,int THRL=8> __device__ __forceinline__ void attn_phase(char*lds,const AttnTensors&T,const Sched&S,const int wave_id){
  AttnUnit u;
  for(int i=0;S.next(i,u);++i){ S.a_ready(u); attn_unit<THRL>(u.bh/NHEAD,u.bh%NHEAD,u.qb,T.Q,T.K,T.V,T.O,lds,wave_id,T.nmax); S.done(u); }
}
#undef SBAR
#undef WAIT_BAR
}
constexpr int NWAVES = 8;
constexpr int BATCH = 2, T = 8192, D = 1024, FF = 2816, M = BATCH * T;
constexpr int WIN_SRC = 5648, WIN_N = 3840;
constexpr float RMS_EPS = 1e-6f, SUBLN_EPS = 1e-5f;
constexpr size_t MiB = 1u << 20;
constexpr size_t WS_SSQA = 1 * MiB, WS_SSQB = 2 * MiB, WS_DNCD = 3 * MiB;
constexpr size_t WS_WG = 4 * MiB, WS_WA = 8 * MiB, WS_WB = 9 * MiB, WS_WOUT = 10 * MiB;
constexpr size_t WS_XB = 12 * MiB;
constexpr size_t WS_H = 44 * MiB;
constexpr size_t WS_WGU1 = 232 * MiB, WS_WD1 = 243 * MiB, WS_WIN = 248 * MiB + 512 * 1024;
constexpr size_t WS_PRE = 44 * MiB, WS_Z = 92 * MiB, WS_QO = 108 * MiB, WS_KD = 140 * MiB, WS_VD = 156 * MiB, WS_AB = 172 * MiB;
constexpr size_t WS_DN = 173 * MiB;
constexpr size_t WS_ODN = 44 * MiB, WS_AA = 60 * MiB, WS_ABB = 76 * MiB;
constexpr size_t WS_WGU2 = 173 * MiB, WS_WD2 = 184 * MiB;
constexpr size_t WS_YA = 190 * MiB, WS_YB = 222 * MiB, WS_MG = 108 * MiB;
constexpr size_t WS_END = 256 * MiB;
constexpr int DN_REC = 40960;
static_assert(WS_DN + (size_t)2048 * DN_REC <= WS_END && WS_WIN + (size_t)WIN_N * D * 2 <= WS_END && WS_YB + (size_t)M * D * 2 <= WS_END, "d_ws map");

constexpr int RING_OFF = 0, RING_BYTES = 147456;
constexpr int MISC_OFF = 147456, LDS_BYTES = 147456 + 256;

#define LAS __attribute__((address_space(3)))
typedef unsigned short bf16;
typedef unsigned v4u __attribute__((ext_vector_type(4)));
typedef float f32x4 __attribute__((ext_vector_type(4)));
typedef float f32x16 __attribute__((ext_vector_type(16)));
typedef short bf16x8 __attribute__((ext_vector_type(8)));
#define LDSFENCE() asm volatile("s_waitcnt lgkmcnt(0)" ::: "memory")
__device__ __forceinline__ unsigned f2bf(float f) { unsigned u = __builtin_bit_cast(unsigned, f); return (u + 0x7fffu + ((u >> 16) & 1u)) >> 16; }
typedef float f32x2_t_ __attribute__((ext_vector_type(2))); typedef __bf16 bf16x2_t_ __attribute__((ext_vector_type(2)));
__device__ __forceinline__ unsigned pk2(float lo, float hi) { f32x2_t_ v = {lo, hi}; bf16x2_t_ b = __builtin_convertvector(v, bf16x2_t_); return __builtin_bit_cast(unsigned, b); }
__device__ __forceinline__ float bflo(unsigned w) { return __uint_as_float(w << 16); }
__device__ __forceinline__ float bfhi(unsigned w) { return __uint_as_float(w & 0xffff0000u); }
__device__ __forceinline__ float wave_sum(float v) {
#pragma unroll
    for (int o = 1; o < 64; o <<= 1) v += __shfl_xor(v, o);
    return v;
}

#define GAS __attribute__((address_space(1)))
typedef GAS unsigned gu32;
#define RLX_AGENT __ATOMIC_RELAXED, __HIP_MEMORY_SCOPE_AGENT
constexpr size_t WS_CTL = 0, CTL_ZERO_BYTES = 65536;
constexpr int CW_BAR = 1024, CW_ATTQ = 8192, CW_NMAX = 12288;
#define XB_TMO      128
#define XB_XCNT(j)  (256  + 64 * (j))
#define XB_XSUB(j)  (1280 + 64 * (j))
#define XB_XGEN(j)  (2304 + 64 * (j))
#define XB_TOP      3328
#define XB_TOPGEN   3392
#define XCD_BAR_WORDS 3456
#define XB_SPIN_CAP (1u << 18)

__device__ __forceinline__ unsigned xb_ld(unsigned* p)              { return __hip_atomic_load(p, __ATOMIC_RELAXED, __HIP_MEMORY_SCOPE_AGENT); }
__device__ __forceinline__ unsigned xb_add(unsigned* p, unsigned v) { return __hip_atomic_fetch_add(p, v, __ATOMIC_RELAXED, __HIP_MEMORY_SCOPE_AGENT); }
__device__ __forceinline__ unsigned xb_xcc_id() { return (unsigned)__builtin_amdgcn_s_getreg((3 << 11) | 20) & 0xFu; }
#define XB_SPIN(cond, bar) do { unsigned _sp = 0; while (cond) { __builtin_amdgcn_s_sleep(1); \
    if ((++_sp & 255u) == 0u) { if (xb_ld(&(bar)[XB_TMO])) break; if (_sp > XB_SPIN_CAP) { atomicAdd(&(bar)[XB_TMO], 1u); break; } } } } while (0)

struct XcdBarrier {
    unsigned* bar; unsigned x; int wave;
    volatile LAS unsigned* st;
};

__device__ __forceinline__ XcdBarrier xcd_barrier_post(unsigned* bar, volatile LAS unsigned* st, int wave) {
    XcdBarrier b; b.bar = bar; b.x = xb_xcc_id(); b.st = st; b.wave = wave;
    if (wave == 0 && lane_id() == 0) (void)xb_add(&bar[XB_XCNT(b.x)], 1u);
    return b;
}
__device__ __forceinline__ void xcd_barrier_complete(unsigned* bar, unsigned x, unsigned& nloc, unsigned& nx) {
    const unsigned G = gridDim.x * gridDim.y * gridDim.z;
    unsigned sum, cnt, mine, sp = 0u;
    for (;;) {
        sum = 0u; cnt = 0u; mine = 0u;
#pragma unroll
        for (unsigned j = 0; j < 16; ++j) { const unsigned c = xb_ld(&bar[XB_XCNT(j)]); sum += c; cnt += (c > 0u) ? 1u : 0u; mine = (j == x) ? c : mine; }
        if (sum == G) break;
        __builtin_amdgcn_s_sleep(1);
        if ((++sp & 255u) == 0u) { if (xb_ld(&bar[XB_TMO])) break; if (sp > XB_SPIN_CAP) { atomicAdd(&bar[XB_TMO], 1u); break; } }
    }
    nloc = mine > 0u ? mine : 1u; nx = cnt > 0u ? cnt : 1u;
}

__device__ __forceinline__ void xcd_barrier(const XcdBarrier& b) {
    asm volatile("s_waitcnt vmcnt(0)" ::: "memory");
    __syncthreads();
    if (b.wave == 0 && lane_id() == 0) {
        unsigned* bar = b.bar;
        __builtin_amdgcn_s_waitcnt(0);
        unsigned nloc = b.st[0], nx = b.st[1];
        if (nloc == 0u) { xcd_barrier_complete(bar, b.x, nloc, nx); b.st[0] = nloc; b.st[1] = nx; }
        const unsigned old = xb_add(&bar[XB_XSUB(b.x)], 1u);
        const unsigned gen = old / nloc;
        if (old + 1u == (gen + 1u) * nloc) {
            __builtin_amdgcn_fence(__ATOMIC_RELEASE, "agent");
            asm volatile("s_waitcnt vmcnt(0)" ::: "memory");
            const unsigned og = xb_add(&bar[XB_TOP], 1u);
            const unsigned tg = og / nx;
            if (og + 1u == (tg + 1u) * nx) xb_add(&bar[XB_TOPGEN], 1u);
            else XB_SPIN(xb_ld(&bar[XB_TOPGEN]) == tg, bar);
            __builtin_amdgcn_fence(__ATOMIC_ACQUIRE, "agent");
            xb_add(&bar[XB_XGEN(b.x)], 1u);
            asm volatile("s_waitcnt vmcnt(0)" ::: "memory");
        } else {
            XB_SPIN(xb_ld(&bar[XB_XGEN(b.x)]) == gen, bar);
            __builtin_amdgcn_fence(__ATOMIC_ACQUIRE, "agent");
            asm volatile("s_waitcnt vmcnt(0)" ::: "memory");
        }
    }
    __syncthreads();
}

struct Ctx {
    const float* const* in; float* out; unsigned char* ws;
    LAS unsigned char* lds; int wave, G, vcu;
};

__device__ __forceinline__ void conv_item(const float* W, int ldw, int scol0, int nvalid, const float* gain, bf16* WT, int K, int drow0, int k0, LAS float* scr, int lane) {
    const int n4 = (lane & 15) * 4, kr = lane >> 4;
    f32x4 v[16];
#pragma unroll
    for (int i = 0; i < 16; ++i) { const int kk = 4 * i + kr; v[i] = (n4 < nvalid) ? *(const f32x4*)(W + (size_t)(k0 + kk) * ldw + scol0 + n4) : (f32x4){0.f, 0.f, 0.f, 0.f}; }
#pragma unroll
    for (int i = 0; i < 16; ++i) { const int kk = 4 * i + kr; f32x4 x = v[i]; if (gain) x = x * gain[k0 + kk];
        LAS float* p = scr + kk * 65 + n4; p[0] = x[0]; p[1] = x[1]; p[2] = x[2]; p[3] = x[3]; }
    LDSFENCE();
    const int c = lane & 7;
#pragma unroll
    for (int j = 0; j < 8; ++j) { const int n = (lane >> 3) + 8 * j; const LAS float* s = scr + (8 * c) * 65 + n;
        v4u o; o.x = pk2(s[0 * 65], s[1 * 65]); o.y = pk2(s[2 * 65], s[3 * 65]); o.z = pk2(s[4 * 65], s[5 * 65]); o.w = pk2(s[6 * 65], s[7 * 65]);
        *(v4u*)(WT + (size_t)(drow0 + n) * K + k0 + 8 * c) = o; }
    LDSFENCE();
}
__device__ __forceinline__ void conv_gu(const float* wg, const float* wu, const float* gain, bf16* WT, int it, LAS float* scr, int lane) {
    const int db = it >> 4, kb = it & 15, tile = db >> 2, w = db & 3;
    conv_item(w < 2 ? wg : wu, FF, 128 * tile + 64 * (w & 1), 64, gain, WT, D, 64 * db, 64 * kb, scr, lane);
}
__device__ __forceinline__ void conv_plain(const float* W, int K, int N, bf16* WT, int it, LAS float* scr, int lane) {
    const int nkb = K / 64, db = it / nkb, kb = it % nkb;
    conv_item(W, N, 64 * db, 64, nullptr, WT, K, 64 * db, 64 * kb, scr, lane);
}
__device__ __forceinline__ void conv_win(const float* W, const float* gain, bf16* WT, int it, LAS float* scr, int lane) {
    const int db = it >> 4, kb = it & 15, d0 = 64 * db; int sc, nv = 64;
    if (d0 < 2048) sc = d0; else if (d0 < 3584) sc = d0 + 16; else if (d0 == 3584) { sc = 2048; nv = 16; } else { sc = 0; nv = 0; }
    conv_item(W, WIN_SRC, sc, nv, gain, WT, D, d0, 64 * kb, scr, lane);
}
__device__ __forceinline__ void conv_wg(const float* W, const float* gain, bf16* WT, int it, LAS float* scr, int lane) {
    const int db = it >> 4, kb = it & 15, tile = db >> 2, w = db & 3;
    conv_item(W, WIN_SRC, 3600 + (w < 2 ? 0 : 1024) + 128 * tile + 64 * (w & 1), 64, gain, WT, D, 64 * db, 64 * kb, scr, lane);
}

__device__ __forceinline__ void p0_prologue(Ctx& F) {
    const int lane = lane_id();
    LAS float* scr = (LAS float*)(F.lds + RING_OFF + F.wave * 17408);
    const int gw = F.vcu * NWAVES + F.wave, NGW = F.G * NWAVES;
    bf16* ws16 = (bf16*)F.ws;
    constexpr int I_GU = 88 * 16, I_DN = 16 * 44, I_WIN = 60 * 16, I_WG = 32 * 16, I_AB = 16 * 8, I_WO = 16 * 16;
    constexpr int NIT = I_GU + I_DN + I_WIN + I_WG + 2 * I_AB + I_WO;
    for (int it = gw; it < NIT; it += NGW) {
        int r = it;
        if (r < I_GU) { conv_gu(F.in[2], F.in[3], F.in[1], (bf16*)(F.ws + WS_WGU1), r, scr, lane); continue; } r -= I_GU;
        if (r < I_DN) { conv_plain(F.in[4], FF, D, (bf16*)(F.ws + WS_WD1), r, scr, lane); continue; } r -= I_DN;
        if (r < I_WIN) { conv_win(F.in[6], F.in[5], (bf16*)(F.ws + WS_WIN), r, scr, lane); continue; } r -= I_WIN;
        if (r < I_WG) { conv_wg(F.in[6], F.in[5], (bf16*)(F.ws + WS_WG), r, scr, lane); continue; } r -= I_WG;
        if (r < I_AB) { conv_plain(F.in[16], 512, D, (bf16*)(F.ws + WS_WA), r, scr, lane); continue; } r -= I_AB;
        if (r < I_AB) { conv_plain(F.in[17], 512, D, (bf16*)(F.ws + WS_WB), r, scr, lane); continue; } r -= I_AB;
        conv_plain(F.in[18], D, D, (bf16*)(F.ws + WS_WOUT), r, scr, lane);
    }
    (void)ws16;
    const float* x = F.in[0]; bf16* xb = (bf16*)(F.ws + WS_XB); float* ssq = (float*)(F.ws + WS_SSQA);
    for (int m0 = gw; m0 < M; m0 += 4 * NGW) {
        f32x4 v[4][4];
#pragma unroll
        for (int q = 0; q < 4; ++q) { const int m = m0 + q * NGW; if (m < M) { const f32x4* xr = (const f32x4*)(x + (size_t)m * D) + lane;
#pragma unroll
            for (int j = 0; j < 4; ++j) v[q][j] = xr[64 * j]; } }
#pragma unroll
        for (int q = 0; q < 4; ++q) { const int m = m0 + q * NGW; if (m < M) { unsigned long long* o8 = (unsigned long long*)(xb + (size_t)m * D) + lane; float s = 0.f;
#pragma unroll
            for (int j = 0; j < 4; ++j) { const f32x4 w = v[q][j]; s += (w.x * w.x + w.y * w.y) + (w.z * w.z + w.w * w.w); o8[64 * j] = (unsigned long long)pk2(w.x, w.y) | ((unsigned long long)pk2(w.z, w.w) << 32); }
            s = wave_sum(s);
            if (lane < 16) ssq[(size_t)m * 16 + lane] = (lane == 0) ? s : 0.f; } }
    }
}
__device__ __forceinline__ void conv_ffn2(Ctx& F) {
    const int lane = lane_id();
    LAS float* scr = (LAS float*)(F.lds + RING_OFF + F.wave * 17408);
    const int gw = F.vcu * NWAVES + F.wave, NGW = F.G * NWAVES;
    constexpr int I_GU = 88 * 16, I_DN = 16 * 44;
    for (int it = gw; it < I_GU + I_DN; it += NGW) {
        if (it < I_GU) conv_gu(F.in[20], F.in[21], F.in[19], (bf16*)(F.ws + WS_WGU2), it, scr, lane);
        else conv_plain(F.in[22], FF, D, (bf16*)(F.ws + WS_WD2), it - I_GU, scr, lane);
    }
}

__device__ __forceinline__ float silu_acc(float v) { return v * __builtin_amdgcn_rcpf(1.0f + __builtin_amdgcn_exp2f(-1.4426950408889634f * v)); }
typedef unsigned u32x2 __attribute__((ext_vector_type(2)));
__device__ __forceinline__ void dn_conv_l1(const bf16* PRE, const float* cw, long row0, int tin0, int colbase, int r, int hh, float (&y)[2][4][8]) {
#pragma unroll
    for (int s = 0; s < 4; ++s) {
        const int ch0 = colbase + 16 * s + 4 * hh;
        f32x4 wl[4], wh[4];
#pragma unroll
        for (int j = 0; j < 4; ++j) { wl[j] = *(const f32x4*)(cw + j * 1536 + ch0); wh[j] = *(const f32x4*)(cw + j * 1536 + ch0 + 8); }
#pragma unroll
        for (int i = 0; i < 2; ++i) { const int tok = r + 32 * i, tin = tin0 + tok; const long row = row0 + tok;
            float a[8];
#pragma unroll
            for (int e = 0; e < 8; ++e) a[e] = 0.f;
#pragma unroll
            for (int j = 0; j < 4; ++j) { u32x2 lo = (u32x2){0u, 0u}, hi = (u32x2){0u, 0u};
                if (tin - 3 + j >= 0) { const bf16* p = PRE + (size_t)(row - 3 + j) * 1536 + ch0; lo = *(const u32x2*)p; hi = *(const u32x2*)(p + 8); }
                a[0] += wl[j][0] * bflo(lo.x); a[1] += wl[j][1] * bfhi(lo.x); a[2] += wl[j][2] * bflo(lo.y); a[3] += wl[j][3] * bfhi(lo.y);
                a[4] += wh[j][0] * bflo(hi.x); a[5] += wh[j][1] * bfhi(hi.x); a[6] += wh[j][2] * bflo(hi.y); a[7] += wh[j][3] * bfhi(hi.y); }
#pragma unroll
            for (int e = 0; e < 8; ++e) { y[i][s][e] = silu_acc(a[e]); asm volatile("" : "+v"(y[i][s][e])); } }
        __builtin_amdgcn_sched_barrier(0);
    }
}
__device__ __forceinline__ bf16x8 pack8f(const float (&v)[8], float sc) {
    v4u o; o.x = pk2(v[0] * sc, v[1] * sc); o.y = pk2(v[2] * sc, v[3] * sc); o.z = pk2(v[4] * sc, v[5] * sc); o.w = pk2(v[6] * sc, v[7] * sc);
    return __builtin_bit_cast(bf16x8, o);
}
__device__ __forceinline__ v4u pack8acc(const f32x16& X, int kq) {
    v4u o; o.x = pk2(X[8 * kq], X[8 * kq + 1]); o.y = pk2(X[8 * kq + 2], X[8 * kq + 3]); o.z = pk2(X[8 * kq + 4], X[8 * kq + 5]); o.w = pk2(X[8 * kq + 6], X[8 * kq + 7]);
    return o;
}
__device__ __forceinline__ void write_xt(LAS unsigned short* XT, const bf16x8 (&fr)[2][4], const float (&sc)[2], int r, int hh) {
#pragma unroll
    for (int i = 0; i < 2; ++i)
#pragma unroll
        for (int s = 0; s < 4; ++s) { const v4u w = __builtin_bit_cast(v4u, fr[i][s]);
#pragma unroll
            for (int e2 = 0; e2 < 4; ++e2) { const unsigned ww = w[e2]; const unsigned o = pk2(bflo(ww) * sc[i], bfhi(ww) * sc[i]); const int e = 2 * e2;
                LAS unsigned short* p = XT + (16 * s + 8 * (e >> 2) + 4 * hh + (e & 3)) * 72 + r + 32 * i;
                p[0] = (unsigned short)o; p[72] = (unsigned short)(o >> 16); } }
}
__device__ __forceinline__ float lane_bcast(float v, int l) { return __uint_as_float((unsigned)__builtin_amdgcn_readlane((int)__float_as_uint(v), l)); }

__device__ __forceinline__ float fexp(float v) { return __builtin_amdgcn_exp2f(1.4426950408889634f * v); }
__device__ __forceinline__ void dn_prep_chunk(Ctx& F, int ch, LAS unsigned char* scrb, int opq  ) {
    int lane_ = lane_id();
    const int lane = lane_, r = lane & 31, hh = lane >> 5;
    const int n = ch & 127, h = (ch >> 7) & 7, b = ch >> 10;
    const long row0 = (long)b * T + 64 * n; const int tin0 = 64 * n;
    const bf16* PRE = (const bf16*)(F.ws + WS_PRE); const float* AB = (const float*)(F.ws + WS_AB); const float* cw = F.in[7];
    unsigned char* rec = F.ws + WS_DN + (size_t)ch * DN_REC;
    LAS float* At = (LAS float*)scrb; LAS unsigned short* TT = (LAS unsigned short*)scrb; LAS unsigned short* XT = (LAS unsigned short*)(scrb + 9216);
    float gc, betac;
    { const float al = AB[(size_t)(row0 + lane) * 16 + h], bl = AB[(size_t)(row0 + lane) * 16 + 8 + h];
      const float xs = al + F.in[9][h];
      const float sp = fmaxf(xs, 0.f) + log1pf(fexp(-fabsf(xs)));
      gc = -fexp(F.in[8][h]) * sp; betac = 1.0f / (1.0f + fexp(-bl));
#pragma unroll
      for (int o = 1; o < 64; o <<= 1) { const float t = __shfl_up(gc, o); if (lane >= o) gc += t; } }
    const float gl = lane_bcast(gc, 63);
    float gct[2], bet[2];
#pragma unroll
    for (int i = 0; i < 2; ++i) { gct[i] = __shfl(gc, r + 32 * i); bet[i] = __shfl(betac, r + 32 * i); }
    bf16x8 kf[2][4];
#pragma unroll
    for (int i = 0; i < 2; ++i)
#pragma unroll
        for (int s = 0; s < 4; ++s) kf[i][s] = (bf16x8){0, 0, 0, 0, 0, 0, 0, 0};
    if (opq > 0) { int lane = lane_; asm volatile("" : "+v"(lane)); const int r = lane & 31, hh = lane >> 5;
      float y[2][4][8]; dn_conv_l1(PRE, cw, row0, tin0, 512 + h * 64, r, hh, y);
#pragma unroll
      for (int i = 0; i < 2; ++i) { float ss = 0.f;
#pragma unroll
          for (int s = 0; s < 4; ++s)
#pragma unroll
              for (int e = 0; e < 8; ++e) ss += y[i][s][e] * y[i][s][e];
          ss += __shfl_xor(ss, 32); const float rn = 1.0f / sqrtf(ss + 1e-6f);
#pragma unroll
          for (int s = 0; s < 4; ++s) { kf[i][s] = pack8f(y[i][s], rn); asm volatile("" : "+v"(kf[i][s])); } } }
    __builtin_amdgcn_sched_barrier(0);
    if (opq > 1) { int lane = lane_; asm volatile("" : "+v"(lane)); const int r = lane & 31, hh = lane >> 5;
      float sc[2] = {fexp(gl - gct[0]), fexp(gl - gct[1])};
      write_xt(XT, kf, sc, r, hh);
      LDSFENCE();
#pragma unroll
      for (int id = 0; id < 2; ++id)
#pragma unroll
          for (int ks = 0; ks < 4; ++ks) { const int d = r + 32 * id; const LAS unsigned short* p = XT + d * 72 + 16 * ks + 4 * hh;
              const u32x2 lo = *(const LAS u32x2*)p, hi = *(const LAS u32x2*)(p + 8);
              *(v4u*)(rec + 24576 + d * 128 + (ks * 2 + hh) * 16) = (v4u){lo.x, lo.y, hi.x, hi.y}; }
      LDSFENCE(); }
    __builtin_amdgcn_sched_barrier(0);
#ifndef SKQ
    if (opq > 2) {
        int lane = lane_; asm volatile("" : "+v"(lane)); const int r = lane & 31, hh = lane >> 5;
        bf16x8 qf[2][4];
        { float y[2][4][8]; dn_conv_l1(PRE, cw, row0, tin0, h * 64, r, hh, y);
#pragma unroll
          for (int i = 0; i < 2; ++i) { float ss = 0.f;
#pragma unroll
              for (int s = 0; s < 4; ++s)
#pragma unroll
                  for (int e = 0; e < 8; ++e) ss += y[i][s][e] * y[i][s][e];
              ss += __shfl_xor(ss, 32); const float rn = 0.125f / sqrtf(ss + 1e-6f); const float eg = fexp(gct[i]);
#pragma unroll
              for (int s = 0; s < 4; ++s) { qf[i][s] = pack8f(y[i][s], rn);
                  *(bf16x8*)(rec + 8192 + (r + 32 * i) * 128 + (s * 2 + hh) * 16) = pack8f(y[i][s], rn * eg); asm volatile("" : "+v"(qf[i][s])); } } }
        __builtin_amdgcn_sched_barrier(0);
#pragma unroll
        for (int is = 0; is < 2; ++is) {
            float gcr[16];
#pragma unroll
            for (int g = 0; g < 16; ++g) gcr[g] = __shfl(gc, 32 * is + (g & 3) + 8 * (g >> 2) + 4 * hh);
#pragma unroll
            for (int ic = 0; ic < 2; ++ic) {
                if (is == 1 && ic == 0) {
#pragma unroll
                    for (int kq = 0; kq < 2; ++kq) *(v4u*)(rec + 16384 + r * 128 + ((2 + kq) * 2 + hh) * 16) = (v4u){0u, 0u, 0u, 0u};
#pragma unroll
                    for (int g = 0; g < 16; ++g) At[(32 + (g & 3) + 8 * (g >> 2) + 4 * hh) * 68 + r] = 0.f;
                    continue;
                }
                f32x16 pt, pk;
#pragma unroll
                for (int g = 0; g < 16; ++g) { pt[g] = 0.f; pk[g] = 0.f; }
#pragma unroll
                for (int ks = 0; ks < 4; ++ks) { pt = __builtin_amdgcn_mfma_f32_32x32x16_bf16(kf[is][ks], qf[ic][ks], pt, 0, 0, 0); pk = __builtin_amdgcn_mfma_f32_32x32x16_bf16(kf[is][ks], kf[ic][ks], pk, 0, 0, 0); }
                const int ccol = 32 * ic + r;
#pragma unroll
                for (int g = 0; g < 16; ++g) { const int srow = 32 * is + (g & 3) + 8 * (g >> 2) + 4 * hh; const float dec = fexp(fminf(gct[ic] - gcr[g], 0.f));
                    pt[g] = (srow <= ccol) ? pt[g] * dec : 0.f;
                    At[srow * 68 + ccol] = (srow < ccol) ? bet[ic] * pk[g] * dec : 0.f; }
#pragma unroll
                for (int kq = 0; kq < 2; ++kq) *(v4u*)(rec + 16384 + ccol * 128 + ((2 * is + kq) * 2 + hh) * 16) = pack8acc(pt, kq);
                __builtin_amdgcn_sched_barrier(0);
            }
        }
    }
    LDSFENCE();
#endif
    __builtin_amdgcn_sched_barrier(0);
#ifndef SKS
    if (opq > 3) {
        int lane = lane_; asm volatile("" : "+v"(lane)); const int r = lane & 31, hh = lane >> 5;
        float t[64];
#pragma unroll
        for (int k = 0; k < 64; ++k) t[k] = (k == lane) ? 1.0f : 0.0f;
#pragma unroll
        for (int j = 62; j >= 0; --j) { float acc = 0.f;
#pragma unroll
            for (int k4 = (j + 1) & ~3; k4 < 64; k4 += 4) { const f32x4 x = *(const volatile LAS f32x4*)(At + j * 68 + k4);
#pragma unroll
                for (int i = 0; i < 4; ++i) if (k4 + i > j) acc += t[k4 + i] * x[i]; }
            t[j] -= acc; asm volatile("" : "+v"(t[j])); }
        LDSFENCE();
#pragma unroll
        for (int i = 0; i < 8; ++i) { v4u o; o.x = pk2(t[8 * i], t[8 * i + 1]); o.y = pk2(t[8 * i + 2], t[8 * i + 3]); o.z = pk2(t[8 * i + 4], t[8 * i + 5]); o.w = pk2(t[8 * i + 6], t[8 * i + 7]);
            *(LAS v4u*)(TT + lane * 72 + 8 * i) = o; }
    }
#endif
    __builtin_amdgcn_sched_barrier(0);
#ifndef SKW
    if (opq > 4) { int lane = lane_; asm volatile("" : "+v"(lane)); const int r = lane & 31, hh = lane >> 5;
      float sc[2] = {bet[0] * fexp(gct[0]), bet[1] * fexp(gct[1])};
      write_xt(XT, kf, sc, r, hh);
      LDSFENCE();
#pragma unroll
      for (int id = 0; id < 2; ++id)
#pragma unroll
          for (int ic = 0; ic < 2; ++ic) { f32x16 acc;
#pragma unroll
              for (int g = 0; g < 16; ++g) acc[g] = 0.f;
#pragma unroll
              for (int ks = 0; ks < 4; ++ks) { const bf16x8 af = *(const LAS bf16x8*)(XT + (r + 32 * id) * 72 + 16 * ks + 8 * hh), bfr = *(const LAS bf16x8*)(TT + (r + 32 * ic) * 72 + 16 * ks + 8 * hh);
                  acc = __builtin_amdgcn_mfma_f32_32x32x16_bf16(af, bfr, acc, 0, 0, 0); }
#pragma unroll
              for (int kq = 0; kq < 2; ++kq) *(v4u*)(rec + (32 * ic + r) * 128 + ((2 * id + kq) * 2 + hh) * 16) = pack8acc(acc, kq); __builtin_amdgcn_sched_barrier(0); }
      LDSFENCE(); }
    __builtin_amdgcn_sched_barrier(0);
#endif
#ifndef SKU
    if (opq > 1) { int lane = lane_; asm volatile("" : "+v"(lane)); const int r = lane & 31, hh = lane >> 5;
      bf16x8 vf[2][4];
      { float y[2][4][8]; dn_conv_l1(PRE, cw, row0, tin0, 1024 + h * 64, r, hh, y);
#pragma unroll
        for (int i = 0; i < 2; ++i)
#pragma unroll
            for (int s = 0; s < 4; ++s) { vf[i][s] = pack8f(y[i][s], bet[i]); asm volatile("" : "+v"(vf[i][s])); } }
      __builtin_amdgcn_sched_barrier(0);
      float one[2] = {1.0f, 1.0f};
      write_xt(XT, vf, one, r, hh);
      LDSFENCE();
      unsigned* U = (unsigned*)(rec + 32768);
#pragma unroll
      for (int ic = 0; ic < 2; ++ic)
#pragma unroll
          for (int ie = 0; ie < 2; ++ie) { f32x16 acc;
#pragma unroll
              for (int g = 0; g < 16; ++g) acc[g] = 0.f;
#pragma unroll
              for (int ks = 0; ks < 4; ++ks) { const bf16x8 af = *(const LAS bf16x8*)(TT + (r + 32 * ic) * 72 + 16 * ks + 8 * hh), bfr = *(const LAS bf16x8*)(XT + (r + 32 * ie) * 72 + 16 * ks + 8 * hh);
                  acc = __builtin_amdgcn_mfma_f32_32x32x16_bf16(af, bfr, acc, 0, 0, 0); }
#pragma unroll
              for (int gp = 0; gp < 8; ++gp) U[((ie * 2 + ic) * 8 + gp) * 64 + lane] = pk2(acc[2 * gp], acc[2 * gp + 1]); __builtin_amdgcn_sched_barrier(0); }
      LDSFENCE(); }
#endif
    if (lane == 0) ((float*)(F.ws + WS_DNCD))[ch] = fexp(gl);
}

__device__ __forceinline__ bf16x8 pack8(const f32x16& X, int s) {
    v4u o; o.x = pg8::cvt_pk_bf16(X[8 * s], X[8 * s + 1]); o.y = pg8::cvt_pk_bf16(X[8 * s + 2], X[8 * s + 3]); o.z = pg8::cvt_pk_bf16(X[8 * s + 4], X[8 * s + 5]); o.w = pg8::cvt_pk_bf16(X[8 * s + 6], X[8 * s + 7]);
    return __builtin_bit_cast(bf16x8, o);
}
__device__ __forceinline__ void dn_scan(Ctx& F, int sw) {
    const int lane = lane_id(), r = lane & 31, hh = lane >> 5;
    const int bh = sw >> 1, sl = sw & 1, b = bh >> 3, h = bh & 7;
    const float* CD = (const float*)(F.ws + WS_DNCD) + bh * 128;
    bf16* ODN = (bf16*)(F.ws + WS_ODN);
    f32x16 S0, S1;
#pragma unroll
    for (int i = 0; i < 16; ++i) { S0[i] = 0.f; S1[i] = 0.f; }
    for (int n = 0; n < 128; ++n) {
        const unsigned char* rec = F.ws + WS_DN + ((size_t)bh * 128 + n) * DN_REC;
        const unsigned char* fb = rec + r * 128 + hh * 16;
        bf16x8 w[2][4], qd[2][4], at[2][4], kt[2][4];
#pragma unroll
        for (int i = 0; i < 2; ++i)
#pragma unroll
            for (int ks = 0; ks < 4; ++ks) { const int o = i * 4096 + ks * 32;
                w[i][ks] = *(const bf16x8*)(fb + o); qd[i][ks] = *(const bf16x8*)(fb + 8192 + o); at[i][ks] = *(const bf16x8*)(fb + 16384 + o); kt[i][ks] = *(const bf16x8*)(fb + 24576 + o); }
        const unsigned* up = (const unsigned*)(rec + 32768) + (sl * 2) * 8 * 64 + lane;
        unsigned uw[2][8];
#pragma unroll
        for (int i = 0; i < 2; ++i)
#pragma unroll
            for (int gp = 0; gp < 8; ++gp) uw[i][gp] = up[(i * 8 + gp) * 64];
        const float cd = CD[n];
        bf16x8 sb[4]; sb[0] = pack8(S0, 0); sb[1] = pack8(S0, 1); sb[2] = pack8(S1, 0); sb[3] = pack8(S1, 1);
        f32x16 ws[2], qs[2];
#pragma unroll
        for (int i = 0; i < 2; ++i) {
#pragma unroll
            for (int g = 0; g < 16; ++g) { ws[i][g] = 0.f; qs[i][g] = 0.f; }
#pragma unroll
            for (int ks = 0; ks < 4; ++ks) { ws[i] = __builtin_amdgcn_mfma_f32_32x32x16_bf16(w[i][ks], sb[ks], ws[i], 0, 0, 0); qs[i] = __builtin_amdgcn_mfma_f32_32x32x16_bf16(qd[i][ks], sb[ks], qs[i], 0, 0, 0); }
        }
#pragma unroll
        for (int i = 0; i < 2; ++i)
#pragma unroll
            for (int gp = 0; gp < 8; ++gp) { ws[i][2 * gp] = bflo(uw[i][gp]) - ws[i][2 * gp]; ws[i][2 * gp + 1] = bfhi(uw[i][gp]) - ws[i][2 * gp + 1]; }
        bf16x8 vb[4]; vb[0] = pack8(ws[0], 0); vb[1] = pack8(ws[0], 1); vb[2] = pack8(ws[1], 0); vb[3] = pack8(ws[1], 1);
#pragma unroll
        for (int g = 0; g < 16; ++g) { S0[g] *= cd; S1[g] *= cd; }
#pragma unroll
        for (int ks = 0; ks < 4; ++ks) {
            qs[0] = __builtin_amdgcn_mfma_f32_32x32x16_bf16(at[0][ks], vb[ks], qs[0], 0, 0, 0);
            qs[1] = __builtin_amdgcn_mfma_f32_32x32x16_bf16(at[1][ks], vb[ks], qs[1], 0, 0, 0);
            S0 = __builtin_amdgcn_mfma_f32_32x32x16_bf16(kt[0][ks], vb[ks], S0, 0, 0, 0);
            S1 = __builtin_amdgcn_mfma_f32_32x32x16_bf16(kt[1][ks], vb[ks], S1, 0, 0, 0);
        }
        bf16* orow = ODN + ((size_t)b * T + 64 * n) * 512 + h * 64 + 32 * sl + r;
#pragma unroll
        for (int i = 0; i < 2; ++i)
#pragma unroll
            for (int g = 0; g < 16; ++g) { const int c = 32 * i + (g & 3) + 8 * (g >> 2) + 4 * hh; orow[(size_t)c * 512] = (bf16)f2bf(qs[i][g]); }
    }
}

constexpr int SC_SLOT = 4 * 9216 + 8192, SC_NPIECE = DN_REC / 16, SC_LANES = 5 * 64, SC_PPL = SC_NPIECE / SC_LANES;
static_assert(SC_PPL * SC_LANES == SC_NPIECE, "whole pieces per loader lane");
static_assert(3 * SC_SLOT <= RING_BYTES, "scan ring fits the phase scratch");
__device__ __forceinline__ int sc_piece_off(int p) { return p < 2048 ? (p >> 9) * 9216 + ((p & 511) >> 3) * 144 + (p & 7) * 16 : 36864 + (p - 2048) * 16; }
__device__ __forceinline__ void dn_scan_block(Ctx& F, int bh) {
    const int lane = lane_id(), wave = F.wave;
    LAS unsigned char* ring = F.lds + RING_OFF;
    const unsigned char* recs = F.ws + WS_DN + (size_t)bh * 128 * DN_REC;
#define SC_BAR() asm volatile("s_waitcnt vmcnt(0) lgkmcnt(0)\n\ts_barrier" ::: "memory")
    if (wave == 7) {
        asm volatile("s_barrier" ::: "memory");
#pragma unroll 1
        for (int n = 0; n < 128; ++n) asm volatile("s_barrier" ::: "memory");
    } else if (wave >= 2) {
        const int ll = (wave - 2) * 64 + lane; v4u d0[SC_PPL], d1[SC_PPL], d2[SC_PPL], d3[SC_PPL];
#define SC_LOAD(D, rec_) do { _Pragma("unroll") for (int j = 0; j < SC_PPL; ++j) { const int p = ll + j * SC_LANES; D[j] = *(const v4u*)(recs + (size_t)(rec_) * DN_REC + p * 16); } } while (0)
#define SC_STORE(D, slot_) do { _Pragma("unroll") for (int j = 0; j < SC_PPL; ++j) { const int p = ll + j * SC_LANES; *(LAS v4u*)(ring + (slot_) * SC_SLOT + sc_piece_off(p)) = D[j]; } } while (0)
#define SC_LBAR() asm volatile("s_waitcnt lgkmcnt(0)\n\ts_barrier" ::: "memory")
        SC_LOAD(d0, 0); SC_LOAD(d1, 1); SC_STORE(d0, 0); SC_STORE(d1, 1);
        SC_LOAD(d0, 2); SC_LOAD(d1, 3); SC_LOAD(d2, 4); SC_LOAD(d3, 5);
        SC_LBAR();
#define SC_STEP(D, n_, slot_) do { SC_STORE(D, slot_); SC_LOAD(D, (n_) + 6); SC_LBAR(); } while (0)
#pragma unroll 1
        for (int n = 0; n < 128; n += 12) {
            SC_STEP(d0, n, 2); SC_STEP(d1, n + 1, 0); SC_STEP(d2, n + 2, 1); SC_STEP(d3, n + 3, 2);
            SC_STEP(d0, n + 4, 0); SC_STEP(d1, n + 5, 1); SC_STEP(d2, n + 6, 2); SC_STEP(d3, n + 7, 0);
            if (n + 8 < 128) { SC_STEP(d0, n + 8, 1); SC_STEP(d1, n + 9, 2); SC_STEP(d2, n + 10, 0); SC_STEP(d3, n + 11, 1); }
        }
#undef SC_LOAD
#undef SC_STORE
#undef SC_STEP
#undef SC_LBAR
    } else {
        const int r = lane & 31, hh = lane >> 5, sl = wave, b = bh >> 3, h = bh & 7;
        const float* CD = (const float*)(F.ws + WS_DNCD) + bh * 128;
        bf16* ODN = (bf16*)(F.ws + WS_ODN);
        f32x16 S0, S1;
#pragma unroll
        for (int i = 0; i < 16; ++i) { S0[i] = 0.f; S1[i] = 0.f; }
        float cd = CD[0];
        asm volatile("s_waitcnt lgkmcnt(0)\n\ts_barrier" ::: "memory");
        int slot = 0;
#pragma unroll 1
        for (int n = 0; n < 128; ++n) {
            const LAS unsigned char* sb_ = ring + slot * SC_SLOT; const LAS unsigned char* fb = sb_ + r * 144 + hh * 16;
            const float cdn = CD[n + 1 < 128 ? n + 1 : n];
            bf16x8 w[2][4], qd[2][4];
#pragma unroll
            for (int i = 0; i < 2; ++i)
#pragma unroll
                for (int ks = 0; ks < 4; ++ks) { const int o = i * 32 * 144 + ks * 32; w[i][ks] = *(const LAS bf16x8*)(fb + o); qd[i][ks] = *(const LAS bf16x8*)(fb + 9216 + o); }
            bf16x8 sb[4]; sb[0] = pack8(S0, 0); sb[1] = pack8(S0, 1); sb[2] = pack8(S1, 0); sb[3] = pack8(S1, 1);
            f32x16 ws[2], qs[2];
#pragma unroll
            for (int i = 0; i < 2; ++i) {
#pragma unroll
                for (int g = 0; g < 16; ++g) { ws[i][g] = 0.f; qs[i][g] = 0.f; }
#pragma unroll
                for (int ks = 0; ks < 4; ++ks) { ws[i] = __builtin_amdgcn_mfma_f32_32x32x16_bf16(w[i][ks], sb[ks], ws[i], 0, 0, 0); qs[i] = __builtin_amdgcn_mfma_f32_32x32x16_bf16(qd[i][ks], sb[ks], qs[i], 0, 0, 0); }
            }
            bf16x8 at[2][4], kt[2][4];
#pragma unroll
            for (int i = 0; i < 2; ++i)
#pragma unroll
                for (int ks = 0; ks < 4; ++ks) { const int o = i * 32 * 144 + ks * 32; at[i][ks] = *(const LAS bf16x8*)(fb + 2 * 9216 + o); kt[i][ks] = *(const LAS bf16x8*)(fb + 3 * 9216 + o); }
            const LAS unsigned* up = (const LAS unsigned*)(sb_ + 36864) + (sl * 2) * 8 * 64 + lane;
#pragma unroll
            for (int i = 0; i < 2; ++i)
#pragma unroll
                for (int gp = 0; gp < 8; ++gp) { const unsigned uw = up[(i * 8 + gp) * 64]; ws[i][2 * gp] = bflo(uw) - ws[i][2 * gp]; ws[i][2 * gp + 1] = bfhi(uw) - ws[i][2 * gp + 1]; }
            bf16x8 vb[4]; vb[0] = pack8(ws[0], 0); vb[1] = pack8(ws[0], 1); vb[2] = pack8(ws[1], 0); vb[3] = pack8(ws[1], 1);
#pragma unroll
            for (int g = 0; g < 16; ++g) { S0[g] *= cd; S1[g] *= cd; }
#pragma unroll
            for (int ks = 0; ks < 4; ++ks) {
                S0 = __builtin_amdgcn_mfma_f32_32x32x16_bf16(kt[0][ks], vb[ks], S0, 0, 0, 0);
                S1 = __builtin_amdgcn_mfma_f32_32x32x16_bf16(kt[1][ks], vb[ks], S1, 0, 0, 0);
                qs[0] = __builtin_amdgcn_mfma_f32_32x32x16_bf16(at[0][ks], vb[ks], qs[0], 0, 0, 0);
                qs[1] = __builtin_amdgcn_mfma_f32_32x32x16_bf16(at[1][ks], vb[ks], qs[1], 0, 0, 0);
            }
            bf16* orow = ODN + ((size_t)b * T + 64 * n) * 512 + h * 64 + 32 * sl + r;
#pragma unroll
            for (int i = 0; i < 2; ++i)
#pragma unroll
                for (int g = 0; g < 16; ++g) { const int c = 32 * i + (g & 3) + 8 * (g >> 2) + 4 * hh; orow[(size_t)c * 512] = (bf16)f2bf(qs[i][g]); }
            cd = cdn; slot = (slot == 2) ? 0 : slot + 1;
            asm volatile("s_waitcnt lgkmcnt(0)\n\ts_barrier" ::: "memory");
        }
    }
    SC_BAR();
#undef SC_BAR
}

__device__ __forceinline__ void qk_norm_max(Ctx& F) {
    const int gw = F.vcu * NWAVES + F.wave, NGW = F.G * NWAVES, lane = lane_id(), j = lane >> 3;
    const bf16* QO = (const bf16*)(F.ws + WS_QO); const bf16* KD = (const bf16*)(F.ws + WS_KD);
    float mq[2] = {0.f, 0.f}, mk[2] = {0.f, 0.f};
    for (int m = gw; m < M; m += NGW) {
        const v4u qv = *(const v4u*)(QO + (size_t)m * 1024 + (2 * j) * 64 + (lane & 7) * 8), kv = *(const v4u*)(KD + (size_t)m * 512 + lane * 8);
        float sq = 0.f, sk = 0.f;
#pragma unroll
        for (int e = 0; e < 4; ++e) { const float a = bflo(qv[e]), b2 = bfhi(qv[e]), c = bflo(kv[e]), d = bfhi(kv[e]); sq += a * a + b2 * b2; sk += c * c + d * d; }
        sq += __shfl_xor(sq, 1); sq += __shfl_xor(sq, 2); sq += __shfl_xor(sq, 4);
        sk += __shfl_xor(sk, 1); sk += __shfl_xor(sk, 2); sk += __shfl_xor(sk, 4);
        const int bb = m >> 13;
        if (bb == 0) { mq[0] = fmaxf(mq[0], sq); mk[0] = fmaxf(mk[0], sk); } else { mq[1] = fmaxf(mq[1], sq); mk[1] = fmaxf(mk[1], sk); }
    }
    if ((lane & 7) == 0) { unsigned* nm = (unsigned*)(F.ws + WS_CTL) + CW_NMAX;
#pragma unroll
        for (int bb = 0; bb < 2; ++bb) { atomicMax(nm + bb * 8 + j, __float_as_uint(mq[bb])); atomicMax(nm + 16 + bb * 8 + j, __float_as_uint(mk[bb])); } }
}

__device__ __forceinline__ void finalize_rows(Ctx& F) {
    const int gw = F.vcu * NWAVES + F.wave, NGW = F.G * NWAVES, lane = lane_id();
    const bf16* ODN = (const bf16*)(F.ws + WS_ODN); const bf16* Z = (const bf16*)(F.ws + WS_Z); const bf16* QO = (const bf16*)(F.ws + WS_QO);
    bf16* AA = (bf16*)(F.ws + WS_AA); bf16* ABB = (bf16*)(F.ws + WS_ABB);
    float s1 = 0.f, s2 = 0.f;
    { const float a = F.in[11][lane] * F.in[12][lane], bq = F.in[13][lane] * F.in[14][lane]; s1 = wave_sum(a); s2 = wave_sum(bq); }
    const float lam_init = 0.2f;
    const float lam = expf(s1) - expf(s2) + lam_init;
    float gdn[8], gsub[8];
#pragma unroll
    for (int e = 0; e < 8; ++e) { gdn[e] = F.in[10][(lane & 7) * 8 + e]; gsub[e] = F.in[15][(lane & 15) * 8 + e] * (1.0f - lam_init); }
    for (int m = gw; m < M; m += NGW) {
        { const v4u ov = *(const v4u*)(ODN + (size_t)m * 512 + lane * 8), zv = *(const v4u*)(Z + (size_t)m * 512 + lane * 8);
          float o[8], z[8]; float ss = 0.f;
#pragma unroll
          for (int e = 0; e < 4; ++e) { o[2 * e] = bflo(ov[e]); o[2 * e + 1] = bfhi(ov[e]); z[2 * e] = bflo(zv[e]); z[2 * e + 1] = bfhi(zv[e]); }
#pragma unroll
          for (int e = 0; e < 8; ++e) ss += o[e] * o[e];
          ss += __shfl_xor(ss, 1); ss += __shfl_xor(ss, 2); ss += __shfl_xor(ss, 4);
          const float rn = 1.0f / sqrtf(ss * (1.0f / 64.0f) + RMS_EPS);
          float y[8];
#pragma unroll
          for (int e = 0; e < 8; ++e) y[e] = o[e] * rn * gdn[e] * silu_acc(z[e]);
          v4u w; w.x = pk2(y[0], y[1]); w.y = pk2(y[2], y[3]); w.z = pk2(y[4], y[5]); w.w = pk2(y[6], y[7]);
          *(v4u*)(AA + (size_t)m * 512 + lane * 8) = w; }
        { const int hd = lane >> 4, e0 = (lane & 15) * 8;
          const v4u a1 = *(const v4u*)(QO + (size_t)m * 1024 + hd * 256 + e0), a2 = *(const v4u*)(QO + (size_t)m * 1024 + hd * 256 + 128 + e0);
          float o[8]; float ss = 0.f;
#pragma unroll
          for (int e = 0; e < 4; ++e) { o[2 * e] = bflo(a1[e]) - lam * bflo(a2[e]); o[2 * e + 1] = bfhi(a1[e]) - lam * bfhi(a2[e]); }
#pragma unroll
          for (int e = 0; e < 8; ++e) ss += o[e] * o[e];
          ss += __shfl_xor(ss, 1); ss += __shfl_xor(ss, 2); ss += __shfl_xor(ss, 4); ss += __shfl_xor(ss, 8);
          const float rn = 1.0f / sqrtf(ss * (1.0f / 128.0f) + SUBLN_EPS);
          float y[8];
#pragma unroll
          for (int e = 0; e < 8; ++e) y[e] = o[e] * rn * gsub[e];
          v4u w; w.x = pk2(y[0], y[1]); w.y = pk2(y[2], y[3]); w.z = pk2(y[4], y[5]); w.w = pk2(y[6], y[7]);
          *(v4u*)(ABB + (size_t)m * 512 + hd * 128 + e0) = w; }
    }
}
__device__ __forceinline__ void final_norm_rows(Ctx& F) {
    const int lane = lane_id();
    const int gw = F.vcu * NWAVES + F.wave, NGW = F.G * NWAVES;
    const f32x4* gp = (const f32x4*)F.in[23] + lane; f32x4 gg[4];
#pragma unroll
    for (int j = 0; j < 4; ++j) gg[j] = gp[64 * j];
    for (int m0 = gw; m0 < M; m0 += 4 * NGW) {
        f32x4 v[4][4];
#pragma unroll
        for (int q = 0; q < 4; ++q) { const int m = m0 + q * NGW; if (m < M) { const f32x4* xr = (const f32x4*)(F.out + (size_t)m * D) + lane;
#pragma unroll
            for (int j = 0; j < 4; ++j) v[q][j] = xr[64 * j]; } }
#pragma unroll
        for (int q = 0; q < 4; ++q) { const int m = m0 + q * NGW; if (m < M) { f32x4* xr = (f32x4*)(F.out + (size_t)m * D) + lane; float s = 0.f;
#pragma unroll
            for (int j = 0; j < 4; ++j) s += (v[q][j].x * v[q][j].x + v[q][j].y * v[q][j].y) + (v[q][j].z * v[q][j].z + v[q][j].w * v[q][j].w);
            const float rn = 1.0f / sqrtf(wave_sum(s) * (1.0f / D) + RMS_EPS);
#pragma unroll
            for (int j = 0; j < 4; ++j) xr[64 * j] = v[q][j] * rn * gg[j]; } }
    }
}

constexpr int N_PHASES = 14;
struct Args { const float* in[24]; float* out; unsigned char* ws; int ph_lo, ph_hi; };
__global__ void __launch_bounds__(NWAVES * 64, 2) mk_fwd(Args args) {
    extern __shared__ __attribute__((aligned(16))) unsigned char lds[];
    Ctx F;
    F.in = args.in;
    F.out = args.out; F.ws = args.ws;
    F.lds = (LAS unsigned char*)lds;
    F.wave = __builtin_amdgcn_readfirstlane((int)threadIdx.x >> 6);
    F.G = gridDim.x; { const int bx = blockIdx.x; F.vcu = (F.G % 8 == 0) ? (bx % 8) * (F.G / 8) + bx / 8 : bx; }
    const int lo = args.ph_lo, hi = args.ph_hi;
    { volatile LAS unsigned* misc = (volatile LAS unsigned*)(F.lds + MISC_OFF); if (F.wave == 0) misc[lane_id()] = 0u; }
    __syncthreads();
    XcdBarrier bar = xcd_barrier_post((unsigned*)(args.ws + WS_CTL) + CW_BAR, (volatile LAS unsigned*)(F.lds + MISC_OFF) + 8, F.wave);
    if (lo < -7) cg::this_grid().sync();
    unsigned char* ws = F.ws;
    typedef pg8::bf16_t pb;
#ifndef PH_MASK
#define PH_MASK 0x3fff
#endif
#define IN(k) (((PH_MASK >> (k)) & 1) && lo <= (k) && (k) < hi)
#ifndef PROBE_A
#define PROBE_A -1
#endif
#ifndef PROBE_B
#define PROBE_B -1
#endif
#define STAMP(k) do { if (PROBE_A >= 0 && blockIdx.x == 0 && F.wave == 0 && lane_id() == 0) ((volatile unsigned long long*)(args.ws + WS_CTL + 32768))[k] = __builtin_amdgcn_s_memrealtime(); } while (0)
#define SEAM(k) do { if (IN(k) && IN((k) + 1)) xcd_barrier(bar); STAMP((k) + 1); } while (0)

    STAMP(0);
    if (IN(0)) { p0_prologue(F); } SEAM(0);
    if (IN(1)) { pg8::Gemm g{(const pb*)(ws + WS_XB), (const pb*)(ws + WS_WGU1), M, 2 * FF, D}; pg8::StaticOrder S; S.init(M, 2 * FF, F.G, (int)blockIdx.x);
        pg8::EpiSwiGLU E{(pb*)(ws + WS_H), FF, (const float*)(ws + WS_SSQA), RMS_EPS};
        pg8::gemm_phase<pg8::EpiSwiGLU, pg8::StaticOrder, true, true>(F.lds + RING_OFF, g, S, E, F.wave); } SEAM(1);
    if (IN(2)) { pg8::Gemm g{(const pb*)(ws + WS_H), (const pb*)(ws + WS_WD1), M, D, FF}; pg8::StaticOrder S; S.init(M, D, F.G, (int)blockIdx.x);
        pg8::EpiResid E{F.in[0], F.out, (pb*)(ws + WS_XB), (float*)(ws + WS_SSQB), 0.5f};
        pg8::gemm_phase<pg8::EpiResid, pg8::StaticOrder, true, true>(F.lds + RING_OFF, g, S, E, F.wave); } SEAM(2);
    if (IN(3)) { pg8::Gemm g{(const pb*)(ws + WS_XB), (const pb*)(ws + WS_WIN), M, WIN_N, D}; pg8::StaticOrder S; S.init(M, WIN_N, F.G, (int)blockIdx.x);
        pg8::EpiWin E{(pb*)(ws + WS_PRE), (pb*)(ws + WS_Z), (pb*)(ws + WS_QO), (pb*)(ws + WS_KD), (pb*)(ws + WS_VD), (float*)(ws + WS_AB), (const float*)(ws + WS_SSQB), RMS_EPS, attn_body::C2};
        pg8::gemm_phase<pg8::EpiWin, pg8::StaticOrder, true, true>(F.lds + RING_OFF, g, S, E, F.wave); } SEAM(3);
    if (IN(4)) { LAS unsigned char* scr = F.lds + RING_OFF + F.wave * 18432; const int gw = F.vcu * NWAVES + F.wave, NGW = F.G * NWAVES;
        for (int ch = gw; ch < 2048; ch += NGW) dn_prep_chunk(F, ch, scr, hi);
        qk_norm_max(F); } SEAM(4);
    if (IN(5)) {
        if (blockIdx.x < 16) dn_scan_block(F, (int)blockIdx.x);
        const attn_body::AttnTensors AT{(const attn_body::bf16*)(ws + WS_QO), (const attn_body::bf16*)(ws + WS_KD), (const attn_body::bf16*)(ws + WS_VD), (attn_body::bf16*)(ws + WS_QO), (const unsigned*)(ws + WS_CTL) + CW_NMAX};
        const attn_body::DynOrder S{(unsigned*)(ws + WS_CTL) + CW_ATTQ, (volatile LAS unsigned*)(F.lds + MISC_OFF) + 16, (int)(blockIdx.x & 7), F.wave};
        attn_body::attn_phase<attn_body::DynOrder>((char*)lds + RING_OFF, AT, S, F.wave); } SEAM(5);
    if (IN(7)) { finalize_rows(F); conv_ffn2(F); } SEAM(7);
    if (IN(8)) { pg8::StaticOrder S; S.init(M, D, F.G, (int)blockIdx.x);
        { pg8::Gemm g{(const pb*)(ws + WS_AA), (const pb*)(ws + WS_WA), M, D, 512}; pg8::EpiStoreBf16 E{(pb*)(ws + WS_YA), D};
          pg8::gemm_phase<pg8::EpiStoreBf16, pg8::StaticOrder, true, true>(F.lds + RING_OFF, g, S, E, F.wave); }
        { pg8::Gemm g{(const pb*)(ws + WS_ABB), (const pb*)(ws + WS_WB), M, D, 512}; pg8::EpiStoreBf16 E{(pb*)(ws + WS_YB), D};
          pg8::gemm_phase<pg8::EpiStoreBf16, pg8::StaticOrder, true, true>(F.lds + RING_OFF, g, S, E, F.wave); } } SEAM(8);
    if (IN(9)) { pg8::Gemm g{(const pb*)(ws + WS_XB), (const pb*)(ws + WS_WG), M, 2 * D, D}; pg8::StaticOrder S; S.init(M, 2 * D, F.G, (int)blockIdx.x);
        pg8::EpiGateMerge E{(const pb*)(ws + WS_YA), (const pb*)(ws + WS_YB), (pb*)(ws + WS_MG), (const float*)(ws + WS_SSQB), RMS_EPS};
        pg8::gemm_phase<pg8::EpiGateMerge, pg8::StaticOrder, true, true>(F.lds + RING_OFF, g, S, E, F.wave); } SEAM(9);
    if (IN(10)) { pg8::Gemm g{(const pb*)(ws + WS_MG), (const pb*)(ws + WS_WOUT), M, D, D}; pg8::StaticOrder S; S.init(M, D, F.G, (int)blockIdx.x);
        pg8::EpiResid E{F.out, F.out, (pb*)(ws + WS_XB), (float*)(ws + WS_SSQA), 1.0f};
        pg8::gemm_phase<pg8::EpiResid, pg8::StaticOrder, true, true>(F.lds + RING_OFF, g, S, E, F.wave); } SEAM(10);
    if (IN(11)) { pg8::Gemm g{(const pb*)(ws + WS_XB), (const pb*)(ws + WS_WGU2), M, 2 * FF, D}; pg8::StaticOrder S; S.init(M, 2 * FF, F.G, (int)blockIdx.x);
        pg8::EpiSwiGLU E{(pb*)(ws + WS_H), FF, (const float*)(ws + WS_SSQA), RMS_EPS};
        pg8::gemm_phase<pg8::EpiSwiGLU, pg8::StaticOrder, true, true>(F.lds + RING_OFF, g, S, E, F.wave); } SEAM(11);
    if (IN(12)) { pg8::Gemm g{(const pb*)(ws + WS_H), (const pb*)(ws + WS_WD2), M, D, FF}; pg8::StaticOrder S; S.init(M, D, F.G, (int)blockIdx.x);
        pg8::EpiResid E{F.out, F.out, (pb*)(ws + WS_XB), (float*)(ws + WS_SSQB), 0.5f};
        pg8::gemm_phase<pg8::EpiResid, pg8::StaticOrder, true, true>(F.lds + RING_OFF, g, S, E, F.wave); } SEAM(12);
    if (IN(13)) { final_norm_rows(F); } STAMP(14);
    if (PROBE_A >= 0) {
        xcd_barrier(bar);
        if (blockIdx.x == 0 && F.wave == 0) { volatile unsigned long long* ts = (volatile unsigned long long*)(args.ws + WS_CTL + 32768); const int l = lane_id();
            const float da = (float)(ts[PROBE_A + 1] - ts[PROBE_A]) * 0.01f, db = (float)(ts[PROBE_B + 1] - ts[PROBE_B]) * 0.01f;
            for (int i = l; i < 16384; i += 64) F.out[(size_t)i * 1024 + 512] = db;
            if (l == 0) F.out[0] = da; }
    }
#undef IN
#undef SEAM
}

#ifndef MK_N_LAUNCHES
#define MK_N_LAUNCHES 1
#endif
extern "C" void kernel_launch(void* const* d_in, const int* in_sizes, int n_in, void* d_out, int out_size, void* d_ws, size_t ws_size, hipStream_t stream) {
    static int grid = 0;
    if (grid == 0) {
        if (n_in != 24 || in_sizes[0] != M * D || out_size != M * D || ws_size < WS_END) { fprintf(stderr, "kernel_launch: unexpected shapes (n_in %d, in0 %d, out %d, ws %zu)\n", n_in, n_in > 0 ? in_sizes[0] : -1, out_size, ws_size); grid = -1; return; }
        int dev = 0, cus = 0, per_cu = 0;
        if (hipGetDevice(&dev) != hipSuccess || hipDeviceGetAttribute(&cus, hipDeviceAttributeMultiprocessorCount, dev) != hipSuccess) { grid = -1; return; }
        if (hipFuncSetAttribute((const void*)mk_fwd, hipFuncAttributeMaxDynamicSharedMemorySize, LDS_BYTES) != hipSuccess) { fprintf(stderr, "kernel_launch: hipFuncSetAttribute failed\n"); grid = -1; return; }
        if (hipOccupancyMaxActiveBlocksPerMultiprocessor(&per_cu, (const void*)mk_fwd, NWAVES * 64, LDS_BYTES) != hipSuccess || per_cu < 1) { fprintf(stderr, "kernel_launch: occupancy query says %d\n", per_cu); per_cu = 1; }
        (void)hipGetLastError();
        grid = cus;
    }
    if (grid < 0) return;
    if (hipMemsetAsync((char*)d_ws + WS_CTL, 0, CTL_ZERO_BYTES, stream) != hipSuccess) { fprintf(stderr, "kernel_launch: hipMemsetAsync failed\n"); return; }
    Args a{};
    for (int i = 0; i < 24; ++i) a.in[i] = (const float*)d_in[i];
    a.out = (float*)d_out; a.ws = (unsigned char*)d_ws;
#if MK_N_LAUNCHES == 1
    a.ph_lo = 0; a.ph_hi = N_PHASES;
    void* kargs[] = {&a};
    hipError_t e = hipLaunchCooperativeKernel((const void*)mk_fwd, dim3(grid), dim3(NWAVES * 64), kargs, LDS_BYTES, stream);
    if (e != hipSuccess) fprintf(stderr, "kernel_launch: cooperative launch failed: %s (grid %d)\n", hipGetErrorString(e), grid);
#else
    for (int p = 0; p < N_PHASES; ++p) { a.ph_lo = p; a.ph_hi = p + 1; hipLaunchKernelGGL(mk_fwd, dim3(grid), dim3(NWAVES * 64), LDS_BYTES, stream, a); }
#endif
}
```

```cpp
#include <hip/hip_runtime.h>
#include <hip/hip_cooperative_groups.h>
#include <cstdio>
#include <cstdint>
namespace cg = cooperative_groups;
__device__ __forceinline__ int lane_id() { int l = (int)__builtin_amdgcn_mbcnt_hi(~0u, __builtin_amdgcn_mbcnt_lo(~0u, 0u)); asm volatile("" : "+v"(l)); return l; }
namespace pg8 {
#define PG8_LAS __attribute__((address_space(3)))
typedef unsigned short bf16_t;
typedef short bf16x8 __attribute__((ext_vector_type(8)));
typedef float f32x4 __attribute__((ext_vector_type(4)));
typedef unsigned u32x4 __attribute__((ext_vector_type(4)));
constexpr int BM = 256, BK = 64, HALF = 128, HTB = HALF * BK * 2  , STAGE_BYTES = 8 * HTB, NXCD = 8, WGM = 8;

__host__ __device__ __forceinline__ int lds_byte(int r, int c) { const int st = (r >> 4) * 2 + (c >> 5), rr = r & 15, cc = c & 31, ob = rr * 64 + cc * 2; return st * 1024 + (ob ^ (((ob >> 9) & 1) << 5)); }
__host__ __device__ __forceinline__ void stage_rc(int b, int& R, int& C) { const int st = b / 1024, sb = b % 1024, swz = sb ^ (((sb >> 9) & 1) << 5); R = (st >> 1) * 16 + swz / 64; C = (st & 1) * 32 + (swz % 64) / 2; }
__host__ __device__ __forceinline__ int perm32(int rho) { const int n = rho >> 4, i = rho & 15; return 8 * (i >> 2) + 4 * n + (i & 3); }

struct Unit { int pm, pn; };
struct Gemm { const bf16_t* A; const bf16_t* Bt; int M, N, K; };

struct StaticOrder {
    int nM, nN, nwg, G, c;
    __host__ __device__ void init(int M, int N, int G_, int c_) { nM = M / BM; nN = N / BM; nwg = nM * nN; G = G_; c = c_; }
    __host__ __device__ bool next(int i, Unit& u) const {
        const long L = (long)i * G + c; if (L >= nwg) return false;
        int wgid = (int)L; { const int q = nwg / NXCD, r = nwg % NXCD, xcd = wgid % NXCD, off = wgid / NXCD; wgid = (xcd < r ? xcd * (q + 1) : r * (q + 1) + (xcd - r) * q) + off; }
        const int nig = WGM * nN, gid = wgid / nig, fm = gid * WGM, gsz = (nM - fm) < WGM ? (nM - fm) : WGM;
        u.pm = fm + ((wgid % nig) % gsz); u.pn = (wgid % nig) / gsz; return true;
    }
    __device__ __forceinline__ void a_ready(const Unit&) const {}
    __device__ __forceinline__ void done(const Unit&) const {}
};

__device__ __forceinline__ unsigned cvt_pk_bf16(float lo, float hi) { unsigned r; asm volatile("v_cvt_pk_bf16_f32 %0, %1, %2" : "=v"(r) : "v"(lo), "v"(hi)); return r; }
__device__ __forceinline__ float fast_sigmoid(float v) { return __builtin_amdgcn_rcpf(1.0f + __builtin_amdgcn_exp2f(-1.4426950408889634f * v)); }
__device__ __forceinline__ float fast_silu(float v) { return v * fast_sigmoid(v); }
__device__ __forceinline__ void load_rs(float (&rs)[2][4], const float* ssq, int row0, float eps) {
#pragma unroll
    for (int ai = 0; ai < 2; ++ai)
#pragma unroll
        for (int m = 0; m < 4; ++m) { const f32x4* p = (const f32x4*)(ssq + (size_t)(row0 + ai * HALF + m * 16) * 16); const f32x4 a = p[0], b = p[1], c = p[2], d = p[3];
            const float s = ((a[0] + a[1]) + (a[2] + a[3])) + ((b[0] + b[1]) + (b[2] + b[3])) + ((c[0] + c[1]) + (c[2] + c[3])) + ((d[0] + d[1]) + (d[2] + d[3]));
            rs[ai][m] = 1.0f / sqrtf(s * (1.0f / 1024.0f) + eps); }
}
struct EpiSwiGLU {
    static constexpr bool PERM = true, AFTER_DRAIN = false;
    bf16_t* H; int ldh; const float* ssq; float eps;
    __device__ __forceinline__ void operator()(const f32x4 (&acc)[2][2][4][2], const Unit& u, int wr, int wc, int fr, int fq) const {
        const int row0 = u.pm * BM + wr * 64 + fr, col0 = u.pn * HALF + wc * 32 + 8 * fq;
        float rs[2][4]; load_rs(rs, ssq, row0, eps);
#pragma unroll
        for (int ai = 0; ai < 2; ++ai)
#pragma unroll
            for (int m = 0; m < 4; ++m) { bf16_t* rowp = H + (size_t)(row0 + ai * HALF + m * 16) * ldh + col0; const float s = rs[ai][m];
                float h[8];
#pragma unroll
                for (int n = 0; n < 2; ++n)
#pragma unroll
                    for (int j = 0; j < 4; ++j) h[n * 4 + j] = fast_silu(acc[ai][0][m][n][j] * s) * (acc[ai][1][m][n][j] * s);
                u32x4 w; w.x = cvt_pk_bf16(h[0], h[1]); w.y = cvt_pk_bf16(h[2], h[3]); w.z = cvt_pk_bf16(h[4], h[5]); w.w = cvt_pk_bf16(h[6], h[7]);
                *(u32x4*)rowp = w; }
    }
};
struct EpiResid {
    static constexpr bool PERM = false, AFTER_DRAIN = false;
    const float* base; float* out; bf16_t* xb; float* ssq_out; float scale;
    __device__ __forceinline__ void operator()(const f32x4 (&acc)[2][2][4][2], const Unit& u, int wr, int wc, int fr, int fq) const {
        typedef unsigned u32x2v __attribute__((ext_vector_type(2)));
        const int row0 = u.pm * BM + wr * 64 + fr, col0 = u.pn * BM + wc * 32 + 4 * fq;
#pragma unroll
        for (int ai = 0; ai < 2; ++ai)
#pragma unroll
            for (int m = 0; m < 4; ++m) { const int row = row0 + ai * HALF + m * 16; const size_t off = (size_t)row * 1024 + col0; float ss = 0.f;
#pragma unroll
                for (int bj = 0; bj < 2; ++bj)
#pragma unroll
                    for (int n = 0; n < 2; ++n) { const f32x4 bs = *(const f32x4*)(base + off + bj * HALF + n * 16); const f32x4 o = bs + acc[ai][bj][m][n] * scale;
                        *(f32x4*)(out + off + bj * HALF + n * 16) = o; ss += (o[0] * o[0] + o[1] * o[1]) + (o[2] * o[2] + o[3] * o[3]);
                        u32x2v w; w.x = cvt_pk_bf16(o[0], o[1]); w.y = cvt_pk_bf16(o[2], o[3]); *(u32x2v*)(xb + off + bj * HALF + n * 16) = w; }
                ss += __shfl_xor(ss, 16); ss += __shfl_xor(ss, 32);
                if (fq == 0) ssq_out[(size_t)row * 16 + u.pn * 4 + wc] = ss; }
    }
};
struct EpiStoreBf16 {
    static constexpr bool PERM = true, AFTER_DRAIN = false;
    bf16_t* O; int ldc;
    __device__ __forceinline__ void operator()(const f32x4 (&acc)[2][2][4][2], const Unit& u, int wr, int wc, int fr, int fq) const {
        const int row0 = u.pm * BM + wr * 64 + fr, col0 = u.pn * BM + wc * 32 + 8 * fq;
#pragma unroll
        for (int ai = 0; ai < 2; ++ai)
#pragma unroll
            for (int m = 0; m < 4; ++m) { bf16_t* rowp = O + (size_t)(row0 + ai * HALF + m * 16) * ldc + col0;
#pragma unroll
                for (int bj = 0; bj < 2; ++bj) { const f32x4 v0 = acc[ai][bj][m][0], v1 = acc[ai][bj][m][1];
                    u32x4 w; w.x = cvt_pk_bf16(v0[0], v0[1]); w.y = cvt_pk_bf16(v0[2], v0[3]); w.z = cvt_pk_bf16(v1[0], v1[1]); w.w = cvt_pk_bf16(v1[2], v1[3]);
                    *(u32x4*)(rowp + bj * HALF) = w; } }
    }
};
struct EpiWin {
    static constexpr bool PERM = true, AFTER_DRAIN = false;
    bf16_t *PRE, *Z, *QO, *KD, *VD; float* AB; const float* ssq; float eps, qscale;
    __device__ __forceinline__ void operator()(const f32x4 (&acc)[2][2][4][2], const Unit& u, int wr, int wc, int fr, int fq) const {
        const int row0 = u.pm * BM + wr * 64 + fr, cl0 = wc * 32 + 8 * fq, pn = u.pn;
        float rs[2][4]; load_rs(rs, ssq, row0, eps);
        if (pn == 14) {
            if (wc == 0 && fq < 2) {
#pragma unroll
                for (int ai = 0; ai < 2; ++ai)
#pragma unroll
                    for (int m = 0; m < 4; ++m) { float* rowp = AB + (size_t)(row0 + ai * HALF + m * 16) * 16 + 8 * fq; const float s = rs[ai][m];
                        *(f32x4*)rowp = acc[ai][0][m][0] * s; *(f32x4*)(rowp + 4) = acc[ai][0][m][1] * s; }
            }
            return;
        }
        bf16_t* base; int ld, cb; float sc = 1.f; bool dup = false;
        if (pn < 6) { base = PRE; ld = 1536; cb = pn * 256; }
        else if (pn < 8) { base = Z; ld = 512; cb = (pn - 6) * 256; }
        else if (pn < 10) { base = QO; ld = 1024; cb = (pn - 8) * 256; sc = qscale; dup = true; }
        else if (pn < 12) { base = KD; ld = 512; cb = (pn - 10) * 256; }
        else { base = VD; ld = 512; cb = (pn - 12) * 256; }
#pragma unroll
        for (int ai = 0; ai < 2; ++ai)
#pragma unroll
            for (int m = 0; m < 4; ++m) { const float s = rs[ai][m] * sc; bf16_t* rowp = base + (size_t)(row0 + ai * HALF + m * 16) * ld;
#pragma unroll
                for (int bj = 0; bj < 2; ++bj) { const f32x4 v0 = acc[ai][bj][m][0] * s, v1 = acc[ai][bj][m][1] * s;
                    u32x4 w; w.x = cvt_pk_bf16(v0[0], v0[1]); w.y = cvt_pk_bf16(v0[2], v0[3]); w.z = cvt_pk_bf16(v1[0], v1[1]); w.w = cvt_pk_bf16(v1[2], v1[3]);
                    const int c = cb + bj * HALF + cl0;
                    if (dup) { const int qc = ((c >> 6) * 2) * 64 + (c & 63); *(u32x4*)(rowp + qc) = w; *(u32x4*)(rowp + qc + 64) = w; }
                    else *(u32x4*)(rowp + c) = w; } }
    }
};
struct EpiGateMerge {
    static constexpr bool PERM = true, AFTER_DRAIN = false;
    const bf16_t *YA, *YB; bf16_t* MG; const float* ssq; float eps;
    __device__ __forceinline__ void operator()(const f32x4 (&acc)[2][2][4][2], const Unit& u, int wr, int wc, int fr, int fq) const {
        const int row0 = u.pm * BM + wr * 64 + fr, col0 = u.pn * HALF + wc * 32 + 8 * fq;
        float rs[2][4]; load_rs(rs, ssq, row0, eps);
#pragma unroll
        for (int ai = 0; ai < 2; ++ai)
#pragma unroll
            for (int m = 0; m < 4; ++m) { const size_t off = (size_t)(row0 + ai * HALF + m * 16) * 1024 + col0; const float s = rs[ai][m];
                const u32x4 ya = *(const u32x4*)(YA + off), yb = *(const u32x4*)(YB + off);
                float o[8];
#pragma unroll
                for (int n = 0; n < 2; ++n)
#pragma unroll
                    for (int j = 0; j < 4; ++j) { const int e = n * 4 + j; const unsigned wa = ya[e >> 1], wb = yb[e >> 1];
                        const float fa = __uint_as_float((e & 1) ? (wa & 0xffff0000u) : (wa << 16)), fb = __uint_as_float((e & 1) ? (wb & 0xffff0000u) : (wb << 16));
                        o[e] = fast_sigmoid(acc[ai][0][m][n][j] * s) * fa + fast_sigmoid(acc[ai][1][m][n][j] * s) * fb; }
                u32x4 w; w.x = cvt_pk_bf16(o[0], o[1]); w.y = cvt_pk_bf16(o[2], o[3]); w.z = cvt_pk_bf16(o[4], o[5]); w.w = cvt_pk_bf16(o[6], o[7]);
                *(u32x4*)(MG + off) = w; }
    }
};

template <class Epi, class Sched, bool ALIGN_EPI = false, bool SP2 = false>
__device__ __forceinline__ void gemm_phase(PG8_LAS unsigned char* lds, const Gemm g, const Sched& S, const Epi& E, const int wave_id) {
    const int wid = wave_id, lane = lane_id(), tid = wid * 64 + lane, wr = wid >> 2, wc = wid & 3, fr = lane & 15, fq = lane >> 4;
    const int K = g.K, nt = K / BK;
    unsigned voffA[2], voffB[2];
#pragma unroll
    for (int i = 0; i < 2; ++i) { int R, C; stage_rc(tid * 16 + i * 8192, R, C); const int Rb = Epi::PERM ? ((R & ~31) + perm32(R & 31)) : R;
        voffA[i] = (unsigned)(R * K + C) * 2u; voffB[i] = (unsigned)(Rb * K + C) * 2u; }
    const size_t kstep = (size_t)(BK * 2);
    const size_t hstep = (size_t)HALF * K * 2;
    const size_t tstep = 2 * hstep;
    const unsigned ldsw = (unsigned)wid * 1024u;
    const int aoff = lds_byte(wr * 64 + fr, fq * 8), boff = lds_byte(wc * 32 + fr, fq * 8);
#define PG8_SA(b, h) (((b) * 2 + (h)) * HTB)
#define PG8_SB(b, h) ((4 + (b) * 2 + (h)) * HTB)
#define PG8_STAGE(bufoff, gbase, voff) do { _Pragma("unroll") for (int _i = 0; _i < 2; ++_i) \
        __builtin_amdgcn_global_load_lds((const unsigned*)((const char*)(gbase) + (voff)[_i]), (PG8_LAS unsigned*)(lds + (bufoff) + ldsw + _i * 8192), 16, 0, 0); } while (0)
#define PG8_LDA(dst, b, h) do { _Pragma("unroll") for (int m = 0; m < 4; ++m) _Pragma("unroll") for (int k = 0; k < 2; ++k) dst[m][k] = *(const PG8_LAS bf16x8*)(lds + PG8_SA(b, h) + aoff + m * 2048 + k * 1024); } while (0)
#define PG8_LDB(dst, b, h) do { _Pragma("unroll") for (int n = 0; n < 2; ++n) _Pragma("unroll") for (int k = 0; k < 2; ++k) dst[n][k] = *(const PG8_LAS bf16x8*)(lds + PG8_SB(b, h) + boff + n * 2048 + k * 1024); } while (0)
#define PG8_MMA(ai, bj, At, Bt) do { __builtin_amdgcn_s_setprio(1); _Pragma("unroll") for (int m = 0; m < 4; ++m) _Pragma("unroll") for (int n = 0; n < 2; ++n) _Pragma("unroll") for (int k = 0; k < 2; ++k) \
        acc[ai][bj][m][n] = __builtin_amdgcn_mfma_f32_16x16x32_bf16(Bt[n][k], At[m][k], acc[ai][bj][m][n], 0, 0, 0); __builtin_amdgcn_s_setprio(0); } while (0)
#define PG8_WAIT_V(n) asm volatile("s_waitcnt vmcnt(" #n ")" ::: "memory")
#define PG8_WAIT_L(n) asm volatile("s_waitcnt lgkmcnt(" #n ")" ::: "memory")
#define PG8_BAR __builtin_amdgcn_s_barrier()
#define PG8_SCHED __builtin_amdgcn_sched_barrier(0)
    Unit cur, nxt; int ui = 0;
    if (!S.next(0, cur)) return;
    f32x4 acc[2][2][4][2];
#pragma unroll
    for (int a = 0; a < 2; ++a)
#pragma unroll
        for (int b = 0; b < 2; ++b)
#pragma unroll
            for (int m = 0; m < 4; ++m)
#pragma unroll
                for (int n = 0; n < 2; ++n) acc[a][b][m][n] = (f32x4){0.f, 0.f, 0.f, 0.f};
    bf16x8 At[4][2], B0[2][2], B1[2][2];
    const char* cA = (const char*)g.A + (size_t)cur.pm * tstep; const char* cB = (const char*)g.Bt + (size_t)cur.pn * tstep;
    S.a_ready(cur);
    if constexpr (SP2) {
        PG8_STAGE(PG8_SB(0, 0), cB, voffB); PG8_STAGE(PG8_SB(0, 1), cB + hstep, voffB); PG8_STAGE(PG8_SA(0, 0), cA, voffA); PG8_STAGE(PG8_SA(0, 1), cA + hstep, voffA);
        if (wr == 1) PG8_BAR;
        PG8_WAIT_V(2); PG8_BAR;
        PG8_STAGE(PG8_SB(1, 0), cB + kstep, voffB); PG8_STAGE(PG8_SA(1, 0), cA + kstep, voffA); PG8_STAGE(PG8_SB(1, 1), cB + hstep + kstep, voffB);
        PG8_WAIT_V(6); PG8_BAR;
    } else {
        PG8_STAGE(PG8_SB(0, 0), cB, voffB); PG8_STAGE(PG8_SA(0, 0), cA, voffA); PG8_STAGE(PG8_SB(0, 1), cB + hstep, voffB); PG8_STAGE(PG8_SA(0, 1), cA + hstep, voffA);
        if (wr == 1) PG8_BAR;
        PG8_WAIT_V(4); PG8_BAR;
        PG8_STAGE(PG8_SB(1, 0), cB + kstep, voffB); PG8_STAGE(PG8_SA(1, 0), cA + kstep, voffA); PG8_STAGE(PG8_SB(1, 1), cB + hstep + kstep, voffB);
        PG8_WAIT_V(6); PG8_BAR;
    }
    for (;;) {
        const bool has_next = S.next(ui + 1, nxt);
        const char* nA = has_next ? (const char*)g.A + (size_t)nxt.pm * tstep : cA; const char* nB = has_next ? (const char*)g.Bt + (size_t)nxt.pn * tstep : cB;
        for (int t = 0; t < nt; t += 2) {
            const bool last = (t == nt - 2);
            const char* a1 = cA + (size_t)(t + 1) * kstep;
            const char* a2 = last ? nA : cA + (size_t)(t + 2) * kstep; const char* b2 = last ? nB : cB + (size_t)(t + 2) * kstep;
            const char* a3 = a2 + kstep; const char* b3 = b2 + kstep;
            if (last && has_next) S.a_ready(nxt);
            if constexpr (SP2) {
            PG8_LDB(B0, 0, 0); PG8_LDB(B1, 0, 1); PG8_SCHED; PG8_LDA(At, 0, 0); PG8_STAGE(PG8_SA(1, 1), a1 + hstep, voffA);
            PG8_WAIT_V(8); PG8_WAIT_L(0); PG8_BAR; PG8_MMA(0, 0, At, B0); PG8_MMA(0, 1, At, B1); PG8_BAR; PG8_SCHED;
            PG8_LDA(At, 0, 1); PG8_STAGE(PG8_SB(0, 0), b2, voffB); PG8_STAGE(PG8_SB(0, 1), b2 + hstep, voffB); PG8_STAGE(PG8_SA(0, 0), a2, voffA);
            PG8_WAIT_V(8); PG8_WAIT_L(0); PG8_BAR; PG8_MMA(1, 0, At, B0); PG8_MMA(1, 1, At, B1); PG8_BAR; PG8_SCHED;
            PG8_LDB(B0, 1, 0); PG8_LDB(B1, 1, 1); PG8_SCHED; PG8_LDA(At, 1, 0); PG8_STAGE(PG8_SA(0, 1), a2 + hstep, voffA);
            PG8_WAIT_V(8); PG8_WAIT_L(0); PG8_BAR; PG8_MMA(0, 0, At, B0); PG8_MMA(0, 1, At, B1); PG8_BAR; PG8_SCHED;
            PG8_LDA(At, 1, 1); PG8_STAGE(PG8_SB(1, 0), b3, voffB); PG8_STAGE(PG8_SB(1, 1), b3 + hstep, voffB); PG8_STAGE(PG8_SA(1, 0), a3, voffA);
            PG8_WAIT_V(8); PG8_WAIT_L(0); PG8_BAR; PG8_MMA(1, 0, At, B0); PG8_MMA(1, 1, At, B1); PG8_BAR; PG8_SCHED;
            } else {
            PG8_LDB(B0, 0, 0); PG8_SCHED; PG8_LDA(At, 0, 0); PG8_STAGE(PG8_SA(1, 1), a1 + hstep, voffA);
            PG8_WAIT_L(8); PG8_BAR; PG8_WAIT_L(0); PG8_MMA(0, 0, At, B0); PG8_BAR; PG8_SCHED;
            PG8_LDB(B1, 0, 1); PG8_STAGE(PG8_SB(0, 0), b2, voffB);
            PG8_BAR; PG8_WAIT_L(0); PG8_MMA(0, 1, At, B1); PG8_BAR;
            PG8_LDA(At, 0, 1); PG8_STAGE(PG8_SA(0, 0), a2, voffA);
            PG8_BAR; PG8_WAIT_L(0); PG8_MMA(1, 0, At, B0); PG8_BAR; PG8_SCHED;
            PG8_STAGE(PG8_SB(0, 1), b2 + hstep, voffB);
            PG8_WAIT_V(6); PG8_BAR; PG8_MMA(1, 1, At, B1); PG8_BAR;
            PG8_LDB(B0, 1, 0); PG8_SCHED; PG8_LDA(At, 1, 0); PG8_STAGE(PG8_SA(0, 1), a2 + hstep, voffA);
            PG8_WAIT_L(8); PG8_BAR; PG8_WAIT_L(0); PG8_MMA(0, 0, At, B0); PG8_BAR; PG8_SCHED;
            PG8_LDB(B1, 1, 1); PG8_STAGE(PG8_SB(1, 0), b3, voffB);
            PG8_BAR; PG8_WAIT_L(0); PG8_MMA(0, 1, At, B1); PG8_BAR;
            PG8_LDA(At, 1, 1); PG8_STAGE(PG8_SA(1, 0), a3, voffA);
            PG8_BAR; PG8_WAIT_L(0); PG8_MMA(1, 0, At, B0); PG8_BAR; PG8_SCHED;
            PG8_STAGE(PG8_SB(1, 1), b3 + hstep, voffB);
            PG8_WAIT_V(6); PG8_BAR; PG8_MMA(1, 1, At, B1); PG8_BAR;
            }
        }
        if constexpr (ALIGN_EPI) { if (wr == 0) PG8_BAR; }
        if constexpr (!Epi::AFTER_DRAIN) { E(acc, cur, wr, wc, fr, fq); S.done(cur); }
        if (!has_next) break;
#pragma unroll
        for (int a = 0; a < 2; ++a)
#pragma unroll
            for (int b = 0; b < 2; ++b)
#pragma unroll
                for (int m = 0; m < 4; ++m)
#pragma unroll
                    for (int n = 0; n < 2; ++n) acc[a][b][m][n] = (f32x4){0.f, 0.f, 0.f, 0.f};
        cur = nxt; cA = nA; cB = nB; ++ui;
        if constexpr (ALIGN_EPI) { if (wr == 1) PG8_BAR; }
    }
    PG8_WAIT_V(0);
    if constexpr (!ALIGN_EPI) { if (wr == 0) PG8_BAR; }
    PG8_BAR;
    if constexpr (Epi::AFTER_DRAIN) { E.fused(acc, cur, wr, wc, fr, fq, lds, wid, lane); S.done(cur); }
#undef PG8_SA
#undef PG8_SB
#undef PG8_STAGE
#undef PG8_LDA
#undef PG8_LDB
#undef PG8_MMA
#undef PG8_WAIT_V
#undef PG8_WAIT_L
#undef PG8_BAR
#undef PG8_SCHED
}
}
#include <hip/hip_bf16.h>
#include <cmath>
namespace attn_body {
using bf16=__hip_bfloat16;
using bf16x8=__attribute__((ext_vector_type(8)))short;
using s16x4=__attribute__((ext_vector_type(4)))short;
using f32x16=__attribute__((ext_vector_type(16)))float;
using u32x4=__attribute__((ext_vector_type(4)))unsigned;
constexpr int BATCH=2,NHEAD=16,SEQ=8192,D=64,DM=NHEAD*D,KP=512;
constexpr int NW=8,QBLK=32,QB=QBLK*NW,KVBLK=64,NQB=SEQ/QB;
constexpr int ATTN_PITCH=DM, ATTN_UNIT_ROWS=QB;
__device__ __forceinline__ int crow(int r,int hi){return (r&3)+8*(r>>2)+4*hi;}
#define SBAR() __builtin_amdgcn_sched_barrier(0)
__device__ __forceinline__ void cmask(f32x16&p0,f32x16&p1,int jb,int qrel,int hi){
  const float NEG=-INFINITY; int lim=qrel-64*jb-4*hi; asm volatile("":"+v"(lim));
  #pragma unroll
  for(int r=0;r<16;++r){const int cr=(r&3)+8*(r>>2); if(cr>lim)p0[r]=NEG; if(cr+32>lim)p1[r]=NEG;}
}

constexpr int NSLOT=3, SLOTB=8192;
constexpr int LDS_K=0, LDS_V=NSLOT*SLOTB, LDS_WS=2*NSLOT*SLOTB, LDS_OST=LDS_WS+NW*64*4, LDS_BYTES=LDS_OST+NW*4096;
constexpr float C2=0.125f*1.4426950408889634f;
__device__ __forceinline__ void glds16(const void*gsrc,unsigned lds_dst){unsigned keep;
  asm volatile("s_mov_b32 %0, m0\n\ts_mov_b32 m0, %2\n\ts_nop 0\n\tglobal_load_lds_dwordx4 %1, off\n\ts_mov_b32 m0, %0":"=&s"(keep):"v"(gsrc),"s"(lds_dst):"memory");}
__device__ __forceinline__ float max3f(float a,float b,float c){float r;asm("v_max3_f32 %0, %1, %2, %3":"=v"(r):"v"(a),"v"(b),"v"(c));return r;}
__device__ __forceinline__ float max2f(float a,float b){float r;asm("v_max_f32_e32 %0, %1, %2":"=v"(r):"v"(a),"v"(b));return r;}
__device__ __forceinline__ float fadd_s(float a,float b){float r;asm("v_add_f32_e32 %0, %1, %2":"=v"(r):"v"(a),"v"(b));return r;}
__device__ __forceinline__ float fsub_s(float a,float b){float r;asm("v_sub_f32_e32 %0, %1, %2":"=v"(r):"v"(a),"v"(b));return r;}
typedef float f32x2_t __attribute__((ext_vector_type(2))); typedef __bf16 bf16x2_t __attribute__((ext_vector_type(2)));
__device__ __forceinline__ unsigned cvtpk_s(float lo,float hi){f32x2_t v={lo,hi};bf16x2_t b=__builtin_convertvector(v,bf16x2_t);return __builtin_bit_cast(unsigned,b);}
#define WAIT_BAR(N) asm volatile("s_waitcnt vmcnt(" #N ") lgkmcnt(0)\n\ts_barrier":::"memory")

__device__ __forceinline__ void qkt(f32x16&p0,f32x16&p1,const char*Kslot,const bf16x8*qr,const f32x16&negm,int r32,int hi){
  const char*kb=Kslot+hi*1024+r32*16;
  #pragma unroll
  for(int d0=0;d0<4;++d0){
    const bf16x8 b0=*reinterpret_cast<const bf16x8*>(kb+d0*2048);
    const bf16x8 b1=*reinterpret_cast<const bf16x8*>(kb+d0*2048+512);
    if(d0==0){p0=__builtin_amdgcn_mfma_f32_32x32x16_bf16(b0,qr[0],negm,0,0,0);p1=__builtin_amdgcn_mfma_f32_32x32x16_bf16(b1,qr[0],negm,0,0,0);}
    else{p0=__builtin_amdgcn_mfma_f32_32x32x16_bf16(b0,qr[d0],p0,0,0,0);p1=__builtin_amdgcn_mfma_f32_32x32x16_bf16(b1,qr[d0],p1,0,0,0);}}
}
typedef __attribute__((address_space(3))) const char* lds_cptr;
typedef short v4i16_t __attribute__((ext_vector_type(4)));
__device__ __forceinline__ void kload8(bf16x8*kf,lds_cptr kp){
  kf[0]=*(const __attribute__((address_space(3))) bf16x8*)(kp);      kf[1]=*(const __attribute__((address_space(3))) bf16x8*)(kp+512);
  kf[2]=*(const __attribute__((address_space(3))) bf16x8*)(kp+2048); kf[3]=*(const __attribute__((address_space(3))) bf16x8*)(kp+2560);
  kf[4]=*(const __attribute__((address_space(3))) bf16x8*)(kp+4096); kf[5]=*(const __attribute__((address_space(3))) bf16x8*)(kp+4608);
  kf[6]=*(const __attribute__((address_space(3))) bf16x8*)(kp+6144); kf[7]=*(const __attribute__((address_space(3))) bf16x8*)(kp+6656);
}
__device__ __forceinline__ void kload2(bf16x8*kf,lds_cptr kp,int j){ kf[2*j]=*(const __attribute__((address_space(3))) bf16x8*)(kp+j*2048); kf[2*j+1]=*(const __attribute__((address_space(3))) bf16x8*)(kp+j*2048+512); }
__device__ __forceinline__ s16x4 vtr(lds_cptr p){ return __builtin_bit_cast(s16x4,__builtin_amdgcn_ds_read_tr16_b64_v4i16((__attribute__((address_space(3))) v4i16_t*)p)); }
__device__ __forceinline__ float rowmax(const f32x16&p0,const f32x16&p1){
  float a=max3f(p0[0],p0[1],p1[0]),b=max3f(p0[2],p0[3],p1[1]);a=max3f(a,p1[2],p1[3]);
  #pragma unroll
  for(int r=4;r<16;r+=4){a=max3f(a,p0[r],p0[r+1]);b=max3f(b,p0[r+2],p0[r+3]);a=max3f(a,p1[r],p1[r+1]);b=max3f(b,p1[r+2],p1[r+3]);}
  const float m=max2f(a,b);
  auto rr=__builtin_amdgcn_permlane32_swap(__float_as_uint(m),__float_as_uint(m),false,false);
  return max2f(__uint_as_float(rr[0]),__uint_as_float(rr[1]));
}
__device__ __forceinline__ void pv(f32x16*o,int vb,bf16x8 pa0,bf16x8 pa1,bf16x8 pa2,bf16x8 pa3){
  #pragma unroll
  for(int d0=0;d0<2;++d0){s16x4 lo[4],hi[4];
    #pragma unroll
    for(int ks=0;ks<4;++ks){
      asm volatile("ds_read_b64_tr_b16 %0,%1 offset:%c2":"=&v"(lo[ks]):"v"(vb),"i"(d0*4096+ks*1024):"memory");
      asm volatile("ds_read_b64_tr_b16 %0,%1 offset:%c2":"=&v"(hi[ks]):"v"(vb),"i"(d0*4096+ks*1024+512):"memory");}
    asm volatile("s_waitcnt lgkmcnt(0)":::"memory");SBAR();
    #define PK(k) (bf16x8){lo[k][0],lo[k][1],lo[k][2],lo[k][3],hi[k][0],hi[k][1],hi[k][2],hi[k][3]}
    o[d0]=__builtin_amdgcn_mfma_f32_32x32x16_bf16(pa0,PK(0),o[d0],0,0,0);
    o[d0]=__builtin_amdgcn_mfma_f32_32x32x16_bf16(pa1,PK(1),o[d0],0,0,0);
    o[d0]=__builtin_amdgcn_mfma_f32_32x32x16_bf16(pa2,PK(2),o[d0],0,0,0);
    o[d0]=__builtin_amdgcn_mfma_f32_32x32x16_bf16(pa3,PK(3),o[d0],0,0,0);
    #undef PK
  }
}

#ifndef ATTN_STORE16
#define ATTN_STORE16(p,v) (*(u32x4*)(p)=(v))
#endif
template<int THRL> __device__ __forceinline__ void attn_unit(int b,int h,int qb,const bf16*Q,const bf16*__restrict__ K,const bf16*__restrict__ V,bf16*O,char*shm,const int wave_id,const unsigned*nmax){
  const int wid=wave_id,lane=lane_id(),tid=wid*64+lane,r32=lane&31,hi=lane>>5;
  const long rowbase=(long)b*SEQ; const int q0=qb*QB;
  const bf16*Qw=Q+(rowbase+q0+wid*QBLK)*DM+h*D;
  int t0=0;
  { const int j=b*8+(h>>1); const float q2=__uint_as_float(__builtin_amdgcn_readfirstlane((int)nmax[j])), k2=__uint_as_float(__builtin_amdgcn_readfirstlane((int)nmax[16+j]));
    const unsigned slb0_=0x3eb8aa3bu-((unsigned)__builtin_amdgcn_readfirstlane(h>>2)<<24);
    const float B2=2.0f*sqrtf(q2*k2)*1.0001f+34.7f, dmin=B2/__uint_as_float(slb0_);
    const float tf=floorf(((float)(q0+1)-dmin)*(1.0f/64.0f)); int tt=(tf>0.f)?(int)tf:0; tt&=~1; const int tmax=(q0+QB)/KVBLK-4; t0=tt<tmax?tt:tmax; t0=__builtin_amdgcn_readfirstlane(t0); }
  const bf16*Kh=K+(rowbase+(long)t0*KVBLK)*KP+(h>>1)*D,*Vh=V+(rowbase+(long)t0*KVBLK)*KP+(h>>2)*128+(h&1)*D;
  const unsigned lds0=(unsigned)(uintptr_t)shm;
  float*wsf=(float*)(shm+LDS_WS)+wid*64;
  const bf16*ksrc=Kh+(long)lane*KP+wid*8;
  const bf16*vsrc=Vh+(long)(16*(wid&3)+(lane>>2))*KP+(wid>>2)*32+(lane&3)*8;
  const unsigned kdst=lds0+LDS_K+wid*1024, vdst=lds0+LDS_V+wid*1024;
  #define DMA_K(t,slot) glds16(ksrc+(long)(t)*KVBLK*KP,(unsigned)__builtin_amdgcn_readfirstlane(kdst+(slot)))
  #define DMA_V(t,slot) glds16(vsrc+(long)(t)*KVBLK*KP,(unsigned)__builtin_amdgcn_readfirstlane(vdst+(slot)))
  const int vb0=(int)(lds0+LDS_V)+((lane>>4)&1)*32+(lane&3)*8+(4*hi+((lane&15)>>2))*64;
  const char*Kbase=shm+LDS_K; bf16x8 kf[8];
  const lds_cptr shm3=(lds_cptr)shm; const lds_cptr kp0=shm3+LDS_K+hi*1024+r32*16; const lds_cptr vp0=shm3+LDS_V+((lane>>4)&1)*32+(lane&3)*8+(4*hi+((lane&15)>>2))*64;
  const int NT=(q0+QB)/KVBLK-t0;
  DMA_K(0,0);DMA_V(0,0);DMA_K(1,SLOTB);
  bf16x8 qr[4];
  #pragma unroll
  for(int d0=0;d0<4;++d0)qr[d0]=*reinterpret_cast<const bf16x8*>(&Qw[(long)r32*DM+d0*16+hi*8]);
  float mhat=0.f,l_reg=0.f;f32x16 o[2];o[0]=f32x16{};o[1]=f32x16{};const f32x16 negm=f32x16{};
  const int qrel=wid*QBLK+r32;
  const unsigned slb_=0x3eb8aa3bu-((unsigned)__builtin_amdgcn_readfirstlane(h>>2)<<24); const float sl2=__uint_as_float(slb_);
  const float qposf=(float)(q0+qrel-4*hi-64*t0);
  const float s1_=sl2, s8_=__uint_as_float(slb_+(3u<<23)), s32_=__uint_as_float(slb_+(5u<<23));
  #define AADD(d,a,sv) asm volatile("v_add_f32_e32 %0, %1, %2":"=v"(d):"s"(sv),"v"(a))
  #define ALIBI(P0,P1,t) do{ float bq_=__builtin_fmaf(sl2,((float)(64*(t))-qposf),-mhat); \
    _Pragma("unroll") for(int q_=0;q_<4;++q_){ float b0_=bq_,b1_,b2_,b3_,c_; AADD(b1_,b0_,s1_); AADD(b2_,b1_,s1_); AADD(b3_,b2_,s1_); \
      P0[4*q_]+=b0_; P0[4*q_+1]+=b1_; P0[4*q_+2]+=b2_; P0[4*q_+3]+=b3_; \
      AADD(c_,b0_,s32_); P1[4*q_]+=c_; AADD(c_,b1_,s32_); P1[4*q_+1]+=c_; AADD(c_,b2_,s32_); P1[4*q_+2]+=c_; AADD(c_,b3_,s32_); P1[4*q_+3]+=c_; \
      if(q_<3){ AADD(bq_,b0_,s8_); } } }while(0)
  #define CMASK(P0,P1,t) do{int jb_=(t)-(NT-4); if(jb_>=0)cmask(P0,P1,jb_,qrel,hi);}while(0)
  bool resc=false;
  #define START(P0,P1) do{ const float rm=rowmax(P0,P1); resc=false; \
    { const float dl=rm; mhat=fadd_s(mhat,dl); \
      _Pragma("unroll") for(int r=0;r<16;++r){P0[r]=fsub_s(P0[r],dl);P1[r]=fsub_s(P1[r],dl);} \
      } \
    _Pragma("unroll") for(int r=0;r<16;++r)P0[r]=__builtin_amdgcn_exp2f(P0[r]); }while(0)
  #define RESC() do{ if(resc){ asm volatile("s_waitcnt lgkmcnt(0)":::"memory"); \
      _Pragma("unroll") for(int d_=0;d_<2;++d_) _Pragma("unroll") for(int r=0;r<16;++r)o[d_][r]*=wsf[crow(r,hi)]; } }while(0)
  f32x16 pA0,pA1,pB0,pB1;
  int sl_prev=0,sl_cur=0,sl_next=SLOTB;
  #define ROT() do{sl_prev=sl_cur;sl_cur=sl_next;sl_next=(sl_next==(NSLOT-1)*SLOTB)?0:sl_next+SLOTB;}while(0)
  DMA_K(2,2*SLOTB);
  WAIT_BAR(3);
  qkt(pA0,pA1,Kbase,qr,negm,r32,hi);asm volatile("s_nop 15\n\ts_nop 7":"+v"(pA0),"+v"(pA1));ALIBI(pA0,pA1,0);CMASK(pA0,pA1,0);
  START(pA0,pA1);
  _Pragma("unroll") for(int r=0;r<16;++r)pA1[r]=__builtin_amdgcn_exp2f(pA1[r]);
  WAIT_BAR(0);
  DMA_K(3,0);DMA_V(1,SLOTB);
  ROT();
  kload8(kf,kp0+sl_cur);
  WAIT_BAR(2);
  s16x4 vlo[8],vhi[8]; u32x4 pw0,pw1,pw2,pw3;
  #define PKW(P,B) cvtpk_s(P[B],P[B+1])
  #define PAF(k) __builtin_bit_cast(bf16x8,pw##k)
  #define VFR(i) (bf16x8){vlo[i][0],vlo[i][1],vlo[i][2],vlo[i][3],vhi[i][0],vhi[i][1],vhi[i][2],vhi[i][3]}
  #define PIN(x) asm volatile("":"+v"(x))
  #define MX3(a,b,c) __builtin_fmaxf(__builtin_fmaxf((a),(b)),(c))
  #define GAPA(MF,A0,A1,A2,A3,W0,W1,PW) do{ MF; sacc+=A0; sacc+=A1; sacc+=A2; sacc+=A3; PIN(sacc); W0; W1; PIN(PW); SBAR(); }while(0)
  #define EX(v) __builtin_amdgcn_exp2f(v)
  #define GAPB(MF,X,B) do{ MF; X[B]=EX(X[B]); X[B+1]=EX(X[B+1]); X[B+2]=EX(X[B+2]); X[B+3]=EX(X[B+3]); PIN(X); SBAR(); }while(0)
  #define VRD(i) do{ vlo[i]=vtr(vp_+(((i)>>2)*4096+((i)&3)*1024)); vhi[i]=vtr(vp_+(((i)>>2)*4096+((i)&3)*1024+512)); }while(0)
  #define KRD(G,j) do{ if(G){ kload2(kf,kp0+sl_next,j); SBAR(); } }while(0)
  #define STEP(C0,C1,P0,P1,t,GK,GV,GL) do{ SBAR(); \
    const lds_cptr vp_=vp0+sl_prev; \
    VRD(0); SBAR(); float sacc=(P0[0]+P0[1]); \
    GAPA(C0=__builtin_amdgcn_mfma_f32_32x32x16_bf16(kf[0],qr[0],negm,0,0,0), P0[2],P0[3],P0[4],P0[5],     pw0[0]=PKW(P0,0), pw0[1]=PKW(P0,2), pw0); \
    VRD(4); SBAR(); GAPA(C1=__builtin_amdgcn_mfma_f32_32x32x16_bf16(kf[1],qr[0],negm,0,0,0), P0[6],P0[7],P0[8],P0[9],     pw0[2]=PKW(P0,4), pw0[3]=PKW(P0,6), pw0); \
    VRD(1); SBAR(); GAPA(C0=__builtin_amdgcn_mfma_f32_32x32x16_bf16(kf[2],qr[1],C0,0,0,0),   P0[10],P0[11],P0[12],P0[13], pw1[0]=PKW(P0,8), pw1[1]=PKW(P0,10), pw1); \
    VRD(5); SBAR(); GAPA(C1=__builtin_amdgcn_mfma_f32_32x32x16_bf16(kf[3],qr[1],C1,0,0,0),   P0[14],P0[15],P1[0],P1[1],   pw1[2]=PKW(P0,12),pw1[3]=PKW(P0,14), pw1); \
    VRD(2); SBAR(); GAPA(C0=__builtin_amdgcn_mfma_f32_32x32x16_bf16(kf[4],qr[2],C0,0,0,0),   P1[2],P1[3],P1[4],P1[5],     pw2[0]=PKW(P1,0), pw2[1]=PKW(P1,2), pw2); \
    VRD(6); SBAR(); GAPA(C1=__builtin_amdgcn_mfma_f32_32x32x16_bf16(kf[5],qr[2],C1,0,0,0),   P1[6],P1[7],P1[8],P1[9],     pw2[2]=PKW(P1,4), pw2[3]=PKW(P1,6), pw2); \
    VRD(3); SBAR(); GAPA(C0=__builtin_amdgcn_mfma_f32_32x32x16_bf16(kf[6],qr[3],C0,0,0,0),   P1[10],P1[11],P1[12],P1[13], pw3[0]=PKW(P1,8), pw3[1]=PKW(P1,10), pw3); \
    VRD(7); SBAR(); GAPA(C1=__builtin_amdgcn_mfma_f32_32x32x16_bf16(kf[7],qr[3],C1,0,0,0),   P1[14],P1[15],0.f,0.f,       pw3[2]=PKW(P1,12),pw3[3]=PKW(P1,14), pw3); \
    l_reg+=sacc; \
    if(GK){DMA_K((t)+3,sl_cur);} if(GV){DMA_V((t)+1,sl_next);} \
    ALIBI(C0,C1,t); CMASK(C0,C1,t); \
    { float a=MX3(C0[0],C0[1],C1[0]),b=MX3(C0[2],C0[3],C1[1]); a=MX3(a,C1[2],C1[3]); \
      _Pragma("unroll") for(int r=4;r<16;r+=4){a=MX3(a,C0[r],C0[r+1]);b=MX3(b,C0[r+2],C0[r+3]);a=MX3(a,C1[r],C1[r+1]);b=MX3(b,C1[r+2],C1[r+3]);} \
      float rm=__builtin_fmaxf(a,b); { auto rr=__builtin_amdgcn_permlane32_swap(__float_as_uint(rm),__float_as_uint(rm),false,false); rm=__builtin_fmaxf(__uint_as_float(rr[0]),__uint_as_float(rr[1])); } \
      resc=false; \
      if(__builtin_expect(__any(rm>(float)THRL),0)){ const float dl=__builtin_fmaxf(rm,0.f); mhat+=dl; \
        _Pragma("unroll") for(int r=0;r<16;++r){C0[r]-=dl;C1[r]-=dl;} \
        const float f=__builtin_amdgcn_exp2f(-dl); l_reg*=f; if(hi==0)wsf[r32]=f; resc=true; } } \
    SBAR(); \
    GAPB(o[0]=__builtin_amdgcn_mfma_f32_32x32x16_bf16(PAF(0),VFR(0),o[0],0,0,0), C0,0); \
    GAPB(o[1]=__builtin_amdgcn_mfma_f32_32x32x16_bf16(PAF(0),VFR(4),o[1],0,0,0), C0,4); \
    KRD(GL,0); GAPB(o[0]=__builtin_amdgcn_mfma_f32_32x32x16_bf16(PAF(1),VFR(1),o[0],0,0,0), C0,8); \
    KRD(GL,1); GAPB(o[1]=__builtin_amdgcn_mfma_f32_32x32x16_bf16(PAF(1),VFR(5),o[1],0,0,0), C0,12); \
    KRD(GL,2); GAPB(o[0]=__builtin_amdgcn_mfma_f32_32x32x16_bf16(PAF(2),VFR(2),o[0],0,0,0), C1,0); \
    KRD(GL,3); GAPB(o[1]=__builtin_amdgcn_mfma_f32_32x32x16_bf16(PAF(2),VFR(6),o[1],0,0,0), C1,4); \
    GAPB(o[0]=__builtin_amdgcn_mfma_f32_32x32x16_bf16(PAF(3),VFR(3),o[0],0,0,0), C1,8); \
    GAPB(o[1]=__builtin_amdgcn_mfma_f32_32x32x16_bf16(PAF(3),VFR(7),o[1],0,0,0), C1,12); \
    }while(0)
  int t=1;
  #undef CMASK
  #define CMASK(P0,P1,t) do{}while(0)
  for(;t+5<NT;t+=2){
    STEP(pB0,pB1,pA0,pA1,t,true,true,true);     WAIT_BAR(2); RESC(); ROT();
    STEP(pA0,pA1,pB0,pB1,t+1,true,true,true);   WAIT_BAR(2); RESC(); ROT();
  }
  #undef CMASK
  #define CMASK(P0,P1,t) do{int jb_=(t)-(NT-4); if(jb_>=0)cmask(P0,P1,jb_,qrel,hi);}while(0)
  #define ENDW(tt) do{ if((tt)+3<NT){WAIT_BAR(2);} else if((tt)+2<NT){WAIT_BAR(1);} else {WAIT_BAR(0);} }while(0)
  for(;t+1<NT;t+=2){
    STEP(pB0,pB1,pA0,pA1,t,(t+3<NT),(t+1<NT),(t+1<NT));       ENDW(t);   RESC(); ROT();
    STEP(pA0,pA1,pB0,pB1,t+1,(t+4<NT),(t+2<NT),(t+2<NT));     ENDW(t+1); RESC(); ROT();
  }
  STEP(pB0,pB1,pA0,pA1,NT-1,false,false,false); RESC();
  { float sacc=pB0[0]+pB0[1]; _Pragma("unroll") for(int r=2;r<16;++r)sacc+=pB0[r]; _Pragma("unroll") for(int r=0;r<16;++r)sacc+=pB1[r]; l_reg+=sacc;
    pw0=(u32x4){PKW(pB0,0),PKW(pB0,2),PKW(pB0,4),PKW(pB0,6)};pw1=(u32x4){PKW(pB0,8),PKW(pB0,10),PKW(pB0,12),PKW(pB0,14)};pw2=(u32x4){PKW(pB1,0),PKW(pB1,2),PKW(pB1,4),PKW(pB1,6)};pw3=(u32x4){PKW(pB1,8),PKW(pB1,10),PKW(pB1,12),PKW(pB1,14)};
    SBAR(); pv(o,vb0+sl_cur,PAF(0),PAF(1),PAF(2),PAF(3)); }
  #undef PKW
  #undef PAF
  #undef VFR
  #undef PIN
  #undef MX3
  #undef GAPA
  #undef GAPB
  #undef EX
  #undef VRD
  #undef KRD
  #undef STEP
  #undef ENDW
  {auto rr=__builtin_amdgcn_permlane32_swap(__float_as_uint(l_reg),__float_as_uint(l_reg),false,false);l_reg=__uint_as_float(rr[0])+__uint_as_float(rr[1]);}
  if(hi==0)wsf[32+r32]=l_reg;asm volatile("s_waitcnt lgkmcnt(0)":::"memory");
  float rli[16];
  #pragma unroll
  for(int r=0;r<16;++r)rli[r]=__builtin_amdgcn_rcpf(wsf[32+crow(r,hi)]);
  bf16*Ow=O+(rowbase+q0+wid*QBLK)*DM+h*D;
  { bf16*stg=(bf16*)(shm+LDS_OST)+wid*2048;
    #pragma unroll
    for(int r=0;r<16;++r){const int orow=crow(r,hi);
      #pragma unroll
      for(int d0=0;d0<2;++d0)stg[orow*64+d0*32+r32]=__float2bfloat16(o[d0][r]*rli[r]);}
    asm volatile("s_waitcnt lgkmcnt(0)":::"memory");
    #pragma unroll
    for(int i=0;i<4;++i){const int row=i*8+(lane>>3),ch=lane&7; const u32x4 v=*(const u32x4*)(stg+row*64+ch*8); ATTN_STORE16(Ow+(long)row*DM+ch*8,v);} }
  asm volatile("s_waitcnt lgkmcnt(0)\n\ts_barrier":::"memory");
  #undef ALIBI
  #undef AADD
  #undef DMA_K
  #undef DMA_V
  #undef CMASK
  #undef START
  #undef RESC
  #undef ROT
}
constexpr int ATTN_LDS_BYTES=LDS_BYTES;
struct AttnTensors { const bf16* Q; const bf16* K; const bf16* V; bf16* O; const unsigned* nmax; };
struct AttnUnit { int bh; int qb; };
struct StaticOrder {
  int vcu;
  __device__ __forceinline__ explicit StaticOrder(int grid,int block):vcu((block%8)*(grid/8)+block/8){}
  __device__ __forceinline__ bool next(int i,AttnUnit&u)const{ if(i>=4)return false; const int s=vcu&7; u.bh=vcu>>3; u.qb=(i==0)?s:(i==1)?15-s:(i==2)?16+s:31-s; return true; }
  __device__ __forceinline__ void a_ready(const AttnUnit&)const{}
  __device__ __forceinline__ void done(const AttnUnit&)const{}
};
struct DynOrder {
  unsigned* qctr; volatile __attribute__((address_space(3))) unsigned* slot; int xq, wave;
  __device__ __forceinline__ bool next(int,AttnUnit&u)const{
    if(wave==0&&lane_id()==0){ slot[0]=__hip_atomic_fetch_add(qctr+64*xq,1u,__ATOMIC_RELAXED,__HIP_MEMORY_SCOPE_AGENT); }
    __syncthreads(); const unsigned v=slot[0]; __syncthreads();
    if(v>=128u)return false; u.qb=31-(int)(v>>2); u.bh=(xq>>2)*16+(3-(int)(v&3u))*4+(xq&3); return true; }
  __device__ __forceinline__ void a_ready(const AttnUnit&)const{}
  __device__ __forceinline__ void done(const AttnUnit&)const{}
};
template<class Sched,int THRL=8> __device__ __forceinline__ void attn_phase(char*lds,const AttnTensors&T,const Sched&S,const int wave_id){
  AttnUnit u;
  for(int i=0;S.next(i,u);++i){ S.a_ready(u); attn_unit<THRL>(u.bh/NHEAD,u.bh%NHEAD,u.qb,T.Q,T.K,T.V,T.O,lds,wave_id,T.nmax); S.done(u); }
}
#undef SBAR
#undef WAIT_BAR
}
constexpr int NWAVES = 8;
constexpr int BATCH = 2, T = 8192, D = 1024, FF = 2816, M = BATCH * T;
constexpr int WIN_SRC = 5648, WIN_N = 3840;
constexpr float RMS_EPS = 1e-6f, SUBLN_EPS = 1e-5f;
constexpr size_t MiB = 1u << 20;
constexpr size_t WS_SSQA = 1 * MiB, WS_SSQB = 2 * MiB, WS_DNCD = 3 * MiB;
constexpr size_t WS_WG = 4 * MiB, WS_WA = 8 * MiB, WS_WB = 9 * MiB, WS_WOUT = 10 * MiB;
constexpr size_t WS_XB = 12 * MiB;
constexpr size_t WS_H = 44 * MiB;
constexpr size_t WS_WGU1 = 232 * MiB, WS_WD1 = 243 * MiB, WS_WIN = 248 * MiB + 512 * 1024;
constexpr size_t WS_PRE = 44 * MiB, WS_Z = 92 * MiB, WS_QO = 108 * MiB, WS_KD = 140 * MiB, WS_VD = 156 * MiB, WS_AB = 172 * MiB;
constexpr size_t WS_DN = 173 * MiB;
constexpr size_t WS_ODN = 44 * MiB, WS_AA = 60 * MiB, WS_ABB = 76 * MiB;
constexpr size_t WS_WGU2 = 173 * MiB, WS_WD2 = 184 * MiB;
constexpr size_t WS_YA = 190 * MiB, WS_YB = 222 * MiB, WS_MG = 108 * MiB;
constexpr size_t WS_END = 256 * MiB;
constexpr int DN_REC = 40960;
static_assert(WS_DN + (size_t)2048 * DN_REC <= WS_END && WS_WIN + (size_t)WIN_N * D * 2 <= WS_END && WS_YB + (size_t)M * D * 2 <= WS_END, "d_ws map");

constexpr int RING_OFF = 0, RING_BYTES = 147456;
constexpr int MISC_OFF = 147456, LDS_BYTES = 147456 + 256;

#define LAS __attribute__((address_space(3)))
typedef unsigned short bf16;
typedef unsigned v4u __attribute__((ext_vector_type(4)));
typedef float f32x4 __attribute__((ext_vector_type(4)));
typedef float f32x16 __attribute__((ext_vector_type(16)));
typedef short bf16x8 __attribute__((ext_vector_type(8)));
#define LDSFENCE() asm volatile("s_waitcnt lgkmcnt(0)" ::: "memory")
__device__ __forceinline__ unsigned f2bf(float f) { unsigned u = __builtin_bit_cast(unsigned, f); return (u + 0x7fffu + ((u >> 16) & 1u)) >> 16; }
typedef float f32x2_t_ __attribute__((ext_vector_type(2))); typedef __bf16 bf16x2_t_ __attribute__((ext_vector_type(2)));
__device__ __forceinline__ unsigned pk2(float lo, float hi) { f32x2_t_ v = {lo, hi}; bf16x2_t_ b = __builtin_convertvector(v, bf16x2_t_); return __builtin_bit_cast(unsigned, b); }
__device__ __forceinline__ float bflo(unsigned w) { return __uint_as_float(w << 16); }
__device__ __forceinline__ float bfhi(unsigned w) { return __uint_as_float(w & 0xffff0000u); }
__device__ __forceinline__ float wave_sum(float v) {
#pragma unroll
    for (int o = 1; o < 64; o <<= 1) v += __shfl_xor(v, o);
    return v;
}

#define GAS __attribute__((address_space(1)))
typedef GAS unsigned gu32;
#define RLX_AGENT __ATOMIC_RELAXED, __HIP_MEMORY_SCOPE_AGENT
constexpr size_t WS_CTL = 0, CTL_ZERO_BYTES = 65536;
constexpr int CW_BAR = 1024, CW_ATTQ = 8192, CW_NMAX = 12288;
#define XB_TMO      128
#define XB_XCNT(j)  (256  + 64 * (j))
#define XB_XSUB(j)  (1280 + 64 * (j))
#define XB_XGEN(j)  (2304 + 64 * (j))
#define XB_TOP      3328
#define XB_TOPGEN   3392
#define XCD_BAR_WORDS 3456
#define XB_SPIN_CAP (1u << 18)

__device__ __forceinline__ unsigned xb_ld(unsigned* p)              { return __hip_atomic_load(p, __ATOMIC_RELAXED, __HIP_MEMORY_SCOPE_AGENT); }
__device__ __forceinline__ unsigned xb_add(unsigned* p, unsigned v) { return __hip_atomic_fetch_add(p, v, __ATOMIC_RELAXED, __HIP_MEMORY_SCOPE_AGENT); }
__device__ __forceinline__ unsigned xb_xcc_id() { return (unsigned)__builtin_amdgcn_s_getreg((3 << 11) | 20) & 0xFu; }
#define XB_SPIN(cond, bar) do { unsigned _sp = 0; while (cond) { __builtin_amdgcn_s_sleep(1); \
    if ((++_sp & 255u) == 0u) { if (xb_ld(&(bar)[XB_TMO])) break; if (_sp > XB_SPIN_CAP) { atomicAdd(&(bar)[XB_TMO], 1u); break; } } } } while (0)

struct XcdBarrier {
    unsigned* bar; unsigned x; int wave;
    volatile LAS unsigned* st;
};

__device__ __forceinline__ XcdBarrier xcd_barrier_post(unsigned* bar, volatile LAS unsigned* st, int wave) {
    XcdBarrier b; b.bar = bar; b.x = xb_xcc_id(); b.st = st; b.wave = wave;
    if (wave == 0 && lane_id() == 0) (void)xb_add(&bar[XB_XCNT(b.x)], 1u);
    return b;
}
__device__ __forceinline__ void xcd_barrier_complete(unsigned* bar, unsigned x, unsigned& nloc, unsigned& nx) {
    const unsigned G = gridDim.x * gridDim.y * gridDim.z;
    unsigned sum, cnt, mine, sp = 0u;
    for (;;) {
        sum = 0u; cnt = 0u; mine = 0u;
#pragma unroll
        for (unsigned j = 0; j < 16; ++j) { const unsigned c = xb_ld(&bar[XB_XCNT(j)]); sum += c; cnt += (c > 0u) ? 1u : 0u; mine = (j == x) ? c : mine; }
        if (sum == G) break;
        __builtin_amdgcn_s_sleep(1);
        if ((++sp & 255u) == 0u) { if (xb_ld(&bar[XB_TMO])) break; if (sp > XB_SPIN_CAP) { atomicAdd(&bar[XB_TMO], 1u); break; } }
    }
    nloc = mine > 0u ? mine : 1u; nx = cnt > 0u ? cnt : 1u;
}

__device__ __forceinline__ void xcd_barrier(const XcdBarrier& b) {
    asm volatile("s_waitcnt vmcnt(0)" ::: "memory");
    __syncthreads();
    if (b.wave == 0 && lane_id() == 0) {
        unsigned* bar = b.bar;
        __builtin_amdgcn_s_waitcnt(0);
        unsigned nloc = b.st[0], nx = b.st[1];
        if (nloc == 0u) { xcd_barrier_complete(bar, b.x, nloc, nx); b.st[0] = nloc; b.st[1] = nx; }
        const unsigned old = xb_add(&bar[XB_XSUB(b.x)], 1u);
        const unsigned gen = old / nloc;
        if (old + 1u == (gen + 1u) * nloc) {
            __builtin_amdgcn_fence(__ATOMIC_RELEASE, "agent");
            asm volatile("s_waitcnt vmcnt(0)" ::: "memory");
            const unsigned og = xb_add(&bar[XB_TOP], 1u);
            const unsigned tg = og / nx;
            if (og + 1u == (tg + 1u) * nx) xb_add(&bar[XB_TOPGEN], 1u);
            else XB_SPIN(xb_ld(&bar[XB_TOPGEN]) == tg, bar);
            __builtin_amdgcn_fence(__ATOMIC_ACQUIRE, "agent");
            xb_add(&bar[XB_XGEN(b.x)], 1u);
            asm volatile("s_waitcnt vmcnt(0)" ::: "memory");
        } else {
            XB_SPIN(xb_ld(&bar[XB_XGEN(b.x)]) == gen, bar);
            __builtin_amdgcn_fence(__ATOMIC_ACQUIRE, "agent");
            asm volatile("s_waitcnt vmcnt(0)" ::: "memory");
        }
    }
    __syncthreads();
}

struct Ctx {
    const float* const* in; float* out; unsigned char* ws;
    LAS unsigned char* lds; int wave, G, vcu;
};

__device__ __forceinline__ void conv_item(const float* W, int ldw, int scol0, int nvalid, const float* gain, bf16* WT, int K, int drow0, int k0, LAS float* scr, int lane) {
    const int n4 = (lane & 15) * 4, kr = lane >> 4;
    f32x4 v[16];
#pragma unroll
    for (int i = 0; i < 16; ++i) { const int kk = 4 * i + kr; v[i] = (n4 < nvalid) ? *(const f32x4*)(W + (size_t)(k0 + kk) * ldw + scol0 + n4) : (f32x4){0.f, 0.f, 0.f, 0.f}; }
#pragma unroll
    for (int i = 0; i < 16; ++i) { const int kk = 4 * i + kr; f32x4 x = v[i]; if (gain) x = x * gain[k0 + kk];
        LAS float* p = scr + kk * 65 + n4; p[0] = x[0]; p[1] = x[1]; p[2] = x[2]; p[3] = x[3]; }
    LDSFENCE();
    const int c = lane & 7;
#pragma unroll
    for (int j = 0; j < 8; ++j) { const int n = (lane >> 3) + 8 * j; const LAS float* s = scr + (8 * c) * 65 + n;
        v4u o; o.x = pk2(s[0 * 65], s[1 * 65]); o.y = pk2(s[2 * 65], s[3 * 65]); o.z = pk2(s[4 * 65], s[5 * 65]); o.w = pk2(s[6 * 65], s[7 * 65]);
        *(v4u*)(WT + (size_t)(drow0 + n) * K + k0 + 8 * c) = o; }
    LDSFENCE();
}
__device__ __forceinline__ void conv_gu(const float* wg, const float* wu, const float* gain, bf16* WT, int it, LAS float* scr, int lane) {
    const int db = it >> 4, kb = it & 15, tile = db >> 2, w = db & 3;
    conv_item(w < 2 ? wg : wu, FF, 128 * tile + 64 * (w & 1), 64, gain, WT, D, 64 * db, 64 * kb, scr, lane);
}
__device__ __forceinline__ void conv_plain(const float* W, int K, int N, bf16* WT, int it, LAS float* scr, int lane) {
    const int nkb = K / 64, db = it / nkb, kb = it % nkb;
    conv_item(W, N, 64 * db, 64, nullptr, WT, K, 64 * db, 64 * kb, scr, lane);
}
__device__ __forceinline__ void conv_win(const float* W, const float* gain, bf16* WT, int it, LAS float* scr, int lane) {
    const int db = it >> 4, kb = it & 15, d0 = 64 * db; int sc, nv = 64;
    if (d0 < 2048) sc = d0; else if (d0 < 3584) sc = d0 + 16; else if (d0 == 3584) { sc = 2048; nv = 16; } else { sc = 0; nv = 0; }
    conv_item(W, WIN_SRC, sc, nv, gain, WT, D, d0, 64 * kb, scr, lane);
}
__device__ __forceinline__ void conv_wg(const float* W, const float* gain, bf16* WT, int it, LAS float* scr, int lane) {
    const int db = it >> 4, kb = it & 15, tile = db >> 2, w = db & 3;
    conv_item(W, WIN_SRC, 3600 + (w < 2 ? 0 : 1024) + 128 * tile + 64 * (w & 1), 64, gain, WT, D, 64 * db, 64 * kb, scr, lane);
}

__device__ __forceinline__ void p0_prologue(Ctx& F) {
    const int lane = lane_id();
    LAS float* scr = (LAS float*)(F.lds + RING_OFF + F.wave * 17408);
    const int gw = F.vcu * NWAVES + F.wave, NGW = F.G * NWAVES;
    bf16* ws16 = (bf16*)F.ws;
    constexpr int I_GU = 88 * 16, I_DN = 16 * 44;
    for (int it = gw; it < I_GU + I_DN; it += NGW) {
        if (it < I_GU) conv_gu(F.in[2], F.in[3], F.in[1], (bf16*)(F.ws + WS_WGU1), it, scr, lane);
        else conv_plain(F.in[4], FF, D, (bf16*)(F.ws + WS_WD1), it - I_GU, scr, lane);
    }
    (void)ws16;
    const float* x = F.in[0]; bf16* xb = (bf16*)(F.ws + WS_XB); float* ssq = (float*)(F.ws + WS_SSQA);
    for (int m0 = gw; m0 < M; m0 += 4 * NGW) {
        f32x4 v[4][4];
#pragma unroll
        for (int q = 0; q < 4; ++q) { const int m = m0 + q * NGW; if (m < M) { const f32x4* xr = (const f32x4*)(x + (size_t)m * D) + lane;
#pragma unroll
            for (int j = 0; j < 4; ++j) v[q][j] = xr[64 * j]; } }
#pragma unroll
        for (int q = 0; q < 4; ++q) { const int m = m0 + q * NGW; if (m < M) { unsigned long long* o8 = (unsigned long long*)(xb + (size_t)m * D) + lane; float s = 0.f;
#pragma unroll
            for (int j = 0; j < 4; ++j) { const f32x4 w = v[q][j]; s += (w.x * w.x + w.y * w.y) + (w.z * w.z + w.w * w.w); o8[64 * j] = (unsigned long long)pk2(w.x, w.y) | ((unsigned long long)pk2(w.z, w.w) << 32); }
            s = wave_sum(s);
            if (lane < 16) ssq[(size_t)m * 16 + lane] = (lane == 0) ? s : 0.f; } }
    }
}
__device__ __forceinline__ void conv_late(Ctx& F, int slot, int nslots) {
    const int lane = lane_id();
    LAS float* scr = (LAS float*)(F.lds + RING_OFF + F.wave * 17408);
    const int gw = slot * NWAVES + F.wave, NGW = nslots * NWAVES;
    constexpr int I_WIN = 60 * 16, I_WG = 32 * 16, I_AB = 16 * 8, I_WO = 16 * 16;
    constexpr int NIT = I_WIN + I_WG + 2 * I_AB + I_WO;
    for (int it = gw; it < NIT; it += NGW) {
        int r = it;
        if (r < I_WIN) { conv_win(F.in[6], F.in[5], (bf16*)(F.ws + WS_WIN), r, scr, lane); continue; } r -= I_WIN;
        if (r < I_WG) { conv_wg(F.in[6], F.in[5], (bf16*)(F.ws + WS_WG), r, scr, lane); continue; } r -= I_WG;
        if (r < I_AB) { conv_plain(F.in[16], 512, D, (bf16*)(F.ws + WS_WA), r, scr, lane); continue; } r -= I_AB;
        if (r < I_AB) { conv_plain(F.in[17], 512, D, (bf16*)(F.ws + WS_WB), r, scr, lane); continue; } r -= I_AB;
        conv_plain(F.in[18], D, D, (bf16*)(F.ws + WS_WOUT), r, scr, lane);
    }
}
__device__ __forceinline__ void conv_ffn2(Ctx& F) {
    const int lane = lane_id();
    LAS float* scr = (LAS float*)(F.lds + RING_OFF + F.wave * 17408);
    const int gw = F.vcu * NWAVES + F.wave, NGW = F.G * NWAVES;
    constexpr int I_GU = 88 * 16, I_DN = 16 * 44;
    for (int it = gw; it < I_GU + I_DN; it += NGW) {
        if (it < I_GU) conv_gu(F.in[20], F.in[21], F.in[19], (bf16*)(F.ws + WS_WGU2), it, scr, lane);
        else conv_plain(F.in[22], FF, D, (bf16*)(F.ws + WS_WD2), it - I_GU, scr, lane);
    }
}

__device__ __forceinline__ float silu_acc(float v) { return v * __builtin_amdgcn_rcpf(1.0f + __builtin_amdgcn_exp2f(-1.4426950408889634f * v)); }
typedef unsigned u32x2 __attribute__((ext_vector_type(2)));
__device__ __forceinline__ void dn_conv_l1(const bf16* PRE, const float* cw, long row0, int tin0, int colbase, int r, int hh, float (&y)[2][4][8]) {
#pragma unroll
    for (int s = 0; s < 4; ++s) {
        const int ch0 = colbase + 16 * s + 4 * hh;
        f32x4 wl[4], wh[4];
#pragma unroll
        for (int j = 0; j < 4; ++j) { wl[j] = *(const f32x4*)(cw + j * 1536 + ch0); wh[j] = *(const f32x4*)(cw + j * 1536 + ch0 + 8); }
#pragma unroll
        for (int i = 0; i < 2; ++i) { const int tok = r + 32 * i, tin = tin0 + tok; const long row = row0 + tok;
            float a[8];
#pragma unroll
            for (int e = 0; e < 8; ++e) a[e] = 0.f;
#pragma unroll
            for (int j = 0; j < 4; ++j) { u32x2 lo = (u32x2){0u, 0u}, hi = (u32x2){0u, 0u};
                if (tin - 3 + j >= 0) { const bf16* p = PRE + (size_t)(row - 3 + j) * 1536 + ch0; lo = *(const u32x2*)p; hi = *(const u32x2*)(p + 8); }
                a[0] += wl[j][0] * bflo(lo.x); a[1] += wl[j][1] * bfhi(lo.x); a[2] += wl[j][2] * bflo(lo.y); a[3] += wl[j][3] * bfhi(lo.y);
                a[4] += wh[j][0] * bflo(hi.x); a[5] += wh[j][1] * bfhi(hi.x); a[6] += wh[j][2] * bflo(hi.y); a[7] += wh[j][3] * bfhi(hi.y); }
#pragma unroll
            for (int e = 0; e < 8; ++e) { y[i][s][e] = silu_acc(a[e]); asm volatile("" : "+v"(y[i][s][e])); } }
        __builtin_amdgcn_sched_barrier(0);
    }
}
__device__ __forceinline__ bf16x8 pack8f(const float (&v)[8], float sc) {
    v4u o; o.x = pk2(v[0] * sc, v[1] * sc); o.y = pk2(v[2] * sc, v[3] * sc); o.z = pk2(v[4] * sc, v[5] * sc); o.w = pk2(v[6] * sc, v[7] * sc);
    return __builtin_bit_cast(bf16x8, o);
}
__device__ __forceinline__ v4u pack8acc(const f32x16& X, int kq) {
    v4u o; o.x = pk2(X[8 * kq], X[8 * kq + 1]); o.y = pk2(X[8 * kq + 2], X[8 * kq + 3]); o.z = pk2(X[8 * kq + 4], X[8 * kq + 5]); o.w = pk2(X[8 * kq + 6], X[8 * kq + 7]);
    return o;
}
__device__ __forceinline__ void write_xt(LAS unsigned short* XT, const bf16x8 (&fr)[2][4], const float (&sc)[2], int r, int hh) {
#pragma unroll
    for (int i = 0; i < 2; ++i)
#pragma unroll
        for (int s = 0; s < 4; ++s) { const v4u w = __builtin_bit_cast(v4u, fr[i][s]);
#pragma unroll
            for (int e2 = 0; e2 < 4; ++e2) { const unsigned ww = w[e2]; const unsigned o = pk2(bflo(ww) * sc[i], bfhi(ww) * sc[i]); const int e = 2 * e2;
                LAS unsigned short* p = XT + (16 * s + 8 * (e >> 2) + 4 * hh + (e & 3)) * 72 + r + 32 * i;
                p[0] = (unsigned short)o; p[72] = (unsigned short)(o >> 16); } }
}
__device__ __forceinline__ float lane_bcast(float v, int l) { return __uint_as_float((unsigned)__builtin_amdgcn_readlane((int)__float_as_uint(v), l)); }

__device__ __forceinline__ float fexp(float v) { return __builtin_amdgcn_exp2f(1.4426950408889634f * v); }
__device__ __forceinline__ void dn_prep_chunk(Ctx& F, int ch, LAS unsigned char* scrb, int opq  ) {
    int lane_ = lane_id();
    const int lane = lane_, r = lane & 31, hh = lane >> 5;
    const int n = ch & 127, h = (ch >> 7) & 7, b = ch >> 10;
    const long row0 = (long)b * T + 64 * n; const int tin0 = 64 * n;
    const bf16* PRE = (const bf16*)(F.ws + WS_PRE); const float* AB = (const float*)(F.ws + WS_AB); const float* cw = F.in[7];
    unsigned char* rec = F.ws + WS_DN + (size_t)ch * DN_REC;
    LAS float* At = (LAS float*)scrb; LAS unsigned short* TT = (LAS unsigned short*)scrb; LAS unsigned short* XT = (LAS unsigned short*)(scrb + 9216);
    float gc, betac;
    { const float al = AB[(size_t)(row0 + lane) * 16 + h], bl = AB[(size_t)(row0 + lane) * 16 + 8 + h];
      const float xs = al + F.in[9][h];
      const float sp = fmaxf(xs, 0.f) + log1pf(fexp(-fabsf(xs)));
      gc = -fexp(F.in[8][h]) * sp; betac = 1.0f / (1.0f + fexp(-bl));
#pragma unroll
      for (int o = 1; o < 64; o <<= 1) { const float t = __shfl_up(gc, o); if (lane >= o) gc += t; } }
    const float gl = lane_bcast(gc, 63);
    float gct[2], bet[2];
#pragma unroll
    for (int i = 0; i < 2; ++i) { gct[i] = __shfl(gc, r + 32 * i); bet[i] = __shfl(betac, r + 32 * i); }
    bf16x8 kf[2][4];
#pragma unroll
    for (int i = 0; i < 2; ++i)
#pragma unroll
        for (int s = 0; s < 4; ++s) kf[i][s] = (bf16x8){0, 0, 0, 0, 0, 0, 0, 0};
    if (opq > 0) { int lane = lane_; asm volatile("" : "+v"(lane)); const int r = lane & 31, hh = lane >> 5;
      float y[2][4][8]; dn_conv_l1(PRE, cw, row0, tin0, 512 + h * 64, r, hh, y);
#pragma unroll
      for (int i = 0; i < 2; ++i) { float ss = 0.f;
#pragma unroll
          for (int s = 0; s < 4; ++s)
#pragma unroll
              for (int e = 0; e < 8; ++e) ss += y[i][s][e] * y[i][s][e];
          ss += __shfl_xor(ss, 32); const float rn = 1.0f / sqrtf(ss + 1e-6f);
#pragma unroll
          for (int s = 0; s < 4; ++s) { kf[i][s] = pack8f(y[i][s], rn); asm volatile("" : "+v"(kf[i][s])); } } }
    __builtin_amdgcn_sched_barrier(0);
    if (opq > 1) { int lane = lane_; asm volatile("" : "+v"(lane)); const int r = lane & 31, hh = lane >> 5;
      float sc[2] = {fexp(gl - gct[0]), fexp(gl - gct[1])};
      write_xt(XT, kf, sc, r, hh);
      LDSFENCE();
#pragma unroll
      for (int id = 0; id < 2; ++id)
#pragma unroll
          for (int ks = 0; ks < 4; ++ks) { const int d = r + 32 * id; const LAS unsigned short* p = XT + d * 72 + 16 * ks + 4 * hh;
              const u32x2 lo = *(const LAS u32x2*)p, hi = *(const LAS u32x2*)(p + 8);
              *(v4u*)(rec + 24576 + d * 128 + (ks * 2 + hh) * 16) = (v4u){lo.x, lo.y, hi.x, hi.y}; }
      LDSFENCE(); }
    __builtin_amdgcn_sched_barrier(0);
#ifndef SKQ
    if (opq > 2) {
        int lane = lane_; asm volatile("" : "+v"(lane)); const int r = lane & 31, hh = lane >> 5;
        bf16x8 qf[2][4];
        { float y[2][4][8]; dn_conv_l1(PRE, cw, row0, tin0, h * 64, r, hh, y);
#pragma unroll
          for (int i = 0; i < 2; ++i) { float ss = 0.f;
#pragma unroll
              for (int s = 0; s < 4; ++s)
#pragma unroll
                  for (int e = 0; e < 8; ++e) ss += y[i][s][e] * y[i][s][e];
              ss += __shfl_xor(ss, 32); const float rn = 0.125f / sqrtf(ss + 1e-6f); const float eg = fexp(gct[i]);
#pragma unroll
              for (int s = 0; s < 4; ++s) { qf[i][s] = pack8f(y[i][s], rn);
                  *(bf16x8*)(rec + 8192 + (r + 32 * i) * 128 + (s * 2 + hh) * 16) = pack8f(y[i][s], rn * eg); asm volatile("" : "+v"(qf[i][s])); } } }
        __builtin_amdgcn_sched_barrier(0);
#pragma unroll
        for (int is = 0; is < 2; ++is) {
            float gcr[16];
#pragma unroll
            for (int g = 0; g < 16; ++g) gcr[g] = __shfl(gc, 32 * is + (g & 3) + 8 * (g >> 2) + 4 * hh);
#pragma unroll
            for (int ic = 0; ic < 2; ++ic) {
                if (is == 1 && ic == 0) {
#pragma unroll
                    for (int kq = 0; kq < 2; ++kq) *(v4u*)(rec + 16384 + r * 128 + ((2 + kq) * 2 + hh) * 16) = (v4u){0u, 0u, 0u, 0u};
#pragma unroll
                    for (int g = 0; g < 16; ++g) At[(32 + (g & 3) + 8 * (g >> 2) + 4 * hh) * 68 + r] = 0.f;
                    continue;
                }
                f32x16 pt, pk;
#pragma unroll
                for (int g = 0; g < 16; ++g) { pt[g] = 0.f; pk[g] = 0.f; }
#pragma unroll
                for (int ks = 0; ks < 4; ++ks) { pt = __builtin_amdgcn_mfma_f32_32x32x16_bf16(kf[is][ks], qf[ic][ks], pt, 0, 0, 0); pk = __builtin_amdgcn_mfma_f32_32x32x16_bf16(kf[is][ks], kf[ic][ks], pk, 0, 0, 0); }
                const int ccol = 32 * ic + r;
#pragma unroll
                for (int g = 0; g < 16; ++g) { const int srow = 32 * is + (g & 3) + 8 * (g >> 2) + 4 * hh; const float dec = fexp(fminf(gct[ic] - gcr[g], 0.f));
                    pt[g] = (srow <= ccol) ? pt[g] * dec : 0.f;
                    At[srow * 68 + ccol] = (srow < ccol) ? bet[ic] * pk[g] * dec : 0.f; }
#pragma unroll
                for (int kq = 0; kq < 2; ++kq) *(v4u*)(rec + 16384 + ccol * 128 + ((2 * is + kq) * 2 + hh) * 16) = pack8acc(pt, kq);
                __builtin_amdgcn_sched_barrier(0);
            }
        }
    }
    LDSFENCE();
#endif
    __builtin_amdgcn_sched_barrier(0);
#ifndef SKS
    if (opq > 3) {
        int lane = lane_; asm volatile("" : "+v"(lane)); const int r = lane & 31, hh = lane >> 5;
        float t[64];
#pragma unroll
        for (int k = 0; k < 64; ++k) t[k] = (k == lane) ? 1.0f : 0.0f;
#pragma unroll
        for (int j = 62; j >= 0; --j) { float acc = 0.f;
#pragma unroll
            for (int k4 = (j + 1) & ~3; k4 < 64; k4 += 4) { const f32x4 x = *(const volatile LAS f32x4*)(At + j * 68 + k4);
#pragma unroll
                for (int i = 0; i < 4; ++i) if (k4 + i > j) acc += t[k4 + i] * x[i]; }
            t[j] -= acc; asm volatile("" : "+v"(t[j])); }
        LDSFENCE();
#pragma unroll
        for (int i = 0; i < 8; ++i) { v4u o; o.x = pk2(t[8 * i], t[8 * i + 1]); o.y = pk2(t[8 * i + 2], t[8 * i + 3]); o.z = pk2(t[8 * i + 4], t[8 * i + 5]); o.w = pk2(t[8 * i + 6], t[8 * i + 7]);
            *(LAS v4u*)(TT + lane * 72 + 8 * i) = o; }
    }
#endif
    __builtin_amdgcn_sched_barrier(0);
#ifndef SKW
    if (opq > 4) { int lane = lane_; asm volatile("" : "+v"(lane)); const int r = lane & 31, hh = lane >> 5;
      float sc[2] = {bet[0] * fexp(gct[0]), bet[1] * fexp(gct[1])};
      write_xt(XT, kf, sc, r, hh);
      LDSFENCE();
#pragma unroll
      for (int id = 0; id < 2; ++id)
#pragma unroll
          for (int ic = 0; ic < 2; ++ic) { f32x16 acc;
#pragma unroll
              for (int g = 0; g < 16; ++g) acc[g] = 0.f;
#pragma unroll
              for (int ks = 0; ks < 4; ++ks) { const bf16x8 af = *(const LAS bf16x8*)(XT + (r + 32 * id) * 72 + 16 * ks + 8 * hh), bfr = *(const LAS bf16x8*)(TT + (r + 32 * ic) * 72 + 16 * ks + 8 * hh);
                  acc = __builtin_amdgcn_mfma_f32_32x32x16_bf16(af, bfr, acc, 0, 0, 0); }
#pragma unroll
              for (int kq = 0; kq < 2; ++kq) *(v4u*)(rec + (32 * ic + r) * 128 + ((2 * id + kq) * 2 + hh) * 16) = pack8acc(acc, kq); __builtin_amdgcn_sched_barrier(0); }
      LDSFENCE(); }
    __builtin_amdgcn_sched_barrier(0);
#endif
#ifndef SKU
    if (opq > 1) { int lane = lane_; asm volatile("" : "+v"(lane)); const int r = lane & 31, hh = lane >> 5;
      bf16x8 vf[2][4];
      { float y[2][4][8]; dn_conv_l1(PRE, cw, row0, tin0, 1024 + h * 64, r, hh, y);
#pragma unroll
        for (int i = 0; i < 2; ++i)
#pragma unroll
            for (int s = 0; s < 4; ++s) { vf[i][s] = pack8f(y[i][s], bet[i]); asm volatile("" : "+v"(vf[i][s])); } }
      __builtin_amdgcn_sched_barrier(0);
      float one[2] = {1.0f, 1.0f};
      write_xt(XT, vf, one, r, hh);
      LDSFENCE();
      unsigned* U = (unsigned*)(rec + 32768);
#pragma unroll
      for (int ic = 0; ic < 2; ++ic)
#pragma unroll
          for (int ie = 0; ie < 2; ++ie) { f32x16 acc;
#pragma unroll
              for (int g = 0; g < 16; ++g) acc[g] = 0.f;
#pragma unroll
              for (int ks = 0; ks < 4; ++ks) { const bf16x8 af = *(const LAS bf16x8*)(TT + (r + 32 * ic) * 72 + 16 * ks + 8 * hh), bfr = *(const LAS bf16x8*)(XT + (r + 32 * ie) * 72 + 16 * ks + 8 * hh);
                  acc = __builtin_amdgcn_mfma_f32_32x32x16_bf16(af, bfr, acc, 0, 0, 0); }
#pragma unroll
              for (int gp = 0; gp < 8; ++gp) U[((ie * 2 + ic) * 8 + gp) * 64 + lane] = pk2(acc[2 * gp], acc[2 * gp + 1]); __builtin_amdgcn_sched_barrier(0); }
      LDSFENCE(); }
#endif
    if (lane == 0) ((float*)(F.ws + WS_DNCD))[ch] = fexp(gl);
}

__device__ __forceinline__ bf16x8 pack8(const f32x16& X, int s) {
    v4u o; o.x = pg8::cvt_pk_bf16(X[8 * s], X[8 * s + 1]); o.y = pg8::cvt_pk_bf16(X[8 * s + 2], X[8 * s + 3]); o.z = pg8::cvt_pk_bf16(X[8 * s + 4], X[8 * s + 5]); o.w = pg8::cvt_pk_bf16(X[8 * s + 6], X[8 * s + 7]);
    return __builtin_bit_cast(bf16x8, o);
}
__device__ __forceinline__ void dn_scan(Ctx& F, int sw) {
    const int lane = lane_id(), r = lane & 31, hh = lane >> 5;
    const int bh = sw >> 1, sl = sw & 1, b = bh >> 3, h = bh & 7;
    const float* CD = (const float*)(F.ws + WS_DNCD) + bh * 128;
    bf16* ODN = (bf16*)(F.ws + WS_ODN);
    f32x16 S0, S1;
#pragma unroll
    for (int i = 0; i < 16; ++i) { S0[i] = 0.f; S1[i] = 0.f; }
    for (int n = 0; n < 128; ++n) {
        const unsigned char* rec = F.ws + WS_DN + ((size_t)bh * 128 + n) * DN_REC;
        const unsigned char* fb = rec + r * 128 + hh * 16;
        bf16x8 w[2][4], qd[2][4], at[2][4], kt[2][4];
#pragma unroll
        for (int i = 0; i < 2; ++i)
#pragma unroll
            for (int ks = 0; ks < 4; ++ks) { const int o = i * 4096 + ks * 32;
                w[i][ks] = *(const bf16x8*)(fb + o); qd[i][ks] = *(const bf16x8*)(fb + 8192 + o); at[i][ks] = *(const bf16x8*)(fb + 16384 + o); kt[i][ks] = *(const bf16x8*)(fb + 24576 + o); }
        const unsigned* up = (const unsigned*)(rec + 32768) + (sl * 2) * 8 * 64 + lane;
        unsigned uw[2][8];
#pragma unroll
        for (int i = 0; i < 2; ++i)
#pragma unroll
            for (int gp = 0; gp < 8; ++gp) uw[i][gp] = up[(i * 8 + gp) * 64];
        const float cd = CD[n];
        bf16x8 sb[4]; sb[0] = pack8(S0, 0); sb[1] = pack8(S0, 1); sb[2] = pack8(S1, 0); sb[3] = pack8(S1, 1);
        f32x16 ws[2], qs[2];
#pragma unroll
        for (int i = 0; i < 2; ++i) {
#pragma unroll
            for (int g = 0; g < 16; ++g) { ws[i][g] = 0.f; qs[i][g] = 0.f; }
#pragma unroll
            for (int ks = 0; ks < 4; ++ks) { ws[i] = __builtin_amdgcn_mfma_f32_32x32x16_bf16(w[i][ks], sb[ks], ws[i], 0, 0, 0); qs[i] = __builtin_amdgcn_mfma_f32_32x32x16_bf16(qd[i][ks], sb[ks], qs[i], 0, 0, 0); }
        }
#pragma unroll
        for (int i = 0; i < 2; ++i)
#pragma unroll
            for (int gp = 0; gp < 8; ++gp) { ws[i][2 * gp] = bflo(uw[i][gp]) - ws[i][2 * gp]; ws[i][2 * gp + 1] = bfhi(uw[i][gp]) - ws[i][2 * gp + 1]; }
        bf16x8 vb[4]; vb[0] = pack8(ws[0], 0); vb[1] = pack8(ws[0], 1); vb[2] = pack8(ws[1], 0); vb[3] = pack8(ws[1], 1);
#pragma unroll
        for (int g = 0; g < 16; ++g) { S0[g] *= cd; S1[g] *= cd; }
#pragma unroll
        for (int ks = 0; ks < 4; ++ks) {
            qs[0] = __builtin_amdgcn_mfma_f32_32x32x16_bf16(at[0][ks], vb[ks], qs[0], 0, 0, 0);
            qs[1] = __builtin_amdgcn_mfma_f32_32x32x16_bf16(at[1][ks], vb[ks], qs[1], 0, 0, 0);
            S0 = __builtin_amdgcn_mfma_f32_32x32x16_bf16(kt[0][ks], vb[ks], S0, 0, 0, 0);
            S1 = __builtin_amdgcn_mfma_f32_32x32x16_bf16(kt[1][ks], vb[ks], S1, 0, 0, 0);
        }
        bf16* orow = ODN + ((size_t)b * T + 64 * n) * 512 + h * 64 + 32 * sl + r;
#pragma unroll
        for (int i = 0; i < 2; ++i)
#pragma unroll
            for (int g = 0; g < 16; ++g) { const int c = 32 * i + (g & 3) + 8 * (g >> 2) + 4 * hh; orow[(size_t)c * 512] = (bf16)f2bf(qs[i][g]); }
    }
}

constexpr int SC_SLOT = 4 * 9216 + 8192, SC_NPIECE = DN_REC / 16, SC_LANES = 5 * 64, SC_PPL = SC_NPIECE / SC_LANES;
static_assert(SC_PPL * SC_LANES == SC_NPIECE, "whole pieces per loader lane");
static_assert(3 * SC_SLOT <= RING_BYTES, "scan ring fits the phase scratch");
__device__ __forceinline__ int sc_piece_off(int p) { return p < 2048 ? (p >> 9) * 9216 + ((p & 511) >> 3) * 144 + (p & 7) * 16 : 36864 + (p - 2048) * 16; }
__device__ __forceinline__ void dn_scan_block(Ctx& F, int bh) {
    const int lane = lane_id(), wave = F.wave;
    LAS unsigned char* ring = F.lds + RING_OFF;
    const unsigned char* recs = F.ws + WS_DN + (size_t)bh * 128 * DN_REC;
#define SC_BAR() asm volatile("s_waitcnt vmcnt(0) lgkmcnt(0)\n\ts_barrier" ::: "memory")
    if (wave == 7) {
        asm volatile("s_barrier" ::: "memory");
#pragma unroll 1
        for (int n = 0; n < 128; ++n) asm volatile("s_barrier" ::: "memory");
    } else if (wave >= 2) {
        const int ll = (wave - 2) * 64 + lane; v4u d0[SC_PPL], d1[SC_PPL], d2[SC_PPL], d3[SC_PPL];
#define SC_LOAD(D, rec_) do { _Pragma("unroll") for (int j = 0; j < SC_PPL; ++j) { const int p = ll + j * SC_LANES; D[j] = *(const v4u*)(recs + (size_t)(rec_) * DN_REC + p * 16); } } while (0)
#define SC_STORE(D, slot_) do { _Pragma("unroll") for (int j = 0; j < SC_PPL; ++j) { const int p = ll + j * SC_LANES; *(LAS v4u*)(ring + (slot_) * SC_SLOT + sc_piece_off(p)) = D[j]; } } while (0)
#define SC_LBAR() asm volatile("s_waitcnt lgkmcnt(0)\n\ts_barrier" ::: "memory")
        SC_LOAD(d0, 0); SC_LOAD(d1, 1); SC_STORE(d0, 0); SC_STORE(d1, 1);
        SC_LOAD(d0, 2); SC_LOAD(d1, 3); SC_LOAD(d2, 4); SC_LOAD(d3, 5);
        SC_LBAR();
#define SC_STEP(D, n_, slot_) do { SC_STORE(D, slot_); SC_LOAD(D, (n_) + 6); SC_LBAR(); } while (0)
#pragma unroll 1
        for (int n = 0; n < 128; n += 12) {
            SC_STEP(d0, n, 2); SC_STEP(d1, n + 1, 0); SC_STEP(d2, n + 2, 1); SC_STEP(d3, n + 3, 2);
            SC_STEP(d0, n + 4, 0); SC_STEP(d1, n + 5, 1); SC_STEP(d2, n + 6, 2); SC_STEP(d3, n + 7, 0);
            if (n + 8 < 128) { SC_STEP(d0, n + 8, 1); SC_STEP(d1, n + 9, 2); SC_STEP(d2, n + 10, 0); SC_STEP(d3, n + 11, 1); }
        }
#undef SC_LOAD
#undef SC_STORE
#undef SC_STEP
#undef SC_LBAR
    } else {
        const int r = lane & 31, hh = lane >> 5, sl = wave, b = bh >> 3, h = bh & 7;
        const float* CD = (const float*)(F.ws + WS_DNCD) + bh * 128;
        bf16* ODN = (bf16*)(F.ws + WS_ODN);
        f32x16 S0, S1;
#pragma unroll
        for (int i = 0; i < 16; ++i) { S0[i] = 0.f; S1[i] = 0.f; }
        float cd = CD[0];
        asm volatile("s_waitcnt lgkmcnt(0)\n\ts_barrier" ::: "memory");
        int slot = 0;
#pragma unroll 1
        for (int n = 0; n < 128; ++n) {
            const LAS unsigned char* sb_ = ring + slot * SC_SLOT; const LAS unsigned char* fb = sb_ + r * 144 + hh * 16;
            const float cdn = CD[n + 1 < 128 ? n + 1 : n];
            bf16x8 w[2][4], qd[2][4];
#pragma unroll
            for (int i = 0; i < 2; ++i)
#pragma unroll
                for (int ks = 0; ks < 4; ++ks) { const int o = i * 32 * 144 + ks * 32; w[i][ks] = *(const LAS bf16x8*)(fb + o); qd[i][ks] = *(const LAS bf16x8*)(fb + 9216 + o); }
            bf16x8 sb[4]; sb[0] = pack8(S0, 0); sb[1] = pack8(S0, 1); sb[2] = pack8(S1, 0); sb[3] = pack8(S1, 1);
            f32x16 ws[2], qs[2];
#pragma unroll
            for (int i = 0; i < 2; ++i) {
#pragma unroll
                for (int g = 0; g < 16; ++g) { ws[i][g] = 0.f; qs[i][g] = 0.f; }
#pragma unroll
                for (int ks = 0; ks < 4; ++ks) { ws[i] = __builtin_amdgcn_mfma_f32_32x32x16_bf16(w[i][ks], sb[ks], ws[i], 0, 0, 0); qs[i] = __builtin_amdgcn_mfma_f32_32x32x16_bf16(qd[i][ks], sb[ks], qs[i], 0, 0, 0); }
            }
            bf16x8 at[2][4], kt[2][4];
#pragma unroll
            for (int i = 0; i < 2; ++i)
#pragma unroll
                for (int ks = 0; ks < 4; ++ks) { const int o = i * 32 * 144 + ks * 32; at[i][ks] = *(const LAS bf16x8*)(fb + 2 * 9216 + o); kt[i][ks] = *(const LAS bf16x8*)(fb + 3 * 9216 + o); }
            const LAS unsigned* up = (const LAS unsigned*)(sb_ + 36864) + (sl * 2) * 8 * 64 + lane;
#pragma unroll
            for (int i = 0; i < 2; ++i)
#pragma unroll
                for (int gp = 0; gp < 8; ++gp) { const unsigned uw = up[(i * 8 + gp) * 64]; ws[i][2 * gp] = bflo(uw) - ws[i][2 * gp]; ws[i][2 * gp + 1] = bfhi(uw) - ws[i][2 * gp + 1]; }
            bf16x8 vb[4]; vb[0] = pack8(ws[0], 0); vb[1] = pack8(ws[0], 1); vb[2] = pack8(ws[1], 0); vb[3] = pack8(ws[1], 1);
#pragma unroll
            for (int g = 0; g < 16; ++g) { S0[g] *= cd; S1[g] *= cd; }
#pragma unroll
            for (int ks = 0; ks < 4; ++ks) {
                S0 = __builtin_amdgcn_mfma_f32_32x32x16_bf16(kt[0][ks], vb[ks], S0, 0, 0, 0);
                S1 = __builtin_amdgcn_mfma_f32_32x32x16_bf16(kt[1][ks], vb[ks], S1, 0, 0, 0);
                qs[0] = __builtin_amdgcn_mfma_f32_32x32x16_bf16(at[0][ks], vb[ks], qs[0], 0, 0, 0);
                qs[1] = __builtin_amdgcn_mfma_f32_32x32x16_bf16(at[1][ks], vb[ks], qs[1], 0, 0, 0);
            }
            bf16* orow = ODN + ((size_t)b * T + 64 * n) * 512 + h * 64 + 32 * sl + r;
#pragma unroll
            for (int i = 0; i < 2; ++i)
#pragma unroll
                for (int g = 0; g < 16; ++g) { const int c = 32 * i + (g & 3) + 8 * (g >> 2) + 4 * hh; orow[(size_t)c * 512] = (bf16)f2bf(qs[i][g]); }
            cd = cdn; slot = (slot == 2) ? 0 : slot + 1;
            asm volatile("s_waitcnt lgkmcnt(0)\n\ts_barrier" ::: "memory");
        }
    }
    SC_BAR();
#undef SC_BAR
}

__device__ __forceinline__ void qk_norm_max(Ctx& F) {
    const int gw = F.vcu * NWAVES + F.wave, NGW = F.G * NWAVES, lane = lane_id(), j = lane >> 3;
    const bf16* QO = (const bf16*)(F.ws + WS_QO); const bf16* KD = (const bf16*)(F.ws + WS_KD);
    float mq[2] = {0.f, 0.f}, mk[2] = {0.f, 0.f};
    for (int m0 = gw; m0 < M; m0 += 4 * NGW) {
        v4u qv[4], kv[4];
#pragma unroll
        for (int q = 0; q < 4; ++q) { const int m = m0 + q * NGW; if (m < M) { qv[q] = *(const v4u*)(QO + (size_t)m * 1024 + (2 * j) * 64 + (lane & 7) * 8); kv[q] = *(const v4u*)(KD + (size_t)m * 512 + lane * 8); } }
#pragma unroll
        for (int q = 0; q < 4; ++q) { const int m = m0 + q * NGW; if (m < M) {
            float sq = 0.f, sk = 0.f;
#pragma unroll
            for (int e = 0; e < 4; ++e) { const float a = bflo(qv[q][e]), b2 = bfhi(qv[q][e]), c = bflo(kv[q][e]), d = bfhi(kv[q][e]); sq += a * a + b2 * b2; sk += c * c + d * d; }
            sq += __shfl_xor(sq, 1); sq += __shfl_xor(sq, 2); sq += __shfl_xor(sq, 4);
            sk += __shfl_xor(sk, 1); sk += __shfl_xor(sk, 2); sk += __shfl_xor(sk, 4);
            const int bb = m >> 13;
            if (bb == 0) { mq[0] = fmaxf(mq[0], sq); mk[0] = fmaxf(mk[0], sk); } else { mq[1] = fmaxf(mq[1], sq); mk[1] = fmaxf(mk[1], sk); } } }
    }
    if ((lane & 7) == 0) { unsigned* nm = (unsigned*)(F.ws + WS_CTL) + CW_NMAX;
#pragma unroll
        for (int bb = 0; bb < 2; ++bb) { atomicMax(nm + bb * 8 + j, __float_as_uint(mq[bb])); atomicMax(nm + 16 + bb * 8 + j, __float_as_uint(mk[bb])); } }
}

__device__ __forceinline__ void finalize_rows(Ctx& F) {
    const int gw = F.vcu * NWAVES + F.wave, NGW = F.G * NWAVES, lane = lane_id();
    const bf16* ODN = (const bf16*)(F.ws + WS_ODN); const bf16* Z = (const bf16*)(F.ws + WS_Z); const bf16* QO = (const bf16*)(F.ws + WS_QO);
    bf16* AA = (bf16*)(F.ws + WS_AA); bf16* ABB = (bf16*)(F.ws + WS_ABB);
    float s1 = 0.f, s2 = 0.f;
    { const float a = F.in[11][lane] * F.in[12][lane], bq = F.in[13][lane] * F.in[14][lane]; s1 = wave_sum(a); s2 = wave_sum(bq); }
    const float lam_init = 0.2f;
    const float lam = expf(s1) - expf(s2) + lam_init;
    float gdn[8], gsub[8];
#pragma unroll
    for (int e = 0; e < 8; ++e) { gdn[e] = F.in[10][(lane & 7) * 8 + e]; gsub[e] = F.in[15][(lane & 15) * 8 + e] * (1.0f - lam_init); }
    const int hd = lane >> 4, e0 = (lane & 15) * 8;
    for (int m0 = gw; m0 < M; m0 += 4 * NGW) {
        v4u ov[4], zv[4], a1[4], a2[4];
#pragma unroll
        for (int q = 0; q < 4; ++q) { const int m = m0 + q * NGW; if (m < M) {
            ov[q] = *(const v4u*)(ODN + (size_t)m * 512 + lane * 8); zv[q] = *(const v4u*)(Z + (size_t)m * 512 + lane * 8);
            a1[q] = *(const v4u*)(QO + (size_t)m * 1024 + hd * 256 + e0); a2[q] = *(const v4u*)(QO + (size_t)m * 1024 + hd * 256 + 128 + e0); } }
#pragma unroll
        for (int q = 0; q < 4; ++q) { const int m = m0 + q * NGW; if (m < M) {
        { float o[8], z[8]; float ss = 0.f;
#pragma unroll
          for (int e = 0; e < 4; ++e) { o[2 * e] = bflo(ov[q][e]); o[2 * e + 1] = bfhi(ov[q][e]); z[2 * e] = bflo(zv[q][e]); z[2 * e + 1] = bfhi(zv[q][e]); }
#pragma unroll
          for (int e = 0; e < 8; ++e) ss += o[e] * o[e];
          ss += __shfl_xor(ss, 1); ss += __shfl_xor(ss, 2); ss += __shfl_xor(ss, 4);
          const float rn = 1.0f / sqrtf(ss * (1.0f / 64.0f) + RMS_EPS);
          float y[8];
#pragma unroll
          for (int e = 0; e < 8; ++e) y[e] = o[e] * rn * gdn[e] * silu_acc(z[e]);
          v4u w; w.x = pk2(y[0], y[1]); w.y = pk2(y[2], y[3]); w.z = pk2(y[4], y[5]); w.w = pk2(y[6], y[7]);
          *(v4u*)(AA + (size_t)m * 512 + lane * 8) = w; }
        { float o[8]; float ss = 0.f;
#pragma unroll
          for (int e = 0; e < 4; ++e) { o[2 * e] = bflo(a1[q][e]) - lam * bflo(a2[q][e]); o[2 * e + 1] = bfhi(a1[q][e]) - lam * bfhi(a2[q][e]); }
#pragma unroll
          for (int e = 0; e < 8; ++e) ss += o[e] * o[e];
          ss += __shfl_xor(ss, 1); ss += __shfl_xor(ss, 2); ss += __shfl_xor(ss, 4); ss += __shfl_xor(ss, 8);
          const float rn = 1.0f / sqrtf(ss * (1.0f / 128.0f) + SUBLN_EPS);
          float y[8];
#pragma unroll
          for (int e = 0; e < 8; ++e) y[e] = o[e] * rn * gsub[e];
          v4u w; w.x = pk2(y[0], y[1]); w.y = pk2(y[2], y[3]); w.z = pk2(y[4], y[5]); w.w = pk2(y[6], y[7]);
          *(v4u*)(ABB + (size_t)m * 512 + hd * 128 + e0) = w; }
        } }
    }
}
__device__ __forceinline__ void final_norm_rows(Ctx& F) {
    const int lane = lane_id();
    const int gw = F.vcu * NWAVES + F.wave, NGW = F.G * NWAVES;
    const f32x4* gp = (const f32x4*)F.in[23] + lane; f32x4 gg[4];
#pragma unroll
    for (int j = 0; j < 4; ++j) gg[j] = gp[64 * j];
    for (int m0 = gw; m0 < M; m0 += 4 * NGW) {
        f32x4 v[4][4];
#pragma unroll
        for (int q = 0; q < 4; ++q) { const int m = m0 + q * NGW; if (m < M) { const f32x4* xr = (const f32x4*)(F.out + (size_t)m * D) + lane;
#pragma unroll
            for (int j = 0; j < 4; ++j) v[q][j] = xr[64 * j]; } }
#pragma unroll
        for (int q = 0; q < 4; ++q) { const int m = m0 + q * NGW; if (m < M) { f32x4* xr = (f32x4*)(F.out + (size_t)m * D) + lane; float s = 0.f;
#pragma unroll
            for (int j = 0; j < 4; ++j) s += (v[q][j].x * v[q][j].x + v[q][j].y * v[q][j].y) + (v[q][j].z * v[q][j].z + v[q][j].w * v[q][j].w);
            const float rn = 1.0f / sqrtf(wave_sum(s) * (1.0f / D) + RMS_EPS);
#pragma unroll
            for (int j = 0; j < 4; ++j) xr[64 * j] = v[q][j] * rn * gg[j]; } }
    }
}

constexpr int N_PHASES = 14;
struct Args { const float* in[24]; float* out; unsigned char* ws; int ph_lo, ph_hi; };
__global__ void __launch_bounds__(NWAVES * 64, 2) mk_fwd(Args args) {
    extern __shared__ __attribute__((aligned(16))) unsigned char lds[];
    Ctx F;
    F.in = args.in;
    F.out = args.out; F.ws = args.ws;
    F.lds = (LAS unsigned char*)lds;
    F.wave = __builtin_amdgcn_readfirstlane((int)threadIdx.x >> 6);
    F.G = gridDim.x; { const int bx = blockIdx.x; F.vcu = (F.G % 8 == 0) ? (bx % 8) * (F.G / 8) + bx / 8 : bx; }
    const int lo = args.ph_lo, hi = args.ph_hi;
    { volatile LAS unsigned* misc = (volatile LAS unsigned*)(F.lds + MISC_OFF); if (F.wave == 0) misc[lane_id()] = 0u; }
    __syncthreads();
    XcdBarrier bar = xcd_barrier_post((unsigned*)(args.ws + WS_CTL) + CW_BAR, (volatile LAS unsigned*)(F.lds + MISC_OFF) + 8, F.wave);
    if (lo < -7) cg::this_grid().sync();
    unsigned char* ws = F.ws;
    typedef pg8::bf16_t pb;
#ifndef PH_MASK
#define PH_MASK 0x3fff
#endif
#define IN(k) (((PH_MASK >> (k)) & 1) && lo <= (k) && (k) < hi)
#ifndef PROBE_A
#define PROBE_A -1
#endif
#ifndef PROBE_B
#define PROBE_B -1
#endif
#define STAMP(k) do { if (PROBE_A >= 0 && blockIdx.x == 0 && F.wave == 0 && lane_id() == 0) ((volatile unsigned long long*)(args.ws + WS_CTL + 32768))[k] = __builtin_amdgcn_s_memrealtime(); } while (0)
#define SEAM(k) do { if (IN(k) && IN((k) + 1)) xcd_barrier(bar); STAMP((k) + 1); } while (0)

    STAMP(0);
    if (IN(0)) { p0_prologue(F); } SEAM(0);
    if (IN(1)) { pg8::Gemm g{(const pb*)(ws + WS_XB), (const pb*)(ws + WS_WGU1), M, 2 * FF, D}; pg8::StaticOrder S; S.init(M, 2 * FF, F.G, (int)blockIdx.x);
        pg8::EpiSwiGLU E{(pb*)(ws + WS_H), FF, (const float*)(ws + WS_SSQA), RMS_EPS};
        pg8::gemm_phase<pg8::EpiSwiGLU, pg8::StaticOrder, true, true>(F.lds + RING_OFF, g, S, E, F.wave);
        { const int nfull = (M / 256) * (2 * FF / 256) % F.G;
          if (nfull > 0) { if ((int)blockIdx.x >= nfull) conv_late(F, (int)blockIdx.x - nfull, F.G - nfull); } else conv_late(F, (int)blockIdx.x, F.G); } } SEAM(1);
    if (IN(2)) { pg8::Gemm g{(const pb*)(ws + WS_H), (const pb*)(ws + WS_WD1), M, D, FF}; pg8::StaticOrder S; S.init(M, D, F.G, (int)blockIdx.x);
        pg8::EpiResid E{F.in[0], F.out, (pb*)(ws + WS_XB), (float*)(ws + WS_SSQB), 0.5f};
        pg8::gemm_phase<pg8::EpiResid, pg8::StaticOrder, true, true>(F.lds + RING_OFF, g, S, E, F.wave); } SEAM(2);
    if (IN(3)) { pg8::Gemm g{(const pb*)(ws + WS_XB), (const pb*)(ws + WS_WIN), M, WIN_N, D}; pg8::StaticOrder S; S.init(M, WIN_N, F.G, (int)blockIdx.x);
        pg8::EpiWin E{(pb*)(ws + WS_PRE), (pb*)(ws + WS_Z), (pb*)(ws + WS_QO), (pb*)(ws + WS_KD), (pb*)(ws + WS_VD), (float*)(ws + WS_AB), (const float*)(ws + WS_SSQB), RMS_EPS, attn_body::C2};
        pg8::gemm_phase<pg8::EpiWin, pg8::StaticOrder, true, true>(F.lds + RING_OFF, g, S, E, F.wave); } SEAM(3);
    if (IN(4)) { LAS unsigned char* scr = F.lds + RING_OFF + F.wave * 18432; const int gw = F.vcu * NWAVES + F.wave, NGW = F.G * NWAVES;
        for (int ch = gw; ch < 2048; ch += NGW) dn_prep_chunk(F, ch, scr, hi);
        qk_norm_max(F); } SEAM(4);
    if (IN(5)) {
        if (blockIdx.x < 16) dn_scan_block(F, (int)blockIdx.x);
        const attn_body::AttnTensors AT{(const attn_body::bf16*)(ws + WS_QO), (const attn_body::bf16*)(ws + WS_KD), (const attn_body::bf16*)(ws + WS_VD), (attn_body::bf16*)(ws + WS_QO), (const unsigned*)(ws + WS_CTL) + CW_NMAX};
        const attn_body::DynOrder S{(unsigned*)(ws + WS_CTL) + CW_ATTQ, (volatile LAS unsigned*)(F.lds + MISC_OFF) + 16, (int)(blockIdx.x & 7), F.wave};
        attn_body::attn_phase<attn_body::DynOrder>((char*)lds + RING_OFF, AT, S, F.wave); } SEAM(5);
    if (IN(7)) { finalize_rows(F); conv_ffn2(F); } SEAM(7);
    if (IN(8)) { pg8::StaticOrder S; S.init(M, D, F.G, (int)blockIdx.x);
        { pg8::Gemm g{(const pb*)(ws + WS_AA), (const pb*)(ws + WS_WA), M, D, 512}; pg8::EpiStoreBf16 E{(pb*)(ws + WS_YA), D};
          pg8::gemm_phase<pg8::EpiStoreBf16, pg8::StaticOrder, true, true>(F.lds + RING_OFF, g, S, E, F.wave); }
        { pg8::Gemm g{(const pb*)(ws + WS_ABB), (const pb*)(ws + WS_WB), M, D, 512}; pg8::EpiStoreBf16 E{(pb*)(ws + WS_YB), D};
          pg8::gemm_phase<pg8::EpiStoreBf16, pg8::StaticOrder, true, true>(F.lds + RING_OFF, g, S, E, F.wave); } } SEAM(8);
    if (IN(9)) { pg8::Gemm g{(const pb*)(ws + WS_XB), (const pb*)(ws + WS_WG), M, 2 * D, D}; pg8::StaticOrder S; S.init(M, 2 * D, F.G, (int)blockIdx.x);
        pg8::EpiGateMerge E{(const pb*)(ws + WS_YA), (const pb*)(ws + WS_YB), (pb*)(ws + WS_MG), (const float*)(ws + WS_SSQB), RMS_EPS};
        pg8::gemm_phase<pg8::EpiGateMerge, pg8::StaticOrder, true, true>(F.lds + RING_OFF, g, S, E, F.wave); } SEAM(9);
    if (IN(10)) { pg8::Gemm g{(const pb*)(ws + WS_MG), (const pb*)(ws + WS_WOUT), M, D, D}; pg8::StaticOrder S; S.init(M, D, F.G, (int)blockIdx.x);
        pg8::EpiResid E{F.out, F.out, (pb*)(ws + WS_XB), (float*)(ws + WS_SSQA), 1.0f};
        pg8::gemm_phase<pg8::EpiResid, pg8::StaticOrder, true, true>(F.lds + RING_OFF, g, S, E, F.wave); } SEAM(10);
    if (IN(11)) { pg8::Gemm g{(const pb*)(ws + WS_XB), (const pb*)(ws + WS_WGU2), M, 2 * FF, D}; pg8::StaticOrder S; S.init(M, 2 * FF, F.G, (int)blockIdx.x);
        pg8::EpiSwiGLU E{(pb*)(ws + WS_H), FF, (const float*)(ws + WS_SSQA), RMS_EPS};
        pg8::gemm_phase<pg8::EpiSwiGLU, pg8::StaticOrder, true, true>(F.lds + RING_OFF, g, S, E, F.wave); } SEAM(11);
    if (IN(12)) { pg8::Gemm g{(const pb*)(ws + WS_H), (const pb*)(ws + WS_WD2), M, D, FF}; pg8::StaticOrder S; S.init(M, D, F.G, (int)blockIdx.x);
        pg8::EpiResid E{F.out, F.out, (pb*)(ws + WS_XB), (float*)(ws + WS_SSQB), 0.5f};
        pg8::gemm_phase<pg8::EpiResid, pg8::StaticOrder, true, true>(F.lds + RING_OFF, g, S, E, F.wave); } SEAM(12);
    if (IN(13)) { final_norm_rows(F); } STAMP(14);
    if (PROBE_A >= 0) {
        xcd_barrier(bar);
        if (blockIdx.x == 0 && F.wave == 0) { volatile unsigned long long* ts = (volatile unsigned long long*)(args.ws + WS_CTL + 32768); const int l = lane_id();
            const float da = (float)(ts[PROBE_A + 1] - ts[PROBE_A]) * 0.01f, db = (float)(ts[PROBE_B + 1] - ts[PROBE_B]) * 0.01f;
            for (int i = l; i < 16384; i += 64) F.out[(size_t)i * 1024 + 512] = db;
            if (l == 0) F.out[0] = da; }
    }
#undef IN
#undef SEAM
}

#ifndef MK_N_LAUNCHES
#define MK_N_LAUNCHES 1
#endif
extern "C" void kernel_launch(void* const* d_in, const int* in_sizes, int n_in, void* d_out, int out_size, void* d_ws, size_t ws_size, hipStream_t stream) {
    static int grid = 0;
    if (grid == 0) {
        if (n_in != 24 || in_sizes[0] != M * D || out_size != M * D || ws_size < WS_END) { fprintf(stderr, "kernel_launch: unexpected shapes (n_in %d, in0 %d, out %d, ws %zu)\n", n_in, n_in > 0 ? in_sizes[0] : -1, out_size, ws_size); grid = -1; return; }
        int dev = 0, cus = 0, per_cu = 0;
        if (hipGetDevice(&dev) != hipSuccess || hipDeviceGetAttribute(&cus, hipDeviceAttributeMultiprocessorCount, dev) != hipSuccess) { grid = -1; return; }
        if (hipFuncSetAttribute((const void*)mk_fwd, hipFuncAttributeMaxDynamicSharedMemorySize, LDS_BYTES) != hipSuccess) { fprintf(stderr, "kernel_launch: hipFuncSetAttribute failed\n"); grid = -1; return; }
        if (hipOccupancyMaxActiveBlocksPerMultiprocessor(&per_cu, (const void*)mk_fwd, NWAVES * 64, LDS_BYTES) != hipSuccess || per_cu < 1) { fprintf(stderr, "kernel_launch: occupancy query says %d\n", per_cu); per_cu = 1; }
        (void)hipGetLastError();
        grid = cus;
    }
    if (grid < 0) return;
    if (hipMemsetAsync((char*)d_ws + WS_CTL, 0, CTL_ZERO_BYTES, stream) != hipSuccess) { fprintf(stderr, "kernel_launch: hipMemsetAsync failed\n"); return; }
    Args a{};
    for (int i = 0; i < 24; ++i) a.in[i] = (const float*)d_in[i];
    a.out = (float*)d_out; a.ws = (unsigned char*)d_ws;
#if MK_N_LAUNCHES == 1
    a.ph_lo = 0; a.ph_hi = N_PHASES;
    void* kargs[] = {&a};
    hipError_t e = hipLaunchCooperativeKernel((const void*)mk_fwd, dim3(grid), dim3(NWAVES * 64), kargs, LDS_BYTES, stream);
    if (e != hipSuccess) fprintf(stderr, "kernel_launch: cooperative launch failed: %s (grid %d)\n", hipGetErrorString(e), grid);
#else
    for (int p = 0; p < N_PHASES; ++p) { a.ph_lo = p; a.ph_hi = p + 1; hipLaunchKernelGGL(mk_fwd, dim3(grid), dim3(NWAVES * 64), LDS_BYTES, stream, a); }
#endif
}
```
